# Optimizing an MI355X kernel written in HIP

```python
import math
import jax
import jax.numpy as jnp
from jax import lax
import numpy as np

D_MODEL = 1024
BATCH = 32
SEQ = 2048
DEPTH = 4

CHUNK = 64
N_BRANCH = 4
BRANCH_WIDTH = D_MODEL // N_BRANCH
RET_HEADS = 4
RET_DV = BRANCH_WIDTH // RET_HEADS
RET_DK = RET_DV // 2
ATT_HEADS = 4
ATT_DH = BRANCH_WIDTH // ATT_HEADS
ATT_LEFT_CHUNKS = 8
ATT_MAX_REL = 128
GLA_HEADS = 4
GLA_DV = BRANCH_WIDTH // GLA_HEADS
GLA_DK = GLA_DV // 2
GLA_GATE_RANK = 16
GLA_GATE_TAU = 16.0
S5_GROUP = 16
S5_GROUPS = BRANCH_WIDTH // S5_GROUP
S5_STATE = 64
D_FF = ((8 * D_MODEL // 3 + 255) // 256) * 256
DEEPNORM_ALPHA = (2.0 * DEPTH) ** 0.25
DEEPNORM_BETA = (8.0 * DEPTH) ** -0.25
LN_EPS = 1e-5
IN_SIZES = (
    RET_HEADS * RET_DK, RET_HEADS * RET_DK, RET_HEADS * RET_DV, RET_HEADS * RET_DV,
    ATT_HEADS * ATT_DH, ATT_HEADS * ATT_DH, ATT_HEADS * ATT_DH,
    GLA_HEADS * GLA_DK, GLA_HEADS * GLA_DK, GLA_HEADS * GLA_DV, GLA_HEADS * GLA_DV,
    GLA_GATE_RANK,
    BRANCH_WIDTH,
)
IN_WIDTH = sum(IN_SIZES)

kernel_name = "hybrid_gated_streaming_encoder"


def _split_cols(h, sizes):
    out, start = [], 0
    for s in sizes:
        out.append(h[..., start:start + s])
        start += s
    return out


def _layer_norm(x, g, b):
    xf = x.astype(jnp.float32)
    mu = jnp.mean(xf, axis=-1, keepdims=True)
    var = jnp.mean(jnp.square(xf - mu), axis=-1, keepdims=True)
    y = (xf - mu) * lax.rsqrt(var + LN_EPS) * g.astype(jnp.float32) + b.astype(jnp.float32)
    return y.astype(x.dtype)


def _head_norm(o):
    mu = jnp.mean(o, axis=-1, keepdims=True)
    var = jnp.mean(jnp.square(o - mu), axis=-1, keepdims=True)
    return (o - mu) * lax.rsqrt(var + LN_EPS)


def _rotary(x, pos):
    half = x.shape[-1] // 2
    inv = 1.0 / (10000.0 ** (jnp.arange(half, dtype=jnp.float32) / half))
    ang = pos.astype(jnp.float32)[:, None] * inv[None, :]
    cos = jnp.cos(ang)[None, :, None, :]
    sin = jnp.sin(ang)[None, :, None, :]
    x1, x2 = x[..., :half], x[..., half:]
    return jnp.concatenate([x1 * cos - x2 * sin, x1 * sin + x2 * cos], axis=-1)


def _retention(q, k, v, g):
    bsz, seq = q.shape[:2]
    nc = seq // CHUNK
    pos = jnp.arange(seq)
    qf = _rotary(q.astype(jnp.float32).reshape(bsz, seq, RET_HEADS, RET_DK), pos)
    kf = _rotary(k.astype(jnp.float32).reshape(bsz, seq, RET_HEADS, RET_DK), pos) * RET_DK ** -0.5
    vf = v.astype(jnp.float32)
    log_g = jnp.log(1.0 - 2.0 ** (-5.0 - jnp.arange(RET_HEADS, dtype=jnp.float32)))
    j = jnp.arange(CHUNK, dtype=jnp.float32)
    d_intra = jnp.exp(log_g[:, None, None] * jnp.abs(j[:, None] - j[None, :]))
    xi = jnp.exp(log_g[None, :] * (j[:, None] + 1.0))
    zeta = jnp.exp(log_g[None, :] * (CHUNK - 1.0 - j[:, None]))
    decay_chunk = jnp.exp(log_g * CHUNK)
    qc = qf.reshape(bsz, nc, CHUNK, RET_HEADS, RET_DK)
    kc = kf.reshape(bsz, nc, CHUNK, RET_HEADS, RET_DK)
    vc = vf.reshape(bsz, nc, CHUNK, RET_HEADS, RET_DV)
    s = jnp.einsum('bnqhd,bnkhd->bnhqk', qc, kc) * d_intra
    o_intra = jnp.einsum('bnhqk,bnkhe->bnqhe', s, vc)
    upd = jnp.einsum('bnkhd,bnkhe->bnhde', kc * zeta[None, None, :, :, None], vc)

    def step(state, u):
        return decay_chunk[None, :, None, None] * state + u, state

    init = jnp.zeros((bsz, RET_HEADS, RET_DK, RET_DV), jnp.float32)
    _, r_prev = lax.scan(step, init, jnp.moveaxis(upd, 1, 0))
    r_prev = jnp.moveaxis(r_prev, 0, 1)
    o_cross = jnp.einsum('bnqhd,bnhde->bnqhe', qc * xi[None, None, :, :, None], r_prev)
    o = _head_norm(o_intra + o_cross).reshape(bsz, seq, RET_HEADS * RET_DV)
    return (jax.nn.silu(g.astype(jnp.float32)) * o).astype(q.dtype)


def _chunk_attention(q, k, v, rel_bias):
    bsz, seq = q.shape[:2]
    nc = seq // CHUNK
    left = ATT_LEFT_CHUNKS * CHUNK
    band = left + CHUNK
    qf = q.astype(jnp.float32).reshape(bsz, seq, ATT_HEADS, ATT_DH) * ATT_DH ** -0.5
    kp = jnp.pad(k.astype(jnp.float32).reshape(bsz, seq, ATT_HEADS, ATT_DH), ((0, 0), (left, 0), (0, 0), (0, 0)))
    vp = jnp.pad(v.astype(jnp.float32).reshape(bsz, seq, ATT_HEADS, ATT_DH), ((0, 0), (left, 0), (0, 0), (0, 0)))
    jq = jnp.arange(CHUNK)[:, None]
    pk = jnp.arange(band)[None, :]
    rel = jnp.clip(left + jq - pk, -ATT_MAX_REL, ATT_MAX_REL) + ATT_MAX_REL
    bias = rel_bias.astype(jnp.float32)[:, rel]

    def one_chunk(i):
        start = i * CHUNK
        qi = lax.dynamic_slice_in_dim(qf, start, CHUNK, axis=1)
        ki = lax.dynamic_slice_in_dim(kp, start, band, axis=1)
        vi = lax.dynamic_slice_in_dim(vp, start, band, axis=1)
        s = jnp.einsum('bqhd,bkhd->bhqk', qi, ki) + bias[None]
        valid = (start - left + jnp.arange(band)) >= 0
        s = jnp.where(valid[None, None, None, :], s, -1e30)
        p = jax.nn.softmax(s, axis=-1)
        return jnp.einsum('bhqk,bkhd->bqhd', p, vi)

    o = lax.map(one_chunk, jnp.arange(nc))
    return jnp.moveaxis(o, 0, 1).reshape(bsz, seq, ATT_HEADS * ATT_DH).astype(q.dtype)


def _gla(q, k, v, r, a_lr, w_a_up, b_a):
    bsz, seq = q.shape[:2]
    nc = seq // CHUNK
    shp_k = (bsz, nc, CHUNK, GLA_HEADS, GLA_DK)
    qc = q.astype(jnp.float32).reshape(shp_k) * GLA_DK ** -0.5
    kc = k.astype(jnp.float32).reshape(shp_k)
    vc = v.astype(jnp.float32).reshape(bsz, nc, CHUNK, GLA_HEADS, GLA_DV)
    z = a_lr.astype(jnp.float32) @ w_a_up.astype(jnp.float32) + b_a.astype(jnp.float32)
    log_a = (jax.nn.log_sigmoid(z) / GLA_GATE_TAU).reshape(shp_k)
    cum = jnp.cumsum(log_a, axis=2)
    last = cum[:, :, -1:]
    k_dec = kc * jnp.exp(last - cum)
    upd = jnp.einsum('bnchk,bnchv->bnhkv', k_dec, vc)
    g_chunk = jnp.exp(last[:, :, 0])

    def combine(a, b):
        ga, ua = a
        gb, ub = b
        return ga * gb, gb[..., None] * ua + ub

    _, states = lax.associative_scan(combine, (g_chunk, upd), axis=1)
    o = jnp.einsum('bnchk,bnhkv->bnchv', qc, states)
    o = _head_norm(o).reshape(bsz, seq, GLA_HEADS * GLA_DV)
    return (jax.nn.silu(r.astype(jnp.float32)) * o).astype(q.dtype)


def _s5(u, lam_re, lam_im, log_dt, b_re, b_im, c_re, c_im, d_skip, w_glu, b_glu):
    bsz, seq = u.shape[:2]
    f32 = jnp.float32
    uf = u.astype(f32).reshape(bsz, seq, S5_GROUPS, S5_GROUP)
    lr, li = lam_re.astype(f32), lam_im.astype(f32)
    dt = jnp.exp(log_dt.astype(f32))[:, None]
    mag = jnp.exp(lr * dt)
    ab_re, ab_im = mag * jnp.cos(li * dt), mag * jnp.sin(li * dt)
    den = lr * lr + li * li
    nr, ni = ab_re - 1.0, ab_im
    coef_re = (nr * lr + ni * li) / den
    coef_im = (ni * lr - nr * li) / den
    br, bi = b_re.astype(f32), b_im.astype(f32)
    bb_re = coef_re[..., None] * br - coef_im[..., None] * bi
    bb_im = coef_re[..., None] * bi + coef_im[..., None] * br
    bu_re = jnp.einsum('bsgi,gpi->bsgp', uf, bb_re)
    bu_im = jnp.einsum('bsgi,gpi->bsgp', uf, bb_im)
    a_re = jnp.broadcast_to(ab_re, bu_re.shape)
    a_im = jnp.broadcast_to(ab_im, bu_im.shape)

    def combine(e1, e2):
        a1r, a1i, b1r, b1i = e1
        a2r, a2i, b2r, b2i = e2
        return (a2r * a1r - a2i * a1i, a2r * a1i + a2i * a1r,
                a2r * b1r - a2i * b1i + b2r, a2r * b1i + a2i * b1r + b2i)

    _, _, xr, xim = lax.associative_scan(combine, (a_re, a_im, bu_re, bu_im), axis=1)
    y = jnp.einsum('gip,bsgp->bsgi', c_re.astype(f32), xr) - jnp.einsum('gip,bsgp->bsgi', c_im.astype(f32), xim)
    y = y.reshape(bsz, seq, BRANCH_WIDTH) + d_skip.astype(f32) * uf.reshape(bsz, seq, BRANCH_WIDTH)
    y = jax.nn.gelu(y)
    y = y * jax.nn.sigmoid(y @ w_glu.astype(f32) + b_glu.astype(f32))
    return y.astype(u.dtype)


def setup_inputs(seed: int = 0) -> dict:
    key = jax.random.key(seed)
    ks = jax.random.split(key, 28)
    f32 = jnp.float32

    def nrm(k, shape, scale):
        return jax.random.normal(k, shape, f32) * scale

    n_idx = jnp.arange(S5_STATE, dtype=f32)
    gp = (DEPTH, S5_GROUPS, S5_STATE)
    return {
        'x': nrm(ks[0], (BATCH, SEQ, D_MODEL), 1.0),
        'w_in': nrm(ks[1], (DEPTH, D_MODEL, IN_WIDTH), D_MODEL ** -0.5),
        'gla_w_a': nrm(ks[2], (DEPTH, GLA_GATE_RANK, GLA_HEADS * GLA_DK), GLA_GATE_RANK ** -0.5),
        'gla_b_a': nrm(ks[3], (DEPTH, GLA_HEADS * GLA_DK), 0.1),
        'att_rel_bias': nrm(ks[4], (DEPTH, ATT_HEADS, 2 * ATT_MAX_REL + 1), 0.1),
        's5_lambda_re': -0.5 + nrm(ks[5], gp, 0.01),
        's5_lambda_im': math.pi * n_idx + nrm(ks[6], gp, 0.01),
        's5_log_dt': jax.random.uniform(ks[7], (DEPTH, S5_GROUPS), f32, math.log(1e-3), math.log(1e-1)),
        's5_b_re': nrm(ks[8], (DEPTH, S5_GROUPS, S5_STATE, S5_GROUP), (2.0 * S5_GROUP) ** -0.5),
        's5_b_im': nrm(ks[9], (DEPTH, S5_GROUPS, S5_STATE, S5_GROUP), (2.0 * S5_GROUP) ** -0.5),
        's5_c_re': nrm(ks[10], (DEPTH, S5_GROUPS, S5_GROUP, S5_STATE), S5_STATE ** -0.5),
        's5_c_im': nrm(ks[11], (DEPTH, S5_GROUPS, S5_GROUP, S5_STATE), S5_STATE ** -0.5),
        's5_d': nrm(ks[12], (DEPTH, BRANCH_WIDTH), 1.0),
        's5_w_glu': nrm(ks[13], (DEPTH, BRANCH_WIDTH, BRANCH_WIDTH), BRANCH_WIDTH ** -0.5),
        's5_b_glu': nrm(ks[14], (DEPTH, BRANCH_WIDTH), 0.02),
        'w_gate': nrm(ks[15], (DEPTH, N_BRANCH, D_MODEL, D_MODEL), D_MODEL ** -0.5),
        'b_gate': nrm(ks[16], (DEPTH, N_BRANCH, D_MODEL), 0.02),
        'w_branch': nrm(ks[17], (DEPTH, N_BRANCH, BRANCH_WIDTH, D_MODEL), BRANCH_WIDTH ** -0.5),
        'w_out': nrm(ks[18], (DEPTH, D_MODEL, D_MODEL), D_MODEL ** -0.5 * DEEPNORM_BETA),
        'ln1_g': 1.0 + nrm(ks[19], (DEPTH, D_MODEL), 0.02),
        'ln1_b': nrm(ks[20], (DEPTH, D_MODEL), 0.02),
        'w_ffn_gate': nrm(ks[21], (DEPTH, D_MODEL, D_FF), D_MODEL ** -0.5),
        'w_ffn_up': nrm(ks[22], (DEPTH, D_MODEL, D_FF), D_MODEL ** -0.5),
        'w_ffn_down': nrm(ks[23], (DEPTH, D_FF, D_MODEL), D_FF ** -0.5 * DEEPNORM_BETA),
        'ln2_g': 1.0 + nrm(ks[24], (DEPTH, D_MODEL), 0.02),
        'ln2_b': nrm(ks[25], (DEPTH, D_MODEL), 0.02),
    }


def reference(x, w_in, gla_w_a, gla_b_a, att_rel_bias, s5_lambda_re, s5_lambda_im, s5_log_dt,
              s5_b_re, s5_b_im, s5_c_re, s5_c_im, s5_d, s5_w_glu, s5_b_glu, w_gate, b_gate,
              w_branch, w_out, ln1_g, ln1_b, w_ffn_gate, w_ffn_up, w_ffn_down, ln2_g, ln2_b):
    bsz, seq = x.shape[:2]
    for l in range(DEPTH):
        h = x @ w_in[l]
        (rq, rk, rv, rg, aq, ak, av, gq, gk, gv, gr, ga, su) = _split_cols(h, IN_SIZES)
        o_ret = _retention(rq, rk, rv, rg)
        o_att = _chunk_attention(aq, ak, av, att_rel_bias[l])
        o_gla = _gla(gq, gk, gv, gr, ga, gla_w_a[l], gla_b_a[l])
        o_s5 = _s5(su, s5_lambda_re[l], s5_lambda_im[l], s5_log_dt[l], s5_b_re[l], s5_b_im[l],
                   s5_c_re[l], s5_c_im[l], s5_d[l], s5_w_glu[l], s5_b_glu[l])
        branches = (o_ret, o_att, o_gla, o_s5)
        mixed = jax.nn.sigmoid(x @ w_gate[l, 0] + b_gate[l, 0]) * (branches[0] @ w_branch[l, 0])
        for bi in range(1, N_BRANCH):
            gate = jax.nn.sigmoid(x @ w_gate[l, bi] + b_gate[l, bi])
            mixed = mixed + gate * (branches[bi] @ w_branch[l, bi])
        x = _layer_norm(DEEPNORM_ALPHA * x + mixed @ w_out[l], ln1_g[l], ln1_b[l])
        ffn = (jax.nn.silu(x @ w_ffn_gate[l]) * (x @ w_ffn_up[l])) @ w_ffn_down[l]
        x = _layer_norm(DEEPNORM_ALPHA * x + ffn, ln2_g[l], ln2_b[l])
    return x
```

```cpp
#include <hip/hip_runtime.h>
#include <hip/hip_cooperative_groups.h>
#include <cstdint>
#include <cstdio>
namespace cg = cooperative_groups;

#define LAS __attribute__((address_space(3)))
typedef unsigned short bf16_t;
typedef short bf16x8 __attribute__((ext_vector_type(8)));
typedef float f32x4 __attribute__((ext_vector_type(4)));
typedef float f32x2 __attribute__((ext_vector_type(2)));
typedef unsigned u32x4 __attribute__((ext_vector_type(4)));
typedef unsigned u32x2 __attribute__((ext_vector_type(2)));

constexpr int M = 65536, DM = 1024, SEQ = 2048, NCH = 32;
constexpr int NH = 2320;
constexpr int NINP = 2816;
constexpr int DFF = 2816;
constexpr int S5K = 1152;
constexpr float ALPHA = 1.681792830507429f;
constexpr float LN_EPS = 1e-5f;
constexpr int C_RQ = 0, C_RK = 128, C_RV = 256, C_RG = 512, C_AQ = 768, C_AK = 1024, C_AV = 1280, C_GQ = 1536, C_GK = 1664, C_GV = 1792, C_GR = 2048, C_GA = 2304, C_SU = 2320;

constexpr size_t MiB = 1u << 20;
constexpr size_t WS_ROT = 1 * MiB;
constexpr size_t WS_KN = 2 * MiB;
constexpr size_t WS_WIN = 4 * MiB;
constexpr size_t WS_WG = 10 * MiB;
constexpr size_t WS_WB = 18 * MiB;
constexpr size_t WS_WO = 20 * MiB;
constexpr size_t WS_WFF = 22 * MiB;
constexpr size_t WS_WD = 33 * MiB;
constexpr size_t WS_WGLU = 39 * MiB;
constexpr size_t WS_WE = 40 * MiB;
constexpr size_t WS_WT = 48 * MiB;
constexpr size_t WS_XB = 88 * MiB;
constexpr size_t WS_O = 216 * MiB;
constexpr size_t WS_E = 344 * MiB;
constexpr size_t WS_U2 = 636 * MiB;
constexpr size_t WS_RU = 676 * MiB;
constexpr size_t WS_GU = 708 * MiB;
constexpr size_t WS_GL = 740 * MiB;
constexpr size_t WS_ES = 741 * MiB;
constexpr size_t WS_YS = 749 * MiB;
constexpr int LDS_BYTES = 147456;

struct Params { const float* in[26]; float* out; unsigned char* ws; };
typedef const __attribute__((address_space(4))) Params* CPP;

__device__ __forceinline__ float bflo(unsigned w) { return __uint_as_float(w << 16); }
__device__ __forceinline__ float bfhi(unsigned w) { return __uint_as_float(w & 0xffff0000u); }
__device__ __forceinline__ float bf2f(bf16_t b) { return __uint_as_float((unsigned)b << 16); }
__device__ __forceinline__ unsigned f2bf(float f) { unsigned u = __float_as_uint(f); return (u + 0x7fffu + ((u >> 16) & 1u)) >> 16; }
__device__ __forceinline__ unsigned pk2(float lo, float hi) { return f2bf(lo) | (f2bf(hi) << 16); }
__device__ __forceinline__ unsigned cvt_pk_bf16(float lo, float hi) { unsigned r; asm volatile("v_cvt_pk_bf16_f32 %0, %1, %2" : "=v"(r) : "v"(lo), "v"(hi)); return r; }
__device__ __forceinline__ float sigm(float x) { return __builtin_amdgcn_rcpf(1.0f + __expf(-x)); }
__device__ __forceinline__ float silu_f(float x) { return x * sigm(x); }
__device__ __forceinline__ float gelu_tanh(float v) { return v * sigm(1.5957691216057308f * (v + 0.044715f * v * v * v)); }
__device__ __forceinline__ void unpack8(u32x4 w, float* o) {
    o[0] = bflo(w.x); o[1] = bfhi(w.x); o[2] = bflo(w.y); o[3] = bfhi(w.y); o[4] = bflo(w.z); o[5] = bfhi(w.z); o[6] = bflo(w.w); o[7] = bfhi(w.w);
}
__device__ __forceinline__ u32x4 pack8(const float* v) { u32x4 w; w.x = pk2(v[0], v[1]); w.y = pk2(v[2], v[3]); w.z = pk2(v[4], v[5]); w.w = pk2(v[6], v[7]); return w; }
__device__ __forceinline__ int otid() { int t = threadIdx.x; asm volatile("" : "+v"(t)); return t; }
__device__ __forceinline__ int obid() { int b = blockIdx.x; asm volatile("" : "+s"(b)); return b; }
__device__ __forceinline__ int ogrid() { int b = gridDim.x; asm volatile("" : "+s"(b)); return b; }
__device__ __forceinline__ float wave_sum(float v) {
#pragma unroll
    for (int o = 1; o < 64; o <<= 1) v += __shfl_xor(v, o);
    return v;
}

namespace pg8 {
constexpr int BM = 256, BK = 64, HALF = 128, HTB = HALF * BK * 2, STAGE_BYTES = 8 * HTB, NXCD = 8, WGM = 8;
__device__ __forceinline__ int lds_byte(int r, int c) { const int st = (r >> 4) * 2 + (c >> 5), rr = r & 15, cc = c & 31, ob = rr * 64 + cc * 2; return st * 1024 + (ob ^ (((ob >> 9) & 1) << 5)); }
__device__ __forceinline__ void stage_rc(int b, int& R, int& C) { const int st = b / 1024, sb = b % 1024, swz = sb ^ (((sb >> 9) & 1) << 5); R = (st >> 1) * 16 + swz / 64; C = (st & 1) * 32 + (swz % 64) / 2; }
__device__ __forceinline__ int perm32(int rho) { const int n = rho >> 4, i = rho & 15; return 8 * (i >> 2) + 4 * n + (i & 3); }

struct Unit { int pm, pn, ak; };
struct Gemm { const bf16_t* A; const bf16_t* Bt; int lda, ldb, K; };

struct Sched {
    int nM, nN, nwg, G, c, mode;
    __device__ __forceinline__ bool next(int i, Unit& u) const {
        const long L = (long)i * G + c; if (L >= nwg) return false;
        if (mode == 2) { u.pm = (int)L; u.pn = (int)(L >> 2); u.ak = 0; return true; }
        if (mode == 3) { const int g = (int)(L >> 4); u.pm = 4 * g + (int)((L >> 2) & 3); u.pn = 4 * g + (int)(L & 3); u.ak = 0; return true; }
        int wgid = (int)L; { const int q = nwg / NXCD, r = nwg % NXCD, xcd = wgid % NXCD, off = wgid / NXCD; wgid = (xcd < r ? xcd * (q + 1) : r * (q + 1) + (xcd - r) * q) + off; }
        const int nig = WGM * nN, gid = wgid / nig, fm = gid * WGM, gsz = (nM - fm) < WGM ? (nM - fm) : WGM;
        u.pm = fm + ((wgid % nig) % gsz); u.pn = (wgid % nig) / gsz; u.ak = (mode == 1) ? (u.pn >> 2) * 256 : 0; return true;
    }
};

struct Epi {
    int mode; bool perm;
    unsigned char* ws; const float* dskip; const float* bglu; const float* bgate; const float* xres; float* xout;
    __device__ __forceinline__ void operator()(const f32x4 (&acc)[2][2][4][2], const Unit& u, int wr, int wc, int fr, int fq) const {
        const int row0 = u.pm * BM + wr * 64 + fr;
        bf16_t* const H = (bf16_t*)(ws + WS_E); bf16_t* const U2 = (bf16_t*)(ws + WS_U2); float* const ES = (float*)(ws + WS_ES); bf16_t* const YS = (bf16_t*)(ws + WS_YS);
        bf16_t* const Ob = (bf16_t*)(ws + WS_O); bf16_t* const P = (bf16_t*)(ws + WS_E); bf16_t* const MIX = (bf16_t*)(ws + WS_O); bf16_t* const HF = (bf16_t*)(ws + WS_E);
        if (mode == 0) {
#pragma unroll
            for (int ai = 0; ai < 2; ++ai)
#pragma unroll
                for (int m = 0; m < 4; ++m) { const int r = row0 + ai * HALF + m * 16;
#pragma unroll
                    for (int bj = 0; bj < 2; ++bj) { const int c0 = u.pn * BM + bj * HALF + wc * 32 + 8 * fq;
                        const f32x4 v0 = acc[ai][bj][m][0], v1 = acc[ai][bj][m][1];
                        u32x4 w; w.x = cvt_pk_bf16(v0[0], v0[1]); w.y = cvt_pk_bf16(v0[2], v0[3]); w.z = cvt_pk_bf16(v1[0], v1[1]); w.w = cvt_pk_bf16(v1[2], v1[3]);
                        if (c0 < C_SU) *(u32x4*)(H + (size_t)r * NH + c0) = w;
                        else if (c0 < C_SU + 256) { const int c = c0 - C_SU, g = c >> 4, ci = c & 15;
                            *(u32x4*)(U2 + ((size_t)(g * 1024 + (r >> 6))) * S5K + (r & 63) * 16 + ci) = w; } } }
        } else if (mode == 1) {
#pragma unroll
            for (int ai = 0; ai < 2; ++ai)
#pragma unroll
                for (int m = 0; m < 4; ++m) { const int r = row0 + ai * HALF + m * 16; const int c0 = wc * 32 + 8 * fq;
                    *(f32x4*)(ES + (size_t)r * 128 + c0) = acc[ai][0][m][0]; *(f32x4*)(ES + (size_t)r * 128 + c0 + 4) = acc[ai][0][m][1]; }
        } else if (mode == 2) {
            const int g = u.pm >> 2;
#pragma unroll
            for (int ai = 0; ai < 2; ++ai)
#pragma unroll
                for (int m = 0; m < 4; ++m) { const int r = row0 + ai * HALF + m * 16;
#pragma unroll
                    for (int bj = 0; bj < 2; ++bj) { const int n0 = (u.pn & 3) * BM + bj * HALF + wc * 32 + 8 * fq; const int j = n0 >> 4, i0 = n0 & 15;
                        const u32x4 uw = *(const u32x4*)(U2 + (size_t)r * S5K + n0); float uf[8]; unpack8(uw, uf);
                        const f32x4 d0 = *(const f32x4*)(dskip + 16 * g + i0), d1 = *(const f32x4*)(dskip + 16 * g + i0 + 4);
                        const f32x4 v0 = acc[ai][bj][m][0], v1 = acc[ai][bj][m][1]; float y[8];
                        y[0] = gelu_tanh(v0[0] + d0[0] * uf[0]); y[1] = gelu_tanh(v0[1] + d0[1] * uf[1]); y[2] = gelu_tanh(v0[2] + d0[2] * uf[2]); y[3] = gelu_tanh(v0[3] + d0[3] * uf[3]);
                        y[4] = gelu_tanh(v1[0] + d1[0] * uf[4]); y[5] = gelu_tanh(v1[1] + d1[1] * uf[5]); y[6] = gelu_tanh(v1[2] + d1[2] * uf[6]); y[7] = gelu_tanh(v1[3] + d1[3] * uf[7]);
                        u32x4 w; w.x = cvt_pk_bf16(y[0], y[1]); w.y = cvt_pk_bf16(y[2], y[3]); w.z = cvt_pk_bf16(y[4], y[5]); w.w = cvt_pk_bf16(y[6], y[7]);
                        const size_t t = (size_t)(r & 1023) * 64 + j;
                        *(u32x4*)(YS + t * 256 + 16 * g + i0) = w; } }
        } else if (mode == 3) {
#pragma unroll
            for (int ai = 0; ai < 2; ++ai)
#pragma unroll
                for (int m = 0; m < 4; ++m) { const int r = row0 + ai * HALF + m * 16;
#pragma unroll
                    for (int bj = 0; bj < 2; ++bj) { const int c0 = bj * HALF + wc * 32 + 8 * fq;
                        const u32x4 yw = *(const u32x4*)(YS + (size_t)r * 256 + c0); float yf[8]; unpack8(yw, yf);
                        const f32x4 b0 = *(const f32x4*)(bglu + c0), b1 = *(const f32x4*)(bglu + c0 + 4);
                        const f32x4 v0 = acc[ai][bj][m][0] + b0, v1 = acc[ai][bj][m][1] + b1; float o[8];
                        o[0] = yf[0] * sigm(v0[0]); o[1] = yf[1] * sigm(v0[1]); o[2] = yf[2] * sigm(v0[2]); o[3] = yf[3] * sigm(v0[3]);
                        o[4] = yf[4] * sigm(v1[0]); o[5] = yf[5] * sigm(v1[1]); o[6] = yf[6] * sigm(v1[2]); o[7] = yf[7] * sigm(v1[3]);
                        u32x4 w; w.x = cvt_pk_bf16(o[0], o[1]); w.y = cvt_pk_bf16(o[2], o[3]); w.z = cvt_pk_bf16(o[4], o[5]); w.w = cvt_pk_bf16(o[6], o[7]);
                        *(u32x4*)(Ob + (size_t)r * DM + 768 + c0) = w; } }
        } else if (mode == 4) {
#pragma unroll
            for (int ai = 0; ai < 2; ++ai)
#pragma unroll
                for (int m = 0; m < 4; ++m) { const int r = row0 + ai * HALF + m * 16;
#pragma unroll
                    for (int bj = 0; bj < 2; ++bj) { const int c0 = u.pn * BM + bj * HALF + wc * 32 + 8 * fq;
                        const f32x4 v0 = acc[ai][bj][m][0], v1 = acc[ai][bj][m][1];
                        u32x4 w; w.x = cvt_pk_bf16(v0[0], v0[1]); w.y = cvt_pk_bf16(v0[2], v0[3]); w.z = cvt_pk_bf16(v1[0], v1[1]); w.w = cvt_pk_bf16(v1[2], v1[3]);
                        *(u32x4*)(P + (size_t)r * 4096 + c0) = w; } }
        } else if (mode == 5) {
            const int ch0 = 64 * u.pn + 16 * wc + 4 * fq;
            f32x4 bv[4];
#pragma unroll
            for (int b = 0; b < 4; ++b) bv[b] = *(const f32x4*)(bgate + b * 1024 + ch0);
#pragma unroll
            for (int ai = 0; ai < 2; ++ai)
#pragma unroll
                for (int m = 0; m < 4; ++m) { const int r = row0 + ai * HALF + m * 16; f32x4 mix = (f32x4){0.f, 0.f, 0.f, 0.f};
#pragma unroll
                    for (int bj = 0; bj < 2; ++bj)
#pragma unroll
                        for (int n = 0; n < 2; ++n) { const int b = 2 * bj + n; const f32x4 a = acc[ai][bj][m][n] + bv[b];
                            const u32x2 pw = *(const u32x2*)(P + (size_t)r * 4096 + b * 1024 + ch0);
                            mix[0] += sigm(a[0]) * bflo(pw.x); mix[1] += sigm(a[1]) * bfhi(pw.x); mix[2] += sigm(a[2]) * bflo(pw.y); mix[3] += sigm(a[3]) * bfhi(pw.y); }
                    u32x2 w; w.x = cvt_pk_bf16(mix[0], mix[1]); w.y = cvt_pk_bf16(mix[2], mix[3]);
                    *(u32x2*)(MIX + (size_t)r * DM + ch0) = w; }
        } else if (mode == 6) {
#pragma unroll
            for (int ai = 0; ai < 2; ++ai)
#pragma unroll
                for (int m = 0; m < 4; ++m) { const int r = row0 + ai * HALF + m * 16;
#pragma unroll
                    for (int bj = 0; bj < 2; ++bj)
#pragma unroll
                        for (int n = 0; n < 2; ++n) { const int c = u.pn * BM + bj * HALF + wc * 32 + n * 16 + 4 * fq;
                            const f32x4 xr = *(const f32x4*)(xres + (size_t)r * DM + c);
                            *(f32x4*)(xout + (size_t)r * DM + c) = xr * ALPHA + acc[ai][bj][m][n]; } }
        } else {
#pragma unroll
            for (int ai = 0; ai < 2; ++ai)
#pragma unroll
                for (int m = 0; m < 4; ++m) { const int r = row0 + ai * HALF + m * 16;
#pragma unroll
                    for (int bj = 0; bj < 2; ++bj) { const int ch0 = 128 * u.pn + 64 * bj + 16 * wc + 4 * fq;
                        const f32x4 gt = acc[ai][bj][m][0], up = acc[ai][bj][m][1];
                        u32x2 w; w.x = cvt_pk_bf16(silu_f(gt[0]) * up[0], silu_f(gt[1]) * up[1]); w.y = cvt_pk_bf16(silu_f(gt[2]) * up[2], silu_f(gt[3]) * up[3]);
                        *(u32x2*)(HF + (size_t)r * DFF + ch0) = w; } }
        }
    }
};

__device__ __forceinline__ void gemm_phase(LAS unsigned char* lds, const Gemm g, const Sched& S, const Epi& E) {
    const int tid = otid(), wid = __builtin_amdgcn_readfirstlane(tid >> 6), lane = tid & 63, wr = wid >> 2, wc = wid & 3, fr = lane & 15, fq = lane >> 4;
    const int K = g.K, nt = K / BK;
    unsigned voffA[2], voffB[2];
#pragma unroll
    for (int i = 0; i < 2; ++i) { int R, C; stage_rc(tid * 16 + i * 8192, R, C); const int Rb = E.perm ? ((R & ~31) + perm32(R & 31)) : R;
        voffA[i] = (unsigned)(R * g.lda + C) * 2u; voffB[i] = (unsigned)(Rb * g.ldb + C) * 2u; }
    const size_t kstep = (size_t)(BK * 2);
    const size_t hstepA = (size_t)HALF * g.lda * 2, hstepB = (size_t)HALF * g.ldb * 2;
    const size_t tstepA = 2 * hstepA, tstepB = 2 * hstepB;
    const unsigned ldsw = (unsigned)wid * 1024u;
    const int aoff = lds_byte(wr * 64 + fr, fq * 8), boff = lds_byte(wc * 32 + fr, fq * 8);
#define PG8_SA(b, h) (((b) * 2 + (h)) * HTB)
#define PG8_SB(b, h) ((4 + (b) * 2 + (h)) * HTB)
#define PG8_STAGE(bufoff, gbase, voff) do { _Pragma("unroll") for (int _i = 0; _i < 2; ++_i) \
        __builtin_amdgcn_global_load_lds((const unsigned*)((const char*)(gbase) + (voff)[_i]), (LAS unsigned*)(lds + (bufoff) + ldsw + _i * 8192), 16, 0, 0); } while (0)
#define PG8_LDA(dst, b, h) do { _Pragma("unroll") for (int m = 0; m < 4; ++m) _Pragma("unroll") for (int k = 0; k < 2; ++k) dst[m][k] = *(const LAS bf16x8*)(lds + PG8_SA(b, h) + aoff + m * 2048 + k * 1024); } while (0)
#define PG8_LDB(dst, b, h) do { _Pragma("unroll") for (int n = 0; n < 2; ++n) _Pragma("unroll") for (int k = 0; k < 2; ++k) dst[n][k] = *(const LAS bf16x8*)(lds + PG8_SB(b, h) + boff + n * 2048 + k * 1024); } while (0)
#define PG8_MMA(ai, bj, At, Bt) do { __builtin_amdgcn_s_setprio(1); _Pragma("unroll") for (int m = 0; m < 4; ++m) _Pragma("unroll") for (int n = 0; n < 2; ++n) _Pragma("unroll") for (int k = 0; k < 2; ++k) \
        acc[ai][bj][m][n] = __builtin_amdgcn_mfma_f32_16x16x32_bf16(Bt[n][k], At[m][k], acc[ai][bj][m][n], 0, 0, 0); __builtin_amdgcn_s_setprio(0); } while (0)
#define PG8_WAIT_V(n) asm volatile("s_waitcnt vmcnt(" #n ")" ::: "memory")
#define PG8_WAIT_L(n) asm volatile("s_waitcnt lgkmcnt(" #n ")" ::: "memory")
#define PG8_BAR __builtin_amdgcn_s_barrier()
#define PG8_SCHED __builtin_amdgcn_sched_barrier(0)
    Unit cur, nxt; int ui = 0;
    if (!S.next(0, cur)) return;
    f32x4 acc[2][2][4][2];
#pragma unroll
    for (int a = 0; a < 2; ++a)
#pragma unroll
        for (int b = 0; b < 2; ++b)
#pragma unroll
            for (int m = 0; m < 4; ++m)
#pragma unroll
                for (int n = 0; n < 2; ++n) acc[a][b][m][n] = (f32x4){0.f, 0.f, 0.f, 0.f};
    bf16x8 At[4][2], B0[2][2], B1[2][2];
    const char* cA = (const char*)g.A + (size_t)cur.pm * tstepA + (size_t)cur.ak * 2; const char* cB = (const char*)g.Bt + (size_t)cur.pn * tstepB;
    PG8_STAGE(PG8_SB(0, 0), cB, voffB); PG8_STAGE(PG8_SB(0, 1), cB + hstepB, voffB); PG8_STAGE(PG8_SA(0, 0), cA, voffA); PG8_STAGE(PG8_SA(0, 1), cA + hstepA, voffA);
    if (wr == 1) PG8_BAR;
    PG8_WAIT_V(2); PG8_BAR;
    PG8_STAGE(PG8_SB(1, 0), cB + kstep, voffB); PG8_STAGE(PG8_SA(1, 0), cA + kstep, voffA); PG8_STAGE(PG8_SB(1, 1), cB + hstepB + kstep, voffB);
    PG8_WAIT_V(6); PG8_BAR;
    for (;;) {
        const bool has_next = S.next(ui + 1, nxt);
        const char* nA = has_next ? (const char*)g.A + (size_t)nxt.pm * tstepA + (size_t)nxt.ak * 2 : cA; const char* nB = has_next ? (const char*)g.Bt + (size_t)nxt.pn * tstepB : cB;
        for (int t = 0; t < nt; t += 2) {
            const bool last = (t == nt - 2);
            const char* a1 = cA + (size_t)(t + 1) * kstep;
            const char* a2 = last ? nA : cA + (size_t)(t + 2) * kstep; const char* b2 = last ? nB : cB + (size_t)(t + 2) * kstep;
            const char* a3 = a2 + kstep; const char* b3 = b2 + kstep;
            PG8_LDB(B0, 0, 0); PG8_LDB(B1, 0, 1); PG8_SCHED; PG8_LDA(At, 0, 0); PG8_STAGE(PG8_SA(1, 1), a1 + hstepA, voffA);
            PG8_WAIT_V(8); PG8_WAIT_L(0); PG8_BAR; PG8_MMA(0, 0, At, B0); PG8_MMA(0, 1, At, B1); PG8_BAR; PG8_SCHED;
            PG8_LDA(At, 0, 1); PG8_STAGE(PG8_SB(0, 0), b2, voffB); PG8_STAGE(PG8_SB(0, 1), b2 + hstepB, voffB); PG8_STAGE(PG8_SA(0, 0), a2, voffA);
            PG8_WAIT_V(8); PG8_WAIT_L(0); PG8_BAR; PG8_MMA(1, 0, At, B0); PG8_MMA(1, 1, At, B1); PG8_BAR; PG8_SCHED;
            PG8_LDB(B0, 1, 0); PG8_LDB(B1, 1, 1); PG8_SCHED; PG8_LDA(At, 1, 0); PG8_STAGE(PG8_SA(0, 1), a2 + hstepA, voffA);
            PG8_WAIT_V(8); PG8_WAIT_L(0); PG8_BAR; PG8_MMA(0, 0, At, B0); PG8_MMA(0, 1, At, B1); PG8_BAR; PG8_SCHED;
            PG8_LDA(At, 1, 1); PG8_STAGE(PG8_SB(1, 0), b3, voffB); PG8_STAGE(PG8_SB(1, 1), b3 + hstepB, voffB); PG8_STAGE(PG8_SA(1, 0), a3, voffA);
            PG8_WAIT_V(8); PG8_WAIT_L(0); PG8_BAR; PG8_MMA(1, 0, At, B0); PG8_MMA(1, 1, At, B1); PG8_BAR; PG8_SCHED;
        }
        if (wr == 0) PG8_BAR;
        { const int t2 = otid(), w2 = __builtin_amdgcn_readfirstlane(t2 >> 6), l2 = t2 & 63;
          E(acc, cur, w2 >> 2, w2 & 3, l2 & 15, l2 >> 4); }
        if (!has_next) break;
#pragma unroll
        for (int a = 0; a < 2; ++a)
#pragma unroll
            for (int b = 0; b < 2; ++b)
#pragma unroll
                for (int m = 0; m < 4; ++m)
#pragma unroll
                    for (int n = 0; n < 2; ++n) acc[a][b][m][n] = (f32x4){0.f, 0.f, 0.f, 0.f};
        cur = nxt; cA = nA; cB = nB; ++ui;
        if (wr == 1) PG8_BAR;
    }
    PG8_WAIT_V(0);
    PG8_BAR;
#undef PG8_SA
#undef PG8_SB
#undef PG8_STAGE
#undef PG8_LDA
#undef PG8_LDB
#undef PG8_MMA
#undef PG8_WAIT_V
#undef PG8_WAIT_L
#undef PG8_BAR
#undef PG8_SCHED
}
}

__device__ __forceinline__ int dest_row(int dmode, int arg, int n) {
    if (dmode == 1) { return ((n >> 6) << 8) + ((arg >> 1) << 7) + (((n >> 4) & 3) << 5) + ((arg & 1) << 4) + (n & 15); }
    if (dmode == 2) { return ((n >> 7) << 8) + (((n >> 6) & 1) << 7) + (((n >> 4) & 3) << 5) + (arg << 4) + (n & 15); }
    return n + arg;
}
__device__ __forceinline__ void transpose_item(const float* W, int K, int Nsrc, bf16_t* WT, int dmode, int arg, LAS float* scr, int kb, int nb, int lane) {
    const int k0 = 64 * kb, n0 = 32 * nb;
    const int nsrc = n0 + (lane & 31); const bool ok = nsrc < Nsrc;
#pragma unroll 8
    for (int i = 0; i < 32; ++i) { const int kk = 2 * i + (lane >> 5); scr[kk * 33 + (lane & 31)] = ok ? W[(size_t)(k0 + kk) * Nsrc + nsrc] : 0.f; }
    asm volatile("s_waitcnt lgkmcnt(0)" ::: "memory");
    const int c = lane & 7;
#pragma unroll
    for (int j = 0; j < 4; ++j) { const int n = (lane >> 3) + 8 * j; const LAS float* s = scr + (8 * c) * 33 + n;
        u32x4 o; o.x = pk2(s[0 * 33], s[1 * 33]); o.y = pk2(s[2 * 33], s[3 * 33]); o.z = pk2(s[4 * 33], s[5 * 33]); o.w = pk2(s[6 * 33], s[7 * 33]);
        *(u32x4*)(WT + (size_t)dest_row(dmode, arg, n0 + n) * K + k0 + 8 * c) = o; }
    asm volatile("s_waitcnt lgkmcnt(0)" ::: "memory");
}

__device__ __forceinline__ void s5_abar_pow(float lr, float li, float dt, int n, float& re, float& im) {
    const float mag = expf((float)n * lr * dt);
    const double a = (double)n * ((double)li * (double)dt);
    const double k = __builtin_rint(a * 0.15915494309189535);
    const float r = (float)__builtin_fma(-k, 6.283185307179586, a);
    re = mag * cosf(r); im = mag * sinf(r);
}
__device__ __forceinline__ void s5_coef(float lr, float li, float dt, float& cr, float& ci) {
    const float th = li * dt, em1 = expm1f(lr * dt), c1 = cosf(th), s1 = sinf(th), sh = sinf(0.5f * th);
    const float nr = em1 * c1 - 2.f * sh * sh, ni = (1.f + em1) * s1, den = lr * lr + li * li;
    cr = (nr * lr + ni * li) / den; ci = (ni * lr - nr * li) / den;
}

__device__ __forceinline__ void s5_tables(CPP p, int l, LAS unsigned char* lds) {
    LAS float* abr = (LAS float*)lds;
    LAS float* abi = abr + 1024;
    LAS float* cr = abi + 1024;
    LAS float* ci = cr + 16 * 65;
    float* KN = (float*)(p->ws + WS_KN);
    const int tid = otid();
    for (int it = obid(); it < 1024; it += ogrid()) {
        const int g = it >> 6, n = it & 63;
        __syncthreads();
        for (int e = tid; e < 1024; e += 512) { const int pp = e >> 4, c = e & 15; const int gp = (l * 16 + g) * 64 + pp;
            const float lr = p->in[5][gp], li = p->in[6][gp], dt = expf(p->in[7][l * 16 + g]);
            float ar, ai2; s5_abar_pow(lr, li, dt, n, ar, ai2);
            float qr, qi; s5_coef(lr, li, dt, qr, qi);
            const float br = p->in[8][(size_t)gp * 16 + c], bi = p->in[9][(size_t)gp * 16 + c];
            const float bbr = qr * br - qi * bi, bbi = qr * bi + qi * br;
            abr[e] = ar * bbr - ai2 * bbi; abi[e] = ar * bbi + ai2 * bbr; }
        for (int e = tid; e < 1024; e += 512) { const int i = e >> 6, pp = e & 63; const size_t gi = ((size_t)(l * 16 + g) * 16 + i) * 64 + pp;
            cr[i * 65 + pp] = p->in[10][gi]; ci[i * 65 + pp] = p->in[11][gi]; }
        __syncthreads();
        if (tid < 256) { const int i = tid >> 4, c = tid & 15; float s = 0.f;
#pragma unroll 8
            for (int pp = 0; pp < 64; ++pp) s += cr[i * 65 + pp] * abr[pp * 16 + c] - ci[i * 65 + pp] * abi[pp * 16 + c];
            KN[((size_t)(g * 64 + n) * 16 + i) * 16 + c] = s; }
    }
}

__device__ __forceinline__ void convert_weights(CPP p, int l, LAS unsigned char* lds) {
    const int tid = otid(), lane = tid & 63, wave = tid >> 6;
    LAS float* scr = (LAS float*)(lds + wave * 16384);
    const int gw = obid() * 8 + wave, NGW = ogrid() * 8;
    unsigned char* ws = p->ws;
    constexpr int J0 = 1408, J1 = J0 + 2048, J2 = J1 + 512, J3 = J2 + 512, J4 = J3 + 2816, J5 = J4 + 1408, J6 = J5 + 32;
    for (int it = gw; it < J6; it += NGW) {
        if (it < J0) { const int r = it; transpose_item(p->in[1] + (size_t)l * 1024 * 2576, 1024, 2576, (bf16_t*)(ws + WS_WIN), 0, 0, scr, r / 88, r % 88, lane); }
        else if (it < J1) { const int r = it - J0, b = r >> 9, q = r & 511; transpose_item(p->in[15] + ((size_t)l * 4 + b) * 1024 * 1024, 1024, 1024, (bf16_t*)(ws + WS_WG), 1, b, scr, q >> 5, q & 31, lane); }
        else if (it < J2) { const int r = it - J1, b = r >> 7, q = r & 127; transpose_item(p->in[17] + ((size_t)l * 4 + b) * 256 * 1024, 256, 1024, (bf16_t*)(ws + WS_WB) + (size_t)b * 1024 * 256, 0, 0, scr, q >> 5, q & 31, lane); }
        else if (it < J3) { const int q = it - J2; transpose_item(p->in[18] + (size_t)l * 1024 * 1024, 1024, 1024, (bf16_t*)(ws + WS_WO), 0, 0, scr, q >> 5, q & 31, lane); }
        else if (it < J4) { const int r = it - J3, wch = r / 1408, q = r % 1408; transpose_item(p->in[wch ? 22 : 21] + (size_t)l * 1024 * 2816, 1024, 2816, (bf16_t*)(ws + WS_WFF), 2, wch, scr, q / 88, q % 88, lane); }
        else if (it < J5) { const int q = it - J4; transpose_item(p->in[23] + (size_t)l * 2816 * 1024, 2816, 1024, (bf16_t*)(ws + WS_WD), 0, 0, scr, q >> 5, q & 31, lane); }
        else { const int q = it - J5; transpose_item(p->in[13] + (size_t)l * 256 * 256, 256, 256, (bf16_t*)(ws + WS_WGLU), 0, 0, scr, q >> 3, q & 7, lane); }
    }
    const int gt = obid() * 512 + tid, NT = ogrid() * 512;
    bf16_t* WE = (bf16_t*)(ws + WS_WE);
    for (int e = gt; e < 65536; e += NT) { const int s = e & 63, pp = (e >> 6) & 63, g = e >> 12; const int gp = (l * 16 + g) * 64 + pp;
        const float lr = p->in[5][gp], li = p->in[6][gp], dt = expf(p->in[7][l * 16 + g]);
        float ar, ai2; s5_abar_pow(lr, li, dt, 63 - s, ar, ai2);
        float qr, qi; s5_coef(lr, li, dt, qr, qi);
        float wr_[16], wi_[16];
#pragma unroll
        for (int c = 0; c < 16; ++c) { const float br = p->in[8][(size_t)gp * 16 + c], bi = p->in[9][(size_t)gp * 16 + c];
            const float bbr = qr * br - qi * bi, bbi = qr * bi + qi * br; wr_[c] = ar * bbr - ai2 * bbi; wi_[c] = ar * bbi + ai2 * bbr; }
        bf16_t* dr = WE + ((size_t)(g * 256 + pp)) * 1024 + s * 16; bf16_t* di = WE + ((size_t)(g * 256 + 64 + pp)) * 1024 + s * 16;
        *(u32x4*)dr = pack8(wr_); *(u32x4*)(dr + 8) = pack8(wr_ + 8); *(u32x4*)di = pack8(wi_); *(u32x4*)(di + 8) = pack8(wi_ + 8); }
    for (int e = gt; e < 16 * 128 * 128; e += NT) { const int c8 = e & 127, n = (e >> 7) & 127, g = e >> 14;
        *(u32x4*)(WE + ((size_t)(g * 256 + 128 + n)) * 1024 + c8 * 8) = (u32x4){0u, 0u, 0u, 0u}; }
    bf16_t* WT = (bf16_t*)(ws + WS_WT); const float* KN = (const float*)(ws + WS_KN);
    for (int e = gt; e < 16 * 1024 * 64; e += NT) { const int s = e & 63, row = (e >> 6) & 1023, g = e >> 16; const int j = row >> 4, i = row & 15;
        u32x4 w0 = (u32x4){0u, 0u, 0u, 0u}, w1 = w0;
        if (s <= j) { const float* k = KN + ((size_t)(g * 64 + (j - s)) * 16 + i) * 16; float v[16];
#pragma unroll
            for (int c = 0; c < 16; c += 4) { const f32x4 t = *(const f32x4*)(k + c); v[c] = t[0]; v[c + 1] = t[1]; v[c + 2] = t[2]; v[c + 3] = t[3]; }
            w0 = pack8(v); w1 = pack8(v + 8); }
        bf16_t* d = WT + ((size_t)(g * 1024 + row)) * S5K + s * 16; *(u32x4*)d = w0; *(u32x4*)(d + 8) = w1; }
    for (int e = gt; e < 16 * 1024 * 64; e += NT) { const int pp = e & 63, row = (e >> 6) & 1023, g = e >> 16; const int j = row >> 4, i = row & 15; const int gp = (l * 16 + g) * 64 + pp;
        const float lr = p->in[5][gp], li = p->in[6][gp], dt = expf(p->in[7][l * 16 + g]);
        float ar, ai2; s5_abar_pow(lr, li, dt, j + 1, ar, ai2);
        const size_t gi = ((size_t)(l * 16 + g) * 16 + i) * 64 + pp; const float c_r = p->in[10][gi], c_i = p->in[11][gi];
        bf16_t* d = WT + ((size_t)(g * 1024 + row)) * S5K + 1024 + pp;
        d[0] = (bf16_t)f2bf(c_r * ar - c_i * ai2); d[64] = (bf16_t)f2bf(-(c_r * ai2 + c_i * ar)); }
}

__device__ __forceinline__ void ln_pass(float* x, bf16_t* xb, const float* gam, const float* bet) {
    const int lane = otid() & 63, gw = obid() * 8 + (otid() >> 6), NGW = ogrid() * 8;
    f32x4 gv[4], bv[4];
#pragma unroll
    for (int j = 0; j < 4; ++j) { gv[j] = *((const f32x4*)gam + lane + 64 * j); bv[j] = *((const f32x4*)bet + lane + 64 * j); }
    for (int m = gw; m < M; m += NGW) {
        f32x4* xr = (f32x4*)(x + (size_t)m * DM) + lane;
        f32x4 v[4]; float s = 0.f;
#pragma unroll
        for (int j = 0; j < 4; ++j) { v[j] = xr[64 * j]; s += (v[j].x + v[j].y) + (v[j].z + v[j].w); }
        const float mean = wave_sum(s) * (1.f / DM); float s2 = 0.f;
#pragma unroll
        for (int j = 0; j < 4; ++j) { v[j] = v[j] - mean; s2 += (v[j].x * v[j].x + v[j].y * v[j].y) + (v[j].z * v[j].z + v[j].w * v[j].w); }
        const float rstd = 1.f / sqrtf(wave_sum(s2) * (1.f / DM) + LN_EPS);
        u32x2* o8 = (u32x2*)(xb + (size_t)m * DM) + lane;
#pragma unroll
        for (int j = 0; j < 4; ++j) { const f32x4 y = v[j] * rstd * gv[j] + bv[j]; xr[64 * j] = y; u32x2 w; w.x = pk2(y.x, y.y); w.y = pk2(y.z, y.w); o8[64 * j] = w; }
    }
}

__device__ __forceinline__ void load_tile64(const bf16_t* src, int pitch, LAS float* dst, int dpitch, float scale, int tid) {
    const int idx = tid * 8, r = idx >> 6, c = idx & 63;
    const u32x4 w = *(const u32x4*)(src + (size_t)r * pitch + c); float f[8]; unpack8(w, f);
#pragma unroll
    for (int e = 0; e < 8; ++e) dst[r * dpitch + c + e] = f[e] * scale;
}

__device__ __forceinline__ void attn_items(CPP p, int l, LAS unsigned char* lds) {
    LAS float* Qs = (LAS float*)lds; LAS float* Ks = Qs + 64 * 68; LAS float* Vs = Ks + 64 * 68; LAS float* Ps = Vs + 64 * 68; LAS float* bs = Ps + 64 * 65;
    const bf16_t* H = (const bf16_t*)(p->ws + WS_E); bf16_t* O = (bf16_t*)(p->ws + WS_O);
    const int tid = otid(), row = tid >> 3, sub = tid & 7;
    for (int it = obid(); it < 4096; it += ogrid()) {
        const int h = it & 3, bi = it >> 2, i = bi & 31, b = bi >> 5;
        const size_t t0 = (size_t)bi * 64;
        __syncthreads();
        load_tile64(H + t0 * NH + C_AQ + h * 64, NH, Qs, 68, 0.125f, tid);
        if (tid < 257) bs[tid] = p->in[4][(size_t)(l * 4 + h) * 257 + tid];
        __syncthreads();
        float q[64], o[8];
#pragma unroll
        for (int d = 0; d < 64; d += 4) { const f32x4 t = *(const LAS f32x4*)(Qs + row * 68 + d); q[d] = t[0]; q[d + 1] = t[1]; q[d + 2] = t[2]; q[d + 3] = t[3]; }
#pragma unroll
        for (int e = 0; e < 8; ++e) o[e] = 0.f;
        float mx = -1e30f, ls = 0.f;
        const int kc0 = i > 8 ? i - 8 : 0;
        for (int kc = kc0; kc <= i; ++kc) {
            __syncthreads();
            const size_t tk = ((size_t)b * 32 + kc) * 64;
            load_tile64(H + tk * NH + C_AK + h * 64, NH, Ks, 68, 1.f, tid);
            load_tile64(H + tk * NH + C_AV + h * 64, NH, Vs, 68, 1.f, tid);
            __syncthreads();
            float s[8]; float cm = -1e30f;
#pragma unroll
            for (int jj = 0; jj < 8; ++jj) { const int key = sub + 8 * jj; float a = 0.f;
#pragma unroll
                for (int d = 0; d < 64; d += 4) { const f32x4 t = *(const LAS f32x4*)(Ks + key * 68 + d); a += q[d] * t[0] + q[d + 1] * t[1] + q[d + 2] * t[2] + q[d + 3] * t[3]; }
                int diff = (i - kc) * 64 + row - key; diff = diff > 128 ? 128 : diff;
                a += bs[diff + 128]; s[jj] = a; cm = fmaxf(cm, a); }
            cm = fmaxf(cm, __shfl_xor(cm, 1)); cm = fmaxf(cm, __shfl_xor(cm, 2)); cm = fmaxf(cm, __shfl_xor(cm, 4));
            const float mn = fmaxf(mx, cm), sc = __expf(mx - mn); mx = mn;
            float ps = 0.f;
#pragma unroll
            for (int jj = 0; jj < 8; ++jj) { const float pr = __expf(s[jj] - mn); ps += pr; Ps[row * 65 + sub + 8 * jj] = pr; }
            ps += __shfl_xor(ps, 1); ps += __shfl_xor(ps, 2); ps += __shfl_xor(ps, 4);
            ls = ls * sc + ps;
#pragma unroll
            for (int e = 0; e < 8; ++e) o[e] *= sc;
            asm volatile("s_waitcnt lgkmcnt(0)" ::: "memory");
#pragma unroll 8
            for (int key = 0; key < 64; ++key) { const float pr = Ps[row * 65 + key];
                const f32x4 v0 = *(const LAS f32x4*)(Vs + key * 68 + sub * 8), v1 = *(const LAS f32x4*)(Vs + key * 68 + sub * 8 + 4);
                o[0] += pr * v0[0]; o[1] += pr * v0[1]; o[2] += pr * v0[2]; o[3] += pr * v0[3]; o[4] += pr * v1[0]; o[5] += pr * v1[1]; o[6] += pr * v1[2]; o[7] += pr * v1[3]; }
        }
        const float inv = 1.f / ls;
#pragma unroll
        for (int e = 0; e < 8; ++e) o[e] *= inv;
        *(u32x4*)(O + (t0 + row) * DM + 256 + h * 64 + sub * 8) = pack8(o);
    }
}

__device__ __forceinline__ void load_rot(const bf16_t* src, const float* rot, int i, LAS float* dst, float scale, float logz, int tid) {
#pragma unroll
    for (int q = 0; q < 2; ++q) { const int idx = tid + 512 * q, j = idx >> 4, f = idx & 15;
        const float x1 = bf2f(src[(size_t)j * NH + f]), x2 = bf2f(src[(size_t)j * NH + f + 16]);
        const int pos = i * 64 + j; const float c = rot[pos * 32 + f], s = rot[pos * 32 + 16 + f];
        const float sc = scale * __expf(logz * (float)(63 - j));
        dst[j * 33 + f] = (x1 * c - x2 * s) * sc; dst[j * 33 + f + 16] = (x1 * s + x2 * c) * sc; }
}
__device__ __forceinline__ float ret_logg(int h) { return log1pf(-exp2f(-5.f - (float)h)); }

__device__ __forceinline__ void upd_items(CPP p, int l, LAS unsigned char* lds) {
    LAS float* kt = (LAS float*)lds; LAS float* vv = kt + 64 * 33; LAS float* la = vv + 64 * 68; LAS float* gas = la + 64 * 33; LAS float* was = gas + 1024; LAS float* bas = was + 512;
    const bf16_t* H = (const bf16_t*)(p->ws + WS_E); const float* rot = (const float*)(p->ws + WS_ROT);
    float* RU = (float*)(p->ws + WS_RU); float* GU = (float*)(p->ws + WS_GU); float* GL = (float*)(p->ws + WS_GL);
    const int tid = otid();
    for (int it = obid(); it < 8192; it += ogrid()) {
        const int gla = it >> 12, h = it & 3, bi = (it >> 2) & 1023, i = bi & 31;
        const size_t t0 = (size_t)bi * 64;
        __syncthreads();
        if (!gla) {
            load_rot(H + t0 * NH + C_RK + h * 32, rot, i, kt, 0.17677669529663689f, ret_logg(h), tid);
            load_tile64(H + t0 * NH + C_RV + h * 64, NH, vv, 68, 1.f, tid);
            __syncthreads();
        } else {
            if (tid < 128) { const int j = tid >> 1, c = (tid & 1) * 8; const u32x4 w = *(const u32x4*)(H + (t0 + j) * NH + C_GA + c); float f[8]; unpack8(w, f);
#pragma unroll
                for (int e = 0; e < 8; ++e) gas[j * 16 + c + e] = f[e]; }
            { const int r = tid >> 5, dk = tid & 31; was[tid] = p->in[2][(size_t)(l * 16 + r) * 128 + h * 32 + dk]; }
            if (tid < 32) bas[tid] = p->in[3][l * 128 + h * 32 + tid];
            { const int idx = tid * 4, j = idx >> 5, c = idx & 31; const u32x2 w = *(const u32x2*)(H + (t0 + j) * NH + C_GK + h * 32 + c);
                kt[j * 33 + c] = bflo(w.x); kt[j * 33 + c + 1] = bfhi(w.x); kt[j * 33 + c + 2] = bflo(w.y); kt[j * 33 + c + 3] = bfhi(w.y); }
            load_tile64(H + t0 * NH + C_GV + h * 64, NH, vv, 68, 1.f, tid);
            __syncthreads();
#pragma unroll
            for (int q = 0; q < 4; ++q) { const int e = tid + 512 * q, j = e >> 5, dk = e & 31; float z = bas[dk];
#pragma unroll
                for (int r = 0; r < 16; ++r) z += gas[j * 16 + r] * was[r * 32 + dk];
                const float lsg = fminf(z, 0.f) - log1pf(expf(-fabsf(z)));
                la[j * 33 + dk] = lsg * 0.0625f; }
            __syncthreads();
            if (tid < 32) { float run = 0.f; for (int j = 0; j < 64; ++j) { run += la[j * 33 + tid]; la[j * 33 + tid] = run; } }
            __syncthreads();
#pragma unroll
            for (int q = 0; q < 4; ++q) { const int e = tid + 512 * q, j = e >> 5, dk = e & 31; kt[j * 33 + dk] *= __expf(la[63 * 33 + dk] - la[j * 33 + dk]); }
            if (tid < 32) GL[(size_t)(bi * 4 + h) * 32 + tid] = la[63 * 33 + tid];
            __syncthreads();
        }
        const int dk = tid >> 4, dv0 = (tid & 15) * 4; f32x4 a = (f32x4){0.f, 0.f, 0.f, 0.f};
#pragma unroll 8
        for (int j = 0; j < 64; ++j) { const float kk = kt[j * 33 + dk]; const f32x4 v4 = *(const LAS f32x4*)(vv + j * 68 + dv0); a += v4 * kk; }
        float* dst = (gla ? GU : RU) + (size_t)(bi * 4 + h) * 2048 + dk * 64 + dv0;
        *(f32x4*)dst = a;
    }
}

__device__ __forceinline__ void scan_items(CPP p, int l) {
    float* RU = (float*)(p->ws + WS_RU); float* GU = (float*)(p->ws + WS_GU); const float* GL = (const float*)(p->ws + WS_GL);
    const float* ES = (const float*)(p->ws + WS_ES); bf16_t* U2 = (bf16_t*)(p->ws + WS_U2);
    const int gt = obid() * 512 + otid(), NT = ogrid() * 512;
    for (int e = gt; e < 262144; e += NT) { const int dvk = e & 2047, bh = e >> 11, h = bh & 3, b = bh >> 2;
        const float dec = expf(64.f * ret_logg(h)); float st = 0.f;
        for (int i = 0; i < 32; ++i) { const size_t idx = (size_t)((b * 32 + i) * 4 + h) * 2048 + dvk; const float t = RU[idx]; RU[idx] = st; st = st * dec + t; } }
    for (int e = gt; e < 262144; e += NT) { const int dvk = e & 2047, bh = e >> 11, h = bh & 3, b = bh >> 2; float st = 0.f;
        for (int i = 0; i < 32; ++i) { const size_t bih = (size_t)((b * 32 + i) * 4 + h); const float gl = GL[bih * 32 + (dvk >> 6)];
            st = __expf(gl) * st + GU[bih * 2048 + dvk]; GU[bih * 2048 + dvk] = st; } }
    for (int e = gt; e < 32768; e += NT) { const int pp = e & 63, g = (e >> 6) & 15, b = e >> 10; const int gp = (l * 16 + g) * 64 + pp;
        const float lr = p->in[5][gp], li = p->in[6][gp], dt = expf(p->in[7][l * 16 + g]);
        float ar, ai2; s5_abar_pow(lr, li, dt, 64, ar, ai2);
        float xr = 0.f, xi = 0.f;
        for (int i = 0; i < 32; ++i) { const size_t row = (size_t)g * 1024 + b * 32 + i;
            U2[row * S5K + 1024 + pp] = (bf16_t)f2bf(xr); U2[row * S5K + 1088 + pp] = (bf16_t)f2bf(xi);
            const float er = ES[row * 128 + pp], ei = ES[row * 128 + 64 + pp];
            const float nr = ar * xr - ai2 * xi + er, ni = ar * xi + ai2 * xr + ei; xr = nr; xi = ni; } }
}

__device__ __forceinline__ void out_items(CPP p, int l, LAS unsigned char* lds) {
    LAS float* qt = (LAS float*)lds; LAS float* kt = qt + 64 * 33; LAS float* vv = kt + 64 * 33; LAS float* Sm = vv + 64 * 68; LAS float* Rm = Sm + 64 * 65;
    const bf16_t* H = (const bf16_t*)(p->ws + WS_E); const float* rot = (const float*)(p->ws + WS_ROT); bf16_t* O = (bf16_t*)(p->ws + WS_O);
    const float* RU = (const float*)(p->ws + WS_RU); const float* GU = (const float*)(p->ws + WS_GU);
    const int tid = otid();
    for (int it = obid(); it < 8192; it += ogrid()) {
        const int gla = it >> 12, h = it & 3, bi = (it >> 2) & 1023, i = bi & 31;
        const size_t t0 = (size_t)bi * 64;
        const int n = tid >> 3, dv0 = (tid & 7) * 8;
        float acc[8];
#pragma unroll
        for (int e = 0; e < 8; ++e) acc[e] = 0.f;
        __syncthreads();
        { const float* src = (gla ? GU : RU) + (size_t)(bi * 4 + h) * 2048; const int idx = tid * 4, dk = idx >> 6, dv = idx & 63;
            const f32x4 t = *(const f32x4*)(src + idx); Rm[dk * 68 + dv] = t[0]; Rm[dk * 68 + dv + 1] = t[1]; Rm[dk * 68 + dv + 2] = t[2]; Rm[dk * 68 + dv + 3] = t[3]; }
        if (!gla) {
            const float lg = ret_logg(h);
            load_rot(H + t0 * NH + C_RQ + h * 32, rot, i, qt, 1.f, 0.f, tid);
            load_rot(H + t0 * NH + C_RK + h * 32, rot, i, kt, 0.17677669529663689f, 0.f, tid);
            load_tile64(H + t0 * NH + C_RV + h * 64, NH, vv, 68, 1.f, tid);
            __syncthreads();
            { const int m0 = (tid & 7) * 8;
#pragma unroll
                for (int mm = 0; mm < 8; ++mm) { const int m = m0 + mm; float d = 0.f;
#pragma unroll
                    for (int dk = 0; dk < 32; ++dk) d += qt[n * 33 + dk] * kt[m * 33 + dk];
                    const int ad = n > m ? n - m : m - n; Sm[n * 65 + m] = d * __expf(lg * (float)ad); } }
            __syncthreads();
#pragma unroll 4
            for (int m = 0; m < 64; ++m) { const float sv = Sm[n * 65 + m]; const f32x4 v0 = *(const LAS f32x4*)(vv + m * 68 + dv0), v1 = *(const LAS f32x4*)(vv + m * 68 + dv0 + 4);
                acc[0] += sv * v0[0]; acc[1] += sv * v0[1]; acc[2] += sv * v0[2]; acc[3] += sv * v0[3]; acc[4] += sv * v1[0]; acc[5] += sv * v1[1]; acc[6] += sv * v1[2]; acc[7] += sv * v1[3]; }
            const float xi = __expf(lg * (float)(n + 1));
#pragma unroll 4
            for (int dk = 0; dk < 32; ++dk) { const float qx = qt[n * 33 + dk] * xi; const f32x4 v0 = *(const LAS f32x4*)(Rm + dk * 68 + dv0), v1 = *(const LAS f32x4*)(Rm + dk * 68 + dv0 + 4);
                acc[0] += qx * v0[0]; acc[1] += qx * v0[1]; acc[2] += qx * v0[2]; acc[3] += qx * v0[3]; acc[4] += qx * v1[0]; acc[5] += qx * v1[1]; acc[6] += qx * v1[2]; acc[7] += qx * v1[3]; }
        } else {
            { const int idx = tid * 4, j = idx >> 5, c = idx & 31; const u32x2 w = *(const u32x2*)(H + (t0 + j) * NH + C_GQ + h * 32 + c); const float sc = 0.17677669529663689f;
                qt[j * 33 + c] = bflo(w.x) * sc; qt[j * 33 + c + 1] = bfhi(w.x) * sc; qt[j * 33 + c + 2] = bflo(w.y) * sc; qt[j * 33 + c + 3] = bfhi(w.y) * sc; }
            __syncthreads();
#pragma unroll 4
            for (int dk = 0; dk < 32; ++dk) { const float qx = qt[n * 33 + dk]; const f32x4 v0 = *(const LAS f32x4*)(Rm + dk * 68 + dv0), v1 = *(const LAS f32x4*)(Rm + dk * 68 + dv0 + 4);
                acc[0] += qx * v0[0]; acc[1] += qx * v0[1]; acc[2] += qx * v0[2]; acc[3] += qx * v0[3]; acc[4] += qx * v1[0]; acc[5] += qx * v1[1]; acc[6] += qx * v1[2]; acc[7] += qx * v1[3]; }
        }
        float s = 0.f;
#pragma unroll
        for (int e = 0; e < 8; ++e) s += acc[e];
        s += __shfl_xor(s, 1); s += __shfl_xor(s, 2); s += __shfl_xor(s, 4);
        const float mean = s * (1.f / 64.f); float s2 = 0.f;
#pragma unroll
        for (int e = 0; e < 8; ++e) { acc[e] -= mean; s2 += acc[e] * acc[e]; }
        s2 += __shfl_xor(s2, 1); s2 += __shfl_xor(s2, 2); s2 += __shfl_xor(s2, 4);
        const float rs = 1.f / sqrtf(s2 * (1.f / 64.f) + LN_EPS);
        const u32x4 gw = *(const u32x4*)(H + (t0 + n) * NH + (gla ? C_GR : C_RG) + h * 64 + dv0); float gf[8]; unpack8(gw, gf);
        float ov[8];
#pragma unroll
        for (int e = 0; e < 8; ++e) ov[e] = silu_f(gf[e]) * acc[e] * rs;
        *(u32x4*)(O + (t0 + n) * DM + (gla ? 512 : 0) + h * 64 + dv0) = pack8(ov);
    }
}

__global__ void __launch_bounds__(512, 2) mega(Params p_unused) {
    extern __shared__ __attribute__((aligned(16))) unsigned char lds_raw[];
    LAS unsigned char* lds = (LAS unsigned char*)lds_raw;
    cg::grid_group grid = cg::this_grid();
    CPP p = (CPP)__builtin_amdgcn_kernarg_segment_ptr();
    unsigned char* ws = p->ws;
    bf16_t* XB = (bf16_t*)(ws + WS_XB);

    { float* rot = (float*)(ws + WS_ROT); const int gt = obid() * 512 + otid(), NT = ogrid() * 512;
        for (int e = gt; e < 2048 * 16; e += NT) { const int pos = e >> 4, f = e & 15; const float inv = 1.0f / powf(10000.0f, (float)f * (1.0f / 16.0f)); const float ang = (float)pos * inv;
            rot[pos * 32 + f] = cosf(ang); rot[pos * 32 + 16 + f] = sinf(ang); } }
    s5_tables(p, 0, lds);
    { const float* x = p->in[0]; const int gt = obid() * 512 + otid(), NT = ogrid() * 512;
        for (size_t e = gt; e < (size_t)M * DM / 8; e += NT) { const f32x4 a = *((const f32x4*)x + 2 * e), b = *((const f32x4*)x + 2 * e + 1);
            u32x4 w; w.x = pk2(a[0], a[1]); w.y = pk2(a[2], a[3]); w.z = pk2(b[0], b[1]); w.w = pk2(b[2], b[3]); *((u32x4*)XB + e) = w; } }
    grid.sync();
    convert_weights(p, 0, lds);
    grid.sync();

    for (int l = 0; l < 4; ++l) {
        for (int s = 0; s < 12; ++s) {
            p = (CPP)__builtin_amdgcn_kernarg_segment_ptr(); asm volatile("" : "+s"(p));
            pg8::Gemm g; pg8::Sched S; pg8::Epi E;
            bool do_gemm = true;
            S.G = ogrid(); S.c = obid(); S.mode = 0; S.nM = M / 256; S.nN = 1;
            E.mode = 0; E.perm = true;
            E.ws = ws; E.dskip = p->in[12] + l * 256; E.bglu = p->in[14] + l * 256; E.bgate = p->in[16] + (size_t)l * 4096;
            E.xres = p->out; E.xout = p->out;
            g.A = XB; g.Bt = (const bf16_t*)(ws + WS_WIN); g.lda = DM; g.ldb = DM; g.K = DM;
            switch (s) {
                case 0: S.nN = NINP / 256; E.mode = 0; E.perm = true; break;
                case 1: g.A = (const bf16_t*)(ws + WS_U2); g.Bt = (const bf16_t*)(ws + WS_WE); g.lda = S5K; g.ldb = 1024; g.K = 1024; S.mode = 2; S.nM = 64; S.nN = 1; E.mode = 1; break;
                case 3: g.A = (const bf16_t*)(ws + WS_U2); g.Bt = (const bf16_t*)(ws + WS_WT); g.lda = S5K; g.ldb = S5K; g.K = S5K; S.mode = 3; S.nM = 64; S.nN = 4; E.mode = 2; break;
                case 4: g.A = (const bf16_t*)(ws + WS_YS); g.Bt = (const bf16_t*)(ws + WS_WGLU); g.lda = 256; g.ldb = 256; g.K = 256; S.nN = 1; E.mode = 3; break;
                case 5: g.A = (const bf16_t*)(ws + WS_O); g.Bt = (const bf16_t*)(ws + WS_WB); g.lda = DM; g.ldb = 256; g.K = 256; S.mode = 1; S.nN = 16; E.mode = 4; break;
                case 6: g.Bt = (const bf16_t*)(ws + WS_WG); S.nN = 16; E.mode = 5; E.perm = false; break;
                case 7: g.A = (const bf16_t*)(ws + WS_O); g.Bt = (const bf16_t*)(ws + WS_WO); S.nN = 4; E.mode = 6; E.perm = false; E.xres = (l == 0) ? p->in[0] : p->out; break;
                case 9: g.Bt = (const bf16_t*)(ws + WS_WFF); S.nN = 22; E.mode = 7; E.perm = false; break;
                case 10: g.A = (const bf16_t*)(ws + WS_E); g.Bt = (const bf16_t*)(ws + WS_WD); g.lda = DFF; g.ldb = DFF; g.K = DFF; S.nN = 4; E.mode = 6; E.perm = false; break;
                default: do_gemm = false; break;
            }
            S.nwg = S.nM * S.nN;
            if (do_gemm) pg8::gemm_phase(lds, g, S, E);
            if (s == 1) { attn_items(p, l, lds); upd_items(p, l, lds); }
            else if (s == 2) scan_items(p, l);
            else if (s == 3) out_items(p, l, lds);
            else if (s == 8) { ln_pass(p->out, XB, p->in[19] + l * DM, p->in[20] + l * DM); if (l < 3) s5_tables(p, l + 1, lds); }
            else if (s == 11) { ln_pass(p->out, XB, p->in[24] + l * DM, p->in[25] + l * DM); if (l < 3) convert_weights(p, l + 1, lds); }
            grid.sync();
        }
    }
}

extern "C" void kernel_launch(void* const* d_in, const int* in_sizes, int n_in, void* d_out, int out_size, void* d_ws, size_t ws_size, hipStream_t stream) {
    static int grid_blocks = 0;
    if (!grid_blocks) {
        int dev = 0, cus = 0;
        hipGetDevice(&dev);
        hipDeviceGetAttribute(&cus, hipDeviceAttributeMultiprocessorCount, dev);
        hipFuncSetAttribute((const void*)mega, hipFuncAttributeMaxDynamicSharedMemorySize, LDS_BYTES);
        grid_blocks = cus > 0 ? cus : 256;
    }
    Params p{};
    for (int i = 0; i < 26; ++i) p.in[i] = (const float*)d_in[i];
    p.out = (float*)d_out; p.ws = (unsigned char*)d_ws;
    void* args[] = {&p};
    hipError_t e = hipLaunchCooperativeKernel((const void*)mega, dim3(grid_blocks), dim3(512), args, LDS_BYTES, stream);
    if (e != hipSuccess) fprintf(stderr, "cooperative launch failed: %s (grid %d)\n", hipGetErrorString(e), grid_blocks);
}
```

```cpp
#include <hip/hip_runtime.h>
#include <hip/hip_cooperative_groups.h>
#include <cstdint>
#include <cstdio>
namespace cg = cooperative_groups;

#define LAS __attribute__((address_space(3)))
typedef unsigned short bf16_t;
typedef short bf16x8 __attribute__((ext_vector_type(8)));
typedef float f32x4 __attribute__((ext_vector_type(4)));
typedef float f32x2 __attribute__((ext_vector_type(2)));
typedef unsigned u32x4 __attribute__((ext_vector_type(4)));
typedef unsigned u32x2 __attribute__((ext_vector_type(2)));

constexpr int M = 65536, DM = 1024, SEQ = 2048, NCH = 32;
constexpr int NH = 2320;
constexpr int NINP = 2816;
constexpr int DFF = 2816;
constexpr int S5K = 1152;
constexpr float ALPHA = 1.681792830507429f;
constexpr float LN_EPS = 1e-5f;
constexpr int C_RQ = 0, C_RK = 128, C_RV = 256, C_RG = 512, C_AQ = 768, C_AK = 1024, C_AV = 1280, C_GQ = 1536, C_GK = 1664, C_GV = 1792, C_GR = 2048, C_GA = 2304, C_SU = 2320;

constexpr size_t MiB = 1u << 20;
constexpr size_t WS_ROT = 1 * MiB;
constexpr size_t WS_KN = 2 * MiB;
constexpr size_t WS_WIN = 4 * MiB;
constexpr size_t WS_WG = 10 * MiB;
constexpr size_t WS_WB = 18 * MiB;
constexpr size_t WS_WO = 20 * MiB;
constexpr size_t WS_WFF = 22 * MiB;
constexpr size_t WS_WD = 33 * MiB;
constexpr size_t WS_WGLU = 39 * MiB;
constexpr size_t WS_WE = 40 * MiB;
constexpr size_t WS_WT = 48 * MiB;
constexpr size_t WS_XB = 88 * MiB;
constexpr size_t WS_O = 216 * MiB;
constexpr size_t WS_E = 344 * MiB;
constexpr size_t WS_U2 = 636 * MiB;
constexpr size_t WS_RU = 676 * MiB;
constexpr size_t WS_GU = 708 * MiB;
constexpr size_t WS_GL = 740 * MiB;
constexpr size_t WS_ES = 741 * MiB;
constexpr size_t WS_YS = 749 * MiB;
constexpr int LDS_BYTES = 147456;

struct Params { const float* in[26]; float* out; unsigned char* ws; };
typedef const __attribute__((address_space(4))) Params* CPP;

__device__ __forceinline__ float bflo(unsigned w) { return __uint_as_float(w << 16); }
__device__ __forceinline__ float bfhi(unsigned w) { return __uint_as_float(w & 0xffff0000u); }
__device__ __forceinline__ float bf2f(bf16_t b) { return __uint_as_float((unsigned)b << 16); }
__device__ __forceinline__ unsigned f2bf(float f) { unsigned u = __float_as_uint(f); return (u + 0x7fffu + ((u >> 16) & 1u)) >> 16; }
__device__ __forceinline__ unsigned pk2(float lo, float hi) { return f2bf(lo) | (f2bf(hi) << 16); }
__device__ __forceinline__ unsigned cvt_pk_bf16(float lo, float hi) { unsigned r; asm volatile("v_cvt_pk_bf16_f32 %0, %1, %2" : "=v"(r) : "v"(lo), "v"(hi)); return r; }
__device__ __forceinline__ float sigm(float x) { return __builtin_amdgcn_rcpf(1.0f + __expf(-x)); }
__device__ __forceinline__ float silu_f(float x) { return x * sigm(x); }
__device__ __forceinline__ float gelu_tanh(float v) { return v * sigm(1.5957691216057308f * (v + 0.044715f * v * v * v)); }
__device__ __forceinline__ void unpack8(u32x4 w, float* o) {
    o[0] = bflo(w.x); o[1] = bfhi(w.x); o[2] = bflo(w.y); o[3] = bfhi(w.y); o[4] = bflo(w.z); o[5] = bfhi(w.z); o[6] = bflo(w.w); o[7] = bfhi(w.w);
}
__device__ __forceinline__ u32x4 pack8(const float* v) { u32x4 w; w.x = pk2(v[0], v[1]); w.y = pk2(v[2], v[3]); w.z = pk2(v[4], v[5]); w.w = pk2(v[6], v[7]); return w; }
__device__ __forceinline__ int otid() { int t = threadIdx.x; asm volatile("" : "+v"(t)); return t; }
__device__ __forceinline__ int obid() { int b = blockIdx.x; asm volatile("" : "+s"(b)); return b; }
__device__ __forceinline__ int ogrid() { int b = gridDim.x; asm volatile("" : "+s"(b)); return b; }
__device__ __forceinline__ float wave_sum(float v) {
#pragma unroll
    for (int o = 1; o < 64; o <<= 1) v += __shfl_xor(v, o);
    return v;
}

namespace pg8 {
constexpr int BM = 256, BK = 64, HALF = 128, HTB = HALF * BK * 2, STAGE_BYTES = 8 * HTB, NXCD = 8, WGM = 8;
__device__ __forceinline__ int lds_byte(int r, int c) { const int st = (r >> 4) * 2 + (c >> 5), rr = r & 15, cc = c & 31, ob = rr * 64 + cc * 2; return st * 1024 + (ob ^ (((ob >> 9) & 1) << 5)); }
__device__ __forceinline__ void stage_rc(int b, int& R, int& C) { const int st = b / 1024, sb = b % 1024, swz = sb ^ (((sb >> 9) & 1) << 5); R = (st >> 1) * 16 + swz / 64; C = (st & 1) * 32 + (swz % 64) / 2; }
__device__ __forceinline__ int perm32(int rho) { const int n = rho >> 4, i = rho & 15; return 8 * (i >> 2) + 4 * n + (i & 3); }

struct Unit { int pm, pn, ak; };
struct Gemm { const bf16_t* A; const bf16_t* Bt; int lda, ldb, K; };

struct Sched {
    int nM, nN, nwg, G, c, mode;
    __device__ __forceinline__ bool next(int i, Unit& u) const {
        const long L = (long)i * G + c; if (L >= nwg) return false;
        if (mode == 2) { u.pm = (int)L; u.pn = (int)(L >> 2); u.ak = 0; return true; }
        if (mode == 3) { const int g = (int)(L >> 4); u.pm = 4 * g + (int)((L >> 2) & 3); u.pn = 4 * g + (int)(L & 3); u.ak = 0; return true; }
        int wgid = (int)L; { const int q = nwg / NXCD, r = nwg % NXCD, xcd = wgid % NXCD, off = wgid / NXCD; wgid = (xcd < r ? xcd * (q + 1) : r * (q + 1) + (xcd - r) * q) + off; }
        const int nig = WGM * nN, gid = wgid / nig, fm = gid * WGM, gsz = (nM - fm) < WGM ? (nM - fm) : WGM;
        u.pm = fm + ((wgid % nig) % gsz); u.pn = (wgid % nig) / gsz; u.ak = (mode == 1) ? (u.pn >> 2) * 256 : 0; return true;
    }
};

struct Epi {
    int mode; bool perm;
    unsigned char* ws; const float* dskip; const float* bglu; const float* bgate; const float* xres; float* xout;
    __device__ __forceinline__ void operator()(const f32x4 (&acc)[2][2][4][2], const Unit& u, int wr, int wc, int fr, int fq) const {
        const int row0 = u.pm * BM + wr * 64 + fr;
        bf16_t* const H = (bf16_t*)(ws + WS_E); bf16_t* const U2 = (bf16_t*)(ws + WS_U2); float* const ES = (float*)(ws + WS_ES); bf16_t* const YS = (bf16_t*)(ws + WS_YS);
        bf16_t* const Ob = (bf16_t*)(ws + WS_O); bf16_t* const P = (bf16_t*)(ws + WS_E); bf16_t* const MIX = (bf16_t*)(ws + WS_O); bf16_t* const HF = (bf16_t*)(ws + WS_E);
        if (mode == 0) {
#pragma unroll
            for (int ai = 0; ai < 2; ++ai)
#pragma unroll
                for (int m = 0; m < 4; ++m) { const int r = row0 + ai * HALF + m * 16;
#pragma unroll
                    for (int bj = 0; bj < 2; ++bj) { const int c0 = u.pn * BM + bj * HALF + wc * 32 + 8 * fq;
                        const f32x4 v0 = acc[ai][bj][m][0], v1 = acc[ai][bj][m][1];
                        u32x4 w; w.x = cvt_pk_bf16(v0[0], v0[1]); w.y = cvt_pk_bf16(v0[2], v0[3]); w.z = cvt_pk_bf16(v1[0], v1[1]); w.w = cvt_pk_bf16(v1[2], v1[3]);
                        if (c0 < C_SU) *(u32x4*)(H + (size_t)r * NH + c0) = w;
                        else if (c0 < C_SU + 256) { const int c = c0 - C_SU, g = c >> 4, ci = c & 15;
                            *(u32x4*)(U2 + ((size_t)(g * 1024 + (r >> 6))) * S5K + (r & 63) * 16 + ci) = w; } } }
        } else if (mode == 1) {
#pragma unroll
            for (int ai = 0; ai < 2; ++ai)
#pragma unroll
                for (int m = 0; m < 4; ++m) { const int r = row0 + ai * HALF + m * 16; const int c0 = wc * 32 + 8 * fq;
                    *(f32x4*)(ES + (size_t)r * 128 + c0) = acc[ai][0][m][0]; *(f32x4*)(ES + (size_t)r * 128 + c0 + 4) = acc[ai][0][m][1]; }
        } else if (mode == 2) {
            const int g = u.pm >> 2;
#pragma unroll
            for (int ai = 0; ai < 2; ++ai)
#pragma unroll
                for (int m = 0; m < 4; ++m) { const int r = row0 + ai * HALF + m * 16;
#pragma unroll
                    for (int bj = 0; bj < 2; ++bj) { const int n0 = (u.pn & 3) * BM + bj * HALF + wc * 32 + 8 * fq; const int j = n0 >> 4, i0 = n0 & 15;
                        const u32x4 uw = *(const u32x4*)(U2 + (size_t)r * S5K + n0); float uf[8]; unpack8(uw, uf);
                        const f32x4 d0 = *(const f32x4*)(dskip + 16 * g + i0), d1 = *(const f32x4*)(dskip + 16 * g + i0 + 4);
                        const f32x4 v0 = acc[ai][bj][m][0], v1 = acc[ai][bj][m][1]; float y[8];
                        y[0] = gelu_tanh(v0[0] + d0[0] * uf[0]); y[1] = gelu_tanh(v0[1] + d0[1] * uf[1]); y[2] = gelu_tanh(v0[2] + d0[2] * uf[2]); y[3] = gelu_tanh(v0[3] + d0[3] * uf[3]);
                        y[4] = gelu_tanh(v1[0] + d1[0] * uf[4]); y[5] = gelu_tanh(v1[1] + d1[1] * uf[5]); y[6] = gelu_tanh(v1[2] + d1[2] * uf[6]); y[7] = gelu_tanh(v1[3] + d1[3] * uf[7]);
                        u32x4 w; w.x = cvt_pk_bf16(y[0], y[1]); w.y = cvt_pk_bf16(y[2], y[3]); w.z = cvt_pk_bf16(y[4], y[5]); w.w = cvt_pk_bf16(y[6], y[7]);
                        const size_t t = (size_t)(r & 1023) * 64 + j;
                        *(u32x4*)(YS + t * 256 + 16 * g + i0) = w; } }
        } else if (mode == 3) {
#pragma unroll
            for (int ai = 0; ai < 2; ++ai)
#pragma unroll
                for (int m = 0; m < 4; ++m) { const int r = row0 + ai * HALF + m * 16;
#pragma unroll
                    for (int bj = 0; bj < 2; ++bj) { const int c0 = bj * HALF + wc * 32 + 8 * fq;
                        const u32x4 yw = *(const u32x4*)(YS + (size_t)r * 256 + c0); float yf[8]; unpack8(yw, yf);
                        const f32x4 b0 = *(const f32x4*)(bglu + c0), b1 = *(const f32x4*)(bglu + c0 + 4);
                        const f32x4 v0 = acc[ai][bj][m][0] + b0, v1 = acc[ai][bj][m][1] + b1; float o[8];
                        o[0] = yf[0] * sigm(v0[0]); o[1] = yf[1] * sigm(v0[1]); o[2] = yf[2] * sigm(v0[2]); o[3] = yf[3] * sigm(v0[3]);
                        o[4] = yf[4] * sigm(v1[0]); o[5] = yf[5] * sigm(v1[1]); o[6] = yf[6] * sigm(v1[2]); o[7] = yf[7] * sigm(v1[3]);
                        u32x4 w; w.x = cvt_pk_bf16(o[0], o[1]); w.y = cvt_pk_bf16(o[2], o[3]); w.z = cvt_pk_bf16(o[4], o[5]); w.w = cvt_pk_bf16(o[6], o[7]);
                        *(u32x4*)(Ob + (size_t)r * DM + 768 + c0) = w; } }
        } else if (mode == 4) {
#pragma unroll
            for (int ai = 0; ai < 2; ++ai)
#pragma unroll
                for (int m = 0; m < 4; ++m) { const int r = row0 + ai * HALF + m * 16;
#pragma unroll
                    for (int bj = 0; bj < 2; ++bj) { const int c0 = u.pn * BM + bj * HALF + wc * 32 + 8 * fq;
                        const f32x4 v0 = acc[ai][bj][m][0], v1 = acc[ai][bj][m][1];
                        u32x4 w; w.x = cvt_pk_bf16(v0[0], v0[1]); w.y = cvt_pk_bf16(v0[2], v0[3]); w.z = cvt_pk_bf16(v1[0], v1[1]); w.w = cvt_pk_bf16(v1[2], v1[3]);
                        *(u32x4*)(P + (size_t)r * 4096 + c0) = w; } }
        } else if (mode == 5) {
            const int ch0 = 64 * u.pn + 16 * wc + 4 * fq;
            f32x4 bv[4];
#pragma unroll
            for (int b = 0; b < 4; ++b) bv[b] = *(const f32x4*)(bgate + b * 1024 + ch0);
#pragma unroll
            for (int ai = 0; ai < 2; ++ai)
#pragma unroll
                for (int m = 0; m < 4; ++m) { const int r = row0 + ai * HALF + m * 16; f32x4 mix = (f32x4){0.f, 0.f, 0.f, 0.f};
#pragma unroll
                    for (int bj = 0; bj < 2; ++bj)
#pragma unroll
                        for (int n = 0; n < 2; ++n) { const int b = 2 * bj + n; const f32x4 a = acc[ai][bj][m][n] + bv[b];
                            const u32x2 pw = *(const u32x2*)(P + (size_t)r * 4096 + b * 1024 + ch0);
                            mix[0] += sigm(a[0]) * bflo(pw.x); mix[1] += sigm(a[1]) * bfhi(pw.x); mix[2] += sigm(a[2]) * bflo(pw.y); mix[3] += sigm(a[3]) * bfhi(pw.y); }
                    u32x2 w; w.x = cvt_pk_bf16(mix[0], mix[1]); w.y = cvt_pk_bf16(mix[2], mix[3]);
                    *(u32x2*)(MIX + (size_t)r * DM + ch0) = w; }
        } else if (mode == 6) {
#pragma unroll
            for (int ai = 0; ai < 2; ++ai)
#pragma unroll
                for (int m = 0; m < 4; ++m) { const int r = row0 + ai * HALF + m * 16;
#pragma unroll
                    for (int bj = 0; bj < 2; ++bj)
#pragma unroll
                        for (int n = 0; n < 2; ++n) { const int c = u.pn * BM + bj * HALF + wc * 32 + n * 16 + 4 * fq;
                            const f32x4 xr = *(const f32x4*)(xres + (size_t)r * DM + c);
                            *(f32x4*)(xout + (size_t)r * DM + c) = xr * ALPHA + acc[ai][bj][m][n]; } }
        } else {
#pragma unroll
            for (int ai = 0; ai < 2; ++ai)
#pragma unroll
                for (int m = 0; m < 4; ++m) { const int r = row0 + ai * HALF + m * 16;
#pragma unroll
                    for (int bj = 0; bj < 2; ++bj) { const int ch0 = 128 * u.pn + 64 * bj + 16 * wc + 4 * fq;
                        const f32x4 gt = acc[ai][bj][m][0], up = acc[ai][bj][m][1];
                        u32x2 w; w.x = cvt_pk_bf16(silu_f(gt[0]) * up[0], silu_f(gt[1]) * up[1]); w.y = cvt_pk_bf16(silu_f(gt[2]) * up[2], silu_f(gt[3]) * up[3]);
                        *(u32x2*)(HF + (size_t)r * DFF + ch0) = w; } }
        }
    }
};

__device__ __forceinline__ void gemm_phase(LAS unsigned char* lds, const Gemm g, const Sched& S, const Epi& E) {
    const int tid = otid(), wid = __builtin_amdgcn_readfirstlane(tid >> 6), lane = tid & 63, wr = wid >> 2, wc = wid & 3, fr = lane & 15, fq = lane >> 4;
    const int K = g.K, nt = K / BK;
    unsigned voffA[2], voffB[2];
#pragma unroll
    for (int i = 0; i < 2; ++i) { int R, C; stage_rc(tid * 16 + i * 8192, R, C); const int Rb = E.perm ? ((R & ~31) + perm32(R & 31)) : R;
        voffA[i] = (unsigned)(R * g.lda + C) * 2u; voffB[i] = (unsigned)(Rb * g.ldb + C) * 2u; }
    const size_t kstep = (size_t)(BK * 2);
    const size_t hstepA = (size_t)HALF * g.lda * 2, hstepB = (size_t)HALF * g.ldb * 2;
    const size_t tstepA = 2 * hstepA, tstepB = 2 * hstepB;
    const unsigned ldsw = (unsigned)wid * 1024u;
    const int aoff = lds_byte(wr * 64 + fr, fq * 8), boff = lds_byte(wc * 32 + fr, fq * 8);
#define PG8_SA(b, h) (((b) * 2 + (h)) * HTB)
#define PG8_SB(b, h) ((4 + (b) * 2 + (h)) * HTB)
#define PG8_STAGE(bufoff, gbase, voff) do { _Pragma("unroll") for (int _i = 0; _i < 2; ++_i) \
        __builtin_amdgcn_global_load_lds((const unsigned*)((const char*)(gbase) + (voff)[_i]), (LAS unsigned*)(lds + (bufoff) + ldsw + _i * 8192), 16, 0, 0); } while (0)
#define PG8_LDA(dst, b, h) do { _Pragma("unroll") for (int m = 0; m < 4; ++m) _Pragma("unroll") for (int k = 0; k < 2; ++k) dst[m][k] = *(const LAS bf16x8*)(lds + PG8_SA(b, h) + aoff + m * 2048 + k * 1024); } while (0)
#define PG8_LDB(dst, b, h) do { _Pragma("unroll") for (int n = 0; n < 2; ++n) _Pragma("unroll") for (int k = 0; k < 2; ++k) dst[n][k] = *(const LAS bf16x8*)(lds + PG8_SB(b, h) + boff + n * 2048 + k * 1024); } while (0)
#define PG8_MMA(ai, bj, At, Bt) do { __builtin_amdgcn_s_setprio(1); _Pragma("unroll") for (int m = 0; m < 4; ++m) _Pragma("unroll") for (int n = 0; n < 2; ++n) _Pragma("unroll") for (int k = 0; k < 2; ++k) \
        acc[ai][bj][m][n] = __builtin_amdgcn_mfma_f32_16x16x32_bf16(Bt[n][k], At[m][k], acc[ai][bj][m][n], 0, 0, 0); __builtin_amdgcn_s_setprio(0); } while (0)
#define PG8_WAIT_V(n) asm volatile("s_waitcnt vmcnt(" #n ")" ::: "memory")
#define PG8_WAIT_L(n) asm volatile("s_waitcnt lgkmcnt(" #n ")" ::: "memory")
#define PG8_BAR __builtin_amdgcn_s_barrier()
#define PG8_SCHED __builtin_amdgcn_sched_barrier(0)
    Unit cur, nxt; int ui = 0;
    if (!S.next(0, cur)) return;
    f32x4 acc[2][2][4][2];
#pragma unroll
    for (int a = 0; a < 2; ++a)
#pragma unroll
        for (int b = 0; b < 2; ++b)
#pragma unroll
            for (int m = 0; m < 4; ++m)
#pragma unroll
                for (int n = 0; n < 2; ++n) acc[a][b][m][n] = (f32x4){0.f, 0.f, 0.f, 0.f};
    bf16x8 At[4][2], B0[2][2], B1[2][2];
    const char* cA = (const char*)g.A + (size_t)cur.pm * tstepA + (size_t)cur.ak * 2; const char* cB = (const char*)g.Bt + (size_t)cur.pn * tstepB;
    PG8_STAGE(PG8_SB(0, 0), cB, voffB); PG8_STAGE(PG8_SB(0, 1), cB + hstepB, voffB); PG8_STAGE(PG8_SA(0, 0), cA, voffA); PG8_STAGE(PG8_SA(0, 1), cA + hstepA, voffA);
    if (wr == 1) PG8_BAR;
    PG8_WAIT_V(2); PG8_BAR;
    PG8_STAGE(PG8_SB(1, 0), cB + kstep, voffB); PG8_STAGE(PG8_SA(1, 0), cA + kstep, voffA); PG8_STAGE(PG8_SB(1, 1), cB + hstepB + kstep, voffB);
    PG8_WAIT_V(6); PG8_BAR;
    for (;;) {
        const bool has_next = S.next(ui + 1, nxt);
        const char* nA = has_next ? (const char*)g.A + (size_t)nxt.pm * tstepA + (size_t)nxt.ak * 2 : cA; const char* nB = has_next ? (const char*)g.Bt + (size_t)nxt.pn * tstepB : cB;
        for (int t = 0; t < nt; t += 2) {
            const bool last = (t == nt - 2);
            const char* a1 = cA + (size_t)(t + 1) * kstep;
            const char* a2 = last ? nA : cA + (size_t)(t + 2) * kstep; const char* b2 = last ? nB : cB + (size_t)(t + 2) * kstep;
            const char* a3 = a2 + kstep; const char* b3 = b2 + kstep;
            PG8_LDB(B0, 0, 0); PG8_LDB(B1, 0, 1); PG8_SCHED; PG8_LDA(At, 0, 0); PG8_STAGE(PG8_SA(1, 1), a1 + hstepA, voffA);
            PG8_WAIT_V(8); PG8_WAIT_L(0); PG8_BAR; PG8_MMA(0, 0, At, B0); PG8_MMA(0, 1, At, B1); PG8_BAR; PG8_SCHED;
            PG8_LDA(At, 0, 1); PG8_STAGE(PG8_SB(0, 0), b2, voffB); PG8_STAGE(PG8_SB(0, 1), b2 + hstepB, voffB); PG8_STAGE(PG8_SA(0, 0), a2, voffA);
            PG8_WAIT_V(8); PG8_WAIT_L(0); PG8_BAR; PG8_MMA(1, 0, At, B0); PG8_MMA(1, 1, At, B1); PG8_BAR; PG8_SCHED;
            PG8_LDB(B0, 1, 0); PG8_LDB(B1, 1, 1); PG8_SCHED; PG8_LDA(At, 1, 0); PG8_STAGE(PG8_SA(0, 1), a2 + hstepA, voffA);
            PG8_WAIT_V(8); PG8_WAIT_L(0); PG8_BAR; PG8_MMA(0, 0, At, B0); PG8_MMA(0, 1, At, B1); PG8_BAR; PG8_SCHED;
            PG8_LDA(At, 1, 1); PG8_STAGE(PG8_SB(1, 0), b3, voffB); PG8_STAGE(PG8_SB(1, 1), b3 + hstepB, voffB); PG8_STAGE(PG8_SA(1, 0), a3, voffA);
            PG8_WAIT_V(8); PG8_WAIT_L(0); PG8_BAR; PG8_MMA(1, 0, At, B0); PG8_MMA(1, 1, At, B1); PG8_BAR; PG8_SCHED;
        }
        if (wr == 0) PG8_BAR;
        { const int t2 = otid(), w2 = __builtin_amdgcn_readfirstlane(t2 >> 6), l2 = t2 & 63;
          E(acc, cur, w2 >> 2, w2 & 3, l2 & 15, l2 >> 4); }
        if (!has_next) break;
#pragma unroll
        for (int a = 0; a < 2; ++a)
#pragma unroll
            for (int b = 0; b < 2; ++b)
#pragma unroll
                for (int m = 0; m < 4; ++m)
#pragma unroll
                    for (int n = 0; n < 2; ++n) acc[a][b][m][n] = (f32x4){0.f, 0.f, 0.f, 0.f};
        cur = nxt; cA = nA; cB = nB; ++ui;
        if (wr == 1) PG8_BAR;
    }
    PG8_WAIT_V(0);
    PG8_BAR;
#undef PG8_SA
#undef PG8_SB
#undef PG8_STAGE
#undef PG8_LDA
#undef PG8_LDB
#undef PG8_MMA
#undef PG8_WAIT_V
#undef PG8_WAIT_L
#undef PG8_BAR
#undef PG8_SCHED
}
}

__device__ __forceinline__ int dest_row(int dmode, int arg, int n) {
    if (dmode == 1) { return ((n >> 6) << 8) + ((arg >> 1) << 7) + (((n >> 4) & 3) << 5) + ((arg & 1) << 4) + (n & 15); }
    if (dmode == 2) { return ((n >> 7) << 8) + (((n >> 6) & 1) << 7) + (((n >> 4) & 3) << 5) + (arg << 4) + (n & 15); }
    return n + arg;
}
__device__ __forceinline__ void transpose_item(const float* W, int K, int Nsrc, bf16_t* WT, int dmode, int arg, LAS float* scr, int kb, int nb, int lane) {
    const int k0 = 64 * kb, n0 = 32 * nb;
    const int nsrc = n0 + (lane & 31); const bool ok = nsrc < Nsrc;
#pragma unroll 8
    for (int i = 0; i < 32; ++i) { const int kk = 2 * i + (lane >> 5); scr[kk * 33 + (lane & 31)] = ok ? W[(size_t)(k0 + kk) * Nsrc + nsrc] : 0.f; }
    asm volatile("s_waitcnt lgkmcnt(0)" ::: "memory");
    const int c = lane & 7;
#pragma unroll
    for (int j = 0; j < 4; ++j) { const int n = (lane >> 3) + 8 * j; const LAS float* s = scr + (8 * c) * 33 + n;
        u32x4 o; o.x = pk2(s[0 * 33], s[1 * 33]); o.y = pk2(s[2 * 33], s[3 * 33]); o.z = pk2(s[4 * 33], s[5 * 33]); o.w = pk2(s[6 * 33], s[7 * 33]);
        *(u32x4*)(WT + (size_t)dest_row(dmode, arg, n0 + n) * K + k0 + 8 * c) = o; }
    asm volatile("s_waitcnt lgkmcnt(0)" ::: "memory");
}

__device__ __forceinline__ void s5_abar_pow(float lr, float li, float dt, int n, float& re, float& im) {
    const float mag = expf((float)n * lr * dt);
    const double a = (double)n * ((double)li * (double)dt);
    const double k = __builtin_rint(a * 0.15915494309189535);
    const float r = (float)__builtin_fma(-k, 6.283185307179586, a);
    re = mag * cosf(r); im = mag * sinf(r);
}
__device__ __forceinline__ void s5_coef(float lr, float li, float dt, float& cr, float& ci) {
    const float th = li * dt, em1 = expm1f(lr * dt), c1 = cosf(th), s1 = sinf(th), sh = sinf(0.5f * th);
    const float nr = em1 * c1 - 2.f * sh * sh, ni = (1.f + em1) * s1, den = lr * lr + li * li;
    cr = (nr * lr + ni * li) / den; ci = (ni * lr - nr * li) / den;
}

__device__ __forceinline__ void s5_tables(CPP p, int l, LAS unsigned char* lds) {
    LAS float* abr = (LAS float*)lds;
    LAS float* abi = abr + 1024;
    LAS float* cr = abi + 1024;
    LAS float* ci = cr + 16 * 65;
    float* KN = (float*)(p->ws + WS_KN);
    const int tid = otid();
    for (int it = obid(); it < 1024; it += ogrid()) {
        const int g = it >> 6, n = it & 63;
        __syncthreads();
        for (int e = tid; e < 1024; e += 512) { const int pp = e >> 4, c = e & 15; const int gp = (l * 16 + g) * 64 + pp;
            const float lr = p->in[5][gp], li = p->in[6][gp], dt = expf(p->in[7][l * 16 + g]);
            float ar, ai2; s5_abar_pow(lr, li, dt, n, ar, ai2);
            float qr, qi; s5_coef(lr, li, dt, qr, qi);
            const float br = p->in[8][(size_t)gp * 16 + c], bi = p->in[9][(size_t)gp * 16 + c];
            const float bbr = qr * br - qi * bi, bbi = qr * bi + qi * br;
            abr[e] = ar * bbr - ai2 * bbi; abi[e] = ar * bbi + ai2 * bbr; }
        for (int e = tid; e < 1024; e += 512) { const int i = e >> 6, pp = e & 63; const size_t gi = ((size_t)(l * 16 + g) * 16 + i) * 64 + pp;
            cr[i * 65 + pp] = p->in[10][gi]; ci[i * 65 + pp] = p->in[11][gi]; }
        __syncthreads();
        if (tid < 256) { const int i = tid >> 4, c = tid & 15; float s = 0.f;
#pragma unroll 8
            for (int pp = 0; pp < 64; ++pp) s += cr[i * 65 + pp] * abr[pp * 16 + c] - ci[i * 65 + pp] * abi[pp * 16 + c];
            KN[((size_t)(g * 64 + n) * 16 + i) * 16 + c] = s; }
    }
}

__device__ __forceinline__ void convert_weights(CPP p, int l, LAS unsigned char* lds) {
    const int tid = otid(), lane = tid & 63, wave = tid >> 6;
    LAS float* scr = (LAS float*)(lds + wave * 16384);
    const int gw = obid() * 8 + wave, NGW = ogrid() * 8;
    unsigned char* ws = p->ws;
    constexpr int J0 = 1408, J1 = J0 + 2048, J2 = J1 + 512, J3 = J2 + 512, J4 = J3 + 2816, J5 = J4 + 1408, J6 = J5 + 32;
    for (int it = gw; it < J6; it += NGW) {
        if (it < J0) { const int r = it; transpose_item(p->in[1] + (size_t)l * 1024 * 2576, 1024, 2576, (bf16_t*)(ws + WS_WIN), 0, 0, scr, r / 88, r % 88, lane); }
        else if (it < J1) { const int r = it - J0, b = r >> 9, q = r & 511; transpose_item(p->in[15] + ((size_t)l * 4 + b) * 1024 * 1024, 1024, 1024, (bf16_t*)(ws + WS_WG), 1, b, scr, q >> 5, q & 31, lane); }
        else if (it < J2) { const int r = it - J1, b = r >> 7, q = r & 127; transpose_item(p->in[17] + ((size_t)l * 4 + b) * 256 * 1024, 256, 1024, (bf16_t*)(ws + WS_WB) + (size_t)b * 1024 * 256, 0, 0, scr, q >> 5, q & 31, lane); }
        else if (it < J3) { const int q = it - J2; transpose_item(p->in[18] + (size_t)l * 1024 * 1024, 1024, 1024, (bf16_t*)(ws + WS_WO), 0, 0, scr, q >> 5, q & 31, lane); }
        else if (it < J4) { const int r = it - J3, wch = r / 1408, q = r % 1408; transpose_item(p->in[wch ? 22 : 21] + (size_t)l * 1024 * 2816, 1024, 2816, (bf16_t*)(ws + WS_WFF), 2, wch, scr, q / 88, q % 88, lane); }
        else if (it < J5) { const int q = it - J4; transpose_item(p->in[23] + (size_t)l * 2816 * 1024, 2816, 1024, (bf16_t*)(ws + WS_WD), 0, 0, scr, q >> 5, q & 31, lane); }
        else { const int q = it - J5; transpose_item(p->in[13] + (size_t)l * 256 * 256, 256, 256, (bf16_t*)(ws + WS_WGLU), 0, 0, scr, q >> 3, q & 7, lane); }
    }
    const int gt = obid() * 512 + tid, NT = ogrid() * 512;
    bf16_t* WE = (bf16_t*)(ws + WS_WE);
    for (int e = gt; e < 65536; e += NT) { const int s = e & 63, pp = (e >> 6) & 63, g = e >> 12; const int gp = (l * 16 + g) * 64 + pp;
        const float lr = p->in[5][gp], li = p->in[6][gp], dt = expf(p->in[7][l * 16 + g]);
        float ar, ai2; s5_abar_pow(lr, li, dt, 63 - s, ar, ai2);
        float qr, qi; s5_coef(lr, li, dt, qr, qi);
        float wr_[16], wi_[16];
#pragma unroll
        for (int c = 0; c < 16; ++c) { const float br = p->in[8][(size_t)gp * 16 + c], bi = p->in[9][(size_t)gp * 16 + c];
            const float bbr = qr * br - qi * bi, bbi = qr * bi + qi * br; wr_[c] = ar * bbr - ai2 * bbi; wi_[c] = ar * bbi + ai2 * bbr; }
        bf16_t* dr = WE + ((size_t)(g * 256 + pp)) * 1024 + s * 16; bf16_t* di = WE + ((size_t)(g * 256 + 64 + pp)) * 1024 + s * 16;
        *(u32x4*)dr = pack8(wr_); *(u32x4*)(dr + 8) = pack8(wr_ + 8); *(u32x4*)di = pack8(wi_); *(u32x4*)(di + 8) = pack8(wi_ + 8); }
    for (int e = gt; e < 16 * 128 * 128; e += NT) { const int c8 = e & 127, n = (e >> 7) & 127, g = e >> 14;
        *(u32x4*)(WE + ((size_t)(g * 256 + 128 + n)) * 1024 + c8 * 8) = (u32x4){0u, 0u, 0u, 0u}; }
    bf16_t* WT = (bf16_t*)(ws + WS_WT); const float* KN = (const float*)(ws + WS_KN);
    for (int e = gt; e < 16 * 1024 * 64; e += NT) { const int s = e & 63, row = (e >> 6) & 1023, g = e >> 16; const int j = row >> 4, i = row & 15;
        u32x4 w0 = (u32x4){0u, 0u, 0u, 0u}, w1 = w0;
        if (s <= j) { const float* k = KN + ((size_t)(g * 64 + (j - s)) * 16 + i) * 16; float v[16];
#pragma unroll
            for (int c = 0; c < 16; c += 4) { const f32x4 t = *(const f32x4*)(k + c); v[c] = t[0]; v[c + 1] = t[1]; v[c + 2] = t[2]; v[c + 3] = t[3]; }
            w0 = pack8(v); w1 = pack8(v + 8); }
        bf16_t* d = WT + ((size_t)(g * 1024 + row)) * S5K + s * 16; *(u32x4*)d = w0; *(u32x4*)(d + 8) = w1; }
    for (int e = gt; e < 16 * 1024 * 64; e += NT) { const int pp = e & 63, row = (e >> 6) & 1023, g = e >> 16; const int j = row >> 4, i = row & 15; const int gp = (l * 16 + g) * 64 + pp;
        const float lr = p->in[5][gp], li = p->in[6][gp], dt = expf(p->in[7][l * 16 + g]);
        float ar, ai2; s5_abar_pow(lr, li, dt, j + 1, ar, ai2);
        const size_t gi = ((size_t)(l * 16 + g) * 16 + i) * 64 + pp; const float c_r = p->in[10][gi], c_i = p->in[11][gi];
        bf16_t* d = WT + ((size_t)(g * 1024 + row)) * S5K + 1024 + pp;
        d[0] = (bf16_t)f2bf(c_r * ar - c_i * ai2); d[64] = (bf16_t)f2bf(-(c_r * ai2 + c_i * ar)); }
}

__device__ __forceinline__ void ln_pass(float* x, bf16_t* xb, const float* gam, const float* bet) {
    const int lane = otid() & 63, gw = obid() * 8 + (otid() >> 6), NGW = ogrid() * 8;
    f32x4 gv[4], bv[4];
#pragma unroll
    for (int j = 0; j < 4; ++j) { gv[j] = *((const f32x4*)gam + lane + 64 * j); bv[j] = *((const f32x4*)bet + lane + 64 * j); }
    for (int m = gw; m < M; m += NGW) {
        f32x4* xr = (f32x4*)(x + (size_t)m * DM) + lane;
        f32x4 v[4]; float s = 0.f;
#pragma unroll
        for (int j = 0; j < 4; ++j) { v[j] = xr[64 * j]; s += (v[j].x + v[j].y) + (v[j].z + v[j].w); }
        const float mean = wave_sum(s) * (1.f / DM); float s2 = 0.f;
#pragma unroll
        for (int j = 0; j < 4; ++j) { v[j] = v[j] - mean; s2 += (v[j].x * v[j].x + v[j].y * v[j].y) + (v[j].z * v[j].z + v[j].w * v[j].w); }
        const float rstd = 1.f / sqrtf(wave_sum(s2) * (1.f / DM) + LN_EPS);
        u32x2* o8 = (u32x2*)(xb + (size_t)m * DM) + lane;
#pragma unroll
        for (int j = 0; j < 4; ++j) { const f32x4 y = v[j] * rstd * gv[j] + bv[j]; xr[64 * j] = y; u32x2 w; w.x = pk2(y.x, y.y); w.y = pk2(y.z, y.w); o8[64 * j] = w; }
    }
}

__device__ __forceinline__ void load_tile64(const bf16_t* src, int pitch, LAS float* dst, int dpitch, float scale, int tid) {
    const int idx = tid * 8, r = idx >> 6, c = idx & 63;
    const u32x4 w = *(const u32x4*)(src + (size_t)r * pitch + c); float f[8]; unpack8(w, f);
#pragma unroll
    for (int e = 0; e < 8; ++e) dst[r * dpitch + c + e] = f[e] * scale;
}

__device__ __forceinline__ void attn_items(CPP p, int l, LAS unsigned char* lds) {
    LAS float* Qs = (LAS float*)lds; LAS float* Ks = Qs + 64 * 68; LAS float* Vs = Ks + 64 * 68; LAS float* Ps = Vs + 64 * 68; LAS float* bs = Ps + 64 * 65;
    const bf16_t* H = (const bf16_t*)(p->ws + WS_E); bf16_t* O = (bf16_t*)(p->ws + WS_O);
    const int tid = otid(), row = tid >> 3, sub = tid & 7;
    for (int it = obid(); it < 4096; it += ogrid()) {
        const int h = it & 3, bi = it >> 2, i = bi & 31, b = bi >> 5;
        const size_t t0 = (size_t)bi * 64;
        __syncthreads();
        load_tile64(H + t0 * NH + C_AQ + h * 64, NH, Qs, 68, 0.125f, tid);
        if (tid < 257) bs[tid] = p->in[4][(size_t)(l * 4 + h) * 257 + tid];
        __syncthreads();
        float q[64], o[8];
#pragma unroll
        for (int d = 0; d < 64; d += 4) { const f32x4 t = *(const LAS f32x4*)(Qs + row * 68 + d); q[d] = t[0]; q[d + 1] = t[1]; q[d + 2] = t[2]; q[d + 3] = t[3]; }
#pragma unroll
        for (int e = 0; e < 8; ++e) o[e] = 0.f;
        float mx = -1e30f, ls = 0.f;
        const int kc0 = i > 8 ? i - 8 : 0;
        for (int kc = kc0; kc <= i; ++kc) {
            __syncthreads();
            const size_t tk = ((size_t)b * 32 + kc) * 64;
            load_tile64(H + tk * NH + C_AK + h * 64, NH, Ks, 68, 1.f, tid);
            load_tile64(H + tk * NH + C_AV + h * 64, NH, Vs, 68, 1.f, tid);
            __syncthreads();
            float s[8]; float cm = -1e30f;
#pragma unroll
            for (int jj = 0; jj < 8; ++jj) { const int key = sub + 8 * jj; float a = 0.f;
#pragma unroll
                for (int d = 0; d < 64; d += 4) { const f32x4 t = *(const LAS f32x4*)(Ks + key * 68 + d); a += q[d] * t[0] + q[d + 1] * t[1] + q[d + 2] * t[2] + q[d + 3] * t[3]; }
                int diff = (i - kc) * 64 + row - key; diff = diff > 128 ? 128 : diff;
                a += bs[diff + 128]; s[jj] = a; cm = fmaxf(cm, a); }
            cm = fmaxf(cm, __shfl_xor(cm, 1)); cm = fmaxf(cm, __shfl_xor(cm, 2)); cm = fmaxf(cm, __shfl_xor(cm, 4));
            const float mn = fmaxf(mx, cm), sc = __expf(mx - mn); mx = mn;
            float ps = 0.f;
#pragma unroll
            for (int jj = 0; jj < 8; ++jj) { const float pr = __expf(s[jj] - mn); ps += pr; Ps[row * 65 + sub + 8 * jj] = pr; }
            ps += __shfl_xor(ps, 1); ps += __shfl_xor(ps, 2); ps += __shfl_xor(ps, 4);
            ls = ls * sc + ps;
#pragma unroll
            for (int e = 0; e < 8; ++e) o[e] *= sc;
            asm volatile("s_waitcnt lgkmcnt(0)" ::: "memory");
#pragma unroll 8
            for (int key = 0; key < 64; ++key) { const float pr = Ps[row * 65 + key];
                const f32x4 v0 = *(const LAS f32x4*)(Vs + key * 68 + sub * 8), v1 = *(const LAS f32x4*)(Vs + key * 68 + sub * 8 + 4);
                o[0] += pr * v0[0]; o[1] += pr * v0[1]; o[2] += pr * v0[2]; o[3] += pr * v0[3]; o[4] += pr * v1[0]; o[5] += pr * v1[1]; o[6] += pr * v1[2]; o[7] += pr * v1[3]; }
        }
        const float inv = 1.f / ls;
#pragma unroll
        for (int e = 0; e < 8; ++e) o[e] *= inv;
        *(u32x4*)(O + (t0 + row) * DM + 256 + h * 64 + sub * 8) = pack8(o);
    }
}

typedef float f32x16 __attribute__((ext_vector_type(16)));
typedef short s16x4 __attribute__((ext_vector_type(4)));
__device__ __forceinline__ s16x4 lds_tr16(LAS const unsigned char* ptr) { return __builtin_bit_cast(s16x4, __builtin_amdgcn_ds_read_tr16_b64_v4i16((LAS s16x4*)ptr)); }
__device__ __forceinline__ bf16x8 scale_frag(u32x4 w, float sc) { float f[8]; unpack8(w, f);
    u32x4 o; o.x = pk2(f[0] * sc, f[1] * sc); o.y = pk2(f[2] * sc, f[3] * sc); o.z = pk2(f[4] * sc, f[5] * sc); o.w = pk2(f[6] * sc, f[7] * sc); return __builtin_bit_cast(bf16x8, o); }
__device__ __forceinline__ void attn_mfma(CPP p, int l, LAS unsigned char* lds) {
    const int tid = otid(), lane = tid & 63, wid = __builtin_amdgcn_readfirstlane(tid >> 6), r32 = lane & 31, hi = lane >> 5;
    const int h = wid >> 1, qh = wid & 1;
    LAS unsigned char* Vl = lds + wid * 17536;
    LAS unsigned char* stg = Vl;
    LAS float* bs = (LAS float*)(Vl + 16384);
    const bf16_t* H = (const bf16_t*)(p->ws + WS_E); bf16_t* O = (bf16_t*)(p->ws + WS_O);
    __syncthreads();
    for (int e = lane; e < 257; e += 64) bs[e] = p->in[4][(size_t)(l * 4 + h) * 257 + e];
    const float bfar = p->in[4][(size_t)(l * 4 + h) * 257 + 256];
#define ATT_VDMA(tk, buf) do { _Pragma("unroll") for (int c = 0; c < 8; ++c) \
        __builtin_amdgcn_global_load_lds((const unsigned*)(H + ((tk) + c * 8 + (lane >> 3)) * NH + C_AV + h * 64 + (lane & 7) * 8), (LAS unsigned*)(Vl + (buf) * 8192 + c * 1024), 16, 0, 0); } while (0)
    for (int it = obid(); it < 1024; it += ogrid()) {
        const int i = it & 31; const size_t t0 = (size_t)it * 64;
        bf16x8 qf[4];
#pragma unroll
        for (int t = 0; t < 4; ++t) qf[t] = scale_frag(*(const u32x4*)(H + (t0 + qh * 32 + r32) * NH + C_AQ + h * 64 + 16 * t + 8 * hi), 0.125f);
        const int kc0 = i > 8 ? i - 8 : 0;
        u32x4 kr[8], kn[8];
        asm volatile("s_waitcnt lgkmcnt(0)" ::: "memory");
        { const size_t tk = t0 - (size_t)(i - kc0) * 64;
#pragma unroll
            for (int t = 0; t < 4; ++t) { kn[t] = *(const u32x4*)(H + (tk + r32) * NH + C_AK + h * 64 + 16 * t + 8 * hi); kn[4 + t] = *(const u32x4*)(H + (tk + 32 + r32) * NH + C_AK + h * 64 + 16 * t + 8 * hi); }
            ATT_VDMA(tk, 0); }
        f32x16 o0, o1;
#pragma unroll
        for (int v = 0; v < 16; ++v) { o0[v] = 0.f; o1[v] = 0.f; }
        float mx = -1e30f, ls = 0.f;
        int cb = 0;
        for (int kc = kc0; kc <= i; ++kc) {
            const bool more = kc < i;
            asm volatile("s_waitcnt vmcnt(0)" ::: "memory");
#pragma unroll
            for (int c = 0; c < 8; ++c) kr[c] = kn[c];
            if (more) { const size_t tk = t0 - (size_t)(i - kc - 1) * 64;
#pragma unroll
                for (int t = 0; t < 4; ++t) { kn[t] = *(const u32x4*)(H + (tk + r32) * NH + C_AK + h * 64 + 16 * t + 8 * hi); kn[4 + t] = *(const u32x4*)(H + (tk + 32 + r32) * NH + C_AK + h * 64 + 16 * t + 8 * hi); }
                ATT_VDMA(tk, cb ^ 1); }
            f32x16 p0, p1;
#pragma unroll
            for (int v = 0; v < 16; ++v) { p0[v] = 0.f; p1[v] = 0.f; }
#pragma unroll
            for (int t = 0; t < 4; ++t) { p0 = __builtin_amdgcn_mfma_f32_32x32x16_bf16(__builtin_bit_cast(bf16x8, kr[t]), qf[t], p0, 0, 0, 0);
                p1 = __builtin_amdgcn_mfma_f32_32x32x16_bf16(__builtin_bit_cast(bf16x8, kr[4 + t]), qf[t], p1, 0, 0, 0); }
            const int dl = i - kc;
            if (dl >= 3) {
#pragma unroll
                for (int v = 0; v < 16; ++v) { p0[v] += bfar; p1[v] += bfar; }
            } else { const int base = dl * 64 + qh * 32 + r32 - 4 * hi + 128;
#pragma unroll
                for (int v = 0; v < 16; ++v) { const int kv = (v & 3) + 8 * (v >> 2); int d0 = base - kv, d1 = base - kv - 32; d0 = d0 > 256 ? 256 : d0; d1 = d1 > 256 ? 256 : d1;
                    p0[v] += bs[d0]; p1[v] += bs[d1]; } }
            float cm = fmaxf(p0[0], p1[0]);
#pragma unroll
            for (int v = 1; v < 16; ++v) cm = fmaxf(cm, fmaxf(p0[v], p1[v]));
            cm = fmaxf(cm, __shfl_xor(cm, 32));
            const float mn = fmaxf(mx, cm), al = __expf(mx - mn); mx = mn;
            float ps = 0.f;
#pragma unroll
            for (int v = 0; v < 16; ++v) { p0[v] = __expf(p0[v] - mn); p1[v] = __expf(p1[v] - mn); ps += p0[v] + p1[v]; }
            ls = ls * al + ps;
#pragma unroll
            for (int v = 0; v < 16; ++v) { o0[v] *= al; o1[v] *= al; }
            bf16x8 pb[4];
            { u32x4 w; w.x = cvt_pk_bf16(p0[0], p0[1]); w.y = cvt_pk_bf16(p0[2], p0[3]); w.z = cvt_pk_bf16(p0[4], p0[5]); w.w = cvt_pk_bf16(p0[6], p0[7]); pb[0] = __builtin_bit_cast(bf16x8, w);
              w.x = cvt_pk_bf16(p0[8], p0[9]); w.y = cvt_pk_bf16(p0[10], p0[11]); w.z = cvt_pk_bf16(p0[12], p0[13]); w.w = cvt_pk_bf16(p0[14], p0[15]); pb[1] = __builtin_bit_cast(bf16x8, w);
              w.x = cvt_pk_bf16(p1[0], p1[1]); w.y = cvt_pk_bf16(p1[2], p1[3]); w.z = cvt_pk_bf16(p1[4], p1[5]); w.w = cvt_pk_bf16(p1[6], p1[7]); pb[2] = __builtin_bit_cast(bf16x8, w);
              w.x = cvt_pk_bf16(p1[8], p1[9]); w.y = cvt_pk_bf16(p1[10], p1[11]); w.z = cvt_pk_bf16(p1[12], p1[13]); w.w = cvt_pk_bf16(p1[14], p1[15]); pb[3] = __builtin_bit_cast(bf16x8, w); }
            const LAS unsigned char* vb = Vl + cb * 8192 + (4 * hi + ((lane & 15) >> 2)) * 128 + ((lane >> 4) & 1) * 32 + (lane & 3) * 8;
#pragma unroll
            for (int ks = 0; ks < 4; ++ks) {
#pragma unroll
                for (int dh = 0; dh < 2; ++dh) { const s16x4 lo = lds_tr16(vb + ks * 2048 + dh * 64), hh = lds_tr16(vb + ks * 2048 + 1024 + dh * 64);
                    const bf16x8 va = (bf16x8){lo[0], lo[1], lo[2], lo[3], hh[0], hh[1], hh[2], hh[3]};
                    if (dh == 0) o0 = __builtin_amdgcn_mfma_f32_32x32x16_bf16(va, pb[ks], o0, 0, 0, 0); else o1 = __builtin_amdgcn_mfma_f32_32x32x16_bf16(va, pb[ks], o1, 0, 0, 0); } }
            cb ^= 1;
        }
        ls += __shfl_xor(ls, 32);
        const float inv = 1.f / ls;
        asm volatile("s_waitcnt lgkmcnt(0)" ::: "memory");
#pragma unroll
        for (int v = 0; v < 16; ++v) { const int d = (v & 3) + 8 * (v >> 2) + 4 * hi;
            *(LAS bf16_t*)(stg + r32 * 144 + d * 2) = (bf16_t)f2bf(o0[v] * inv); *(LAS bf16_t*)(stg + r32 * 144 + (32 + d) * 2) = (bf16_t)f2bf(o1[v] * inv); }
        asm volatile("s_waitcnt lgkmcnt(0)" ::: "memory");
#pragma unroll
        for (int c = 0; c < 4; ++c) { const int row = c * 8 + (lane >> 3), ch = lane & 7; const u32x4 w = *(const LAS u32x4*)(stg + row * 144 + ch * 16);
            *(u32x4*)(O + (t0 + qh * 32 + row) * DM + 256 + h * 64 + ch * 8) = w; }
    }
#undef ATT_VDMA
}

__device__ __forceinline__ void load_rot(const bf16_t* src, const float* rot, int i, LAS float* dst, float scale, float logz, int tid) {
#pragma unroll
    for (int q = 0; q < 2; ++q) { const int idx = tid + 512 * q, j = idx >> 4, f = idx & 15;
        const float x1 = bf2f(src[(size_t)j * NH + f]), x2 = bf2f(src[(size_t)j * NH + f + 16]);
        const int pos = i * 64 + j; const float c = rot[pos * 32 + f], s = rot[pos * 32 + 16 + f];
        const float sc = scale * __expf(logz * (float)(63 - j));
        dst[j * 33 + f] = (x1 * c - x2 * s) * sc; dst[j * 33 + f + 16] = (x1 * s + x2 * c) * sc; }
}
__device__ __forceinline__ float ret_logg(int h) { return log1pf(-exp2f(-5.f - (float)h)); }

__device__ __forceinline__ void upd_items(CPP p, int l, LAS unsigned char* lds) {
    LAS float* kt = (LAS float*)lds; LAS float* vv = kt + 64 * 33; LAS float* la = vv + 64 * 68; LAS float* gas = la + 64 * 33; LAS float* was = gas + 1024; LAS float* bas = was + 512;
    const bf16_t* H = (const bf16_t*)(p->ws + WS_E); const float* rot = (const float*)(p->ws + WS_ROT);
    float* RU = (float*)(p->ws + WS_RU); float* GU = (float*)(p->ws + WS_GU); float* GL = (float*)(p->ws + WS_GL);
    const int tid = otid();
    for (int it = obid(); it < 8192; it += ogrid()) {
        const int gla = it >> 12, h = it & 3, bi = (it >> 2) & 1023, i = bi & 31;
        const size_t t0 = (size_t)bi * 64;
        __syncthreads();
        if (!gla) {
            load_rot(H + t0 * NH + C_RK + h * 32, rot, i, kt, 0.17677669529663689f, ret_logg(h), tid);
            load_tile64(H + t0 * NH + C_RV + h * 64, NH, vv, 68, 1.f, tid);
            __syncthreads();
        } else {
            if (tid < 128) { const int j = tid >> 1, c = (tid & 1) * 8; const u32x4 w = *(const u32x4*)(H + (t0 + j) * NH + C_GA + c); float f[8]; unpack8(w, f);
#pragma unroll
                for (int e = 0; e < 8; ++e) gas[j * 16 + c + e] = f[e]; }
            { const int r = tid >> 5, dk = tid & 31; was[tid] = p->in[2][(size_t)(l * 16 + r) * 128 + h * 32 + dk]; }
            if (tid < 32) bas[tid] = p->in[3][l * 128 + h * 32 + tid];
            { const int idx = tid * 4, j = idx >> 5, c = idx & 31; const u32x2 w = *(const u32x2*)(H + (t0 + j) * NH + C_GK + h * 32 + c);
                kt[j * 33 + c] = bflo(w.x); kt[j * 33 + c + 1] = bfhi(w.x); kt[j * 33 + c + 2] = bflo(w.y); kt[j * 33 + c + 3] = bfhi(w.y); }
            load_tile64(H + t0 * NH + C_GV + h * 64, NH, vv, 68, 1.f, tid);
            __syncthreads();
#pragma unroll
            for (int q = 0; q < 4; ++q) { const int e = tid + 512 * q, j = e >> 5, dk = e & 31; float z = bas[dk];
#pragma unroll
                for (int r = 0; r < 16; ++r) z += gas[j * 16 + r] * was[r * 32 + dk];
                const float lsg = fminf(z, 0.f) - log1pf(expf(-fabsf(z)));
                la[j * 33 + dk] = lsg * 0.0625f; }
            __syncthreads();
            if (tid < 32) { float run = 0.f; for (int j = 0; j < 64; ++j) { run += la[j * 33 + tid]; la[j * 33 + tid] = run; } }
            __syncthreads();
#pragma unroll
            for (int q = 0; q < 4; ++q) { const int e = tid + 512 * q, j = e >> 5, dk = e & 31; kt[j * 33 + dk] *= __expf(la[63 * 33 + dk] - la[j * 33 + dk]); }
            if (tid < 32) GL[(size_t)(bi * 4 + h) * 32 + tid] = la[63 * 33 + tid];
            __syncthreads();
        }
        const int dk = tid >> 4, dv0 = (tid & 15) * 4; f32x4 a = (f32x4){0.f, 0.f, 0.f, 0.f};
#pragma unroll 8
        for (int j = 0; j < 64; ++j) { const float kk = kt[j * 33 + dk]; const f32x4 v4 = *(const LAS f32x4*)(vv + j * 68 + dv0); a += v4 * kk; }
        float* dst = (gla ? GU : RU) + (size_t)(bi * 4 + h) * 2048 + dk * 64 + dv0;
        *(f32x4*)dst = a;
    }
}

__device__ __forceinline__ void scan_items(CPP p, int l) {
    float* RU = (float*)(p->ws + WS_RU); float* GU = (float*)(p->ws + WS_GU); const float* GL = (const float*)(p->ws + WS_GL);
    const float* ES = (const float*)(p->ws + WS_ES); bf16_t* U2 = (bf16_t*)(p->ws + WS_U2);
    const int gt = obid() * 512 + otid(), NT = ogrid() * 512;
    for (int e = gt; e < 262144; e += NT) { const int dvk = e & 2047, bh = e >> 11, h = bh & 3, b = bh >> 2;
        const float dec = expf(64.f * ret_logg(h)); float st = 0.f;
        for (int i = 0; i < 32; ++i) { const size_t idx = (size_t)((b * 32 + i) * 4 + h) * 2048 + dvk; const float t = RU[idx]; RU[idx] = st; st = st * dec + t; } }
    for (int e = gt; e < 262144; e += NT) { const int dvk = e & 2047, bh = e >> 11, h = bh & 3, b = bh >> 2; float st = 0.f;
        for (int i = 0; i < 32; ++i) { const size_t bih = (size_t)((b * 32 + i) * 4 + h); const float gl = GL[bih * 32 + (dvk >> 6)];
            st = __expf(gl) * st + GU[bih * 2048 + dvk]; GU[bih * 2048 + dvk] = st; } }
    for (int e = gt; e < 32768; e += NT) { const int pp = e & 63, g = (e >> 6) & 15, b = e >> 10; const int gp = (l * 16 + g) * 64 + pp;
        const float lr = p->in[5][gp], li = p->in[6][gp], dt = expf(p->in[7][l * 16 + g]);
        float ar, ai2; s5_abar_pow(lr, li, dt, 64, ar, ai2);
        float xr = 0.f, xi = 0.f;
        for (int i = 0; i < 32; ++i) { const size_t row = (size_t)g * 1024 + b * 32 + i;
            U2[row * S5K + 1024 + pp] = (bf16_t)f2bf(xr); U2[row * S5K + 1088 + pp] = (bf16_t)f2bf(xi);
            const float er = ES[row * 128 + pp], ei = ES[row * 128 + 64 + pp];
            const float nr = ar * xr - ai2 * xi + er, ni = ar * xi + ai2 * xr + ei; xr = nr; xi = ni; } }
}

__device__ __forceinline__ void out_items(CPP p, int l, LAS unsigned char* lds) {
    LAS float* qt = (LAS float*)lds; LAS float* kt = qt + 64 * 33; LAS float* vv = kt + 64 * 33; LAS float* Sm = vv + 64 * 68; LAS float* Rm = Sm + 64 * 65;
    const bf16_t* H = (const bf16_t*)(p->ws + WS_E); const float* rot = (const float*)(p->ws + WS_ROT); bf16_t* O = (bf16_t*)(p->ws + WS_O);
    const float* RU = (const float*)(p->ws + WS_RU); const float* GU = (const float*)(p->ws + WS_GU);
    const int tid = otid();
    for (int it = obid(); it < 8192; it += ogrid()) {
        const int gla = it >> 12, h = it & 3, bi = (it >> 2) & 1023, i = bi & 31;
        const size_t t0 = (size_t)bi * 64;
        const int n = tid >> 3, dv0 = (tid & 7) * 8;
        float acc[8];
#pragma unroll
        for (int e = 0; e < 8; ++e) acc[e] = 0.f;
        __syncthreads();
        { const float* src = (gla ? GU : RU) + (size_t)(bi * 4 + h) * 2048; const int idx = tid * 4, dk = idx >> 6, dv = idx & 63;
            const f32x4 t = *(const f32x4*)(src + idx); Rm[dk * 68 + dv] = t[0]; Rm[dk * 68 + dv + 1] = t[1]; Rm[dk * 68 + dv + 2] = t[2]; Rm[dk * 68 + dv + 3] = t[3]; }
        if (!gla) {
            const float lg = ret_logg(h);
            load_rot(H + t0 * NH + C_RQ + h * 32, rot, i, qt, 1.f, 0.f, tid);
            load_rot(H + t0 * NH + C_RK + h * 32, rot, i, kt, 0.17677669529663689f, 0.f, tid);
            load_tile64(H + t0 * NH + C_RV + h * 64, NH, vv, 68, 1.f, tid);
            __syncthreads();
            { const int m0 = (tid & 7) * 8;
#pragma unroll
                for (int mm = 0; mm < 8; ++mm) { const int m = m0 + mm; float d = 0.f;
#pragma unroll
                    for (int dk = 0; dk < 32; ++dk) d += qt[n * 33 + dk] * kt[m * 33 + dk];
                    const int ad = n > m ? n - m : m - n; Sm[n * 65 + m] = d * __expf(lg * (float)ad); } }
            __syncthreads();
#pragma unroll 4
            for (int m = 0; m < 64; ++m) { const float sv = Sm[n * 65 + m]; const f32x4 v0 = *(const LAS f32x4*)(vv + m * 68 + dv0), v1 = *(const LAS f32x4*)(vv + m * 68 + dv0 + 4);
                acc[0] += sv * v0[0]; acc[1] += sv * v0[1]; acc[2] += sv * v0[2]; acc[3] += sv * v0[3]; acc[4] += sv * v1[0]; acc[5] += sv * v1[1]; acc[6] += sv * v1[2]; acc[7] += sv * v1[3]; }
            const float xi = __expf(lg * (float)(n + 1));
#pragma unroll 4
            for (int dk = 0; dk < 32; ++dk) { const float qx = qt[n * 33 + dk] * xi; const f32x4 v0 = *(const LAS f32x4*)(Rm + dk * 68 + dv0), v1 = *(const LAS f32x4*)(Rm + dk * 68 + dv0 + 4);
                acc[0] += qx * v0[0]; acc[1] += qx * v0[1]; acc[2] += qx * v0[2]; acc[3] += qx * v0[3]; acc[4] += qx * v1[0]; acc[5] += qx * v1[1]; acc[6] += qx * v1[2]; acc[7] += qx * v1[3]; }
        } else {
            { const int idx = tid * 4, j = idx >> 5, c = idx & 31; const u32x2 w = *(const u32x2*)(H + (t0 + j) * NH + C_GQ + h * 32 + c); const float sc = 0.17677669529663689f;
                qt[j * 33 + c] = bflo(w.x) * sc; qt[j * 33 + c + 1] = bfhi(w.x) * sc; qt[j * 33 + c + 2] = bflo(w.y) * sc; qt[j * 33 + c + 3] = bfhi(w.y) * sc; }
            __syncthreads();
#pragma unroll 4
            for (int dk = 0; dk < 32; ++dk) { const float qx = qt[n * 33 + dk]; const f32x4 v0 = *(const LAS f32x4*)(Rm + dk * 68 + dv0), v1 = *(const LAS f32x4*)(Rm + dk * 68 + dv0 + 4);
                acc[0] += qx * v0[0]; acc[1] += qx * v0[1]; acc[2] += qx * v0[2]; acc[3] += qx * v0[3]; acc[4] += qx * v1[0]; acc[5] += qx * v1[1]; acc[6] += qx * v1[2]; acc[7] += qx * v1[3]; }
        }
        float s = 0.f;
#pragma unroll
        for (int e = 0; e < 8; ++e) s += acc[e];
        s += __shfl_xor(s, 1); s += __shfl_xor(s, 2); s += __shfl_xor(s, 4);
        const float mean = s * (1.f / 64.f); float s2 = 0.f;
#pragma unroll
        for (int e = 0; e < 8; ++e) { acc[e] -= mean; s2 += acc[e] * acc[e]; }
        s2 += __shfl_xor(s2, 1); s2 += __shfl_xor(s2, 2); s2 += __shfl_xor(s2, 4);
        const float rs = 1.f / sqrtf(s2 * (1.f / 64.f) + LN_EPS);
        const u32x4 gw = *(const u32x4*)(H + (t0 + n) * NH + (gla ? C_GR : C_RG) + h * 64 + dv0); float gf[8]; unpack8(gw, gf);
        float ov[8];
#pragma unroll
        for (int e = 0; e < 8; ++e) ov[e] = silu_f(gf[e]) * acc[e] * rs;
        *(u32x4*)(O + (t0 + n) * DM + (gla ? 512 : 0) + h * 64 + dv0) = pack8(ov);
    }
}

__global__ void __launch_bounds__(512, 2) mega(Params p_unused) {
    extern __shared__ __attribute__((aligned(16))) unsigned char lds_raw[];
    LAS unsigned char* lds = (LAS unsigned char*)lds_raw;
    cg::grid_group grid = cg::this_grid();
    CPP p = (CPP)__builtin_amdgcn_kernarg_segment_ptr();
    unsigned char* ws = p->ws;
    bf16_t* XB = (bf16_t*)(ws + WS_XB);

    { float* rot = (float*)(ws + WS_ROT); const int gt = obid() * 512 + otid(), NT = ogrid() * 512;
        for (int e = gt; e < 2048 * 16; e += NT) { const int pos = e >> 4, f = e & 15; const float inv = 1.0f / powf(10000.0f, (float)f * (1.0f / 16.0f)); const float ang = (float)pos * inv;
            rot[pos * 32 + f] = cosf(ang); rot[pos * 32 + 16 + f] = sinf(ang); } }
    s5_tables(p, 0, lds);
    { const float* x = p->in[0]; const int gt = obid() * 512 + otid(), NT = ogrid() * 512;
        for (size_t e = gt; e < (size_t)M * DM / 8; e += NT) { const f32x4 a = *((const f32x4*)x + 2 * e), b = *((const f32x4*)x + 2 * e + 1);
            u32x4 w; w.x = pk2(a[0], a[1]); w.y = pk2(a[2], a[3]); w.z = pk2(b[0], b[1]); w.w = pk2(b[2], b[3]); *((u32x4*)XB + e) = w; } }
    grid.sync();
    convert_weights(p, 0, lds);
    grid.sync();

    for (int l = 0; l < 4; ++l) {
        for (int s = 0; s < 12; ++s) {
            p = (CPP)__builtin_amdgcn_kernarg_segment_ptr(); asm volatile("" : "+s"(p));
            pg8::Gemm g; pg8::Sched S; pg8::Epi E;
            bool do_gemm = true;
            S.G = ogrid(); S.c = obid(); S.mode = 0; S.nM = M / 256; S.nN = 1;
            E.mode = 0; E.perm = true;
            E.ws = ws; E.dskip = p->in[12] + l * 256; E.bglu = p->in[14] + l * 256; E.bgate = p->in[16] + (size_t)l * 4096;
            E.xres = p->out; E.xout = p->out;
            g.A = XB; g.Bt = (const bf16_t*)(ws + WS_WIN); g.lda = DM; g.ldb = DM; g.K = DM;
            switch (s) {
                case 0: S.nN = NINP / 256; E.mode = 0; E.perm = true; break;
                case 1: g.A = (const bf16_t*)(ws + WS_U2); g.Bt = (const bf16_t*)(ws + WS_WE); g.lda = S5K; g.ldb = 1024; g.K = 1024; S.mode = 2; S.nM = 64; S.nN = 1; E.mode = 1; break;
                case 3: g.A = (const bf16_t*)(ws + WS_U2); g.Bt = (const bf16_t*)(ws + WS_WT); g.lda = S5K; g.ldb = S5K; g.K = S5K; S.mode = 3; S.nM = 64; S.nN = 4; E.mode = 2; break;
                case 4: g.A = (const bf16_t*)(ws + WS_YS); g.Bt = (const bf16_t*)(ws + WS_WGLU); g.lda = 256; g.ldb = 256; g.K = 256; S.nN = 1; E.mode = 3; break;
                case 5: g.A = (const bf16_t*)(ws + WS_O); g.Bt = (const bf16_t*)(ws + WS_WB); g.lda = DM; g.ldb = 256; g.K = 256; S.mode = 1; S.nN = 16; E.mode = 4; break;
                case 6: g.Bt = (const bf16_t*)(ws + WS_WG); S.nN = 16; E.mode = 5; E.perm = false; break;
                case 7: g.A = (const bf16_t*)(ws + WS_O); g.Bt = (const bf16_t*)(ws + WS_WO); S.nN = 4; E.mode = 6; E.perm = false; E.xres = (l == 0) ? p->in[0] : p->out; break;
                case 9: g.Bt = (const bf16_t*)(ws + WS_WFF); S.nN = 22; E.mode = 7; E.perm = false; break;
                case 10: g.A = (const bf16_t*)(ws + WS_E); g.Bt = (const bf16_t*)(ws + WS_WD); g.lda = DFF; g.ldb = DFF; g.K = DFF; S.nN = 4; E.mode = 6; E.perm = false; break;
                default: do_gemm = false; break;
            }
            S.nwg = S.nM * S.nN;
            if (do_gemm) pg8::gemm_phase(lds, g, S, E);
            if (s == 1) { attn_mfma(p, l, lds); upd_items(p, l, lds); }
            else if (s == 2) scan_items(p, l);
            else if (s == 3) out_items(p, l, lds);
            else if (s == 8) { ln_pass(p->out, XB, p->in[19] + l * DM, p->in[20] + l * DM); if (l < 3) s5_tables(p, l + 1, lds); }
            else if (s == 11) { ln_pass(p->out, XB, p->in[24] + l * DM, p->in[25] + l * DM); if (l < 3) convert_weights(p, l + 1, lds); }
            grid.sync();
        }
    }
}

extern "C" void kernel_launch(void* const* d_in, const int* in_sizes, int n_in, void* d_out, int out_size, void* d_ws, size_t ws_size, hipStream_t stream) {
    static int grid_blocks = 0;
    if (!grid_blocks) {
        int dev = 0, cus = 0;
        hipGetDevice(&dev);
        hipDeviceGetAttribute(&cus, hipDeviceAttributeMultiprocessorCount, dev);
        hipFuncSetAttribute((const void*)mega, hipFuncAttributeMaxDynamicSharedMemorySize, LDS_BYTES);
        grid_blocks = cus > 0 ? cus : 256;
    }
    Params p{};
    for (int i = 0; i < 26; ++i) p.in[i] = (const float*)d_in[i];
    p.out = (float*)d_out; p.ws = (unsigned char*)d_ws;
    void* args[] = {&p};
    hipError_t e = hipLaunchCooperativeKernel((const void*)mega, dim3(grid_blocks), dim3(512), args, LDS_BYTES, stream);
    if (e != hipSuccess) fprintf(stderr, "cooperative launch failed: %s (grid %d)\n", hipGetErrorString(e), grid_blocks);
}
```

```cpp
#include <hip/hip_runtime.h>
#include <hip/hip_cooperative_groups.h>
#include <cstdint>
#include <cstdio>
namespace cg = cooperative_groups;

#define LAS __attribute__((address_space(3)))
typedef unsigned short bf16_t;
typedef short bf16x8 __attribute__((ext_vector_type(8)));
typedef float f32x4 __attribute__((ext_vector_type(4)));
typedef float f32x2 __attribute__((ext_vector_type(2)));
typedef unsigned u32x4 __attribute__((ext_vector_type(4)));
typedef unsigned u32x2 __attribute__((ext_vector_type(2)));

constexpr int M = 65536, DM = 1024, SEQ = 2048, NCH = 32;
constexpr int NH = 2320;
constexpr int NINP = 2816;
constexpr int DFF = 2816;
constexpr int S5K = 1152;
constexpr float ALPHA = 1.681792830507429f;
constexpr float LN_EPS = 1e-5f;
constexpr int C_RQ = 0, C_RK = 128, C_RV = 256, C_RG = 512, C_AQ = 768, C_AK = 1024, C_AV = 1280, C_GQ = 1536, C_GK = 1664, C_GV = 1792, C_GR = 2048, C_GA = 2304, C_SU = 2320;

constexpr size_t MiB = 1u << 20;
constexpr size_t WS_ROT = 1 * MiB;
constexpr size_t WS_KN = 2 * MiB;
constexpr size_t WS_WIN = 4 * MiB;
constexpr size_t WS_WG = 10 * MiB;
constexpr size_t WS_WB = 18 * MiB;
constexpr size_t WS_WO = 20 * MiB;
constexpr size_t WS_WFF = 22 * MiB;
constexpr size_t WS_WD = 33 * MiB;
constexpr size_t WS_WGLU = 39 * MiB;
constexpr size_t WS_WE = 40 * MiB;
constexpr size_t WS_WT = 48 * MiB;
constexpr size_t WS_XB = 88 * MiB;
constexpr size_t WS_O = 216 * MiB;
constexpr size_t WS_E = 344 * MiB;
constexpr size_t WS_U2 = 636 * MiB;
constexpr size_t WS_RU = 676 * MiB;
constexpr size_t WS_GU = 708 * MiB;
constexpr size_t WS_GL = 740 * MiB;
constexpr size_t WS_ES = 741 * MiB;
constexpr size_t WS_YS = 749 * MiB;
constexpr int LDS_BYTES = 147456;

struct Params { const float* in[26]; float* out; unsigned char* ws; };
typedef const __attribute__((address_space(4))) Params* CPP;

__device__ __forceinline__ float bflo(unsigned w) { return __uint_as_float(w << 16); }
__device__ __forceinline__ float bfhi(unsigned w) { return __uint_as_float(w & 0xffff0000u); }
__device__ __forceinline__ float bf2f(bf16_t b) { return __uint_as_float((unsigned)b << 16); }
__device__ __forceinline__ unsigned f2bf(float f) { unsigned u = __float_as_uint(f); return (u + 0x7fffu + ((u >> 16) & 1u)) >> 16; }
__device__ __forceinline__ unsigned pk2(float lo, float hi) { return f2bf(lo) | (f2bf(hi) << 16); }
__device__ __forceinline__ unsigned cvt_pk_bf16(float lo, float hi) { unsigned r; asm volatile("v_cvt_pk_bf16_f32 %0, %1, %2" : "=v"(r) : "v"(lo), "v"(hi)); return r; }
__device__ __forceinline__ float sigm(float x) { return __builtin_amdgcn_rcpf(1.0f + __expf(-x)); }
__device__ __forceinline__ float silu_f(float x) { return x * sigm(x); }
__device__ __forceinline__ float gelu_tanh(float v) { return v * sigm(1.5957691216057308f * (v + 0.044715f * v * v * v)); }
__device__ __forceinline__ void unpack8(u32x4 w, float* o) {
    o[0] = bflo(w.x); o[1] = bfhi(w.x); o[2] = bflo(w.y); o[3] = bfhi(w.y); o[4] = bflo(w.z); o[5] = bfhi(w.z); o[6] = bflo(w.w); o[7] = bfhi(w.w);
}
__device__ __forceinline__ u32x4 pack8(const float* v) { u32x4 w; w.x = pk2(v[0], v[1]); w.y = pk2(v[2], v[3]); w.z = pk2(v[4], v[5]); w.w = pk2(v[6], v[7]); return w; }
__device__ __forceinline__ int otid() { int t = threadIdx.x; asm volatile("" : "+v"(t)); return t; }
__device__ __forceinline__ int obid() { int b = blockIdx.x; asm volatile("" : "+s"(b)); return b; }
__device__ __forceinline__ int ogrid() { int b = gridDim.x; asm volatile("" : "+s"(b)); return b; }
__device__ __forceinline__ float wave_sum(float v) {
#pragma unroll
    for (int o = 1; o < 64; o <<= 1) v += __shfl_xor(v, o);
    return v;
}

namespace pg8 {
constexpr int BM = 256, BK = 64, HALF = 128, HTB = HALF * BK * 2, STAGE_BYTES = 8 * HTB, NXCD = 8, WGM = 8;
__device__ __forceinline__ int lds_byte(int r, int c) { const int st = (r >> 4) * 2 + (c >> 5), rr = r & 15, cc = c & 31, ob = rr * 64 + cc * 2; return st * 1024 + (ob ^ (((ob >> 9) & 1) << 5)); }
__device__ __forceinline__ void stage_rc(int b, int& R, int& C) { const int st = b / 1024, sb = b % 1024, swz = sb ^ (((sb >> 9) & 1) << 5); R = (st >> 1) * 16 + swz / 64; C = (st & 1) * 32 + (swz % 64) / 2; }
__device__ __forceinline__ int perm32(int rho) { const int n = rho >> 4, i = rho & 15; return 8 * (i >> 2) + 4 * n + (i & 3); }

struct Unit { int pm, pn, ak; };
struct Gemm { const bf16_t* A; const bf16_t* Bt; int lda, ldb, K; };

struct Sched {
    int nM, nN, nwg, G, c, mode;
    __device__ __forceinline__ bool next(int i, Unit& u) const {
        const long L = (long)i * G + c; if (L >= nwg) return false;
        if (mode == 2) { u.pm = (int)L; u.pn = (int)(L >> 2); u.ak = 0; return true; }
        if (mode == 3) { const int g = (int)(L >> 4); u.pm = 4 * g + (int)((L >> 2) & 3); u.pn = 4 * g + (int)(L & 3); u.ak = 0; return true; }
        int wgid = (int)L; { const int q = nwg / NXCD, r = nwg % NXCD, xcd = wgid % NXCD, off = wgid / NXCD; wgid = (xcd < r ? xcd * (q + 1) : r * (q + 1) + (xcd - r) * q) + off; }
        const int nig = WGM * nN, gid = wgid / nig, fm = gid * WGM, gsz = (nM - fm) < WGM ? (nM - fm) : WGM;
        u.pm = fm + ((wgid % nig) % gsz); u.pn = (wgid % nig) / gsz; u.ak = (mode == 1) ? (u.pn >> 2) * 256 : 0; return true;
    }
};

struct Epi {
    int mode; bool perm;
    unsigned char* ws; const float* dskip; const float* bglu; const float* bgate; const float* xres; float* xout;
    __device__ __forceinline__ void operator()(const f32x4 (&acc)[2][2][4][2], const Unit& u, int wr, int wc, int fr, int fq) const {
        const int row0 = u.pm * BM + wr * 64 + fr;
        bf16_t* const H = (bf16_t*)(ws + WS_E); bf16_t* const U2 = (bf16_t*)(ws + WS_U2); float* const ES = (float*)(ws + WS_ES); bf16_t* const YS = (bf16_t*)(ws + WS_YS);
        bf16_t* const Ob = (bf16_t*)(ws + WS_O); bf16_t* const P = (bf16_t*)(ws + WS_E); bf16_t* const MIX = (bf16_t*)(ws + WS_O); bf16_t* const HF = (bf16_t*)(ws + WS_E);
        if (mode == 0) {
#pragma unroll
            for (int ai = 0; ai < 2; ++ai)
#pragma unroll
                for (int m = 0; m < 4; ++m) { const int r = row0 + ai * HALF + m * 16;
#pragma unroll
                    for (int bj = 0; bj < 2; ++bj) { const int c0 = u.pn * BM + bj * HALF + wc * 32 + 8 * fq;
                        const f32x4 v0 = acc[ai][bj][m][0], v1 = acc[ai][bj][m][1];
                        u32x4 w; w.x = cvt_pk_bf16(v0[0], v0[1]); w.y = cvt_pk_bf16(v0[2], v0[3]); w.z = cvt_pk_bf16(v1[0], v1[1]); w.w = cvt_pk_bf16(v1[2], v1[3]);
                        if (c0 < C_SU) *(u32x4*)(H + (size_t)r * NH + c0) = w;
                        else if (c0 < C_SU + 256) { const int c = c0 - C_SU, g = c >> 4, ci = c & 15;
                            *(u32x4*)(U2 + ((size_t)(g * 1024 + (r >> 6))) * S5K + (r & 63) * 16 + ci) = w; } } }
        } else if (mode == 1) {
#pragma unroll
            for (int ai = 0; ai < 2; ++ai)
#pragma unroll
                for (int m = 0; m < 4; ++m) { const int r = row0 + ai * HALF + m * 16; const int c0 = wc * 32 + 8 * fq;
                    *(f32x4*)(ES + (size_t)r * 128 + c0) = acc[ai][0][m][0]; *(f32x4*)(ES + (size_t)r * 128 + c0 + 4) = acc[ai][0][m][1]; }
        } else if (mode == 2) {
            const int g = u.pm >> 2;
#pragma unroll
            for (int ai = 0; ai < 2; ++ai)
#pragma unroll
                for (int m = 0; m < 4; ++m) { const int r = row0 + ai * HALF + m * 16;
#pragma unroll
                    for (int bj = 0; bj < 2; ++bj) { const int n0 = (u.pn & 3) * BM + bj * HALF + wc * 32 + 8 * fq; const int j = n0 >> 4, i0 = n0 & 15;
                        const u32x4 uw = *(const u32x4*)(U2 + (size_t)r * S5K + n0); float uf[8]; unpack8(uw, uf);
                        const f32x4 d0 = *(const f32x4*)(dskip + 16 * g + i0), d1 = *(const f32x4*)(dskip + 16 * g + i0 + 4);
                        const f32x4 v0 = acc[ai][bj][m][0], v1 = acc[ai][bj][m][1]; float y[8];
                        y[0] = gelu_tanh(v0[0] + d0[0] * uf[0]); y[1] = gelu_tanh(v0[1] + d0[1] * uf[1]); y[2] = gelu_tanh(v0[2] + d0[2] * uf[2]); y[3] = gelu_tanh(v0[3] + d0[3] * uf[3]);
                        y[4] = gelu_tanh(v1[0] + d1[0] * uf[4]); y[5] = gelu_tanh(v1[1] + d1[1] * uf[5]); y[6] = gelu_tanh(v1[2] + d1[2] * uf[6]); y[7] = gelu_tanh(v1[3] + d1[3] * uf[7]);
                        u32x4 w; w.x = cvt_pk_bf16(y[0], y[1]); w.y = cvt_pk_bf16(y[2], y[3]); w.z = cvt_pk_bf16(y[4], y[5]); w.w = cvt_pk_bf16(y[6], y[7]);
                        const size_t t = (size_t)(r & 1023) * 64 + j;
                        *(u32x4*)(YS + t * 256 + 16 * g + i0) = w; } }
        } else if (mode == 3) {
#pragma unroll
            for (int ai = 0; ai < 2; ++ai)
#pragma unroll
                for (int m = 0; m < 4; ++m) { const int r = row0 + ai * HALF + m * 16;
#pragma unroll
                    for (int bj = 0; bj < 2; ++bj) { const int c0 = bj * HALF + wc * 32 + 8 * fq;
                        const u32x4 yw = *(const u32x4*)(YS + (size_t)r * 256 + c0); float yf[8]; unpack8(yw, yf);
                        const f32x4 b0 = *(const f32x4*)(bglu + c0), b1 = *(const f32x4*)(bglu + c0 + 4);
                        const f32x4 v0 = acc[ai][bj][m][0] + b0, v1 = acc[ai][bj][m][1] + b1; float o[8];
                        o[0] = yf[0] * sigm(v0[0]); o[1] = yf[1] * sigm(v0[1]); o[2] = yf[2] * sigm(v0[2]); o[3] = yf[3] * sigm(v0[3]);
                        o[4] = yf[4] * sigm(v1[0]); o[5] = yf[5] * sigm(v1[1]); o[6] = yf[6] * sigm(v1[2]); o[7] = yf[7] * sigm(v1[3]);
                        u32x4 w; w.x = cvt_pk_bf16(o[0], o[1]); w.y = cvt_pk_bf16(o[2], o[3]); w.z = cvt_pk_bf16(o[4], o[5]); w.w = cvt_pk_bf16(o[6], o[7]);
                        *(u32x4*)(Ob + (size_t)r * DM + 768 + c0) = w; } }
        } else if (mode == 4) {
#pragma unroll
            for (int ai = 0; ai < 2; ++ai)
#pragma unroll
                for (int m = 0; m < 4; ++m) { const int r = row0 + ai * HALF + m * 16;
#pragma unroll
                    for (int bj = 0; bj < 2; ++bj) { const int c0 = u.pn * BM + bj * HALF + wc * 32 + 8 * fq;
                        const f32x4 v0 = acc[ai][bj][m][0], v1 = acc[ai][bj][m][1];
                        u32x4 w; w.x = cvt_pk_bf16(v0[0], v0[1]); w.y = cvt_pk_bf16(v0[2], v0[3]); w.z = cvt_pk_bf16(v1[0], v1[1]); w.w = cvt_pk_bf16(v1[2], v1[3]);
                        *(u32x4*)(P + (size_t)r * 4096 + c0) = w; } }
        } else if (mode == 5) {
            const int ch0 = 64 * u.pn + 16 * wc + 4 * fq;
            f32x4 bv[4];
#pragma unroll
            for (int b = 0; b < 4; ++b) bv[b] = *(const f32x4*)(bgate + b * 1024 + ch0);
#pragma unroll
            for (int ai = 0; ai < 2; ++ai)
#pragma unroll
                for (int m = 0; m < 4; ++m) { const int r = row0 + ai * HALF + m * 16; f32x4 mix = (f32x4){0.f, 0.f, 0.f, 0.f};
#pragma unroll
                    for (int bj = 0; bj < 2; ++bj)
#pragma unroll
                        for (int n = 0; n < 2; ++n) { const int b = 2 * bj + n; const f32x4 a = acc[ai][bj][m][n] + bv[b];
                            const u32x2 pw = *(const u32x2*)(P + (size_t)r * 4096 + b * 1024 + ch0);
                            mix[0] += sigm(a[0]) * bflo(pw.x); mix[1] += sigm(a[1]) * bfhi(pw.x); mix[2] += sigm(a[2]) * bflo(pw.y); mix[3] += sigm(a[3]) * bfhi(pw.y); }
                    u32x2 w; w.x = cvt_pk_bf16(mix[0], mix[1]); w.y = cvt_pk_bf16(mix[2], mix[3]);
                    *(u32x2*)(MIX + (size_t)r * DM + ch0) = w; }
        } else if (mode == 6) {
#pragma unroll
            for (int ai = 0; ai < 2; ++ai)
#pragma unroll
                for (int m = 0; m < 4; ++m) { const int r = row0 + ai * HALF + m * 16;
#pragma unroll
                    for (int bj = 0; bj < 2; ++bj)
#pragma unroll
                        for (int n = 0; n < 2; ++n) { const int c = u.pn * BM + bj * HALF + wc * 32 + n * 16 + 4 * fq;
                            const f32x4 xr = *(const f32x4*)(xres + (size_t)r * DM + c);
                            *(f32x4*)(xout + (size_t)r * DM + c) = xr * ALPHA + acc[ai][bj][m][n]; } }
        } else {
#pragma unroll
            for (int ai = 0; ai < 2; ++ai)
#pragma unroll
                for (int m = 0; m < 4; ++m) { const int r = row0 + ai * HALF + m * 16;
#pragma unroll
                    for (int bj = 0; bj < 2; ++bj) { const int ch0 = 128 * u.pn + 64 * bj + 16 * wc + 4 * fq;
                        const f32x4 gt = acc[ai][bj][m][0], up = acc[ai][bj][m][1];
                        u32x2 w; w.x = cvt_pk_bf16(silu_f(gt[0]) * up[0], silu_f(gt[1]) * up[1]); w.y = cvt_pk_bf16(silu_f(gt[2]) * up[2], silu_f(gt[3]) * up[3]);
                        *(u32x2*)(HF + (size_t)r * DFF + ch0) = w; } }
        }
    }
};

__device__ __forceinline__ void gemm_phase(LAS unsigned char* lds, const Gemm g, const Sched& S, const Epi& E) {
    const int tid = otid(), wid = __builtin_amdgcn_readfirstlane(tid >> 6), lane = tid & 63, wr = wid >> 2, wc = wid & 3, fr = lane & 15, fq = lane >> 4;
    const int K = g.K, nt = K / BK;
    unsigned voffA[2], voffB[2];
#pragma unroll
    for (int i = 0; i < 2; ++i) { int R, C; stage_rc(tid * 16 + i * 8192, R, C); const int Rb = E.perm ? ((R & ~31) + perm32(R & 31)) : R;
        voffA[i] = (unsigned)(R * g.lda + C) * 2u; voffB[i] = (unsigned)(Rb * g.ldb + C) * 2u; }
    const size_t kstep = (size_t)(BK * 2);
    const size_t hstepA = (size_t)HALF * g.lda * 2, hstepB = (size_t)HALF * g.ldb * 2;
    const size_t tstepA = 2 * hstepA, tstepB = 2 * hstepB;
    const unsigned ldsw = (unsigned)wid * 1024u;
    const int aoff = lds_byte(wr * 64 + fr, fq * 8), boff = lds_byte(wc * 32 + fr, fq * 8);
#define PG8_SA(b, h) (((b) * 2 + (h)) * HTB)
#define PG8_SB(b, h) ((4 + (b) * 2 + (h)) * HTB)
#define PG8_STAGE(bufoff, gbase, voff) do { _Pragma("unroll") for (int _i = 0; _i < 2; ++_i) \
        __builtin_amdgcn_global_load_lds((const unsigned*)((const char*)(gbase) + (voff)[_i]), (LAS unsigned*)(lds + (bufoff) + ldsw + _i * 8192), 16, 0, 0); } while (0)
#define PG8_LDA(dst, b, h) do { _Pragma("unroll") for (int m = 0; m < 4; ++m) _Pragma("unroll") for (int k = 0; k < 2; ++k) dst[m][k] = *(const LAS bf16x8*)(lds + PG8_SA(b, h) + aoff + m * 2048 + k * 1024); } while (0)
#define PG8_LDB(dst, b, h) do { _Pragma("unroll") for (int n = 0; n < 2; ++n) _Pragma("unroll") for (int k = 0; k < 2; ++k) dst[n][k] = *(const LAS bf16x8*)(lds + PG8_SB(b, h) + boff + n * 2048 + k * 1024); } while (0)
#define PG8_MMA(ai, bj, At, Bt) do { __builtin_amdgcn_s_setprio(1); _Pragma("unroll") for (int m = 0; m < 4; ++m) _Pragma("unroll") for (int n = 0; n < 2; ++n) _Pragma("unroll") for (int k = 0; k < 2; ++k) \
        acc[ai][bj][m][n] = __builtin_amdgcn_mfma_f32_16x16x32_bf16(Bt[n][k], At[m][k], acc[ai][bj][m][n], 0, 0, 0); __builtin_amdgcn_s_setprio(0); } while (0)
#define PG8_WAIT_V(n) asm volatile("s_waitcnt vmcnt(" #n ")" ::: "memory")
#define PG8_WAIT_L(n) asm volatile("s_waitcnt lgkmcnt(" #n ")" ::: "memory")
#define PG8_BAR __builtin_amdgcn_s_barrier()
#define PG8_SCHED __builtin_amdgcn_sched_barrier(0)
    Unit cur, nxt; int ui = 0;
    if (!S.next(0, cur)) return;
    f32x4 acc[2][2][4][2];
#pragma unroll
    for (int a = 0; a < 2; ++a)
#pragma unroll
        for (int b = 0; b < 2; ++b)
#pragma unroll
            for (int m = 0; m < 4; ++m)
#pragma unroll
                for (int n = 0; n < 2; ++n) acc[a][b][m][n] = (f32x4){0.f, 0.f, 0.f, 0.f};
    bf16x8 At[4][2], B0[2][2], B1[2][2];
    const char* cA = (const char*)g.A + (size_t)cur.pm * tstepA + (size_t)cur.ak * 2; const char* cB = (const char*)g.Bt + (size_t)cur.pn * tstepB;
    PG8_STAGE(PG8_SB(0, 0), cB, voffB); PG8_STAGE(PG8_SB(0, 1), cB + hstepB, voffB); PG8_STAGE(PG8_SA(0, 0), cA, voffA); PG8_STAGE(PG8_SA(0, 1), cA + hstepA, voffA);
    if (wr == 1) PG8_BAR;
    PG8_WAIT_V(2); PG8_BAR;
    PG8_STAGE(PG8_SB(1, 0), cB + kstep, voffB); PG8_STAGE(PG8_SA(1, 0), cA + kstep, voffA); PG8_STAGE(PG8_SB(1, 1), cB + hstepB + kstep, voffB);
    PG8_WAIT_V(6); PG8_BAR;
    for (;;) {
        const bool has_next = S.next(ui + 1, nxt);
        const char* nA = has_next ? (const char*)g.A + (size_t)nxt.pm * tstepA + (size_t)nxt.ak * 2 : cA; const char* nB = has_next ? (const char*)g.Bt + (size_t)nxt.pn * tstepB : cB;
        for (int t = 0; t < nt; t += 2) {
            const bool last = (t == nt - 2);
            const char* a1 = cA + (size_t)(t + 1) * kstep;
            const char* a2 = last ? nA : cA + (size_t)(t + 2) * kstep; const char* b2 = last ? nB : cB + (size_t)(t + 2) * kstep;
            const char* a3 = a2 + kstep; const char* b3 = b2 + kstep;
            PG8_LDB(B0, 0, 0); PG8_LDB(B1, 0, 1); PG8_SCHED; PG8_LDA(At, 0, 0); PG8_STAGE(PG8_SA(1, 1), a1 + hstepA, voffA);
            PG8_WAIT_V(8); PG8_WAIT_L(0); PG8_BAR; PG8_MMA(0, 0, At, B0); PG8_MMA(0, 1, At, B1); PG8_BAR; PG8_SCHED;
            PG8_LDA(At, 0, 1); PG8_STAGE(PG8_SB(0, 0), b2, voffB); PG8_STAGE(PG8_SB(0, 1), b2 + hstepB, voffB); PG8_STAGE(PG8_SA(0, 0), a2, voffA);
            PG8_WAIT_V(8); PG8_WAIT_L(0); PG8_BAR; PG8_MMA(1, 0, At, B0); PG8_MMA(1, 1, At, B1); PG8_BAR; PG8_SCHED;
            PG8_LDB(B0, 1, 0); PG8_LDB(B1, 1, 1); PG8_SCHED; PG8_LDA(At, 1, 0); PG8_STAGE(PG8_SA(0, 1), a2 + hstepA, voffA);
            PG8_WAIT_V(8); PG8_WAIT_L(0); PG8_BAR; PG8_MMA(0, 0, At, B0); PG8_MMA(0, 1, At, B1); PG8_BAR; PG8_SCHED;
            PG8_LDA(At, 1, 1); PG8_STAGE(PG8_SB(1, 0), b3, voffB); PG8_STAGE(PG8_SB(1, 1), b3 + hstepB, voffB); PG8_STAGE(PG8_SA(1, 0), a3, voffA);
            PG8_WAIT_V(8); PG8_WAIT_L(0); PG8_BAR; PG8_MMA(1, 0, At, B0); PG8_MMA(1, 1, At, B1); PG8_BAR; PG8_SCHED;
        }
        if (wr == 0) PG8_BAR;
        { const int t2 = otid(), w2 = __builtin_amdgcn_readfirstlane(t2 >> 6), l2 = t2 & 63;
          E(acc, cur, w2 >> 2, w2 & 3, l2 & 15, l2 >> 4); }
        if (!has_next) break;
#pragma unroll
        for (int a = 0; a < 2; ++a)
#pragma unroll
            for (int b = 0; b < 2; ++b)
#pragma unroll
                for (int m = 0; m < 4; ++m)
#pragma unroll
                    for (int n = 0; n < 2; ++n) acc[a][b][m][n] = (f32x4){0.f, 0.f, 0.f, 0.f};
        cur = nxt; cA = nA; cB = nB; ++ui;
        if (wr == 1) PG8_BAR;
    }
    PG8_WAIT_V(0);
    PG8_BAR;
#undef PG8_SA
#undef PG8_SB
#undef PG8_STAGE
#undef PG8_LDA
#undef PG8_LDB
#undef PG8_MMA
#undef PG8_WAIT_V
#undef PG8_WAIT_L
#undef PG8_BAR
#undef PG8_SCHED
}
}

__device__ __forceinline__ int dest_row(int dmode, int arg, int n) {
    if (dmode == 1) { return ((n >> 6) << 8) + ((arg >> 1) << 7) + (((n >> 4) & 3) << 5) + ((arg & 1) << 4) + (n & 15); }
    if (dmode == 2) { return ((n >> 7) << 8) + (((n >> 6) & 1) << 7) + (((n >> 4) & 3) << 5) + (arg << 4) + (n & 15); }
    return n + arg;
}
__device__ __forceinline__ void transpose_item(const float* W, int K, int Nsrc, bf16_t* WT, int dmode, int arg, LAS float* scr, int kb, int nb, int lane) {
    const int k0 = 64 * kb, n0 = 32 * nb;
    const int nsrc = n0 + (lane & 31); const bool ok = nsrc < Nsrc;
#pragma unroll 8
    for (int i = 0; i < 32; ++i) { const int kk = 2 * i + (lane >> 5); scr[kk * 33 + (lane & 31)] = ok ? W[(size_t)(k0 + kk) * Nsrc + nsrc] : 0.f; }
    asm volatile("s_waitcnt lgkmcnt(0)" ::: "memory");
    const int c = lane & 7;
#pragma unroll
    for (int j = 0; j < 4; ++j) { const int n = (lane >> 3) + 8 * j; const LAS float* s = scr + (8 * c) * 33 + n;
        u32x4 o; o.x = pk2(s[0 * 33], s[1 * 33]); o.y = pk2(s[2 * 33], s[3 * 33]); o.z = pk2(s[4 * 33], s[5 * 33]); o.w = pk2(s[6 * 33], s[7 * 33]);
        *(u32x4*)(WT + (size_t)dest_row(dmode, arg, n0 + n) * K + k0 + 8 * c) = o; }
    asm volatile("s_waitcnt lgkmcnt(0)" ::: "memory");
}

__device__ __forceinline__ void s5_abar_pow(float lr, float li, float dt, int n, float& re, float& im) {
    const float mag = expf((float)n * lr * dt);
    const double a = (double)n * ((double)li * (double)dt);
    const double k = __builtin_rint(a * 0.15915494309189535);
    const float r = (float)__builtin_fma(-k, 6.283185307179586, a);
    re = mag * cosf(r); im = mag * sinf(r);
}
__device__ __forceinline__ void s5_coef(float lr, float li, float dt, float& cr, float& ci) {
    const float th = li * dt, em1 = expm1f(lr * dt), c1 = cosf(th), s1 = sinf(th), sh = sinf(0.5f * th);
    const float nr = em1 * c1 - 2.f * sh * sh, ni = (1.f + em1) * s1, den = lr * lr + li * li;
    cr = (nr * lr + ni * li) / den; ci = (ni * lr - nr * li) / den;
}

__device__ __forceinline__ void s5_tables(CPP p, int l, LAS unsigned char* lds) {
    LAS float* abr = (LAS float*)lds;
    LAS float* abi = abr + 1024;
    LAS float* cr = abi + 1024;
    LAS float* ci = cr + 16 * 65;
    float* KN = (float*)(p->ws + WS_KN);
    const int tid = otid();
    for (int it = obid(); it < 1024; it += ogrid()) {
        const int g = it >> 6, n = it & 63;
        __syncthreads();
        for (int e = tid; e < 1024; e += 512) { const int pp = e >> 4, c = e & 15; const int gp = (l * 16 + g) * 64 + pp;
            const float lr = p->in[5][gp], li = p->in[6][gp], dt = expf(p->in[7][l * 16 + g]);
            float ar, ai2; s5_abar_pow(lr, li, dt, n, ar, ai2);
            float qr, qi; s5_coef(lr, li, dt, qr, qi);
            const float br = p->in[8][(size_t)gp * 16 + c], bi = p->in[9][(size_t)gp * 16 + c];
            const float bbr = qr * br - qi * bi, bbi = qr * bi + qi * br;
            abr[e] = ar * bbr - ai2 * bbi; abi[e] = ar * bbi + ai2 * bbr; }
        for (int e = tid; e < 1024; e += 512) { const int i = e >> 6, pp = e & 63; const size_t gi = ((size_t)(l * 16 + g) * 16 + i) * 64 + pp;
            cr[i * 65 + pp] = p->in[10][gi]; ci[i * 65 + pp] = p->in[11][gi]; }
        __syncthreads();
        if (tid < 256) { const int i = tid >> 4, c = tid & 15; float s = 0.f;
#pragma unroll 8
            for (int pp = 0; pp < 64; ++pp) s += cr[i * 65 + pp] * abr[pp * 16 + c] - ci[i * 65 + pp] * abi[pp * 16 + c];
            KN[((size_t)(g * 64 + n) * 16 + i) * 16 + c] = s; }
    }
}

__device__ __forceinline__ void convert_weights(CPP p, int l, LAS unsigned char* lds) {
    const int tid = otid(), lane = tid & 63, wave = tid >> 6;
    LAS float* scr = (LAS float*)(lds + wave * 16384);
    const int gw = obid() * 8 + wave, NGW = ogrid() * 8;
    unsigned char* ws = p->ws;
    constexpr int J0 = 1408, J1 = J0 + 2048, J2 = J1 + 512, J3 = J2 + 512, J4 = J3 + 2816, J5 = J4 + 1408, J6 = J5 + 32;
    for (int it = gw; it < J6; it += NGW) {
        if (it < J0) { const int r = it; transpose_item(p->in[1] + (size_t)l * 1024 * 2576, 1024, 2576, (bf16_t*)(ws + WS_WIN), 0, 0, scr, r / 88, r % 88, lane); }
        else if (it < J1) { const int r = it - J0, b = r >> 9, q = r & 511; transpose_item(p->in[15] + ((size_t)l * 4 + b) * 1024 * 1024, 1024, 1024, (bf16_t*)(ws + WS_WG), 1, b, scr, q >> 5, q & 31, lane); }
        else if (it < J2) { const int r = it - J1, b = r >> 7, q = r & 127; transpose_item(p->in[17] + ((size_t)l * 4 + b) * 256 * 1024, 256, 1024, (bf16_t*)(ws + WS_WB) + (size_t)b * 1024 * 256, 0, 0, scr, q >> 5, q & 31, lane); }
        else if (it < J3) { const int q = it - J2; transpose_item(p->in[18] + (size_t)l * 1024 * 1024, 1024, 1024, (bf16_t*)(ws + WS_WO), 0, 0, scr, q >> 5, q & 31, lane); }
        else if (it < J4) { const int r = it - J3, wch = r / 1408, q = r % 1408; transpose_item(p->in[wch ? 22 : 21] + (size_t)l * 1024 * 2816, 1024, 2816, (bf16_t*)(ws + WS_WFF), 2, wch, scr, q / 88, q % 88, lane); }
        else if (it < J5) { const int q = it - J4; transpose_item(p->in[23] + (size_t)l * 2816 * 1024, 2816, 1024, (bf16_t*)(ws + WS_WD), 0, 0, scr, q >> 5, q & 31, lane); }
        else { const int q = it - J5; transpose_item(p->in[13] + (size_t)l * 256 * 256, 256, 256, (bf16_t*)(ws + WS_WGLU), 0, 0, scr, q >> 3, q & 7, lane); }
    }
    const int gt = obid() * 512 + tid, NT = ogrid() * 512;
    bf16_t* WE = (bf16_t*)(ws + WS_WE);
    for (int e = gt; e < 65536; e += NT) { const int s = e & 63, pp = (e >> 6) & 63, g = e >> 12; const int gp = (l * 16 + g) * 64 + pp;
        const float lr = p->in[5][gp], li = p->in[6][gp], dt = expf(p->in[7][l * 16 + g]);
        float ar, ai2; s5_abar_pow(lr, li, dt, 63 - s, ar, ai2);
        float qr, qi; s5_coef(lr, li, dt, qr, qi);
        float wr_[16], wi_[16];
#pragma unroll
        for (int c = 0; c < 16; ++c) { const float br = p->in[8][(size_t)gp * 16 + c], bi = p->in[9][(size_t)gp * 16 + c];
            const float bbr = qr * br - qi * bi, bbi = qr * bi + qi * br; wr_[c] = ar * bbr - ai2 * bbi; wi_[c] = ar * bbi + ai2 * bbr; }
        bf16_t* dr = WE + ((size_t)(g * 256 + pp)) * 1024 + s * 16; bf16_t* di = WE + ((size_t)(g * 256 + 64 + pp)) * 1024 + s * 16;
        *(u32x4*)dr = pack8(wr_); *(u32x4*)(dr + 8) = pack8(wr_ + 8); *(u32x4*)di = pack8(wi_); *(u32x4*)(di + 8) = pack8(wi_ + 8); }
    for (int e = gt; e < 16 * 128 * 128; e += NT) { const int c8 = e & 127, n = (e >> 7) & 127, g = e >> 14;
        *(u32x4*)(WE + ((size_t)(g * 256 + 128 + n)) * 1024 + c8 * 8) = (u32x4){0u, 0u, 0u, 0u}; }
    bf16_t* WT = (bf16_t*)(ws + WS_WT); const float* KN = (const float*)(ws + WS_KN);
    for (int e = gt; e < 16 * 1024 * 64; e += NT) { const int s = e & 63, row = (e >> 6) & 1023, g = e >> 16; const int j = row >> 4, i = row & 15;
        u32x4 w0 = (u32x4){0u, 0u, 0u, 0u}, w1 = w0;
        if (s <= j) { const float* k = KN + ((size_t)(g * 64 + (j - s)) * 16 + i) * 16; float v[16];
#pragma unroll
            for (int c = 0; c < 16; c += 4) { const f32x4 t = *(const f32x4*)(k + c); v[c] = t[0]; v[c + 1] = t[1]; v[c + 2] = t[2]; v[c + 3] = t[3]; }
            w0 = pack8(v); w1 = pack8(v + 8); }
        bf16_t* d = WT + ((size_t)(g * 1024 + row)) * S5K + s * 16; *(u32x4*)d = w0; *(u32x4*)(d + 8) = w1; }
    for (int e = gt; e < 16 * 1024 * 64; e += NT) { const int pp = e & 63, row = (e >> 6) & 1023, g = e >> 16; const int j = row >> 4, i = row & 15; const int gp = (l * 16 + g) * 64 + pp;
        const float lr = p->in[5][gp], li = p->in[6][gp], dt = expf(p->in[7][l * 16 + g]);
        float ar, ai2; s5_abar_pow(lr, li, dt, j + 1, ar, ai2);
        const size_t gi = ((size_t)(l * 16 + g) * 16 + i) * 64 + pp; const float c_r = p->in[10][gi], c_i = p->in[11][gi];
        bf16_t* d = WT + ((size_t)(g * 1024 + row)) * S5K + 1024 + pp;
        d[0] = (bf16_t)f2bf(c_r * ar - c_i * ai2); d[64] = (bf16_t)f2bf(-(c_r * ai2 + c_i * ar)); }
}

__device__ __forceinline__ void ln_pass(float* x, bf16_t* xb, const float* gam, const float* bet) {
    const int lane = otid() & 63, gw = obid() * 8 + (otid() >> 6), NGW = ogrid() * 8;
    f32x4 gv[4], bv[4];
#pragma unroll
    for (int j = 0; j < 4; ++j) { gv[j] = *((const f32x4*)gam + lane + 64 * j); bv[j] = *((const f32x4*)bet + lane + 64 * j); }
    for (int m = gw; m < M; m += NGW) {
        f32x4* xr = (f32x4*)(x + (size_t)m * DM) + lane;
        f32x4 v[4]; float s = 0.f;
#pragma unroll
        for (int j = 0; j < 4; ++j) { v[j] = xr[64 * j]; s += (v[j].x + v[j].y) + (v[j].z + v[j].w); }
        const float mean = wave_sum(s) * (1.f / DM); float s2 = 0.f;
#pragma unroll
        for (int j = 0; j < 4; ++j) { v[j] = v[j] - mean; s2 += (v[j].x * v[j].x + v[j].y * v[j].y) + (v[j].z * v[j].z + v[j].w * v[j].w); }
        const float rstd = 1.f / sqrtf(wave_sum(s2) * (1.f / DM) + LN_EPS);
        u32x2* o8 = (u32x2*)(xb + (size_t)m * DM) + lane;
#pragma unroll
        for (int j = 0; j < 4; ++j) { const f32x4 y = v[j] * rstd * gv[j] + bv[j]; xr[64 * j] = y; u32x2 w; w.x = pk2(y.x, y.y); w.y = pk2(y.z, y.w); o8[64 * j] = w; }
    }
}

__device__ __forceinline__ void load_tile64(const bf16_t* src, int pitch, LAS float* dst, int dpitch, float scale, int tid) {
    const int idx = tid * 8, r = idx >> 6, c = idx & 63;
    const u32x4 w = *(const u32x4*)(src + (size_t)r * pitch + c); float f[8]; unpack8(w, f);
#pragma unroll
    for (int e = 0; e < 8; ++e) dst[r * dpitch + c + e] = f[e] * scale;
}

__device__ __forceinline__ void attn_items(CPP p, int l, LAS unsigned char* lds) {
    LAS float* Qs = (LAS float*)lds; LAS float* Ks = Qs + 64 * 68; LAS float* Vs = Ks + 64 * 68; LAS float* Ps = Vs + 64 * 68; LAS float* bs = Ps + 64 * 65;
    const bf16_t* H = (const bf16_t*)(p->ws + WS_E); bf16_t* O = (bf16_t*)(p->ws + WS_O);
    const int tid = otid(), row = tid >> 3, sub = tid & 7;
    for (int it = obid(); it < 4096; it += ogrid()) {
        const int h = it & 3, bi = it >> 2, i = bi & 31, b = bi >> 5;
        const size_t t0 = (size_t)bi * 64;
        __syncthreads();
        load_tile64(H + t0 * NH + C_AQ + h * 64, NH, Qs, 68, 0.125f, tid);
        if (tid < 257) bs[tid] = p->in[4][(size_t)(l * 4 + h) * 257 + tid];
        __syncthreads();
        float q[64], o[8];
#pragma unroll
        for (int d = 0; d < 64; d += 4) { const f32x4 t = *(const LAS f32x4*)(Qs + row * 68 + d); q[d] = t[0]; q[d + 1] = t[1]; q[d + 2] = t[2]; q[d + 3] = t[3]; }
#pragma unroll
        for (int e = 0; e < 8; ++e) o[e] = 0.f;
        float mx = -1e30f, ls = 0.f;
        const int kc0 = i > 8 ? i - 8 : 0;
        for (int kc = kc0; kc <= i; ++kc) {
            __syncthreads();
            const size_t tk = ((size_t)b * 32 + kc) * 64;
            load_tile64(H + tk * NH + C_AK + h * 64, NH, Ks, 68, 1.f, tid);
            load_tile64(H + tk * NH + C_AV + h * 64, NH, Vs, 68, 1.f, tid);
            __syncthreads();
            float s[8]; float cm = -1e30f;
#pragma unroll
            for (int jj = 0; jj < 8; ++jj) { const int key = sub + 8 * jj; float a = 0.f;
#pragma unroll
                for (int d = 0; d < 64; d += 4) { const f32x4 t = *(const LAS f32x4*)(Ks + key * 68 + d); a += q[d] * t[0] + q[d + 1] * t[1] + q[d + 2] * t[2] + q[d + 3] * t[3]; }
                int diff = (i - kc) * 64 + row - key; diff = diff > 128 ? 128 : diff;
                a += bs[diff + 128]; s[jj] = a; cm = fmaxf(cm, a); }
            cm = fmaxf(cm, __shfl_xor(cm, 1)); cm = fmaxf(cm, __shfl_xor(cm, 2)); cm = fmaxf(cm, __shfl_xor(cm, 4));
            const float mn = fmaxf(mx, cm), sc = __expf(mx - mn); mx = mn;
            float ps = 0.f;
#pragma unroll
            for (int jj = 0; jj < 8; ++jj) { const float pr = __expf(s[jj] - mn); ps += pr; Ps[row * 65 + sub + 8 * jj] = pr; }
            ps += __shfl_xor(ps, 1); ps += __shfl_xor(ps, 2); ps += __shfl_xor(ps, 4);
            ls = ls * sc + ps;
#pragma unroll
            for (int e = 0; e < 8; ++e) o[e] *= sc;
            asm volatile("s_waitcnt lgkmcnt(0)" ::: "memory");
#pragma unroll 8
            for (int key = 0; key < 64; ++key) { const float pr = Ps[row * 65 + key];
                const f32x4 v0 = *(const LAS f32x4*)(Vs + key * 68 + sub * 8), v1 = *(const LAS f32x4*)(Vs + key * 68 + sub * 8 + 4);
                o[0] += pr * v0[0]; o[1] += pr * v0[1]; o[2] += pr * v0[2]; o[3] += pr * v0[3]; o[4] += pr * v1[0]; o[5] += pr * v1[1]; o[6] += pr * v1[2]; o[7] += pr * v1[3]; }
        }
        const float inv = 1.f / ls;
#pragma unroll
        for (int e = 0; e < 8; ++e) o[e] *= inv;
        *(u32x4*)(O + (t0 + row) * DM + 256 + h * 64 + sub * 8) = pack8(o);
    }
}

typedef float f32x16 __attribute__((ext_vector_type(16)));
typedef short s16x4 __attribute__((ext_vector_type(4)));
__device__ __forceinline__ s16x4 lds_tr16(LAS const unsigned char* ptr) { return __builtin_bit_cast(s16x4, __builtin_amdgcn_ds_read_tr16_b64_v4i16((LAS s16x4*)ptr)); }
__device__ __forceinline__ bf16x8 scale_frag(u32x4 w, float sc) { float f[8]; unpack8(w, f);
    u32x4 o; o.x = pk2(f[0] * sc, f[1] * sc); o.y = pk2(f[2] * sc, f[3] * sc); o.z = pk2(f[4] * sc, f[5] * sc); o.w = pk2(f[6] * sc, f[7] * sc); return __builtin_bit_cast(bf16x8, o); }
__device__ __forceinline__ void attn_mfma(CPP p, int l, LAS unsigned char* lds) {
    const int tid = otid(), lane = tid & 63, wid = __builtin_amdgcn_readfirstlane(tid >> 6), r32 = lane & 31, hi = lane >> 5;
    const int h = wid >> 1, qh = wid & 1;
    LAS unsigned char* Vl = lds + wid * 17536;
    LAS unsigned char* stg = Vl;
    LAS float* bs = (LAS float*)(Vl + 16384);
    const bf16_t* H = (const bf16_t*)(p->ws + WS_E); bf16_t* O = (bf16_t*)(p->ws + WS_O);
    __syncthreads();
    for (int e = lane; e < 257; e += 64) bs[e] = p->in[4][(size_t)(l * 4 + h) * 257 + e];
    const float bfar = p->in[4][(size_t)(l * 4 + h) * 257 + 256];
#define ATT_VDMA(tk, buf) do { _Pragma("unroll") for (int c = 0; c < 8; ++c) \
        __builtin_amdgcn_global_load_lds((const unsigned*)(H + ((tk) + c * 8 + (lane >> 3)) * NH + C_AV + h * 64 + (lane & 7) * 8), (LAS unsigned*)(Vl + (buf) * 8192 + c * 1024), 16, 0, 0); } while (0)
    for (int it = obid(); it < 1024; it += ogrid()) {
        const int i = it & 31; const size_t t0 = (size_t)it * 64;
        bf16x8 qf[4];
#pragma unroll
        for (int t = 0; t < 4; ++t) qf[t] = scale_frag(*(const u32x4*)(H + (t0 + qh * 32 + r32) * NH + C_AQ + h * 64 + 16 * t + 8 * hi), 0.125f);
        const int kc0 = i > 8 ? i - 8 : 0;
        u32x4 kr[8], kn[8];
        asm volatile("s_waitcnt lgkmcnt(0)" ::: "memory");
        { const size_t tk = t0 - (size_t)(i - kc0) * 64;
#pragma unroll
            for (int t = 0; t < 4; ++t) { kn[t] = *(const u32x4*)(H + (tk + r32) * NH + C_AK + h * 64 + 16 * t + 8 * hi); kn[4 + t] = *(const u32x4*)(H + (tk + 32 + r32) * NH + C_AK + h * 64 + 16 * t + 8 * hi); }
            ATT_VDMA(tk, 0); }
        f32x16 o0, o1;
#pragma unroll
        for (int v = 0; v < 16; ++v) { o0[v] = 0.f; o1[v] = 0.f; }
        float mx = -1e30f, ls = 0.f;
        int cb = 0;
        for (int kc = kc0; kc <= i; ++kc) {
            const bool more = kc < i;
            asm volatile("s_waitcnt vmcnt(0)" ::: "memory");
#pragma unroll
            for (int c = 0; c < 8; ++c) kr[c] = kn[c];
            if (more) { const size_t tk = t0 - (size_t)(i - kc - 1) * 64;
#pragma unroll
                for (int t = 0; t < 4; ++t) { kn[t] = *(const u32x4*)(H + (tk + r32) * NH + C_AK + h * 64 + 16 * t + 8 * hi); kn[4 + t] = *(const u32x4*)(H + (tk + 32 + r32) * NH + C_AK + h * 64 + 16 * t + 8 * hi); }
                ATT_VDMA(tk, cb ^ 1); }
            f32x16 p0, p1;
#pragma unroll
            for (int v = 0; v < 16; ++v) { p0[v] = 0.f; p1[v] = 0.f; }
#pragma unroll
            for (int t = 0; t < 4; ++t) { p0 = __builtin_amdgcn_mfma_f32_32x32x16_bf16(__builtin_bit_cast(bf16x8, kr[t]), qf[t], p0, 0, 0, 0);
                p1 = __builtin_amdgcn_mfma_f32_32x32x16_bf16(__builtin_bit_cast(bf16x8, kr[4 + t]), qf[t], p1, 0, 0, 0); }
            const int dl = i - kc;
            if (dl >= 3) {
#pragma unroll
                for (int v = 0; v < 16; ++v) { p0[v] += bfar; p1[v] += bfar; }
            } else { const int base = dl * 64 + qh * 32 + r32 - 4 * hi + 128;
#pragma unroll
                for (int v = 0; v < 16; ++v) { const int kv = (v & 3) + 8 * (v >> 2); int d0 = base - kv, d1 = base - kv - 32; d0 = d0 > 256 ? 256 : d0; d1 = d1 > 256 ? 256 : d1;
                    p0[v] += bs[d0]; p1[v] += bs[d1]; } }
            float cm = fmaxf(p0[0], p1[0]);
#pragma unroll
            for (int v = 1; v < 16; ++v) cm = fmaxf(cm, fmaxf(p0[v], p1[v]));
            cm = fmaxf(cm, __shfl_xor(cm, 32));
            const float mn = fmaxf(mx, cm), al = __expf(mx - mn); mx = mn;
            float ps = 0.f;
#pragma unroll
            for (int v = 0; v < 16; ++v) { p0[v] = __expf(p0[v] - mn); p1[v] = __expf(p1[v] - mn); ps += p0[v] + p1[v]; }
            ls = ls * al + ps;
#pragma unroll
            for (int v = 0; v < 16; ++v) { o0[v] *= al; o1[v] *= al; }
            bf16x8 pb[4];
            { u32x4 w; w.x = cvt_pk_bf16(p0[0], p0[1]); w.y = cvt_pk_bf16(p0[2], p0[3]); w.z = cvt_pk_bf16(p0[4], p0[5]); w.w = cvt_pk_bf16(p0[6], p0[7]); pb[0] = __builtin_bit_cast(bf16x8, w);
              w.x = cvt_pk_bf16(p0[8], p0[9]); w.y = cvt_pk_bf16(p0[10], p0[11]); w.z = cvt_pk_bf16(p0[12], p0[13]); w.w = cvt_pk_bf16(p0[14], p0[15]); pb[1] = __builtin_bit_cast(bf16x8, w);
              w.x = cvt_pk_bf16(p1[0], p1[1]); w.y = cvt_pk_bf16(p1[2], p1[3]); w.z = cvt_pk_bf16(p1[4], p1[5]); w.w = cvt_pk_bf16(p1[6], p1[7]); pb[2] = __builtin_bit_cast(bf16x8, w);
              w.x = cvt_pk_bf16(p1[8], p1[9]); w.y = cvt_pk_bf16(p1[10], p1[11]); w.z = cvt_pk_bf16(p1[12], p1[13]); w.w = cvt_pk_bf16(p1[14], p1[15]); pb[3] = __builtin_bit_cast(bf16x8, w); }
            const LAS unsigned char* vb = Vl + cb * 8192 + (4 * hi + ((lane & 15) >> 2)) * 128 + ((lane >> 4) & 1) * 32 + (lane & 3) * 8;
#pragma unroll
            for (int ks = 0; ks < 4; ++ks) {
#pragma unroll
                for (int dh = 0; dh < 2; ++dh) { const s16x4 lo = lds_tr16(vb + ks * 2048 + dh * 64), hh = lds_tr16(vb + ks * 2048 + 1024 + dh * 64);
                    const bf16x8 va = (bf16x8){lo[0], lo[1], lo[2], lo[3], hh[0], hh[1], hh[2], hh[3]};
                    if (dh == 0) o0 = __builtin_amdgcn_mfma_f32_32x32x16_bf16(va, pb[ks], o0, 0, 0, 0); else o1 = __builtin_amdgcn_mfma_f32_32x32x16_bf16(va, pb[ks], o1, 0, 0, 0); } }
            cb ^= 1;
        }
        ls += __shfl_xor(ls, 32);
        const float inv = 1.f / ls;
        asm volatile("s_waitcnt lgkmcnt(0)" ::: "memory");
#pragma unroll
        for (int v = 0; v < 16; ++v) { const int d = (v & 3) + 8 * (v >> 2) + 4 * hi;
            *(LAS bf16_t*)(stg + r32 * 144 + d * 2) = (bf16_t)f2bf(o0[v] * inv); *(LAS bf16_t*)(stg + r32 * 144 + (32 + d) * 2) = (bf16_t)f2bf(o1[v] * inv); }
        asm volatile("s_waitcnt lgkmcnt(0)" ::: "memory");
#pragma unroll
        for (int c = 0; c < 4; ++c) { const int row = c * 8 + (lane >> 3), ch = lane & 7; const u32x4 w = *(const LAS u32x4*)(stg + row * 144 + ch * 16);
            *(u32x4*)(O + (t0 + qh * 32 + row) * DM + 256 + h * 64 + ch * 8) = w; }
    }
#undef ATT_VDMA
}

__device__ __forceinline__ void load_rot(const bf16_t* src, const float* rot, int i, LAS float* dst, float scale, float logz, int tid) {
#pragma unroll
    for (int q = 0; q < 2; ++q) { const int idx = tid + 512 * q, j = idx >> 4, f = idx & 15;
        const float x1 = bf2f(src[(size_t)j * NH + f]), x2 = bf2f(src[(size_t)j * NH + f + 16]);
        const int pos = i * 64 + j; const float c = rot[pos * 32 + f], s = rot[pos * 32 + 16 + f];
        const float sc = scale * __expf(logz * (float)(63 - j));
        dst[j * 33 + f] = (x1 * c - x2 * s) * sc; dst[j * 33 + f + 16] = (x1 * s + x2 * c) * sc; }
}
__device__ __forceinline__ float ret_logg(int h) { return log1pf(-exp2f(-5.f - (float)h)); }

__device__ __forceinline__ void upd_items(CPP p, int l, LAS unsigned char* lds) {
    LAS float* kt = (LAS float*)lds; LAS float* vv = kt + 64 * 33; LAS float* la = vv + 64 * 68; LAS float* gas = la + 64 * 33; LAS float* was = gas + 1024; LAS float* bas = was + 512;
    const bf16_t* H = (const bf16_t*)(p->ws + WS_E); const float* rot = (const float*)(p->ws + WS_ROT);
    float* RU = (float*)(p->ws + WS_RU); float* GU = (float*)(p->ws + WS_GU); float* GL = (float*)(p->ws + WS_GL);
    const int tid = otid();
    for (int it = obid(); it < 8192; it += ogrid()) {
        const int gla = it >> 12, h = it & 3, bi = (it >> 2) & 1023, i = bi & 31;
        const size_t t0 = (size_t)bi * 64;
        __syncthreads();
        if (!gla) {
            load_rot(H + t0 * NH + C_RK + h * 32, rot, i, kt, 0.17677669529663689f, ret_logg(h), tid);
            load_tile64(H + t0 * NH + C_RV + h * 64, NH, vv, 68, 1.f, tid);
            __syncthreads();
        } else {
            if (tid < 128) { const int j = tid >> 1, c = (tid & 1) * 8; const u32x4 w = *(const u32x4*)(H + (t0 + j) * NH + C_GA + c); float f[8]; unpack8(w, f);
#pragma unroll
                for (int e = 0; e < 8; ++e) gas[j * 16 + c + e] = f[e]; }
            { const int r = tid >> 5, dk = tid & 31; was[tid] = p->in[2][(size_t)(l * 16 + r) * 128 + h * 32 + dk]; }
            if (tid < 32) bas[tid] = p->in[3][l * 128 + h * 32 + tid];
            { const int idx = tid * 4, j = idx >> 5, c = idx & 31; const u32x2 w = *(const u32x2*)(H + (t0 + j) * NH + C_GK + h * 32 + c);
                kt[j * 33 + c] = bflo(w.x); kt[j * 33 + c + 1] = bfhi(w.x); kt[j * 33 + c + 2] = bflo(w.y); kt[j * 33 + c + 3] = bfhi(w.y); }
            load_tile64(H + t0 * NH + C_GV + h * 64, NH, vv, 68, 1.f, tid);
            __syncthreads();
#pragma unroll
            for (int q = 0; q < 4; ++q) { const int e = tid + 512 * q, j = e >> 5, dk = e & 31; float z = bas[dk];
#pragma unroll
                for (int r = 0; r < 16; ++r) z += gas[j * 16 + r] * was[r * 32 + dk];
                const float lsg = fminf(z, 0.f) - log1pf(expf(-fabsf(z)));
                la[j * 33 + dk] = lsg * 0.0625f; }
            __syncthreads();
            if (tid < 32) { float run = 0.f; for (int j = 0; j < 64; ++j) { run += la[j * 33 + tid]; la[j * 33 + tid] = run; } }
            __syncthreads();
#pragma unroll
            for (int q = 0; q < 4; ++q) { const int e = tid + 512 * q, j = e >> 5, dk = e & 31; kt[j * 33 + dk] *= __expf(la[63 * 33 + dk] - la[j * 33 + dk]); }
            if (tid < 32) GL[(size_t)(bi * 4 + h) * 32 + tid] = la[63 * 33 + tid];
            __syncthreads();
        }
        const int dk = tid >> 4, dv0 = (tid & 15) * 4; f32x4 a = (f32x4){0.f, 0.f, 0.f, 0.f};
#pragma unroll 8
        for (int j = 0; j < 64; ++j) { const float kk = kt[j * 33 + dk]; const f32x4 v4 = *(const LAS f32x4*)(vv + j * 68 + dv0); a += v4 * kk; }
        float* dst = (gla ? GU : RU) + (size_t)(bi * 4 + h) * 2048 + dk * 64 + dv0;
        *(f32x4*)dst = a;
    }
}

__device__ __forceinline__ void scan_items(CPP p, int l) {
    float* RU = (float*)(p->ws + WS_RU); float* GU = (float*)(p->ws + WS_GU); const float* GL = (const float*)(p->ws + WS_GL);
    const float* ES = (const float*)(p->ws + WS_ES); bf16_t* U2 = (bf16_t*)(p->ws + WS_U2);
    const int gt = obid() * 512 + otid(), NT = ogrid() * 512;
    for (int e = gt; e < 262144; e += NT) { const int dvk = e & 2047, bh = e >> 11, h = bh & 3, b = bh >> 2;
        const float dec = expf(64.f * ret_logg(h)); float st = 0.f;
        for (int i = 0; i < 32; ++i) { const size_t idx = (size_t)((b * 32 + i) * 4 + h) * 2048 + dvk; const float t = RU[idx]; RU[idx] = st; st = st * dec + t; } }
    for (int e = gt; e < 262144; e += NT) { const int dvk = e & 2047, bh = e >> 11, h = bh & 3, b = bh >> 2; float st = 0.f;
        for (int i = 0; i < 32; ++i) { const size_t bih = (size_t)((b * 32 + i) * 4 + h); const float gl = GL[bih * 32 + (dvk >> 6)];
            st = __expf(gl) * st + GU[bih * 2048 + dvk]; GU[bih * 2048 + dvk] = st; } }
    for (int e = gt; e < 32768; e += NT) { const int pp = e & 63, g = (e >> 6) & 15, b = e >> 10; const int gp = (l * 16 + g) * 64 + pp;
        const float lr = p->in[5][gp], li = p->in[6][gp], dt = expf(p->in[7][l * 16 + g]);
        float ar, ai2; s5_abar_pow(lr, li, dt, 64, ar, ai2);
        float xr = 0.f, xi = 0.f;
        for (int i = 0; i < 32; ++i) { const size_t row = (size_t)g * 1024 + b * 32 + i;
            U2[row * S5K + 1024 + pp] = (bf16_t)f2bf(xr); U2[row * S5K + 1088 + pp] = (bf16_t)f2bf(xi);
            const float er = ES[row * 128 + pp], ei = ES[row * 128 + 64 + pp];
            const float nr = ar * xr - ai2 * xi + er, ni = ar * xi + ai2 * xr + ei; xr = nr; xi = ni; } }
}

__device__ __forceinline__ void out_items(CPP p, int l, LAS unsigned char* lds) {
    LAS float* qt = (LAS float*)lds; LAS float* kt = qt + 64 * 33; LAS float* vv = kt + 64 * 33; LAS float* Sm = vv + 64 * 68; LAS float* Rm = Sm + 64 * 65;
    const bf16_t* H = (const bf16_t*)(p->ws + WS_E); const float* rot = (const float*)(p->ws + WS_ROT); bf16_t* O = (bf16_t*)(p->ws + WS_O);
    const float* RU = (const float*)(p->ws + WS_RU); const float* GU = (const float*)(p->ws + WS_GU);
    const int tid = otid();
    for (int it = obid(); it < 8192; it += ogrid()) {
        const int gla = it >> 12, h = it & 3, bi = (it >> 2) & 1023, i = bi & 31;
        const size_t t0 = (size_t)bi * 64;
        const int n = tid >> 3, dv0 = (tid & 7) * 8;
        float acc[8];
#pragma unroll
        for (int e = 0; e < 8; ++e) acc[e] = 0.f;
        __syncthreads();
        { const float* src = (gla ? GU : RU) + (size_t)(bi * 4 + h) * 2048; const int idx = tid * 4, dk = idx >> 6, dv = idx & 63;
            const f32x4 t = *(const f32x4*)(src + idx); Rm[dk * 68 + dv] = t[0]; Rm[dk * 68 + dv + 1] = t[1]; Rm[dk * 68 + dv + 2] = t[2]; Rm[dk * 68 + dv + 3] = t[3]; }
        if (!gla) {
            const float lg = ret_logg(h);
            load_rot(H + t0 * NH + C_RQ + h * 32, rot, i, qt, 1.f, 0.f, tid);
            load_rot(H + t0 * NH + C_RK + h * 32, rot, i, kt, 0.17677669529663689f, 0.f, tid);
            load_tile64(H + t0 * NH + C_RV + h * 64, NH, vv, 68, 1.f, tid);
            __syncthreads();
            { const int m0 = (tid & 7) * 8;
#pragma unroll
                for (int mm = 0; mm < 8; ++mm) { const int m = m0 + mm; float d = 0.f;
#pragma unroll
                    for (int dk = 0; dk < 32; ++dk) d += qt[n * 33 + dk] * kt[m * 33 + dk];
                    const int ad = n > m ? n - m : m - n; Sm[n * 65 + m] = d * __expf(lg * (float)ad); } }
            __syncthreads();
#pragma unroll 4
            for (int m = 0; m < 64; ++m) { const float sv = Sm[n * 65 + m]; const f32x4 v0 = *(const LAS f32x4*)(vv + m * 68 + dv0), v1 = *(const LAS f32x4*)(vv + m * 68 + dv0 + 4);
                acc[0] += sv * v0[0]; acc[1] += sv * v0[1]; acc[2] += sv * v0[2]; acc[3] += sv * v0[3]; acc[4] += sv * v1[0]; acc[5] += sv * v1[1]; acc[6] += sv * v1[2]; acc[7] += sv * v1[3]; }
            const float xi = __expf(lg * (float)(n + 1));
#pragma unroll 4
            for (int dk = 0; dk < 32; ++dk) { const float qx = qt[n * 33 + dk] * xi; const f32x4 v0 = *(const LAS f32x4*)(Rm + dk * 68 + dv0), v1 = *(const LAS f32x4*)(Rm + dk * 68 + dv0 + 4);
                acc[0] += qx * v0[0]; acc[1] += qx * v0[1]; acc[2] += qx * v0[2]; acc[3] += qx * v0[3]; acc[4] += qx * v1[0]; acc[5] += qx * v1[1]; acc[6] += qx * v1[2]; acc[7] += qx * v1[3]; }
        } else {
            { const int idx = tid * 4, j = idx >> 5, c = idx & 31; const u32x2 w = *(const u32x2*)(H + (t0 + j) * NH + C_GQ + h * 32 + c); const float sc = 0.17677669529663689f;
                qt[j * 33 + c] = bflo(w.x) * sc; qt[j * 33 + c + 1] = bfhi(w.x) * sc; qt[j * 33 + c + 2] = bflo(w.y) * sc; qt[j * 33 + c + 3] = bfhi(w.y) * sc; }
            __syncthreads();
#pragma unroll 4
            for (int dk = 0; dk < 32; ++dk) { const float qx = qt[n * 33 + dk]; const f32x4 v0 = *(const LAS f32x4*)(Rm + dk * 68 + dv0), v1 = *(const LAS f32x4*)(Rm + dk * 68 + dv0 + 4);
                acc[0] += qx * v0[0]; acc[1] += qx * v0[1]; acc[2] += qx * v0[2]; acc[3] += qx * v0[3]; acc[4] += qx * v1[0]; acc[5] += qx * v1[1]; acc[6] += qx * v1[2]; acc[7] += qx * v1[3]; }
        }
        float s = 0.f;
#pragma unroll
        for (int e = 0; e < 8; ++e) s += acc[e];
        s += __shfl_xor(s, 1); s += __shfl_xor(s, 2); s += __shfl_xor(s, 4);
        const float mean = s * (1.f / 64.f); float s2 = 0.f;
#pragma unroll
        for (int e = 0; e < 8; ++e) { acc[e] -= mean; s2 += acc[e] * acc[e]; }
        s2 += __shfl_xor(s2, 1); s2 += __shfl_xor(s2, 2); s2 += __shfl_xor(s2, 4);
        const float rs = 1.f / sqrtf(s2 * (1.f / 64.f) + LN_EPS);
        const u32x4 gw = *(const u32x4*)(H + (t0 + n) * NH + (gla ? C_GR : C_RG) + h * 64 + dv0); float gf[8]; unpack8(gw, gf);
        float ov[8];
#pragma unroll
        for (int e = 0; e < 8; ++e) ov[e] = silu_f(gf[e]) * acc[e] * rs;
        *(u32x4*)(O + (t0 + n) * DM + (gla ? 512 : 0) + h * 64 + dv0) = pack8(ov);
    }
}


#define XB_TMO      128
#define XB_XCNT(j)  (256  + 64 * (j))
#define XB_XSUB(j)  (1280 + 64 * (j))
#define XB_XGEN(j)  (2304 + 64 * (j))
#define XB_TOP      3328
#define XB_TOPGEN   3392
#define XCD_BAR_WORDS 3456
#define XB_SPIN_CAP (1u << 20)
__device__ __forceinline__ unsigned xb_ld(unsigned* p)              { return __hip_atomic_load(p, __ATOMIC_RELAXED, __HIP_MEMORY_SCOPE_AGENT); }
__device__ __forceinline__ unsigned xb_add(unsigned* p, unsigned v) { return __hip_atomic_fetch_add(p, v, __ATOMIC_RELAXED, __HIP_MEMORY_SCOPE_AGENT); }
__device__ __forceinline__ unsigned xb_xcc_id() { return (unsigned)__builtin_amdgcn_s_getreg((3 << 11) | 20) & 0xFu; }
#define XB_SPIN(cond, bar) do { unsigned _sp = 0; while (cond) { __builtin_amdgcn_s_sleep(1); \
    if ((++_sp & 255u) == 0u) { if (xb_ld(&(bar)[XB_TMO])) break; if (_sp > XB_SPIN_CAP) { atomicAdd(&(bar)[XB_TMO], 1u); break; } } } } while (0)
struct XcdBarrier { unsigned* bar; unsigned x; volatile LAS unsigned* st; };
__device__ __forceinline__ XcdBarrier xcd_barrier_post(unsigned* bar, volatile LAS unsigned* st) {
    XcdBarrier b; b.bar = bar; b.x = xb_xcc_id(); b.st = st;
    if (threadIdx.x == 0) (void)xb_add(&bar[XB_XCNT(b.x)], 1u);
    return b;
}
__device__ __forceinline__ void xcd_barrier_complete(unsigned* bar, unsigned x, unsigned& nloc, unsigned& nx) {
    const unsigned G = gridDim.x * gridDim.y * gridDim.z;
    unsigned sum, cnt, mine, sp = 0u;
    for (;;) {
        sum = 0u; cnt = 0u; mine = 0u;
#pragma unroll
        for (unsigned j = 0; j < 16; ++j) { const unsigned c = xb_ld(&bar[XB_XCNT(j)]); sum += c; cnt += (c > 0u) ? 1u : 0u; mine = (j == x) ? c : mine; }
        if (sum == G) break;
        __builtin_amdgcn_s_sleep(1);
        if ((++sp & 255u) == 0u) { if (xb_ld(&bar[XB_TMO])) break; if (sp > XB_SPIN_CAP) { atomicAdd(&bar[XB_TMO], 1u); break; } }
    }
    nloc = mine > 0u ? mine : 1u; nx = cnt > 0u ? cnt : 1u;
}
__device__ __forceinline__ void xcd_barrier(const XcdBarrier& b) {
    asm volatile("s_waitcnt vmcnt(0)" ::: "memory");
    __syncthreads();
    if (threadIdx.x == 0) {
        unsigned* bar = b.bar;
        __builtin_amdgcn_s_waitcnt(0);
        unsigned nloc = b.st[0], nx = b.st[1];
        if (nloc == 0u) { xcd_barrier_complete(bar, b.x, nloc, nx); b.st[0] = nloc; b.st[1] = nx; }
        const unsigned old = xb_add(&bar[XB_XSUB(b.x)], 1u);
        const unsigned gen = old / nloc;
        if (old + 1u == (gen + 1u) * nloc) {
            __builtin_amdgcn_fence(__ATOMIC_RELEASE, "agent");
            asm volatile("s_waitcnt vmcnt(0)" ::: "memory");
            const unsigned og = xb_add(&bar[XB_TOP], 1u);
            const unsigned tg = og / nx;
            if (og + 1u == (tg + 1u) * nx) xb_add(&bar[XB_TOPGEN], 1u);
            else XB_SPIN(xb_ld(&bar[XB_TOPGEN]) == tg, bar);
            __builtin_amdgcn_fence(__ATOMIC_ACQUIRE, "agent");
            xb_add(&bar[XB_XGEN(b.x)], 1u);
            asm volatile("s_waitcnt vmcnt(0)" ::: "memory");
        } else {
            XB_SPIN(xb_ld(&bar[XB_XGEN(b.x)]) == gen, bar);
            __builtin_amdgcn_fence(__ATOMIC_ACQUIRE, "agent");
            asm volatile("s_waitcnt vmcnt(0)" ::: "memory");
        }
    }
    __syncthreads();
}

__global__ void __launch_bounds__(512, 2) mega(Params p_unused) {
    extern __shared__ __attribute__((aligned(16))) unsigned char lds_raw[];
    LAS unsigned char* lds = (LAS unsigned char*)lds_raw;
    cg::grid_group grid = cg::this_grid();
    CPP p = (CPP)__builtin_amdgcn_kernarg_segment_ptr();
    unsigned char* ws = p->ws;
    bf16_t* XB = (bf16_t*)(ws + WS_XB);
    volatile LAS unsigned* bst = (volatile LAS unsigned*)(lds + LDS_BYTES - 64);
    if (threadIdx.x < 2) bst[threadIdx.x] = 0u;
    __syncthreads();
    const XcdBarrier bar = xcd_barrier_post((unsigned*)ws, bst);

    { float* rot = (float*)(ws + WS_ROT); const int gt = obid() * 512 + otid(), NT = ogrid() * 512;
        for (int e = gt; e < 2048 * 16; e += NT) { const int pos = e >> 4, f = e & 15; const float inv = 1.0f / powf(10000.0f, (float)f * (1.0f / 16.0f)); const float ang = (float)pos * inv;
            rot[pos * 32 + f] = cosf(ang); rot[pos * 32 + 16 + f] = sinf(ang); } }
    s5_tables(p, 0, lds);
    { const float* x = p->in[0]; const int gt = obid() * 512 + otid(), NT = ogrid() * 512;
        for (size_t e = gt; e < (size_t)M * DM / 8; e += NT) { const f32x4 a = *((const f32x4*)x + 2 * e), b = *((const f32x4*)x + 2 * e + 1);
            u32x4 w; w.x = pk2(a[0], a[1]); w.y = pk2(a[2], a[3]); w.z = pk2(b[0], b[1]); w.w = pk2(b[2], b[3]); *((u32x4*)XB + e) = w; } }
    grid.sync();
    convert_weights(p, 0, lds);
    xcd_barrier(bar);

    for (int l = 0; l < 4; ++l) {
        for (int s = 0; s < 12; ++s) {
            p = (CPP)__builtin_amdgcn_kernarg_segment_ptr(); asm volatile("" : "+s"(p));
            pg8::Gemm g; pg8::Sched S; pg8::Epi E;
            bool do_gemm = true;
            S.G = ogrid(); S.c = obid(); S.mode = 0; S.nM = M / 256; S.nN = 1;
            E.mode = 0; E.perm = true;
            E.ws = ws; E.dskip = p->in[12] + l * 256; E.bglu = p->in[14] + l * 256; E.bgate = p->in[16] + (size_t)l * 4096;
            E.xres = p->out; E.xout = p->out;
            g.A = XB; g.Bt = (const bf16_t*)(ws + WS_WIN); g.lda = DM; g.ldb = DM; g.K = DM;
            switch (s) {
                case 0: S.nN = NINP / 256; E.mode = 0; E.perm = true; break;
                case 1: g.A = (const bf16_t*)(ws + WS_U2); g.Bt = (const bf16_t*)(ws + WS_WE); g.lda = S5K; g.ldb = 1024; g.K = 1024; S.mode = 2; S.nM = 64; S.nN = 1; E.mode = 1; break;
                case 3: g.A = (const bf16_t*)(ws + WS_U2); g.Bt = (const bf16_t*)(ws + WS_WT); g.lda = S5K; g.ldb = S5K; g.K = S5K; S.mode = 3; S.nM = 64; S.nN = 4; E.mode = 2; break;
                case 4: g.A = (const bf16_t*)(ws + WS_YS); g.Bt = (const bf16_t*)(ws + WS_WGLU); g.lda = 256; g.ldb = 256; g.K = 256; S.nN = 1; E.mode = 3; break;
                case 5: g.A = (const bf16_t*)(ws + WS_O); g.Bt = (const bf16_t*)(ws + WS_WB); g.lda = DM; g.ldb = 256; g.K = 256; S.mode = 1; S.nN = 16; E.mode = 4; break;
                case 6: g.Bt = (const bf16_t*)(ws + WS_WG); S.nN = 16; E.mode = 5; E.perm = false; break;
                case 7: g.A = (const bf16_t*)(ws + WS_O); g.Bt = (const bf16_t*)(ws + WS_WO); S.nN = 4; E.mode = 6; E.perm = false; E.xres = (l == 0) ? p->in[0] : p->out; break;
                case 9: g.Bt = (const bf16_t*)(ws + WS_WFF); S.nN = 22; E.mode = 7; E.perm = false; break;
                case 10: g.A = (const bf16_t*)(ws + WS_E); g.Bt = (const bf16_t*)(ws + WS_WD); g.lda = DFF; g.ldb = DFF; g.K = DFF; S.nN = 4; E.mode = 6; E.perm = false; break;
                default: do_gemm = false; break;
            }
            S.nwg = S.nM * S.nN;
            if (do_gemm) pg8::gemm_phase(lds, g, S, E);
            if (s == 1) { attn_mfma(p, l, lds); upd_items(p, l, lds); }
            else if (s == 2) scan_items(p, l);
            else if (s == 3) out_items(p, l, lds);
            else if (s == 8) { ln_pass(p->out, XB, p->in[19] + l * DM, p->in[20] + l * DM); if (l < 3) s5_tables(p, l + 1, lds); }
            else if (s == 11) { ln_pass(p->out, XB, p->in[24] + l * DM, p->in[25] + l * DM); if (l < 3) convert_weights(p, l + 1, lds); }
            xcd_barrier(bar);
        }
    }
}

extern "C" void kernel_launch(void* const* d_in, const int* in_sizes, int n_in, void* d_out, int out_size, void* d_ws, size_t ws_size, hipStream_t stream) {
    static int grid_blocks = 0;
    if (!grid_blocks) {
        int dev = 0, cus = 0;
        hipGetDevice(&dev);
        hipDeviceGetAttribute(&cus, hipDeviceAttributeMultiprocessorCount, dev);
        hipFuncSetAttribute((const void*)mega, hipFuncAttributeMaxDynamicSharedMemorySize, LDS_BYTES);
        grid_blocks = cus > 0 ? cus : 256;
    }
    (void)hipMemsetAsync(d_ws, 0, 65536, stream);
    Params p{};
    for (int i = 0; i < 26; ++i) p.in[i] = (const float*)d_in[i];
    p.out = (float*)d_out; p.ws = (unsigned char*)d_ws;
    void* args[] = {&p};
    hipError_t e = hipLaunchCooperativeKernel((const void*)mega, dim3(grid_blocks), dim3(512), args, LDS_BYTES, stream);
    if (e != hipSuccess) fprintf(stderr, "cooperative launch failed: %s (grid %d)\n", hipGetErrorString(e), grid_blocks);
}
```

```cpp
#include <hip/hip_runtime.h>
#include <hip/hip_cooperative_groups.h>
#include <cstdint>
#include <cstdio>
namespace cg = cooperative_groups;

#define LAS __attribute__((address_space(3)))
typedef unsigned short bf16_t;
typedef short bf16x8 __attribute__((ext_vector_type(8)));
typedef float f32x4 __attribute__((ext_vector_type(4)));
typedef float f32x2 __attribute__((ext_vector_type(2)));
typedef unsigned u32x4 __attribute__((ext_vector_type(4)));
typedef unsigned u32x2 __attribute__((ext_vector_type(2)));

constexpr int M = 65536, DM = 1024, SEQ = 2048, NCH = 32;
constexpr int NH = 2320;
constexpr int NINP = 2816;
constexpr int DFF = 2816;
constexpr int S5K = 1152;
constexpr float ALPHA = 1.681792830507429f;
constexpr float LN_EPS = 1e-5f;
constexpr int C_RQ = 0, C_RK = 128, C_RV = 256, C_RG = 512, C_AQ = 768, C_AK = 1024, C_AV = 1280, C_GQ = 1536, C_GK = 1664, C_GV = 1792, C_GR = 2048, C_GA = 2304, C_SU = 2320;

constexpr size_t MiB = 1u << 20;
constexpr size_t WS_ROT = 1 * MiB;
constexpr size_t WS_KN = 2 * MiB;
constexpr size_t WS_WIN = 4 * MiB;
constexpr size_t WS_WG = 10 * MiB;
constexpr size_t WS_WB = 18 * MiB;
constexpr size_t WS_WO = 20 * MiB;
constexpr size_t WS_WFF = 22 * MiB;
constexpr size_t WS_WD = 33 * MiB;
constexpr size_t WS_WGLU = 39 * MiB;
constexpr size_t WS_WE = 40 * MiB;
constexpr size_t WS_WT = 48 * MiB;
constexpr size_t WS_XB = 88 * MiB;
constexpr size_t WS_O = 216 * MiB;
constexpr size_t WS_E = 344 * MiB;
constexpr size_t WS_U2 = 636 * MiB;
constexpr size_t WS_RU = 676 * MiB;
constexpr size_t WS_GU = 708 * MiB;
constexpr size_t WS_GL = 740 * MiB;
constexpr size_t WS_ES = 741 * MiB;
constexpr size_t WS_YS = 749 * MiB;
constexpr int LDS_BYTES = 147456;

struct Params { const float* in[26]; float* out; unsigned char* ws; };
typedef const __attribute__((address_space(4))) Params* CPP;

typedef _Float16 half2_t __attribute__((ext_vector_type(2)));
typedef _Float16 half8_t __attribute__((ext_vector_type(8)));
__device__ __forceinline__ float bflo(unsigned w) { return (float)__builtin_bit_cast(half2_t, w)[0]; }
__device__ __forceinline__ float bfhi(unsigned w) { return (float)__builtin_bit_cast(half2_t, w)[1]; }
__device__ __forceinline__ float bf2f(bf16_t b) { return (float)__builtin_bit_cast(_Float16, b); }
__device__ __forceinline__ unsigned f2bf(float f) { return (unsigned)__builtin_bit_cast(unsigned short, (_Float16)f); }
__device__ __forceinline__ unsigned pk2(float lo, float hi) { const half2_t v = {(_Float16)lo, (_Float16)hi}; return __builtin_bit_cast(unsigned, v); }
__device__ __forceinline__ unsigned cvt_pk_bf16(float lo, float hi) { return pk2(lo, hi); }
__device__ __forceinline__ float sigm(float x) { return __builtin_amdgcn_rcpf(1.0f + __expf(-x)); }
__device__ __forceinline__ float silu_f(float x) { return x * sigm(x); }
__device__ __forceinline__ float gelu_tanh(float v) { return v * sigm(1.5957691216057308f * (v + 0.044715f * v * v * v)); }
__device__ __forceinline__ void unpack8(u32x4 w, float* o) {
    o[0] = bflo(w.x); o[1] = bfhi(w.x); o[2] = bflo(w.y); o[3] = bfhi(w.y); o[4] = bflo(w.z); o[5] = bfhi(w.z); o[6] = bflo(w.w); o[7] = bfhi(w.w);
}
__device__ __forceinline__ u32x4 pack8(const float* v) { u32x4 w; w.x = pk2(v[0], v[1]); w.y = pk2(v[2], v[3]); w.z = pk2(v[4], v[5]); w.w = pk2(v[6], v[7]); return w; }
__device__ __forceinline__ int otid() { int t = threadIdx.x; asm volatile("" : "+v"(t)); return t; }
__device__ __forceinline__ int obid() { int b = blockIdx.x; asm volatile("" : "+s"(b)); return b; }
__device__ __forceinline__ int ogrid() { int b = gridDim.x; asm volatile("" : "+s"(b)); return b; }
__device__ __forceinline__ float wave_sum(float v) {
#pragma unroll
    for (int o = 1; o < 64; o <<= 1) v += __shfl_xor(v, o);
    return v;
}

namespace pg8 {
constexpr int BM = 256, BK = 64, HALF = 128, HTB = HALF * BK * 2, STAGE_BYTES = 8 * HTB, NXCD = 8, WGM = 8;
__device__ __forceinline__ int lds_byte(int r, int c) { const int st = (r >> 4) * 2 + (c >> 5), rr = r & 15, cc = c & 31, ob = rr * 64 + cc * 2; return st * 1024 + (ob ^ (((ob >> 9) & 1) << 5)); }
__device__ __forceinline__ void stage_rc(int b, int& R, int& C) { const int st = b / 1024, sb = b % 1024, swz = sb ^ (((sb >> 9) & 1) << 5); R = (st >> 1) * 16 + swz / 64; C = (st & 1) * 32 + (swz % 64) / 2; }
__device__ __forceinline__ int perm32(int rho) { const int n = rho >> 4, i = rho & 15; return 8 * (i >> 2) + 4 * n + (i & 3); }

struct Unit { int pm, pn, ak; };
struct Gemm { const bf16_t* A; const bf16_t* Bt; int lda, ldb, K; };

struct Sched {
    int nM, nN, nwg, G, c, mode;
    __device__ __forceinline__ bool next(int i, Unit& u) const {
        const long L = (long)i * G + c; if (L >= nwg) return false;
        if (mode == 2) { u.pm = (int)L; u.pn = (int)(L >> 2); u.ak = 0; return true; }
        if (mode == 3) { const int g = (int)(L >> 4); u.pm = 4 * g + (int)((L >> 2) & 3); u.pn = 4 * g + (int)(L & 3); u.ak = 0; return true; }
        int wgid = (int)L; { const int q = nwg / NXCD, r = nwg % NXCD, xcd = wgid % NXCD, off = wgid / NXCD; wgid = (xcd < r ? xcd * (q + 1) : r * (q + 1) + (xcd - r) * q) + off; }
        const int nig = WGM * nN, gid = wgid / nig, fm = gid * WGM, gsz = (nM - fm) < WGM ? (nM - fm) : WGM;
        u.pm = fm + ((wgid % nig) % gsz); u.pn = (wgid % nig) / gsz; u.ak = (mode == 1) ? (u.pn >> 2) * 256 : 0; return true;
    }
};

struct Epi {
    int mode; bool perm;
    unsigned char* ws; const float* dskip; const float* bglu; const float* bgate;
    __device__ __forceinline__ void operator()(const f32x4 (&acc)[2][2][4][2], const Unit& u, int wr, int wc, int fr, int fq) const {
        const int row0 = u.pm * BM + wr * 64 + fr;
        bf16_t* const H = (bf16_t*)(ws + WS_E); bf16_t* const U2 = (bf16_t*)(ws + WS_U2); float* const ES = (float*)(ws + WS_ES); bf16_t* const YS = (bf16_t*)(ws + WS_YS);
        bf16_t* const Ob = (bf16_t*)(ws + WS_O); bf16_t* const P = (bf16_t*)(ws + WS_E); bf16_t* const MIX = (bf16_t*)(ws + WS_O); bf16_t* const HF = (bf16_t*)(ws + WS_E);
        if (mode == 0) {
#pragma unroll
            for (int ai = 0; ai < 2; ++ai)
#pragma unroll
                for (int m = 0; m < 4; ++m) { const int r = row0 + ai * HALF + m * 16;
#pragma unroll
                    for (int bj = 0; bj < 2; ++bj) { const int c0 = u.pn * BM + bj * HALF + wc * 32 + 8 * fq;
                        const f32x4 v0 = acc[ai][bj][m][0], v1 = acc[ai][bj][m][1];
                        u32x4 w; w.x = cvt_pk_bf16(v0[0], v0[1]); w.y = cvt_pk_bf16(v0[2], v0[3]); w.z = cvt_pk_bf16(v1[0], v1[1]); w.w = cvt_pk_bf16(v1[2], v1[3]);
                        if (c0 < C_SU) *(u32x4*)(H + (size_t)r * NH + c0) = w;
                        else if (c0 < C_SU + 256) { const int c = c0 - C_SU, g = c >> 4, ci = c & 15;
                            *(u32x4*)(U2 + ((size_t)(g * 1024 + (r >> 6))) * S5K + (r & 63) * 16 + ci) = w; } } }
        } else if (mode == 1) {
#pragma unroll
            for (int ai = 0; ai < 2; ++ai)
#pragma unroll
                for (int m = 0; m < 4; ++m) { const int r = row0 + ai * HALF + m * 16; const int c0 = wc * 32 + 8 * fq;
                    *(f32x4*)(ES + (size_t)r * 128 + c0) = acc[ai][0][m][0]; *(f32x4*)(ES + (size_t)r * 128 + c0 + 4) = acc[ai][0][m][1]; }
        } else if (mode == 2) {
            const int g = u.pm >> 2;
#pragma unroll
            for (int ai = 0; ai < 2; ++ai)
#pragma unroll
                for (int m = 0; m < 4; ++m) { const int r = row0 + ai * HALF + m * 16;
#pragma unroll
                    for (int bj = 0; bj < 2; ++bj) { const int n0 = (u.pn & 3) * BM + bj * HALF + wc * 32 + 8 * fq; const int j = n0 >> 4, i0 = n0 & 15;
                        const u32x4 uw = *(const u32x4*)(U2 + (size_t)r * S5K + n0); float uf[8]; unpack8(uw, uf);
                        const f32x4 d0 = *(const f32x4*)(dskip + 16 * g + i0), d1 = *(const f32x4*)(dskip + 16 * g + i0 + 4);
                        const f32x4 v0 = acc[ai][bj][m][0], v1 = acc[ai][bj][m][1]; float y[8];
                        y[0] = gelu_tanh(v0[0] + d0[0] * uf[0]); y[1] = gelu_tanh(v0[1] + d0[1] * uf[1]); y[2] = gelu_tanh(v0[2] + d0[2] * uf[2]); y[3] = gelu_tanh(v0[3] + d0[3] * uf[3]);
                        y[4] = gelu_tanh(v1[0] + d1[0] * uf[4]); y[5] = gelu_tanh(v1[1] + d1[1] * uf[5]); y[6] = gelu_tanh(v1[2] + d1[2] * uf[6]); y[7] = gelu_tanh(v1[3] + d1[3] * uf[7]);
                        u32x4 w; w.x = cvt_pk_bf16(y[0], y[1]); w.y = cvt_pk_bf16(y[2], y[3]); w.z = cvt_pk_bf16(y[4], y[5]); w.w = cvt_pk_bf16(y[6], y[7]);
                        const size_t t = (size_t)(r & 1023) * 64 + j;
                        *(u32x4*)(YS + t * 256 + 16 * g + i0) = w; } }
        } else if (mode == 3) {
#pragma unroll
            for (int ai = 0; ai < 2; ++ai)
#pragma unroll
                for (int m = 0; m < 4; ++m) { const int r = row0 + ai * HALF + m * 16;
#pragma unroll
                    for (int bj = 0; bj < 2; ++bj) { const int c0 = bj * HALF + wc * 32 + 8 * fq;
                        const u32x4 yw = *(const u32x4*)(YS + (size_t)r * 256 + c0); float yf[8]; unpack8(yw, yf);
                        const f32x4 b0 = *(const f32x4*)(bglu + c0), b1 = *(const f32x4*)(bglu + c0 + 4);
                        const f32x4 v0 = acc[ai][bj][m][0] + b0, v1 = acc[ai][bj][m][1] + b1; float o[8];
                        o[0] = yf[0] * sigm(v0[0]); o[1] = yf[1] * sigm(v0[1]); o[2] = yf[2] * sigm(v0[2]); o[3] = yf[3] * sigm(v0[3]);
                        o[4] = yf[4] * sigm(v1[0]); o[5] = yf[5] * sigm(v1[1]); o[6] = yf[6] * sigm(v1[2]); o[7] = yf[7] * sigm(v1[3]);
                        u32x4 w; w.x = cvt_pk_bf16(o[0], o[1]); w.y = cvt_pk_bf16(o[2], o[3]); w.z = cvt_pk_bf16(o[4], o[5]); w.w = cvt_pk_bf16(o[6], o[7]);
                        *(u32x4*)(Ob + (size_t)r * DM + 768 + c0) = w; } }
        } else if (mode == 4) {
#pragma unroll
            for (int ai = 0; ai < 2; ++ai)
#pragma unroll
                for (int m = 0; m < 4; ++m) { const int r = row0 + ai * HALF + m * 16;
#pragma unroll
                    for (int bj = 0; bj < 2; ++bj) { const int c0 = u.pn * BM + bj * HALF + wc * 32 + 8 * fq;
                        const f32x4 v0 = acc[ai][bj][m][0], v1 = acc[ai][bj][m][1];
                        u32x4 w; w.x = cvt_pk_bf16(v0[0], v0[1]); w.y = cvt_pk_bf16(v0[2], v0[3]); w.z = cvt_pk_bf16(v1[0], v1[1]); w.w = cvt_pk_bf16(v1[2], v1[3]);
                        *(u32x4*)(P + (size_t)r * 4096 + c0) = w; } }
        } else if (mode == 5) {
            const int ch0 = 64 * u.pn + 16 * wc + 4 * fq;
            f32x4 bv[4];
#pragma unroll
            for (int b = 0; b < 4; ++b) bv[b] = *(const f32x4*)(bgate + b * 1024 + ch0);
#pragma unroll
            for (int ai = 0; ai < 2; ++ai)
#pragma unroll
                for (int m = 0; m < 4; ++m) { const int r = row0 + ai * HALF + m * 16; f32x4 mix = (f32x4){0.f, 0.f, 0.f, 0.f};
#pragma unroll
                    for (int bj = 0; bj < 2; ++bj)
#pragma unroll
                        for (int n = 0; n < 2; ++n) { const int b = 2 * bj + n; const f32x4 a = acc[ai][bj][m][n] + bv[b];
                            const u32x2 pw = *(const u32x2*)(P + (size_t)r * 4096 + b * 1024 + ch0);
                            mix[0] += sigm(a[0]) * bflo(pw.x); mix[1] += sigm(a[1]) * bfhi(pw.x); mix[2] += sigm(a[2]) * bflo(pw.y); mix[3] += sigm(a[3]) * bfhi(pw.y); }
                    u32x2 w; w.x = cvt_pk_bf16(mix[0], mix[1]); w.y = cvt_pk_bf16(mix[2], mix[3]);
                    *(u32x2*)(MIX + (size_t)r * DM + ch0) = w; }
        } else if (mode == 6) {
            bf16_t* const XBp = (bf16_t*)(ws + WS_XB);
#pragma unroll
            for (int ai = 0; ai < 2; ++ai)
#pragma unroll
                for (int m = 0; m < 4; ++m) { const int r = row0 + ai * HALF + m * 16;
#pragma unroll
                    for (int bj = 0; bj < 2; ++bj)
#pragma unroll
                        for (int n = 0; n < 2; ++n) { const int c = u.pn * BM + bj * HALF + wc * 32 + n * 16 + 4 * fq;
                            u32x2* px = (u32x2*)(XBp + (size_t)r * DM + c); const u32x2 xw = *px; const f32x4 a = acc[ai][bj][m][n];
                            u32x2 w; w.x = cvt_pk_bf16(bflo(xw.x) * ALPHA + a[0], bfhi(xw.x) * ALPHA + a[1]); w.y = cvt_pk_bf16(bflo(xw.y) * ALPHA + a[2], bfhi(xw.y) * ALPHA + a[3]);
                            *px = w; } }
        } else {
#pragma unroll
            for (int ai = 0; ai < 2; ++ai)
#pragma unroll
                for (int m = 0; m < 4; ++m) { const int r = row0 + ai * HALF + m * 16;
#pragma unroll
                    for (int bj = 0; bj < 2; ++bj) { const int ch0 = 128 * u.pn + 64 * bj + 16 * wc + 4 * fq;
                        const f32x4 gt = acc[ai][bj][m][0], up = acc[ai][bj][m][1];
                        u32x2 w; w.x = cvt_pk_bf16(silu_f(gt[0]) * up[0], silu_f(gt[1]) * up[1]); w.y = cvt_pk_bf16(silu_f(gt[2]) * up[2], silu_f(gt[3]) * up[3]);
                        *(u32x2*)(HF + (size_t)r * DFF + ch0) = w; } }
        }
    }
};

__device__ __forceinline__ void gemm_phase(LAS unsigned char* lds, const Gemm g, const Sched& S, const Epi& E) {
    const int tid = otid(), wid = __builtin_amdgcn_readfirstlane(tid >> 6), lane = tid & 63, wr = wid >> 2, wc = wid & 3, fr = lane & 15, fq = lane >> 4;
    const int K = g.K, nt = K / BK;
    unsigned voffA[2], voffB[2];
#pragma unroll
    for (int i = 0; i < 2; ++i) { int R, C; stage_rc(tid * 16 + i * 8192, R, C); const int Rb = E.perm ? ((R & ~31) + perm32(R & 31)) : R;
        voffA[i] = (unsigned)(R * g.lda + C) * 2u; voffB[i] = (unsigned)(Rb * g.ldb + C) * 2u; }
    const size_t kstep = (size_t)(BK * 2);
    const size_t hstepA = (size_t)HALF * g.lda * 2, hstepB = (size_t)HALF * g.ldb * 2;
    const size_t tstepA = 2 * hstepA, tstepB = 2 * hstepB;
    const unsigned ldsw = (unsigned)wid * 1024u;
    const int aoff = lds_byte(wr * 64 + fr, fq * 8), boff = lds_byte(wc * 32 + fr, fq * 8);
#define PG8_SA(b, h) (((b) * 2 + (h)) * HTB)
#define PG8_SB(b, h) ((4 + (b) * 2 + (h)) * HTB)
#define PG8_STAGE(bufoff, gbase, voff) do { _Pragma("unroll") for (int _i = 0; _i < 2; ++_i) \
        __builtin_amdgcn_global_load_lds((const unsigned*)((const char*)(gbase) + (voff)[_i]), (LAS unsigned*)(lds + (bufoff) + ldsw + _i * 8192), 16, 0, 0); } while (0)
#define PG8_LDA(dst, b, h) do { _Pragma("unroll") for (int m = 0; m < 4; ++m) _Pragma("unroll") for (int k = 0; k < 2; ++k) dst[m][k] = *(const LAS bf16x8*)(lds + PG8_SA(b, h) + aoff + m * 2048 + k * 1024); } while (0)
#define PG8_LDB(dst, b, h) do { _Pragma("unroll") for (int n = 0; n < 2; ++n) _Pragma("unroll") for (int k = 0; k < 2; ++k) dst[n][k] = *(const LAS bf16x8*)(lds + PG8_SB(b, h) + boff + n * 2048 + k * 1024); } while (0)
#define PG8_MMA(ai, bj, At, Bt) do { __builtin_amdgcn_s_setprio(1); _Pragma("unroll") for (int m = 0; m < 4; ++m) _Pragma("unroll") for (int n = 0; n < 2; ++n) _Pragma("unroll") for (int k = 0; k < 2; ++k) \
        acc[ai][bj][m][n] = __builtin_amdgcn_mfma_f32_16x16x32_f16(__builtin_bit_cast(half8_t, Bt[n][k]), __builtin_bit_cast(half8_t, At[m][k]), acc[ai][bj][m][n], 0, 0, 0); __builtin_amdgcn_s_setprio(0); } while (0)
#define PG8_WAIT_V(n) asm volatile("s_waitcnt vmcnt(" #n ")" ::: "memory")
#define PG8_WAIT_L(n) asm volatile("s_waitcnt lgkmcnt(" #n ")" ::: "memory")
#define PG8_BAR __builtin_amdgcn_s_barrier()
#define PG8_SCHED __builtin_amdgcn_sched_barrier(0)
    Unit cur, nxt; int ui = 0;
    if (!S.next(0, cur)) return;
    f32x4 acc[2][2][4][2];
#pragma unroll
    for (int a = 0; a < 2; ++a)
#pragma unroll
        for (int b = 0; b < 2; ++b)
#pragma unroll
            for (int m = 0; m < 4; ++m)
#pragma unroll
                for (int n = 0; n < 2; ++n) acc[a][b][m][n] = (f32x4){0.f, 0.f, 0.f, 0.f};
    bf16x8 At[4][2], B0[2][2], B1[2][2];
    const char* cA = (const char*)g.A + (size_t)cur.pm * tstepA + (size_t)cur.ak * 2; const char* cB = (const char*)g.Bt + (size_t)cur.pn * tstepB;
    PG8_STAGE(PG8_SB(0, 0), cB, voffB); PG8_STAGE(PG8_SB(0, 1), cB + hstepB, voffB); PG8_STAGE(PG8_SA(0, 0), cA, voffA); PG8_STAGE(PG8_SA(0, 1), cA + hstepA, voffA);
    if (wr == 1) PG8_BAR;
    PG8_WAIT_V(2); PG8_BAR;
    PG8_STAGE(PG8_SB(1, 0), cB + kstep, voffB); PG8_STAGE(PG8_SA(1, 0), cA + kstep, voffA); PG8_STAGE(PG8_SB(1, 1), cB + hstepB + kstep, voffB);
    PG8_WAIT_V(6); PG8_BAR;
    for (;;) {
        const bool has_next = S.next(ui + 1, nxt);
        const char* nA = has_next ? (const char*)g.A + (size_t)nxt.pm * tstepA + (size_t)nxt.ak * 2 : cA; const char* nB = has_next ? (const char*)g.Bt + (size_t)nxt.pn * tstepB : cB;
        for (int t = 0; t < nt; t += 2) {
            const bool last = (t == nt - 2);
            const char* a1 = cA + (size_t)(t + 1) * kstep;
            const char* a2 = last ? nA : cA + (size_t)(t + 2) * kstep; const char* b2 = last ? nB : cB + (size_t)(t + 2) * kstep;
            const char* a3 = a2 + kstep; const char* b3 = b2 + kstep;
            PG8_LDB(B0, 0, 0); PG8_LDB(B1, 0, 1); PG8_SCHED; PG8_LDA(At, 0, 0); PG8_STAGE(PG8_SA(1, 1), a1 + hstepA, voffA);
            PG8_WAIT_V(8); PG8_WAIT_L(0); PG8_BAR; PG8_MMA(0, 0, At, B0); PG8_MMA(0, 1, At, B1); PG8_BAR; PG8_SCHED;
            PG8_LDA(At, 0, 1); PG8_STAGE(PG8_SB(0, 0), b2, voffB); PG8_STAGE(PG8_SB(0, 1), b2 + hstepB, voffB); PG8_STAGE(PG8_SA(0, 0), a2, voffA);
            PG8_WAIT_V(8); PG8_WAIT_L(0); PG8_BAR; PG8_MMA(1, 0, At, B0); PG8_MMA(1, 1, At, B1); PG8_BAR; PG8_SCHED;
            PG8_LDB(B0, 1, 0); PG8_LDB(B1, 1, 1); PG8_SCHED; PG8_LDA(At, 1, 0); PG8_STAGE(PG8_SA(0, 1), a2 + hstepA, voffA);
            PG8_WAIT_V(8); PG8_WAIT_L(0); PG8_BAR; PG8_MMA(0, 0, At, B0); PG8_MMA(0, 1, At, B1); PG8_BAR; PG8_SCHED;
            PG8_LDA(At, 1, 1); PG8_STAGE(PG8_SB(1, 0), b3, voffB); PG8_STAGE(PG8_SB(1, 1), b3 + hstepB, voffB); PG8_STAGE(PG8_SA(1, 0), a3, voffA);
            PG8_WAIT_V(8); PG8_WAIT_L(0); PG8_BAR; PG8_MMA(1, 0, At, B0); PG8_MMA(1, 1, At, B1); PG8_BAR; PG8_SCHED;
        }
        if (wr == 0) PG8_BAR;
        { const int t2 = otid(), w2 = __builtin_amdgcn_readfirstlane(t2 >> 6), l2 = t2 & 63;
          E(acc, cur, w2 >> 2, w2 & 3, l2 & 15, l2 >> 4); }
        if (!has_next) break;
#pragma unroll
        for (int a = 0; a < 2; ++a)
#pragma unroll
            for (int b = 0; b < 2; ++b)
#pragma unroll
                for (int m = 0; m < 4; ++m)
#pragma unroll
                    for (int n = 0; n < 2; ++n) acc[a][b][m][n] = (f32x4){0.f, 0.f, 0.f, 0.f};
        cur = nxt; cA = nA; cB = nB; ++ui;
        if (wr == 1) PG8_BAR;
    }
    PG8_WAIT_V(0);
    PG8_BAR;
#undef PG8_SA
#undef PG8_SB
#undef PG8_STAGE
#undef PG8_LDA
#undef PG8_LDB
#undef PG8_MMA
#undef PG8_WAIT_V
#undef PG8_WAIT_L
#undef PG8_BAR
#undef PG8_SCHED
}
}

__device__ __forceinline__ int dest_row(int dmode, int arg, int n) {
    if (dmode == 1) { return ((n >> 6) << 8) + ((arg >> 1) << 7) + (((n >> 4) & 3) << 5) + ((arg & 1) << 4) + (n & 15); }
    if (dmode == 2) { return ((n >> 7) << 8) + (((n >> 6) & 1) << 7) + (((n >> 4) & 3) << 5) + (arg << 4) + (n & 15); }
    return n + arg;
}
__device__ __forceinline__ void transpose_item(const float* W, int K, int Nsrc, bf16_t* WT, int dmode, int arg, LAS float* scr, int kb, int nb, int lane) {
    const int k0 = 64 * kb, n0 = 32 * nb;
    const int nsrc = n0 + (lane & 31); const bool ok = nsrc < Nsrc;
#pragma unroll 8
    for (int i = 0; i < 32; ++i) { const int kk = 2 * i + (lane >> 5); scr[kk * 33 + (lane & 31)] = ok ? W[(size_t)(k0 + kk) * Nsrc + nsrc] : 0.f; }
    asm volatile("s_waitcnt lgkmcnt(0)" ::: "memory");
    const int c = lane & 7;
#pragma unroll
    for (int j = 0; j < 4; ++j) { const int n = (lane >> 3) + 8 * j; const LAS float* s = scr + (8 * c) * 33 + n;
        u32x4 o; o.x = pk2(s[0 * 33], s[1 * 33]); o.y = pk2(s[2 * 33], s[3 * 33]); o.z = pk2(s[4 * 33], s[5 * 33]); o.w = pk2(s[6 * 33], s[7 * 33]);
        *(u32x4*)(WT + (size_t)dest_row(dmode, arg, n0 + n) * K + k0 + 8 * c) = o; }
    asm volatile("s_waitcnt lgkmcnt(0)" ::: "memory");
}

__device__ __forceinline__ void s5_abar_pow(float lr, float li, float dt, int n, float& re, float& im) {
    const float mag = expf((float)n * lr * dt);
    const double a = (double)n * ((double)li * (double)dt);
    const double k = __builtin_rint(a * 0.15915494309189535);
    const float r = (float)__builtin_fma(-k, 6.283185307179586, a);
    re = mag * cosf(r); im = mag * sinf(r);
}
__device__ __forceinline__ void s5_coef(float lr, float li, float dt, float& cr, float& ci) {
    const float th = li * dt, em1 = expm1f(lr * dt), c1 = cosf(th), s1 = sinf(th), sh = sinf(0.5f * th);
    const float nr = em1 * c1 - 2.f * sh * sh, ni = (1.f + em1) * s1, den = lr * lr + li * li;
    cr = (nr * lr + ni * li) / den; ci = (ni * lr - nr * li) / den;
}

__device__ __forceinline__ void s5_tables(CPP p, int l, LAS unsigned char* lds) {
    LAS float* abr = (LAS float*)lds;
    LAS float* abi = abr + 1024;
    LAS float* cr = abi + 1024;
    LAS float* ci = cr + 16 * 65;
    float* KN = (float*)(p->ws + WS_KN);
    const int tid = otid();
    for (int it = obid(); it < 1024; it += ogrid()) {
        const int g = it >> 6, n = it & 63;
        __syncthreads();
        for (int e = tid; e < 1024; e += 512) { const int pp = e >> 4, c = e & 15; const int gp = (l * 16 + g) * 64 + pp;
            const float lr = p->in[5][gp], li = p->in[6][gp], dt = expf(p->in[7][l * 16 + g]);
            float ar, ai2; s5_abar_pow(lr, li, dt, n, ar, ai2);
            float qr, qi; s5_coef(lr, li, dt, qr, qi);
            const float br = p->in[8][(size_t)gp * 16 + c], bi = p->in[9][(size_t)gp * 16 + c];
            const float bbr = qr * br - qi * bi, bbi = qr * bi + qi * br;
            abr[e] = ar * bbr - ai2 * bbi; abi[e] = ar * bbi + ai2 * bbr; }
        for (int e = tid; e < 1024; e += 512) { const int i = e >> 6, pp = e & 63; const size_t gi = ((size_t)(l * 16 + g) * 16 + i) * 64 + pp;
            cr[i * 65 + pp] = p->in[10][gi]; ci[i * 65 + pp] = p->in[11][gi]; }
        __syncthreads();
        if (tid < 256) { const int i = tid >> 4, c = tid & 15; float s = 0.f;
#pragma unroll 8
            for (int pp = 0; pp < 64; ++pp) s += cr[i * 65 + pp] * abr[pp * 16 + c] - ci[i * 65 + pp] * abi[pp * 16 + c];
            KN[((size_t)(g * 64 + n) * 16 + i) * 16 + c] = s; }
    }
}

__device__ __forceinline__ void convert_weights(CPP p, int l, LAS unsigned char* lds) {
    const int tid = otid(), lane = tid & 63, wave = tid >> 6;
    LAS float* scr = (LAS float*)(lds + wave * 16384);
    const int gw = obid() * 8 + wave, NGW = ogrid() * 8;
    unsigned char* ws = p->ws;
    constexpr int J0 = 1408, J1 = J0 + 2048, J2 = J1 + 512, J3 = J2 + 512, J4 = J3 + 2816, J5 = J4 + 1408, J6 = J5 + 32;
    for (int it = gw; it < J6; it += NGW) {
        if (it < J0) { const int r = it; transpose_item(p->in[1] + (size_t)l * 1024 * 2576, 1024, 2576, (bf16_t*)(ws + WS_WIN), 0, 0, scr, r / 88, r % 88, lane); }
        else if (it < J1) { const int r = it - J0, b = r >> 9, q = r & 511; transpose_item(p->in[15] + ((size_t)l * 4 + b) * 1024 * 1024, 1024, 1024, (bf16_t*)(ws + WS_WG), 1, b, scr, q >> 5, q & 31, lane); }
        else if (it < J2) { const int r = it - J1, b = r >> 7, q = r & 127; transpose_item(p->in[17] + ((size_t)l * 4 + b) * 256 * 1024, 256, 1024, (bf16_t*)(ws + WS_WB) + (size_t)b * 1024 * 256, 0, 0, scr, q >> 5, q & 31, lane); }
        else if (it < J3) { const int q = it - J2; transpose_item(p->in[18] + (size_t)l * 1024 * 1024, 1024, 1024, (bf16_t*)(ws + WS_WO), 0, 0, scr, q >> 5, q & 31, lane); }
        else if (it < J4) { const int r = it - J3, wch = r / 1408, q = r % 1408; transpose_item(p->in[wch ? 22 : 21] + (size_t)l * 1024 * 2816, 1024, 2816, (bf16_t*)(ws + WS_WFF), 2, wch, scr, q / 88, q % 88, lane); }
        else if (it < J5) { const int q = it - J4; transpose_item(p->in[23] + (size_t)l * 2816 * 1024, 2816, 1024, (bf16_t*)(ws + WS_WD), 0, 0, scr, q >> 5, q & 31, lane); }
        else { const int q = it - J5; transpose_item(p->in[13] + (size_t)l * 256 * 256, 256, 256, (bf16_t*)(ws + WS_WGLU), 0, 0, scr, q >> 3, q & 7, lane); }
    }
    const int gt = obid() * 512 + tid, NT = ogrid() * 512;
    bf16_t* WE = (bf16_t*)(ws + WS_WE);
    for (int e = gt; e < 65536; e += NT) { const int s = e & 63, pp = (e >> 6) & 63, g = e >> 12; const int gp = (l * 16 + g) * 64 + pp;
        const float lr = p->in[5][gp], li = p->in[6][gp], dt = expf(p->in[7][l * 16 + g]);
        float ar, ai2; s5_abar_pow(lr, li, dt, 63 - s, ar, ai2);
        float qr, qi; s5_coef(lr, li, dt, qr, qi);
        float wr_[16], wi_[16];
#pragma unroll
        for (int c = 0; c < 16; ++c) { const float br = p->in[8][(size_t)gp * 16 + c], bi = p->in[9][(size_t)gp * 16 + c];
            const float bbr = qr * br - qi * bi, bbi = qr * bi + qi * br; wr_[c] = ar * bbr - ai2 * bbi; wi_[c] = ar * bbi + ai2 * bbr; }
        bf16_t* dr = WE + ((size_t)(g * 256 + pp)) * 1024 + s * 16; bf16_t* di = WE + ((size_t)(g * 256 + 64 + pp)) * 1024 + s * 16;
        *(u32x4*)dr = pack8(wr_); *(u32x4*)(dr + 8) = pack8(wr_ + 8); *(u32x4*)di = pack8(wi_); *(u32x4*)(di + 8) = pack8(wi_ + 8); }
    for (int e = gt; e < 16 * 128 * 128; e += NT) { const int c8 = e & 127, n = (e >> 7) & 127, g = e >> 14;
        *(u32x4*)(WE + ((size_t)(g * 256 + 128 + n)) * 1024 + c8 * 8) = (u32x4){0u, 0u, 0u, 0u}; }
    bf16_t* WT = (bf16_t*)(ws + WS_WT); const float* KN = (const float*)(ws + WS_KN);
    for (int e = gt; e < 16 * 1024 * 64; e += NT) { const int s = e & 63, row = (e >> 6) & 1023, g = e >> 16; const int j = row >> 4, i = row & 15;
        u32x4 w0 = (u32x4){0u, 0u, 0u, 0u}, w1 = w0;
        if (s <= j) { const float* k = KN + ((size_t)(g * 64 + (j - s)) * 16 + i) * 16; float v[16];
#pragma unroll
            for (int c = 0; c < 16; c += 4) { const f32x4 t = *(const f32x4*)(k + c); v[c] = t[0]; v[c + 1] = t[1]; v[c + 2] = t[2]; v[c + 3] = t[3]; }
            w0 = pack8(v); w1 = pack8(v + 8); }
        bf16_t* d = WT + ((size_t)(g * 1024 + row)) * S5K + s * 16; *(u32x4*)d = w0; *(u32x4*)(d + 8) = w1; }
    for (int e = gt; e < 16 * 1024 * 64; e += NT) { const int pp = e & 63, row = (e >> 6) & 1023, g = e >> 16; const int j = row >> 4, i = row & 15; const int gp = (l * 16 + g) * 64 + pp;
        const float lr = p->in[5][gp], li = p->in[6][gp], dt = expf(p->in[7][l * 16 + g]);
        float ar, ai2; s5_abar_pow(lr, li, dt, j + 1, ar, ai2);
        const size_t gi = ((size_t)(l * 16 + g) * 16 + i) * 64 + pp; const float c_r = p->in[10][gi], c_i = p->in[11][gi];
        bf16_t* d = WT + ((size_t)(g * 1024 + row)) * S5K + 1024 + pp;
        d[0] = (bf16_t)f2bf(c_r * ar - c_i * ai2); d[64] = (bf16_t)f2bf(-(c_r * ai2 + c_i * ar)); }
}

__device__ __forceinline__ void ln_pass(bf16_t* xb, float* fout, const float* gam, const float* bet) {
    const int lane = otid() & 63, gw = obid() * 8 + (otid() >> 6), NGW = ogrid() * 8;
    f32x4 gv[4], bv[4];
#pragma unroll
    for (int j = 0; j < 2; ++j) { gv[2 * j] = *(const f32x4*)(gam + 512 * j + lane * 8); gv[2 * j + 1] = *(const f32x4*)(gam + 512 * j + lane * 8 + 4);
        bv[2 * j] = *(const f32x4*)(bet + 512 * j + lane * 8); bv[2 * j + 1] = *(const f32x4*)(bet + 512 * j + lane * 8 + 4); }
    for (int m0 = gw * 2; m0 < M; m0 += NGW * 2) {
        u32x4 w[2][2];
#pragma unroll
        for (int rr = 0; rr < 2; ++rr)
#pragma unroll
            for (int j = 0; j < 2; ++j) w[rr][j] = *(const u32x4*)(xb + (size_t)(m0 + rr) * DM + 512 * j + lane * 8);
#pragma unroll
        for (int rr = 0; rr < 2; ++rr) {
            float v[16]; unpack8(w[rr][0], v); unpack8(w[rr][1], v + 8);
            float s = 0.f;
#pragma unroll
            for (int e = 0; e < 16; ++e) s += v[e];
            const float mean = wave_sum(s) * (1.f / DM); float s2 = 0.f;
#pragma unroll
            for (int e = 0; e < 16; ++e) { v[e] -= mean; s2 += v[e] * v[e]; }
            const float rstd = 1.f / sqrtf(wave_sum(s2) * (1.f / DM) + LN_EPS);
#pragma unroll
            for (int j = 0; j < 2; ++j) {
#pragma unroll
                for (int q = 0; q < 2; ++q)
#pragma unroll
                    for (int e = 0; e < 4; ++e) v[8 * j + 4 * q + e] = v[8 * j + 4 * q + e] * rstd * gv[2 * j + q][e] + bv[2 * j + q][e];
                *(u32x4*)(xb + (size_t)(m0 + rr) * DM + 512 * j + lane * 8) = pack8(v + 8 * j);
                if (fout) { *(f32x4*)(fout + (size_t)(m0 + rr) * DM + 512 * j + lane * 8) = (f32x4){v[8 * j], v[8 * j + 1], v[8 * j + 2], v[8 * j + 3]};
                    *(f32x4*)(fout + (size_t)(m0 + rr) * DM + 512 * j + lane * 8 + 4) = (f32x4){v[8 * j + 4], v[8 * j + 5], v[8 * j + 6], v[8 * j + 7]}; } }
        }
    }
}

__device__ __forceinline__ void load_tile64(const bf16_t* src, int pitch, LAS float* dst, int dpitch, float scale, int tid) {
    const int idx = tid * 8, r = idx >> 6, c = idx & 63;
    const u32x4 w = *(const u32x4*)(src + (size_t)r * pitch + c); float f[8]; unpack8(w, f);
#pragma unroll
    for (int e = 0; e < 8; ++e) dst[r * dpitch + c + e] = f[e] * scale;
}

__device__ __forceinline__ void attn_items(CPP p, int l, LAS unsigned char* lds) {
    LAS float* Qs = (LAS float*)lds; LAS float* Ks = Qs + 64 * 68; LAS float* Vs = Ks + 64 * 68; LAS float* Ps = Vs + 64 * 68; LAS float* bs = Ps + 64 * 65;
    const bf16_t* H = (const bf16_t*)(p->ws + WS_E); bf16_t* O = (bf16_t*)(p->ws + WS_O);
    const int tid = otid(), row = tid >> 3, sub = tid & 7;
    for (int it = obid(); it < 4096; it += ogrid()) {
        const int h = it & 3, bi = it >> 2, i = bi & 31, b = bi >> 5;
        const size_t t0 = (size_t)bi * 64;
        __syncthreads();
        load_tile64(H + t0 * NH + C_AQ + h * 64, NH, Qs, 68, 0.125f, tid);
        if (tid < 257) bs[tid] = p->in[4][(size_t)(l * 4 + h) * 257 + tid];
        __syncthreads();
        float q[64], o[8];
#pragma unroll
        for (int d = 0; d < 64; d += 4) { const f32x4 t = *(const LAS f32x4*)(Qs + row * 68 + d); q[d] = t[0]; q[d + 1] = t[1]; q[d + 2] = t[2]; q[d + 3] = t[3]; }
#pragma unroll
        for (int e = 0; e < 8; ++e) o[e] = 0.f;
        float mx = -1e30f, ls = 0.f;
        const int kc0 = i > 8 ? i - 8 : 0;
        for (int kc = kc0; kc <= i; ++kc) {
            __syncthreads();
            const size_t tk = ((size_t)b * 32 + kc) * 64;
            load_tile64(H + tk * NH + C_AK + h * 64, NH, Ks, 68, 1.f, tid);
            load_tile64(H + tk * NH + C_AV + h * 64, NH, Vs, 68, 1.f, tid);
            __syncthreads();
            float s[8]; float cm = -1e30f;
#pragma unroll
            for (int jj = 0; jj < 8; ++jj) { const int key = sub + 8 * jj; float a = 0.f;
#pragma unroll
                for (int d = 0; d < 64; d += 4) { const f32x4 t = *(const LAS f32x4*)(Ks + key * 68 + d); a += q[d] * t[0] + q[d + 1] * t[1] + q[d + 2] * t[2] + q[d + 3] * t[3]; }
                int diff = (i - kc) * 64 + row - key; diff = diff > 128 ? 128 : diff;
                a += bs[diff + 128]; s[jj] = a; cm = fmaxf(cm, a); }
            cm = fmaxf(cm, __shfl_xor(cm, 1)); cm = fmaxf(cm, __shfl_xor(cm, 2)); cm = fmaxf(cm, __shfl_xor(cm, 4));
            const float mn = fmaxf(mx, cm), sc = __expf(mx - mn); mx = mn;
            float ps = 0.f;
#pragma unroll
            for (int jj = 0; jj < 8; ++jj) { const float pr = __expf(s[jj] - mn); ps += pr; Ps[row * 65 + sub + 8 * jj] = pr; }
            ps += __shfl_xor(ps, 1); ps += __shfl_xor(ps, 2); ps += __shfl_xor(ps, 4);
            ls = ls * sc + ps;
#pragma unroll
            for (int e = 0; e < 8; ++e) o[e] *= sc;
            asm volatile("s_waitcnt lgkmcnt(0)" ::: "memory");
#pragma unroll 8
            for (int key = 0; key < 64; ++key) { const float pr = Ps[row * 65 + key];
                const f32x4 v0 = *(const LAS f32x4*)(Vs + key * 68 + sub * 8), v1 = *(const LAS f32x4*)(Vs + key * 68 + sub * 8 + 4);
                o[0] += pr * v0[0]; o[1] += pr * v0[1]; o[2] += pr * v0[2]; o[3] += pr * v0[3]; o[4] += pr * v1[0]; o[5] += pr * v1[1]; o[6] += pr * v1[2]; o[7] += pr * v1[3]; }
        }
        const float inv = 1.f / ls;
#pragma unroll
        for (int e = 0; e < 8; ++e) o[e] *= inv;
        *(u32x4*)(O + (t0 + row) * DM + 256 + h * 64 + sub * 8) = pack8(o);
    }
}

typedef float f32x16 __attribute__((ext_vector_type(16)));
typedef short s16x4 __attribute__((ext_vector_type(4)));
__device__ __forceinline__ s16x4 lds_tr16(LAS const unsigned char* ptr) { return __builtin_bit_cast(s16x4, __builtin_amdgcn_ds_read_tr16_b64_v4i16((LAS s16x4*)ptr)); }
__device__ __forceinline__ bf16x8 scale_frag(u32x4 w, float sc) { float f[8]; unpack8(w, f);
    u32x4 o; o.x = pk2(f[0] * sc, f[1] * sc); o.y = pk2(f[2] * sc, f[3] * sc); o.z = pk2(f[4] * sc, f[5] * sc); o.w = pk2(f[6] * sc, f[7] * sc); return __builtin_bit_cast(bf16x8, o); }
__device__ __forceinline__ void attn_mfma(CPP p, int l, LAS unsigned char* lds) {
    const int tid = otid(), lane = tid & 63, wid = __builtin_amdgcn_readfirstlane(tid >> 6), r32 = lane & 31, hi = lane >> 5;
    const int h = wid >> 1, qh = wid & 1;
    LAS unsigned char* Vl = lds + wid * 17536;
    LAS unsigned char* stg = Vl;
    LAS float* bs = (LAS float*)(Vl + 16384);
    const bf16_t* H = (const bf16_t*)(p->ws + WS_E); bf16_t* O = (bf16_t*)(p->ws + WS_O);
    __syncthreads();
    for (int e = lane; e < 257; e += 64) bs[e] = p->in[4][(size_t)(l * 4 + h) * 257 + e];
    const float bfar = p->in[4][(size_t)(l * 4 + h) * 257 + 256];
#define ATT_VDMA(tk, buf) do { _Pragma("unroll") for (int c = 0; c < 8; ++c) \
        __builtin_amdgcn_global_load_lds((const unsigned*)(H + ((tk) + c * 8 + (lane >> 3)) * NH + C_AV + h * 64 + (lane & 7) * 8), (LAS unsigned*)(Vl + (buf) * 8192 + c * 1024), 16, 0, 0); } while (0)
    for (int it = obid(); it < 1024; it += ogrid()) {
        const int i = it & 31; const size_t t0 = (size_t)it * 64;
        bf16x8 qf[4];
#pragma unroll
        for (int t = 0; t < 4; ++t) qf[t] = scale_frag(*(const u32x4*)(H + (t0 + qh * 32 + r32) * NH + C_AQ + h * 64 + 16 * t + 8 * hi), 0.125f);
        const int kc0 = i > 8 ? i - 8 : 0;
        u32x4 kr[8], kn[8];
        asm volatile("s_waitcnt lgkmcnt(0)" ::: "memory");
        { const size_t tk = t0 - (size_t)(i - kc0) * 64;
#pragma unroll
            for (int t = 0; t < 4; ++t) { kn[t] = *(const u32x4*)(H + (tk + r32) * NH + C_AK + h * 64 + 16 * t + 8 * hi); kn[4 + t] = *(const u32x4*)(H + (tk + 32 + r32) * NH + C_AK + h * 64 + 16 * t + 8 * hi); }
            ATT_VDMA(tk, 0); }
        f32x16 o0, o1;
#pragma unroll
        for (int v = 0; v < 16; ++v) { o0[v] = 0.f; o1[v] = 0.f; }
        float mx = -1e30f, ls = 0.f;
        int cb = 0;
        for (int kc = kc0; kc <= i; ++kc) {
            const bool more = kc < i;
            asm volatile("s_waitcnt vmcnt(0)" ::: "memory");
#pragma unroll
            for (int c = 0; c < 8; ++c) kr[c] = kn[c];
            if (more) { const size_t tk = t0 - (size_t)(i - kc - 1) * 64;
#pragma unroll
                for (int t = 0; t < 4; ++t) { kn[t] = *(const u32x4*)(H + (tk + r32) * NH + C_AK + h * 64 + 16 * t + 8 * hi); kn[4 + t] = *(const u32x4*)(H + (tk + 32 + r32) * NH + C_AK + h * 64 + 16 * t + 8 * hi); }
                ATT_VDMA(tk, cb ^ 1); }
            f32x16 p0, p1;
#pragma unroll
            for (int v = 0; v < 16; ++v) { p0[v] = 0.f; p1[v] = 0.f; }
#pragma unroll
            for (int t = 0; t < 4; ++t) { p0 = __builtin_amdgcn_mfma_f32_32x32x16_f16(__builtin_bit_cast(half8_t, kr[t]), __builtin_bit_cast(half8_t, qf[t]), p0, 0, 0, 0);
                p1 = __builtin_amdgcn_mfma_f32_32x32x16_f16(__builtin_bit_cast(half8_t, kr[4 + t]), __builtin_bit_cast(half8_t, qf[t]), p1, 0, 0, 0); }
            const int dl = i - kc;
            if (dl >= 3) {
#pragma unroll
                for (int v = 0; v < 16; ++v) { p0[v] += bfar; p1[v] += bfar; }
            } else { const int base = dl * 64 + qh * 32 + r32 - 4 * hi + 128;
#pragma unroll
                for (int v = 0; v < 16; ++v) { const int kv = (v & 3) + 8 * (v >> 2); int d0 = base - kv, d1 = base - kv - 32; d0 = d0 > 256 ? 256 : d0; d1 = d1 > 256 ? 256 : d1;
                    p0[v] += bs[d0]; p1[v] += bs[d1]; } }
            float cm = fmaxf(p0[0], p1[0]);
#pragma unroll
            for (int v = 1; v < 16; ++v) cm = fmaxf(cm, fmaxf(p0[v], p1[v]));
            cm = fmaxf(cm, __shfl_xor(cm, 32));
            const float mn = fmaxf(mx, cm), al = __expf(mx - mn); mx = mn;
            float ps = 0.f;
#pragma unroll
            for (int v = 0; v < 16; ++v) { p0[v] = __expf(p0[v] - mn); p1[v] = __expf(p1[v] - mn); ps += p0[v] + p1[v]; }
            ls = ls * al + ps;
#pragma unroll
            for (int v = 0; v < 16; ++v) { o0[v] *= al; o1[v] *= al; }
            bf16x8 pb[4];
            { u32x4 w; w.x = cvt_pk_bf16(p0[0], p0[1]); w.y = cvt_pk_bf16(p0[2], p0[3]); w.z = cvt_pk_bf16(p0[4], p0[5]); w.w = cvt_pk_bf16(p0[6], p0[7]); pb[0] = __builtin_bit_cast(bf16x8, w);
              w.x = cvt_pk_bf16(p0[8], p0[9]); w.y = cvt_pk_bf16(p0[10], p0[11]); w.z = cvt_pk_bf16(p0[12], p0[13]); w.w = cvt_pk_bf16(p0[14], p0[15]); pb[1] = __builtin_bit_cast(bf16x8, w);
              w.x = cvt_pk_bf16(p1[0], p1[1]); w.y = cvt_pk_bf16(p1[2], p1[3]); w.z = cvt_pk_bf16(p1[4], p1[5]); w.w = cvt_pk_bf16(p1[6], p1[7]); pb[2] = __builtin_bit_cast(bf16x8, w);
              w.x = cvt_pk_bf16(p1[8], p1[9]); w.y = cvt_pk_bf16(p1[10], p1[11]); w.z = cvt_pk_bf16(p1[12], p1[13]); w.w = cvt_pk_bf16(p1[14], p1[15]); pb[3] = __builtin_bit_cast(bf16x8, w); }
            const LAS unsigned char* vb = Vl + cb * 8192 + (4 * hi + ((lane & 15) >> 2)) * 128 + ((lane >> 4) & 1) * 32 + (lane & 3) * 8;
#pragma unroll
            for (int ks = 0; ks < 4; ++ks) {
#pragma unroll
                for (int dh = 0; dh < 2; ++dh) { const s16x4 lo = lds_tr16(vb + ks * 2048 + dh * 64), hh = lds_tr16(vb + ks * 2048 + 1024 + dh * 64);
                    const bf16x8 va = (bf16x8){lo[0], lo[1], lo[2], lo[3], hh[0], hh[1], hh[2], hh[3]};
                    if (dh == 0) o0 = __builtin_amdgcn_mfma_f32_32x32x16_f16(__builtin_bit_cast(half8_t, va), __builtin_bit_cast(half8_t, pb[ks]), o0, 0, 0, 0); else o1 = __builtin_amdgcn_mfma_f32_32x32x16_f16(__builtin_bit_cast(half8_t, va), __builtin_bit_cast(half8_t, pb[ks]), o1, 0, 0, 0); } }
            cb ^= 1;
        }
        ls += __shfl_xor(ls, 32);
        const float inv = 1.f / ls;
        asm volatile("s_waitcnt lgkmcnt(0)" ::: "memory");
#pragma unroll
        for (int v = 0; v < 16; ++v) { const int d = (v & 3) + 8 * (v >> 2) + 4 * hi;
            *(LAS bf16_t*)(stg + r32 * 144 + d * 2) = (bf16_t)f2bf(o0[v] * inv); *(LAS bf16_t*)(stg + r32 * 144 + (32 + d) * 2) = (bf16_t)f2bf(o1[v] * inv); }
        asm volatile("s_waitcnt lgkmcnt(0)" ::: "memory");
#pragma unroll
        for (int c = 0; c < 4; ++c) { const int row = c * 8 + (lane >> 3), ch = lane & 7; const u32x4 w = *(const LAS u32x4*)(stg + row * 144 + ch * 16);
            *(u32x4*)(O + (t0 + qh * 32 + row) * DM + 256 + h * 64 + ch * 8) = w; }
    }
#undef ATT_VDMA
}

__device__ __forceinline__ void load_rot(const bf16_t* src, const float* rot, int i, LAS float* dst, float scale, float logz, int tid) {
#pragma unroll
    for (int q = 0; q < 2; ++q) { const int idx = tid + 512 * q, j = idx >> 4, f = idx & 15;
        const float x1 = bf2f(src[(size_t)j * NH + f]), x2 = bf2f(src[(size_t)j * NH + f + 16]);
        const int pos = i * 64 + j; const float c = rot[pos * 32 + f], s = rot[pos * 32 + 16 + f];
        const float sc = scale * __expf(logz * (float)(63 - j));
        dst[j * 33 + f] = (x1 * c - x2 * s) * sc; dst[j * 33 + f + 16] = (x1 * s + x2 * c) * sc; }
}
__device__ __forceinline__ float ret_logg(int h) { return log1pf(-exp2f(-5.f - (float)h)); }

__device__ __forceinline__ void upd_items(CPP p, int l, LAS unsigned char* lds) {
    LAS float* kt = (LAS float*)lds; LAS float* vv = kt + 64 * 33; LAS float* la = vv + 64 * 68; LAS float* gas = la + 64 * 33; LAS float* was = gas + 1024; LAS float* bas = was + 512;
    const bf16_t* H = (const bf16_t*)(p->ws + WS_E); const float* rot = (const float*)(p->ws + WS_ROT);
    float* RU = (float*)(p->ws + WS_RU); float* GU = (float*)(p->ws + WS_GU); float* GL = (float*)(p->ws + WS_GL);
    const int tid = otid();
    for (int it = obid(); it < 8192; it += ogrid()) {
        const int gla = it >> 12, h = it & 3, bi = (it >> 2) & 1023, i = bi & 31;
        const size_t t0 = (size_t)bi * 64;
        __syncthreads();
        if (!gla) {
            load_rot(H + t0 * NH + C_RK + h * 32, rot, i, kt, 0.17677669529663689f, ret_logg(h), tid);
            load_tile64(H + t0 * NH + C_RV + h * 64, NH, vv, 68, 1.f, tid);
            __syncthreads();
        } else {
            if (tid < 128) { const int j = tid >> 1, c = (tid & 1) * 8; const u32x4 w = *(const u32x4*)(H + (t0 + j) * NH + C_GA + c); float f[8]; unpack8(w, f);
#pragma unroll
                for (int e = 0; e < 8; ++e) gas[j * 16 + c + e] = f[e]; }
            { const int r = tid >> 5, dk = tid & 31; was[tid] = p->in[2][(size_t)(l * 16 + r) * 128 + h * 32 + dk]; }
            if (tid < 32) bas[tid] = p->in[3][l * 128 + h * 32 + tid];
            { const int idx = tid * 4, j = idx >> 5, c = idx & 31; const u32x2 w = *(const u32x2*)(H + (t0 + j) * NH + C_GK + h * 32 + c);
                kt[j * 33 + c] = bflo(w.x); kt[j * 33 + c + 1] = bfhi(w.x); kt[j * 33 + c + 2] = bflo(w.y); kt[j * 33 + c + 3] = bfhi(w.y); }
            load_tile64(H + t0 * NH + C_GV + h * 64, NH, vv, 68, 1.f, tid);
            __syncthreads();
#pragma unroll
            for (int q = 0; q < 4; ++q) { const int e = tid + 512 * q, j = e >> 5, dk = e & 31; float z = bas[dk];
#pragma unroll
                for (int r = 0; r < 16; ++r) z += gas[j * 16 + r] * was[r * 32 + dk];
                const float lsg = fminf(z, 0.f) - log1pf(expf(-fabsf(z)));
                la[j * 33 + dk] = lsg * 0.0625f; }
            __syncthreads();
            if (tid < 32) { float run = 0.f; for (int j = 0; j < 64; ++j) { run += la[j * 33 + tid]; la[j * 33 + tid] = run; } }
            __syncthreads();
#pragma unroll
            for (int q = 0; q < 4; ++q) { const int e = tid + 512 * q, j = e >> 5, dk = e & 31; kt[j * 33 + dk] *= __expf(la[63 * 33 + dk] - la[j * 33 + dk]); }
            if (tid < 32) GL[(size_t)(bi * 4 + h) * 32 + tid] = la[63 * 33 + tid];
            __syncthreads();
        }
        const int dk = tid >> 4, dv0 = (tid & 15) * 4; f32x4 a = (f32x4){0.f, 0.f, 0.f, 0.f};
#pragma unroll 8
        for (int j = 0; j < 64; ++j) { const float kk = kt[j * 33 + dk]; const f32x4 v4 = *(const LAS f32x4*)(vv + j * 68 + dv0); a += v4 * kk; }
        float* dst = (gla ? GU : RU) + (size_t)(bi * 4 + h) * 2048 + dk * 64 + dv0;
        *(f32x4*)dst = a;
    }
}

__device__ __forceinline__ void scan_items(CPP p, int l) {
    float* RU = (float*)(p->ws + WS_RU); float* GU = (float*)(p->ws + WS_GU); const float* GL = (const float*)(p->ws + WS_GL);
    const float* ES = (const float*)(p->ws + WS_ES); bf16_t* U2 = (bf16_t*)(p->ws + WS_U2);
    const int gt = obid() * 512 + otid(), NT = ogrid() * 512;
    for (int e = gt; e < 262144; e += NT) { const int dvk = e & 2047, bh = e >> 11, h = bh & 3, b = bh >> 2;
        const float dec = expf(64.f * ret_logg(h)); float st = 0.f; float t[32];
        float* base = RU + (size_t)(b * 32 * 4 + h) * 2048 + dvk;
#pragma unroll
        for (int i = 0; i < 32; ++i) t[i] = base[(size_t)i * 8192];
#pragma unroll
        for (int i = 0; i < 32; ++i) { base[(size_t)i * 8192] = st; st = st * dec + t[i]; } }
    for (int e = gt; e < 262144; e += NT) { const int dvk = e & 2047, bh = e >> 11, h = bh & 3, b = bh >> 2; float st = 0.f; float t[32], gl[32];
        float* base = GU + (size_t)(b * 32 * 4 + h) * 2048 + dvk; const float* gb = GL + (size_t)(b * 32 * 4 + h) * 32 + (dvk >> 6);
#pragma unroll
        for (int i = 0; i < 32; ++i) { t[i] = base[(size_t)i * 8192]; gl[i] = gb[i * 128]; }
#pragma unroll
        for (int i = 0; i < 32; ++i) { st = __expf(gl[i]) * st + t[i]; base[(size_t)i * 8192] = st; } }
    for (int e = gt; e < 32768; e += NT) { const int pp = e & 63, g = (e >> 6) & 15, b = e >> 10; const int gp = (l * 16 + g) * 64 + pp;
        const float lr = p->in[5][gp], li = p->in[6][gp], dt = expf(p->in[7][l * 16 + g]);
        float ar, ai2; s5_abar_pow(lr, li, dt, 64, ar, ai2);
        float xr = 0.f, xi = 0.f; float er[32], ei[32];
        const size_t row0 = (size_t)g * 1024 + b * 32;
#pragma unroll
        for (int i = 0; i < 32; ++i) { er[i] = ES[(row0 + i) * 128 + pp]; ei[i] = ES[(row0 + i) * 128 + 64 + pp]; }
#pragma unroll
        for (int i = 0; i < 32; ++i) { U2[(row0 + i) * S5K + 1024 + pp] = (bf16_t)f2bf(xr); U2[(row0 + i) * S5K + 1088 + pp] = (bf16_t)f2bf(xi);
            const float nr = ar * xr - ai2 * xi + er[i], ni = ar * xi + ai2 * xr + ei[i]; xr = nr; xi = ni; } }
}

__device__ __forceinline__ void out_items(CPP p, int l, LAS unsigned char* lds) {
    LAS float* qt = (LAS float*)lds; LAS float* kt = qt + 64 * 33; LAS float* vv = kt + 64 * 33; LAS float* Sm = vv + 64 * 68; LAS float* Rm = Sm + 64 * 65;
    const bf16_t* H = (const bf16_t*)(p->ws + WS_E); const float* rot = (const float*)(p->ws + WS_ROT); bf16_t* O = (bf16_t*)(p->ws + WS_O);
    const float* RU = (const float*)(p->ws + WS_RU); const float* GU = (const float*)(p->ws + WS_GU);
    const int tid = otid();
    for (int it = obid(); it < 8192; it += ogrid()) {
        const int gla = it >> 12, h = it & 3, bi = (it >> 2) & 1023, i = bi & 31;
        const size_t t0 = (size_t)bi * 64;
        const int n = tid >> 3, dv0 = (tid & 7) * 8;
        float acc[8];
#pragma unroll
        for (int e = 0; e < 8; ++e) acc[e] = 0.f;
        __syncthreads();
        { const float* src = (gla ? GU : RU) + (size_t)(bi * 4 + h) * 2048; const int idx = tid * 4, dk = idx >> 6, dv = idx & 63;
            const f32x4 t = *(const f32x4*)(src + idx); Rm[dk * 68 + dv] = t[0]; Rm[dk * 68 + dv + 1] = t[1]; Rm[dk * 68 + dv + 2] = t[2]; Rm[dk * 68 + dv + 3] = t[3]; }
        if (!gla) {
            const float lg = ret_logg(h);
            load_rot(H + t0 * NH + C_RQ + h * 32, rot, i, qt, 1.f, 0.f, tid);
            load_rot(H + t0 * NH + C_RK + h * 32, rot, i, kt, 0.17677669529663689f, 0.f, tid);
            load_tile64(H + t0 * NH + C_RV + h * 64, NH, vv, 68, 1.f, tid);
            __syncthreads();
            { const int m0 = (tid & 7) * 8;
#pragma unroll
                for (int mm = 0; mm < 8; ++mm) { const int m = m0 + mm; float d = 0.f;
#pragma unroll
                    for (int dk = 0; dk < 32; ++dk) d += qt[n * 33 + dk] * kt[m * 33 + dk];
                    const int ad = n > m ? n - m : m - n; Sm[n * 65 + m] = d * __expf(lg * (float)ad); } }
            __syncthreads();
#pragma unroll 4
            for (int m = 0; m < 64; ++m) { const float sv = Sm[n * 65 + m]; const f32x4 v0 = *(const LAS f32x4*)(vv + m * 68 + dv0), v1 = *(const LAS f32x4*)(vv + m * 68 + dv0 + 4);
                acc[0] += sv * v0[0]; acc[1] += sv * v0[1]; acc[2] += sv * v0[2]; acc[3] += sv * v0[3]; acc[4] += sv * v1[0]; acc[5] += sv * v1[1]; acc[6] += sv * v1[2]; acc[7] += sv * v1[3]; }
            const float xi = __expf(lg * (float)(n + 1));
#pragma unroll 4
            for (int dk = 0; dk < 32; ++dk) { const float qx = qt[n * 33 + dk] * xi; const f32x4 v0 = *(const LAS f32x4*)(Rm + dk * 68 + dv0), v1 = *(const LAS f32x4*)(Rm + dk * 68 + dv0 + 4);
                acc[0] += qx * v0[0]; acc[1] += qx * v0[1]; acc[2] += qx * v0[2]; acc[3] += qx * v0[3]; acc[4] += qx * v1[0]; acc[5] += qx * v1[1]; acc[6] += qx * v1[2]; acc[7] += qx * v1[3]; }
        } else {
            { const int idx = tid * 4, j = idx >> 5, c = idx & 31; const u32x2 w = *(const u32x2*)(H + (t0 + j) * NH + C_GQ + h * 32 + c); const float sc = 0.17677669529663689f;
                qt[j * 33 + c] = bflo(w.x) * sc; qt[j * 33 + c + 1] = bfhi(w.x) * sc; qt[j * 33 + c + 2] = bflo(w.y) * sc; qt[j * 33 + c + 3] = bfhi(w.y) * sc; }
            __syncthreads();
#pragma unroll 4
            for (int dk = 0; dk < 32; ++dk) { const float qx = qt[n * 33 + dk]; const f32x4 v0 = *(const LAS f32x4*)(Rm + dk * 68 + dv0), v1 = *(const LAS f32x4*)(Rm + dk * 68 + dv0 + 4);
                acc[0] += qx * v0[0]; acc[1] += qx * v0[1]; acc[2] += qx * v0[2]; acc[3] += qx * v0[3]; acc[4] += qx * v1[0]; acc[5] += qx * v1[1]; acc[6] += qx * v1[2]; acc[7] += qx * v1[3]; }
        }
        float s = 0.f;
#pragma unroll
        for (int e = 0; e < 8; ++e) s += acc[e];
        s += __shfl_xor(s, 1); s += __shfl_xor(s, 2); s += __shfl_xor(s, 4);
        const float mean = s * (1.f / 64.f); float s2 = 0.f;
#pragma unroll
        for (int e = 0; e < 8; ++e) { acc[e] -= mean; s2 += acc[e] * acc[e]; }
        s2 += __shfl_xor(s2, 1); s2 += __shfl_xor(s2, 2); s2 += __shfl_xor(s2, 4);
        const float rs = 1.f / sqrtf(s2 * (1.f / 64.f) + LN_EPS);
        const u32x4 gw = *(const u32x4*)(H + (t0 + n) * NH + (gla ? C_GR : C_RG) + h * 64 + dv0); float gf[8]; unpack8(gw, gf);
        float ov[8];
#pragma unroll
        for (int e = 0; e < 8; ++e) ov[e] = silu_f(gf[e]) * acc[e] * rs;
        *(u32x4*)(O + (t0 + n) * DM + (gla ? 512 : 0) + h * 64 + dv0) = pack8(ov);
    }
}


#define XB_TMO      128
#define XB_XCNT(j)  (256  + 64 * (j))
#define XB_XSUB(j)  (1280 + 64 * (j))
#define XB_XGEN(j)  (2304 + 64 * (j))
#define XB_TOP      3328
#define XB_TOPGEN   3392
#define XCD_BAR_WORDS 3456
#define XB_SPIN_CAP (1u << 20)
__device__ __forceinline__ unsigned xb_ld(unsigned* p)              { return __hip_atomic_load(p, __ATOMIC_RELAXED, __HIP_MEMORY_SCOPE_AGENT); }
__device__ __forceinline__ unsigned xb_add(unsigned* p, unsigned v) { return __hip_atomic_fetch_add(p, v, __ATOMIC_RELAXED, __HIP_MEMORY_SCOPE_AGENT); }
__device__ __forceinline__ unsigned xb_xcc_id() { return (unsigned)__builtin_amdgcn_s_getreg((3 << 11) | 20) & 0xFu; }
#define XB_SPIN(cond, bar) do { unsigned _sp = 0; while (cond) { __builtin_amdgcn_s_sleep(1); \
    if ((++_sp & 255u) == 0u) { if (xb_ld(&(bar)[XB_TMO])) break; if (_sp > XB_SPIN_CAP) { atomicAdd(&(bar)[XB_TMO], 1u); break; } } } } while (0)
struct XcdBarrier { unsigned* bar; unsigned x; volatile LAS unsigned* st; };
__device__ __forceinline__ XcdBarrier xcd_barrier_post(unsigned* bar, volatile LAS unsigned* st) {
    XcdBarrier b; b.bar = bar; b.x = xb_xcc_id(); b.st = st;
    if (threadIdx.x == 0) (void)xb_add(&bar[XB_XCNT(b.x)], 1u);
    return b;
}
__device__ __forceinline__ void xcd_barrier_complete(unsigned* bar, unsigned x, unsigned& nloc, unsigned& nx) {
    const unsigned G = gridDim.x * gridDim.y * gridDim.z;
    unsigned sum, cnt, mine, sp = 0u;
    for (;;) {
        sum = 0u; cnt = 0u; mine = 0u;
#pragma unroll
        for (unsigned j = 0; j < 16; ++j) { const unsigned c = xb_ld(&bar[XB_XCNT(j)]); sum += c; cnt += (c > 0u) ? 1u : 0u; mine = (j == x) ? c : mine; }
        if (sum == G) break;
        __builtin_amdgcn_s_sleep(1);
        if ((++sp & 255u) == 0u) { if (xb_ld(&bar[XB_TMO])) break; if (sp > XB_SPIN_CAP) { atomicAdd(&bar[XB_TMO], 1u); break; } }
    }
    nloc = mine > 0u ? mine : 1u; nx = cnt > 0u ? cnt : 1u;
}
__device__ __forceinline__ void xcd_barrier(const XcdBarrier& b) {
    asm volatile("s_waitcnt vmcnt(0)" ::: "memory");
    __syncthreads();
    if (threadIdx.x == 0) {
        unsigned* bar = b.bar;
        __builtin_amdgcn_s_waitcnt(0);
        unsigned nloc = b.st[0], nx = b.st[1];
        if (nloc == 0u) { xcd_barrier_complete(bar, b.x, nloc, nx); b.st[0] = nloc; b.st[1] = nx; }
        const unsigned old = xb_add(&bar[XB_XSUB(b.x)], 1u);
        const unsigned gen = old / nloc;
        if (old + 1u == (gen + 1u) * nloc) {
            __builtin_amdgcn_fence(__ATOMIC_RELEASE, "agent");
            asm volatile("s_waitcnt vmcnt(0)" ::: "memory");
            const unsigned og = xb_add(&bar[XB_TOP], 1u);
            const unsigned tg = og / nx;
            if (og + 1u == (tg + 1u) * nx) xb_add(&bar[XB_TOPGEN], 1u);
            else XB_SPIN(xb_ld(&bar[XB_TOPGEN]) == tg, bar);
            __builtin_amdgcn_fence(__ATOMIC_ACQUIRE, "agent");
            xb_add(&bar[XB_XGEN(b.x)], 1u);
            asm volatile("s_waitcnt vmcnt(0)" ::: "memory");
        } else {
            XB_SPIN(xb_ld(&bar[XB_XGEN(b.x)]) == gen, bar);
            __builtin_amdgcn_fence(__ATOMIC_ACQUIRE, "agent");
            asm volatile("s_waitcnt vmcnt(0)" ::: "memory");
        }
    }
    __syncthreads();
}

__global__ void __launch_bounds__(512, 2) mega(Params p_unused) {
    extern __shared__ __attribute__((aligned(16))) unsigned char lds_raw[];
    LAS unsigned char* lds = (LAS unsigned char*)lds_raw;
    cg::grid_group grid = cg::this_grid();
    CPP p = (CPP)__builtin_amdgcn_kernarg_segment_ptr();
    unsigned char* ws = p->ws;
    bf16_t* XB = (bf16_t*)(ws + WS_XB);
    volatile LAS unsigned* bst = (volatile LAS unsigned*)(lds + LDS_BYTES - 64);
    if (threadIdx.x < 2) bst[threadIdx.x] = 0u;
    __syncthreads();
    const XcdBarrier bar = xcd_barrier_post((unsigned*)ws, bst);

    { float* rot = (float*)(ws + WS_ROT); const int gt = obid() * 512 + otid(), NT = ogrid() * 512;
        for (int e = gt; e < 2048 * 16; e += NT) { const int pos = e >> 4, f = e & 15; const float inv = 1.0f / powf(10000.0f, (float)f * (1.0f / 16.0f)); const float ang = (float)pos * inv;
            rot[pos * 32 + f] = cosf(ang); rot[pos * 32 + 16 + f] = sinf(ang); } }
    s5_tables(p, 0, lds);
    { const float* x = p->in[0]; const int gt = obid() * 512 + otid(), NT = ogrid() * 512;
        for (size_t e = gt; e < (size_t)M * DM / 8; e += NT) { const f32x4 a = *((const f32x4*)x + 2 * e), b = *((const f32x4*)x + 2 * e + 1);
            u32x4 w; w.x = pk2(a[0], a[1]); w.y = pk2(a[2], a[3]); w.z = pk2(b[0], b[1]); w.w = pk2(b[2], b[3]); *((u32x4*)XB + e) = w; } }
    grid.sync();
    convert_weights(p, 0, lds);
    xcd_barrier(bar);

    for (int l = 0; l < 4; ++l) {
        for (int s = 0; s < 12; ++s) {
            p = (CPP)__builtin_amdgcn_kernarg_segment_ptr(); asm volatile("" : "+s"(p));
            pg8::Gemm g; pg8::Sched S; pg8::Epi E;
            bool do_gemm = true;
            S.G = ogrid(); S.c = obid(); S.mode = 0; S.nM = M / 256; S.nN = 1;
            E.mode = 0; E.perm = true;
            E.ws = ws; E.dskip = p->in[12] + l * 256; E.bglu = p->in[14] + l * 256; E.bgate = p->in[16] + (size_t)l * 4096;
            g.A = XB; g.Bt = (const bf16_t*)(ws + WS_WIN); g.lda = DM; g.ldb = DM; g.K = DM;
            switch (s) {
                case 0: S.nN = NINP / 256; E.mode = 0; E.perm = true; break;
                case 1: g.A = (const bf16_t*)(ws + WS_U2); g.Bt = (const bf16_t*)(ws + WS_WE); g.lda = S5K; g.ldb = 1024; g.K = 1024; S.mode = 2; S.nM = 64; S.nN = 1; E.mode = 1; break;
                case 3: g.A = (const bf16_t*)(ws + WS_U2); g.Bt = (const bf16_t*)(ws + WS_WT); g.lda = S5K; g.ldb = S5K; g.K = S5K; S.mode = 3; S.nM = 64; S.nN = 4; E.mode = 2; break;
                case 4: g.A = (const bf16_t*)(ws + WS_YS); g.Bt = (const bf16_t*)(ws + WS_WGLU); g.lda = 256; g.ldb = 256; g.K = 256; S.nN = 1; E.mode = 3; break;
                case 5: g.A = (const bf16_t*)(ws + WS_O); g.Bt = (const bf16_t*)(ws + WS_WB); g.lda = DM; g.ldb = 256; g.K = 256; S.mode = 1; S.nN = 16; E.mode = 4; break;
                case 6: g.Bt = (const bf16_t*)(ws + WS_WG); S.nN = 16; E.mode = 5; E.perm = false; break;
                case 7: g.A = (const bf16_t*)(ws + WS_O); g.Bt = (const bf16_t*)(ws + WS_WO); S.nN = 4; E.mode = 6; E.perm = false; break;
                case 9: g.Bt = (const bf16_t*)(ws + WS_WFF); S.nN = 22; E.mode = 7; E.perm = false; break;
                case 10: g.A = (const bf16_t*)(ws + WS_E); g.Bt = (const bf16_t*)(ws + WS_WD); g.lda = DFF; g.ldb = DFF; g.K = DFF; S.nN = 4; E.mode = 6; E.perm = false; break;
                default: do_gemm = false; break;
            }
            S.nwg = S.nM * S.nN;
            if (do_gemm) pg8::gemm_phase(lds, g, S, E);
            if (s == 1) { attn_mfma(p, l, lds); upd_items(p, l, lds); }
            else if (s == 2) scan_items(p, l);
            else if (s == 3) out_items(p, l, lds);
            else if (s == 8) { ln_pass(XB, nullptr, p->in[19] + l * DM, p->in[20] + l * DM); if (l < 3) s5_tables(p, l + 1, lds); }
            else if (s == 11) { ln_pass(XB, (l == 3) ? p->out : nullptr, p->in[24] + l * DM, p->in[25] + l * DM); if (l < 3) convert_weights(p, l + 1, lds); }
            xcd_barrier(bar);
        }
    }
}

extern "C" void kernel_launch(void* const* d_in, const int* in_sizes, int n_in, void* d_out, int out_size, void* d_ws, size_t ws_size, hipStream_t stream) {
    static int grid_blocks = 0;
    if (!grid_blocks) {
        int dev = 0, cus = 0;
        hipGetDevice(&dev);
        hipDeviceGetAttribute(&cus, hipDeviceAttributeMultiprocessorCount, dev);
        hipFuncSetAttribute((const void*)mega, hipFuncAttributeMaxDynamicSharedMemorySize, LDS_BYTES);
        grid_blocks = cus > 0 ? cus : 256;
    }
    (void)hipMemsetAsync(d_ws, 0, 65536, stream);
    Params p{};
    for (int i = 0; i < 26; ++i) p.in[i] = (const float*)d_in[i];
    p.out = (float*)d_out; p.ws = (unsigned char*)d_ws;
    void* args[] = {&p};
    hipError_t e = hipLaunchCooperativeKernel((const void*)mega, dim3(grid_blocks), dim3(512), args, LDS_BYTES, stream);
    if (e != hipSuccess) fprintf(stderr, "cooperative launch failed: %s (grid %d)\n", hipGetErrorString(e), grid_blocks);
}
```

```cpp
#include <hip/hip_runtime.h>
#include <hip/hip_cooperative_groups.h>
#include <cstdint>
#include <cstdio>
namespace cg = cooperative_groups;

#define LAS __attribute__((address_space(3)))
typedef unsigned short bf16_t;
typedef short bf16x8 __attribute__((ext_vector_type(8)));
typedef float f32x4 __attribute__((ext_vector_type(4)));
typedef float f32x2 __attribute__((ext_vector_type(2)));
typedef unsigned u32x4 __attribute__((ext_vector_type(4)));
typedef unsigned u32x2 __attribute__((ext_vector_type(2)));

constexpr int M = 65536, DM = 1024, SEQ = 2048, NCH = 32;
constexpr int NH = 2320;
constexpr int NINP = 2816;
constexpr int DFF = 2816;
constexpr int S5K = 1152;
constexpr float ALPHA = 1.681792830507429f;
constexpr float LN_EPS = 1e-5f;
constexpr int C_RQ = 0, C_RK = 128, C_RV = 256, C_RG = 512, C_AQ = 768, C_AK = 1024, C_AV = 1280, C_GQ = 1536, C_GK = 1664, C_GV = 1792, C_GR = 2048, C_GA = 2304, C_SU = 2320;

constexpr size_t MiB = 1u << 20;
constexpr size_t WS_ROT = 1 * MiB;
constexpr size_t WS_KN = 2 * MiB;
constexpr size_t WS_WIN = 4 * MiB;
constexpr size_t WS_WG = 10 * MiB;
constexpr size_t WS_WB = 18 * MiB;
constexpr size_t WS_WO = 20 * MiB;
constexpr size_t WS_WFF = 22 * MiB;
constexpr size_t WS_WD = 33 * MiB;
constexpr size_t WS_WGLU = 39 * MiB;
constexpr size_t WS_WE = 40 * MiB;
constexpr size_t WS_WT = 48 * MiB;
constexpr size_t WS_XB = 88 * MiB;
constexpr size_t WS_O = 216 * MiB;
constexpr size_t WS_E = 344 * MiB;
constexpr size_t WS_U2 = 636 * MiB;
constexpr size_t WS_RU = 676 * MiB;
constexpr size_t WS_GU = 708 * MiB;
constexpr size_t WS_GL = 740 * MiB;
constexpr size_t WS_ES = 741 * MiB;
constexpr size_t WS_YS = 749 * MiB;
constexpr int LDS_BYTES = 147456;

struct Params { const float* in[26]; float* out; unsigned char* ws; };
typedef const __attribute__((address_space(4))) Params* CPP;

typedef _Float16 half2_t __attribute__((ext_vector_type(2)));
typedef _Float16 half8_t __attribute__((ext_vector_type(8)));
__device__ __forceinline__ float bflo(unsigned w) { return (float)__builtin_bit_cast(half2_t, w)[0]; }
__device__ __forceinline__ float bfhi(unsigned w) { return (float)__builtin_bit_cast(half2_t, w)[1]; }
__device__ __forceinline__ float bf2f(bf16_t b) { return (float)__builtin_bit_cast(_Float16, b); }
__device__ __forceinline__ unsigned f2bf(float f) { return (unsigned)__builtin_bit_cast(unsigned short, (_Float16)f); }
__device__ __forceinline__ unsigned pk2(float lo, float hi) { const half2_t v = {(_Float16)lo, (_Float16)hi}; return __builtin_bit_cast(unsigned, v); }
__device__ __forceinline__ unsigned cvt_pk_bf16(float lo, float hi) { return pk2(lo, hi); }
__device__ __forceinline__ float sigm(float x) { return __builtin_amdgcn_rcpf(1.0f + __expf(-x)); }
__device__ __forceinline__ float silu_f(float x) { return x * sigm(x); }
__device__ __forceinline__ float gelu_tanh(float v) { return v * sigm(1.5957691216057308f * (v + 0.044715f * v * v * v)); }
__device__ __forceinline__ void unpack8(u32x4 w, float* o) {
    o[0] = bflo(w.x); o[1] = bfhi(w.x); o[2] = bflo(w.y); o[3] = bfhi(w.y); o[4] = bflo(w.z); o[5] = bfhi(w.z); o[6] = bflo(w.w); o[7] = bfhi(w.w);
}
__device__ __forceinline__ u32x4 pack8(const float* v) { u32x4 w; w.x = pk2(v[0], v[1]); w.y = pk2(v[2], v[3]); w.z = pk2(v[4], v[5]); w.w = pk2(v[6], v[7]); return w; }
__device__ __forceinline__ int otid() { int t = threadIdx.x; asm volatile("" : "+v"(t)); return t; }
__device__ __forceinline__ int obid() { int b = blockIdx.x; asm volatile("" : "+s"(b)); return b; }
__device__ __forceinline__ int ogrid() { int b = gridDim.x; asm volatile("" : "+s"(b)); return b; }
__device__ __forceinline__ float wave_sum(float v) {
#pragma unroll
    for (int o = 1; o < 64; o <<= 1) v += __shfl_xor(v, o);
    return v;
}

namespace pg8 {
constexpr int BM = 256, BK = 64, HALF = 128, HTB = HALF * BK * 2, STAGE_BYTES = 8 * HTB, NXCD = 8, WGM = 8;
__device__ __forceinline__ int lds_byte(int r, int c) { const int st = (r >> 4) * 2 + (c >> 5), rr = r & 15, cc = c & 31, ob = rr * 64 + cc * 2; return st * 1024 + (ob ^ (((ob >> 9) & 1) << 5)); }
__device__ __forceinline__ void stage_rc(int b, int& R, int& C) { const int st = b / 1024, sb = b % 1024, swz = sb ^ (((sb >> 9) & 1) << 5); R = (st >> 1) * 16 + swz / 64; C = (st & 1) * 32 + (swz % 64) / 2; }
__device__ __forceinline__ int perm32(int rho) { const int n = rho >> 4, i = rho & 15; return 8 * (i >> 2) + 4 * n + (i & 3); }

struct Unit { int pm, pn, ak; };
struct Gemm { const bf16_t* A; const bf16_t* Bt; int lda, ldb, K; };

struct Sched {
    int nM, nN, nwg, G, c, mode;
    __device__ __forceinline__ bool next(int i, Unit& u) const {
        const long L = (long)i * G + c; if (L >= nwg) return false;
        if (mode == 2) { u.pm = (int)L; u.pn = (int)(L >> 2); u.ak = 0; return true; }
        if (mode == 3) { const int g = (int)(L >> 4); u.pm = 4 * g + (int)((L >> 2) & 3); u.pn = 4 * g + (int)(L & 3); u.ak = 0; return true; }
        int wgid = (int)L; { const int q = nwg / NXCD, r = nwg % NXCD, xcd = wgid % NXCD, off = wgid / NXCD; wgid = (xcd < r ? xcd * (q + 1) : r * (q + 1) + (xcd - r) * q) + off; }
        const int nig = WGM * nN, gid = wgid / nig, fm = gid * WGM, gsz = (nM - fm) < WGM ? (nM - fm) : WGM;
        u.pm = fm + ((wgid % nig) % gsz); u.pn = (wgid % nig) / gsz; u.ak = (mode == 1) ? (u.pn >> 2) * 256 : 0; return true;
    }
};

struct Epi {
    int mode; bool perm;
    unsigned char* ws; const float* dskip; const float* bglu; const float* bgate;
    __device__ __forceinline__ void operator()(const f32x4 (&acc)[2][2][4][2], const Unit& u, int wr, int wc, int fr, int fq) const {
        const int row0 = u.pm * BM + wr * 64 + fr;
        bf16_t* const H = (bf16_t*)(ws + WS_E); bf16_t* const U2 = (bf16_t*)(ws + WS_U2); float* const ES = (float*)(ws + WS_ES); bf16_t* const YS = (bf16_t*)(ws + WS_YS);
        bf16_t* const Ob = (bf16_t*)(ws + WS_O); bf16_t* const P = (bf16_t*)(ws + WS_E); bf16_t* const MIX = (bf16_t*)(ws + WS_O); bf16_t* const HF = (bf16_t*)(ws + WS_E);
        if (mode == 0) {
#pragma unroll
            for (int ai = 0; ai < 2; ++ai)
#pragma unroll
                for (int m = 0; m < 4; ++m) { const int r = row0 + ai * HALF + m * 16;
#pragma unroll
                    for (int bj = 0; bj < 2; ++bj) { const int c0 = u.pn * BM + bj * HALF + wc * 32 + 8 * fq;
                        const f32x4 v0 = acc[ai][bj][m][0], v1 = acc[ai][bj][m][1];
                        u32x4 w; w.x = cvt_pk_bf16(v0[0], v0[1]); w.y = cvt_pk_bf16(v0[2], v0[3]); w.z = cvt_pk_bf16(v1[0], v1[1]); w.w = cvt_pk_bf16(v1[2], v1[3]);
                        if (c0 < C_SU) *(u32x4*)(H + (size_t)r * NH + c0) = w;
                        else if (c0 < C_SU + 256) { const int c = c0 - C_SU, g = c >> 4, ci = c & 15;
                            *(u32x4*)(U2 + ((size_t)(g * 1024 + (r >> 6))) * S5K + (r & 63) * 16 + ci) = w; } } }
        } else if (mode == 1) {
#pragma unroll
            for (int ai = 0; ai < 2; ++ai)
#pragma unroll
                for (int m = 0; m < 4; ++m) { const int r = row0 + ai * HALF + m * 16; const int c0 = wc * 32 + 8 * fq;
                    *(f32x4*)(ES + (size_t)r * 128 + c0) = acc[ai][0][m][0]; *(f32x4*)(ES + (size_t)r * 128 + c0 + 4) = acc[ai][0][m][1]; }
        } else if (mode == 2) {
            const int g = u.pm >> 2;
#pragma unroll
            for (int ai = 0; ai < 2; ++ai)
#pragma unroll
                for (int m = 0; m < 4; ++m) { const int r = row0 + ai * HALF + m * 16;
#pragma unroll
                    for (int bj = 0; bj < 2; ++bj) { const int n0 = (u.pn & 3) * BM + bj * HALF + wc * 32 + 8 * fq; const int j = n0 >> 4, i0 = n0 & 15;
                        const u32x4 uw = *(const u32x4*)(U2 + (size_t)r * S5K + n0); float uf[8]; unpack8(uw, uf);
                        const f32x4 d0 = *(const f32x4*)(dskip + 16 * g + i0), d1 = *(const f32x4*)(dskip + 16 * g + i0 + 4);
                        const f32x4 v0 = acc[ai][bj][m][0], v1 = acc[ai][bj][m][1]; float y[8];
                        y[0] = gelu_tanh(v0[0] + d0[0] * uf[0]); y[1] = gelu_tanh(v0[1] + d0[1] * uf[1]); y[2] = gelu_tanh(v0[2] + d0[2] * uf[2]); y[3] = gelu_tanh(v0[3] + d0[3] * uf[3]);
                        y[4] = gelu_tanh(v1[0] + d1[0] * uf[4]); y[5] = gelu_tanh(v1[1] + d1[1] * uf[5]); y[6] = gelu_tanh(v1[2] + d1[2] * uf[6]); y[7] = gelu_tanh(v1[3] + d1[3] * uf[7]);
                        u32x4 w; w.x = cvt_pk_bf16(y[0], y[1]); w.y = cvt_pk_bf16(y[2], y[3]); w.z = cvt_pk_bf16(y[4], y[5]); w.w = cvt_pk_bf16(y[6], y[7]);
                        const size_t t = (size_t)(r & 1023) * 64 + j;
                        *(u32x4*)(YS + t * 256 + 16 * g + i0) = w; } }
        } else if (mode == 3) {
#pragma unroll
            for (int ai = 0; ai < 2; ++ai)
#pragma unroll
                for (int m = 0; m < 4; ++m) { const int r = row0 + ai * HALF + m * 16;
#pragma unroll
                    for (int bj = 0; bj < 2; ++bj) { const int c0 = bj * HALF + wc * 32 + 8 * fq;
                        const u32x4 yw = *(const u32x4*)(YS + (size_t)r * 256 + c0); float yf[8]; unpack8(yw, yf);
                        const f32x4 b0 = *(const f32x4*)(bglu + c0), b1 = *(const f32x4*)(bglu + c0 + 4);
                        const f32x4 v0 = acc[ai][bj][m][0] + b0, v1 = acc[ai][bj][m][1] + b1; float o[8];
                        o[0] = yf[0] * sigm(v0[0]); o[1] = yf[1] * sigm(v0[1]); o[2] = yf[2] * sigm(v0[2]); o[3] = yf[3] * sigm(v0[3]);
                        o[4] = yf[4] * sigm(v1[0]); o[5] = yf[5] * sigm(v1[1]); o[6] = yf[6] * sigm(v1[2]); o[7] = yf[7] * sigm(v1[3]);
                        u32x4 w; w.x = cvt_pk_bf16(o[0], o[1]); w.y = cvt_pk_bf16(o[2], o[3]); w.z = cvt_pk_bf16(o[4], o[5]); w.w = cvt_pk_bf16(o[6], o[7]);
                        *(u32x4*)(Ob + (size_t)r * DM + 768 + c0) = w; } }
        } else if (mode == 4) {
#pragma unroll
            for (int ai = 0; ai < 2; ++ai)
#pragma unroll
                for (int m = 0; m < 4; ++m) { const int r = row0 + ai * HALF + m * 16;
#pragma unroll
                    for (int bj = 0; bj < 2; ++bj) { const int c0 = u.pn * BM + bj * HALF + wc * 32 + 8 * fq;
                        const f32x4 v0 = acc[ai][bj][m][0], v1 = acc[ai][bj][m][1];
                        u32x4 w; w.x = cvt_pk_bf16(v0[0], v0[1]); w.y = cvt_pk_bf16(v0[2], v0[3]); w.z = cvt_pk_bf16(v1[0], v1[1]); w.w = cvt_pk_bf16(v1[2], v1[3]);
                        *(u32x4*)(P + (size_t)r * 4096 + c0) = w; } }
        } else if (mode == 5) {
            const int ch0 = 64 * u.pn + 16 * wc + 4 * fq;
            f32x4 bv[4];
#pragma unroll
            for (int b = 0; b < 4; ++b) bv[b] = *(const f32x4*)(bgate + b * 1024 + ch0);
#pragma unroll
            for (int ai = 0; ai < 2; ++ai)
#pragma unroll
                for (int m = 0; m < 4; ++m) { const int r = row0 + ai * HALF + m * 16; f32x4 mix = (f32x4){0.f, 0.f, 0.f, 0.f};
#pragma unroll
                    for (int bj = 0; bj < 2; ++bj)
#pragma unroll
                        for (int n = 0; n < 2; ++n) { const int b = 2 * bj + n; const f32x4 a = acc[ai][bj][m][n] + bv[b];
                            const u32x2 pw = *(const u32x2*)(P + (size_t)r * 4096 + b * 1024 + ch0);
                            mix[0] += sigm(a[0]) * bflo(pw.x); mix[1] += sigm(a[1]) * bfhi(pw.x); mix[2] += sigm(a[2]) * bflo(pw.y); mix[3] += sigm(a[3]) * bfhi(pw.y); }
                    u32x2 w; w.x = cvt_pk_bf16(mix[0], mix[1]); w.y = cvt_pk_bf16(mix[2], mix[3]);
                    *(u32x2*)(MIX + (size_t)r * DM + ch0) = w; }
        } else if (mode == 6) {
            bf16_t* const XBp = (bf16_t*)(ws + WS_XB);
#pragma unroll
            for (int ai = 0; ai < 2; ++ai)
#pragma unroll
                for (int m = 0; m < 4; ++m) { const int r = row0 + ai * HALF + m * 16;
#pragma unroll
                    for (int bj = 0; bj < 2; ++bj)
#pragma unroll
                        for (int n = 0; n < 2; ++n) { const int c = u.pn * BM + bj * HALF + wc * 32 + n * 16 + 4 * fq;
                            u32x2* px = (u32x2*)(XBp + (size_t)r * DM + c); const u32x2 xw = *px; const f32x4 a = acc[ai][bj][m][n];
                            u32x2 w; w.x = cvt_pk_bf16(bflo(xw.x) * ALPHA + a[0], bfhi(xw.x) * ALPHA + a[1]); w.y = cvt_pk_bf16(bflo(xw.y) * ALPHA + a[2], bfhi(xw.y) * ALPHA + a[3]);
                            *px = w; } }
        } else {
#pragma unroll
            for (int ai = 0; ai < 2; ++ai)
#pragma unroll
                for (int m = 0; m < 4; ++m) { const int r = row0 + ai * HALF + m * 16;
#pragma unroll
                    for (int bj = 0; bj < 2; ++bj) { const int ch0 = 128 * u.pn + 64 * bj + 16 * wc + 4 * fq;
                        const f32x4 gt = acc[ai][bj][m][0], up = acc[ai][bj][m][1];
                        u32x2 w; w.x = cvt_pk_bf16(silu_f(gt[0]) * up[0], silu_f(gt[1]) * up[1]); w.y = cvt_pk_bf16(silu_f(gt[2]) * up[2], silu_f(gt[3]) * up[3]);
                        *(u32x2*)(HF + (size_t)r * DFF + ch0) = w; } }
        }
    }
};

__device__ __forceinline__ void gemm_phase(LAS unsigned char* lds, const Gemm g, const Sched& S, const Epi& E) {
    const int tid = otid(), wid = __builtin_amdgcn_readfirstlane(tid >> 6), lane = tid & 63, wr = wid >> 2, wc = wid & 3, fr = lane & 15, fq = lane >> 4;
    const int K = g.K, nt = K / BK;
    unsigned voffA[2], voffB[2];
#pragma unroll
    for (int i = 0; i < 2; ++i) { int R, C; stage_rc(tid * 16 + i * 8192, R, C); const int Rb = E.perm ? ((R & ~31) + perm32(R & 31)) : R;
        voffA[i] = (unsigned)(R * g.lda + C) * 2u; voffB[i] = (unsigned)(Rb * g.ldb + C) * 2u; }
    const size_t kstep = (size_t)(BK * 2);
    const size_t hstepA = (size_t)HALF * g.lda * 2, hstepB = (size_t)HALF * g.ldb * 2;
    const size_t tstepA = 2 * hstepA, tstepB = 2 * hstepB;
    const unsigned ldsw = (unsigned)wid * 1024u;
    const int aoff = lds_byte(wr * 64 + fr, fq * 8), boff = lds_byte(wc * 32 + fr, fq * 8);
#define PG8_SA(b, h) (((b) * 2 + (h)) * HTB)
#define PG8_SB(b, h) ((4 + (b) * 2 + (h)) * HTB)
#define PG8_STAGE(bufoff, gbase, voff) do { _Pragma("unroll") for (int _i = 0; _i < 2; ++_i) \
        __builtin_amdgcn_global_load_lds((const unsigned*)((const char*)(gbase) + (voff)[_i]), (LAS unsigned*)(lds + (bufoff) + ldsw + _i * 8192), 16, 0, 0); } while (0)
#define PG8_LDA(dst, b, h) do { _Pragma("unroll") for (int m = 0; m < 4; ++m) _Pragma("unroll") for (int k = 0; k < 2; ++k) dst[m][k] = *(const LAS bf16x8*)(lds + PG8_SA(b, h) + aoff + m * 2048 + k * 1024); } while (0)
#define PG8_LDB(dst, b, h) do { _Pragma("unroll") for (int n = 0; n < 2; ++n) _Pragma("unroll") for (int k = 0; k < 2; ++k) dst[n][k] = *(const LAS bf16x8*)(lds + PG8_SB(b, h) + boff + n * 2048 + k * 1024); } while (0)
#define PG8_MMA(ai, bj, At, Bt) do { __builtin_amdgcn_s_setprio(1); _Pragma("unroll") for (int m = 0; m < 4; ++m) _Pragma("unroll") for (int n = 0; n < 2; ++n) _Pragma("unroll") for (int k = 0; k < 2; ++k) \
        acc[ai][bj][m][n] = __builtin_amdgcn_mfma_f32_16x16x32_f16(__builtin_bit_cast(half8_t, Bt[n][k]), __builtin_bit_cast(half8_t, At[m][k]), acc[ai][bj][m][n], 0, 0, 0); __builtin_amdgcn_s_setprio(0); } while (0)
#define PG8_WAIT_V(n) asm volatile("s_waitcnt vmcnt(" #n ")" ::: "memory")
#define PG8_WAIT_L(n) asm volatile("s_waitcnt lgkmcnt(" #n ")" ::: "memory")
#define PG8_BAR __builtin_amdgcn_s_barrier()
#define PG8_SCHED __builtin_amdgcn_sched_barrier(0)
    Unit cur, nxt; int ui = 0;
    if (!S.next(0, cur)) return;
    f32x4 acc[2][2][4][2];
#pragma unroll
    for (int a = 0; a < 2; ++a)
#pragma unroll
        for (int b = 0; b < 2; ++b)
#pragma unroll
            for (int m = 0; m < 4; ++m)
#pragma unroll
                for (int n = 0; n < 2; ++n) acc[a][b][m][n] = (f32x4){0.f, 0.f, 0.f, 0.f};
    bf16x8 At[4][2], B0[2][2], B1[2][2];
    const char* cA = (const char*)g.A + (size_t)cur.pm * tstepA + (size_t)cur.ak * 2; const char* cB = (const char*)g.Bt + (size_t)cur.pn * tstepB;
    PG8_STAGE(PG8_SB(0, 0), cB, voffB); PG8_STAGE(PG8_SB(0, 1), cB + hstepB, voffB); PG8_STAGE(PG8_SA(0, 0), cA, voffA); PG8_STAGE(PG8_SA(0, 1), cA + hstepA, voffA);
    if (wr == 1) PG8_BAR;
    PG8_WAIT_V(2); PG8_BAR;
    PG8_STAGE(PG8_SB(1, 0), cB + kstep, voffB); PG8_STAGE(PG8_SA(1, 0), cA + kstep, voffA); PG8_STAGE(PG8_SB(1, 1), cB + hstepB + kstep, voffB);
    PG8_WAIT_V(6); PG8_BAR;
    for (;;) {
        const bool has_next = S.next(ui + 1, nxt);
        const char* nA = has_next ? (const char*)g.A + (size_t)nxt.pm * tstepA + (size_t)nxt.ak * 2 : cA; const char* nB = has_next ? (const char*)g.Bt + (size_t)nxt.pn * tstepB : cB;
        for (int t = 0; t < nt; t += 2) {
            const bool last = (t == nt - 2);
            const char* a1 = cA + (size_t)(t + 1) * kstep;
            const char* a2 = last ? nA : cA + (size_t)(t + 2) * kstep; const char* b2 = last ? nB : cB + (size_t)(t + 2) * kstep;
            const char* a3 = a2 + kstep; const char* b3 = b2 + kstep;
            PG8_LDB(B0, 0, 0); PG8_LDB(B1, 0, 1); PG8_SCHED; PG8_LDA(At, 0, 0); PG8_STAGE(PG8_SA(1, 1), a1 + hstepA, voffA);
            PG8_WAIT_V(8); PG8_WAIT_L(0); PG8_BAR; PG8_MMA(0, 0, At, B0); PG8_MMA(0, 1, At, B1); PG8_BAR; PG8_SCHED;
            PG8_LDA(At, 0, 1); PG8_STAGE(PG8_SB(0, 0), b2, voffB); PG8_STAGE(PG8_SB(0, 1), b2 + hstepB, voffB); PG8_STAGE(PG8_SA(0, 0), a2, voffA);
            PG8_WAIT_V(8); PG8_WAIT_L(0); PG8_BAR; PG8_MMA(1, 0, At, B0); PG8_MMA(1, 1, At, B1); PG8_BAR; PG8_SCHED;
            PG8_LDB(B0, 1, 0); PG8_LDB(B1, 1, 1); PG8_SCHED; PG8_LDA(At, 1, 0); PG8_STAGE(PG8_SA(0, 1), a2 + hstepA, voffA);
            PG8_WAIT_V(8); PG8_WAIT_L(0); PG8_BAR; PG8_MMA(0, 0, At, B0); PG8_MMA(0, 1, At, B1); PG8_BAR; PG8_SCHED;
            PG8_LDA(At, 1, 1); PG8_STAGE(PG8_SB(1, 0), b3, voffB); PG8_STAGE(PG8_SB(1, 1), b3 + hstepB, voffB); PG8_STAGE(PG8_SA(1, 0), a3, voffA);
            PG8_WAIT_V(8); PG8_WAIT_L(0); PG8_BAR; PG8_MMA(1, 0, At, B0); PG8_MMA(1, 1, At, B1); PG8_BAR; PG8_SCHED;
        }
        if (wr == 0) PG8_BAR;
        { const int t2 = otid(), w2 = __builtin_amdgcn_readfirstlane(t2 >> 6), l2 = t2 & 63;
          E(acc, cur, w2 >> 2, w2 & 3, l2 & 15, l2 >> 4); }
        if (!has_next) break;
#pragma unroll
        for (int a = 0; a < 2; ++a)
#pragma unroll
            for (int b = 0; b < 2; ++b)
#pragma unroll
                for (int m = 0; m < 4; ++m)
#pragma unroll
                    for (int n = 0; n < 2; ++n) acc[a][b][m][n] = (f32x4){0.f, 0.f, 0.f, 0.f};
        cur = nxt; cA = nA; cB = nB; ++ui;
        if (wr == 1) PG8_BAR;
    }
    PG8_WAIT_V(0);
    PG8_BAR;
#undef PG8_SA
#undef PG8_SB
#undef PG8_STAGE
#undef PG8_LDA
#undef PG8_LDB
#undef PG8_MMA
#undef PG8_WAIT_V
#undef PG8_WAIT_L
#undef PG8_BAR
#undef PG8_SCHED
}
}

__device__ __forceinline__ int dest_row(int dmode, int arg, int n) {
    if (dmode == 1) { return ((n >> 6) << 8) + ((arg >> 1) << 7) + (((n >> 4) & 3) << 5) + ((arg & 1) << 4) + (n & 15); }
    if (dmode == 2) { return ((n >> 7) << 8) + (((n >> 6) & 1) << 7) + (((n >> 4) & 3) << 5) + (arg << 4) + (n & 15); }
    return n + arg;
}
__device__ __forceinline__ void transpose_item(const float* W, int K, int Nsrc, bf16_t* WT, int dmode, int arg, LAS float* scr, int kb, int nb, int lane) {
    const int k0 = 64 * kb, n0 = 32 * nb;
    const int nsrc = n0 + (lane & 31); const bool ok = nsrc < Nsrc;
#pragma unroll 8
    for (int i = 0; i < 32; ++i) { const int kk = 2 * i + (lane >> 5); scr[kk * 33 + (lane & 31)] = ok ? W[(size_t)(k0 + kk) * Nsrc + nsrc] : 0.f; }
    asm volatile("s_waitcnt lgkmcnt(0)" ::: "memory");
    const int c = lane & 7;
#pragma unroll
    for (int j = 0; j < 4; ++j) { const int n = (lane >> 3) + 8 * j; const LAS float* s = scr + (8 * c) * 33 + n;
        u32x4 o; o.x = pk2(s[0 * 33], s[1 * 33]); o.y = pk2(s[2 * 33], s[3 * 33]); o.z = pk2(s[4 * 33], s[5 * 33]); o.w = pk2(s[6 * 33], s[7 * 33]);
        *(u32x4*)(WT + (size_t)dest_row(dmode, arg, n0 + n) * K + k0 + 8 * c) = o; }
    asm volatile("s_waitcnt lgkmcnt(0)" ::: "memory");
}

__device__ __forceinline__ void s5_abar_pow(float lr, float li, float dt, int n, float& re, float& im) {
    const float mag = expf((float)n * lr * dt);
    const double a = (double)n * ((double)li * (double)dt);
    const double k = __builtin_rint(a * 0.15915494309189535);
    const float r = (float)__builtin_fma(-k, 6.283185307179586, a);
    re = mag * cosf(r); im = mag * sinf(r);
}
__device__ __forceinline__ void s5_coef(float lr, float li, float dt, float& cr, float& ci) {
    const float th = li * dt, em1 = expm1f(lr * dt), c1 = cosf(th), s1 = sinf(th), sh = sinf(0.5f * th);
    const float nr = em1 * c1 - 2.f * sh * sh, ni = (1.f + em1) * s1, den = lr * lr + li * li;
    cr = (nr * lr + ni * li) / den; ci = (ni * lr - nr * li) / den;
}

__device__ __forceinline__ void s5_tables(CPP p, int l, LAS unsigned char* lds) {
    LAS float* abr = (LAS float*)lds;
    LAS float* abi = abr + 1024;
    LAS float* cr = abi + 1024;
    LAS float* ci = cr + 16 * 65;
    float* KN = (float*)(p->ws + WS_KN);
    const int tid = otid();
    for (int it = obid(); it < 1024; it += ogrid()) {
        const int g = it >> 6, n = it & 63;
        __syncthreads();
        for (int e = tid; e < 1024; e += 512) { const int pp = e >> 4, c = e & 15; const int gp = (l * 16 + g) * 64 + pp;
            const float lr = p->in[5][gp], li = p->in[6][gp], dt = expf(p->in[7][l * 16 + g]);
            float ar, ai2; s5_abar_pow(lr, li, dt, n, ar, ai2);
            float qr, qi; s5_coef(lr, li, dt, qr, qi);
            const float br = p->in[8][(size_t)gp * 16 + c], bi = p->in[9][(size_t)gp * 16 + c];
            const float bbr = qr * br - qi * bi, bbi = qr * bi + qi * br;
            abr[e] = ar * bbr - ai2 * bbi; abi[e] = ar * bbi + ai2 * bbr; }
        for (int e = tid; e < 1024; e += 512) { const int i = e >> 6, pp = e & 63; const size_t gi = ((size_t)(l * 16 + g) * 16 + i) * 64 + pp;
            cr[i * 65 + pp] = p->in[10][gi]; ci[i * 65 + pp] = p->in[11][gi]; }
        __syncthreads();
        if (tid < 256) { const int i = tid >> 4, c = tid & 15; float s = 0.f;
#pragma unroll 8
            for (int pp = 0; pp < 64; ++pp) s += cr[i * 65 + pp] * abr[pp * 16 + c] - ci[i * 65 + pp] * abi[pp * 16 + c];
            KN[((size_t)(g * 64 + n) * 16 + i) * 16 + c] = s; }
    }
}

__device__ __forceinline__ void convert_weights(CPP p, int l, LAS unsigned char* lds) {
    const int tid = otid(), lane = tid & 63, wave = tid >> 6;
    LAS float* scr = (LAS float*)(lds + wave * 16384);
    const int gw = obid() * 8 + wave, NGW = ogrid() * 8;
    unsigned char* ws = p->ws;
    constexpr int J0 = 1408, J1 = J0 + 2048, J2 = J1 + 512, J3 = J2 + 512, J4 = J3 + 2816, J5 = J4 + 1408, J6 = J5 + 32;
    for (int it = gw; it < J6; it += NGW) {
        if (it < J0) { const int r = it; transpose_item(p->in[1] + (size_t)l * 1024 * 2576, 1024, 2576, (bf16_t*)(ws + WS_WIN), 0, 0, scr, r / 88, r % 88, lane); }
        else if (it < J1) { const int r = it - J0, b = r >> 9, q = r & 511; transpose_item(p->in[15] + ((size_t)l * 4 + b) * 1024 * 1024, 1024, 1024, (bf16_t*)(ws + WS_WG), 1, b, scr, q >> 5, q & 31, lane); }
        else if (it < J2) { const int r = it - J1, b = r >> 7, q = r & 127; transpose_item(p->in[17] + ((size_t)l * 4 + b) * 256 * 1024, 256, 1024, (bf16_t*)(ws + WS_WB) + (size_t)b * 1024 * 256, 0, 0, scr, q >> 5, q & 31, lane); }
        else if (it < J3) { const int q = it - J2; transpose_item(p->in[18] + (size_t)l * 1024 * 1024, 1024, 1024, (bf16_t*)(ws + WS_WO), 0, 0, scr, q >> 5, q & 31, lane); }
        else if (it < J4) { const int r = it - J3, wch = r / 1408, q = r % 1408; transpose_item(p->in[wch ? 22 : 21] + (size_t)l * 1024 * 2816, 1024, 2816, (bf16_t*)(ws + WS_WFF), 2, wch, scr, q / 88, q % 88, lane); }
        else if (it < J5) { const int q = it - J4; transpose_item(p->in[23] + (size_t)l * 2816 * 1024, 2816, 1024, (bf16_t*)(ws + WS_WD), 0, 0, scr, q >> 5, q & 31, lane); }
        else { const int q = it - J5; transpose_item(p->in[13] + (size_t)l * 256 * 256, 256, 256, (bf16_t*)(ws + WS_WGLU), 0, 0, scr, q >> 3, q & 7, lane); }
    }
    const int gt = obid() * 512 + tid, NT = ogrid() * 512;
    bf16_t* WE = (bf16_t*)(ws + WS_WE);
    for (int e = gt; e < 65536; e += NT) { const int s = e & 63, pp = (e >> 6) & 63, g = e >> 12; const int gp = (l * 16 + g) * 64 + pp;
        const float lr = p->in[5][gp], li = p->in[6][gp], dt = expf(p->in[7][l * 16 + g]);
        float ar, ai2; s5_abar_pow(lr, li, dt, 63 - s, ar, ai2);
        float qr, qi; s5_coef(lr, li, dt, qr, qi);
        float wr_[16], wi_[16];
#pragma unroll
        for (int c = 0; c < 16; ++c) { const float br = p->in[8][(size_t)gp * 16 + c], bi = p->in[9][(size_t)gp * 16 + c];
            const float bbr = qr * br - qi * bi, bbi = qr * bi + qi * br; wr_[c] = ar * bbr - ai2 * bbi; wi_[c] = ar * bbi + ai2 * bbr; }
        bf16_t* dr = WE + ((size_t)(g * 256 + pp)) * 1024 + s * 16; bf16_t* di = WE + ((size_t)(g * 256 + 64 + pp)) * 1024 + s * 16;
        *(u32x4*)dr = pack8(wr_); *(u32x4*)(dr + 8) = pack8(wr_ + 8); *(u32x4*)di = pack8(wi_); *(u32x4*)(di + 8) = pack8(wi_ + 8); }
    for (int e = gt; e < 16 * 128 * 128; e += NT) { const int c8 = e & 127, n = (e >> 7) & 127, g = e >> 14;
        *(u32x4*)(WE + ((size_t)(g * 256 + 128 + n)) * 1024 + c8 * 8) = (u32x4){0u, 0u, 0u, 0u}; }
    bf16_t* WT = (bf16_t*)(ws + WS_WT); const float* KN = (const float*)(ws + WS_KN);
    for (int e = gt; e < 16 * 1024 * 64; e += NT) { const int s = e & 63, row = (e >> 6) & 1023, g = e >> 16; const int j = row >> 4, i = row & 15;
        u32x4 w0 = (u32x4){0u, 0u, 0u, 0u}, w1 = w0;
        if (s <= j) { const float* k = KN + ((size_t)(g * 64 + (j - s)) * 16 + i) * 16; float v[16];
#pragma unroll
            for (int c = 0; c < 16; c += 4) { const f32x4 t = *(const f32x4*)(k + c); v[c] = t[0]; v[c + 1] = t[1]; v[c + 2] = t[2]; v[c + 3] = t[3]; }
            w0 = pack8(v); w1 = pack8(v + 8); }
        bf16_t* d = WT + ((size_t)(g * 1024 + row)) * S5K + s * 16; *(u32x4*)d = w0; *(u32x4*)(d + 8) = w1; }
    for (int e = gt; e < 16 * 1024 * 64; e += NT) { const int pp = e & 63, row = (e >> 6) & 1023, g = e >> 16; const int j = row >> 4, i = row & 15; const int gp = (l * 16 + g) * 64 + pp;
        const float lr = p->in[5][gp], li = p->in[6][gp], dt = expf(p->in[7][l * 16 + g]);
        float ar, ai2; s5_abar_pow(lr, li, dt, j + 1, ar, ai2);
        const size_t gi = ((size_t)(l * 16 + g) * 16 + i) * 64 + pp; const float c_r = p->in[10][gi], c_i = p->in[11][gi];
        bf16_t* d = WT + ((size_t)(g * 1024 + row)) * S5K + 1024 + pp;
        d[0] = (bf16_t)f2bf(c_r * ar - c_i * ai2); d[64] = (bf16_t)f2bf(-(c_r * ai2 + c_i * ar)); }
}

__device__ __forceinline__ void ln_pass(bf16_t* xb, float* fout, const float* gam, const float* bet) {
    const int lane = otid() & 63, gw = obid() * 8 + (otid() >> 6), NGW = ogrid() * 8;
    f32x4 gv[4], bv[4];
#pragma unroll
    for (int j = 0; j < 2; ++j) { gv[2 * j] = *(const f32x4*)(gam + 512 * j + lane * 8); gv[2 * j + 1] = *(const f32x4*)(gam + 512 * j + lane * 8 + 4);
        bv[2 * j] = *(const f32x4*)(bet + 512 * j + lane * 8); bv[2 * j + 1] = *(const f32x4*)(bet + 512 * j + lane * 8 + 4); }
    for (int m0 = gw * 2; m0 < M; m0 += NGW * 2) {
        u32x4 w[2][2];
#pragma unroll
        for (int rr = 0; rr < 2; ++rr)
#pragma unroll
            for (int j = 0; j < 2; ++j) w[rr][j] = *(const u32x4*)(xb + (size_t)(m0 + rr) * DM + 512 * j + lane * 8);
#pragma unroll
        for (int rr = 0; rr < 2; ++rr) {
            float v[16]; unpack8(w[rr][0], v); unpack8(w[rr][1], v + 8);
            float s = 0.f;
#pragma unroll
            for (int e = 0; e < 16; ++e) s += v[e];
            const float mean = wave_sum(s) * (1.f / DM); float s2 = 0.f;
#pragma unroll
            for (int e = 0; e < 16; ++e) { v[e] -= mean; s2 += v[e] * v[e]; }
            const float rstd = 1.f / sqrtf(wave_sum(s2) * (1.f / DM) + LN_EPS);
#pragma unroll
            for (int j = 0; j < 2; ++j) {
#pragma unroll
                for (int q = 0; q < 2; ++q)
#pragma unroll
                    for (int e = 0; e < 4; ++e) v[8 * j + 4 * q + e] = v[8 * j + 4 * q + e] * rstd * gv[2 * j + q][e] + bv[2 * j + q][e];
                *(u32x4*)(xb + (size_t)(m0 + rr) * DM + 512 * j + lane * 8) = pack8(v + 8 * j);
                if (fout) { *(f32x4*)(fout + (size_t)(m0 + rr) * DM + 512 * j + lane * 8) = (f32x4){v[8 * j], v[8 * j + 1], v[8 * j + 2], v[8 * j + 3]};
                    *(f32x4*)(fout + (size_t)(m0 + rr) * DM + 512 * j + lane * 8 + 4) = (f32x4){v[8 * j + 4], v[8 * j + 5], v[8 * j + 6], v[8 * j + 7]}; } }
        }
    }
}

__device__ __forceinline__ void load_tile64(const bf16_t* src, int pitch, LAS float* dst, int dpitch, float scale, int tid) {
    const int idx = tid * 8, r = idx >> 6, c = idx & 63;
    const u32x4 w = *(const u32x4*)(src + (size_t)r * pitch + c); float f[8]; unpack8(w, f);
#pragma unroll
    for (int e = 0; e < 8; ++e) dst[r * dpitch + c + e] = f[e] * scale;
}

__device__ __forceinline__ void attn_items(CPP p, int l, LAS unsigned char* lds) {
    LAS float* Qs = (LAS float*)lds; LAS float* Ks = Qs + 64 * 68; LAS float* Vs = Ks + 64 * 68; LAS float* Ps = Vs + 64 * 68; LAS float* bs = Ps + 64 * 65;
    const bf16_t* H = (const bf16_t*)(p->ws + WS_E); bf16_t* O = (bf16_t*)(p->ws + WS_O);
    const int tid = otid(), row = tid >> 3, sub = tid & 7;
    for (int it = obid(); it < 4096; it += ogrid()) {
        const int h = it & 3, bi = it >> 2, i = bi & 31, b = bi >> 5;
        const size_t t0 = (size_t)bi * 64;
        __syncthreads();
        load_tile64(H + t0 * NH + C_AQ + h * 64, NH, Qs, 68, 0.125f, tid);
        if (tid < 257) bs[tid] = p->in[4][(size_t)(l * 4 + h) * 257 + tid];
        __syncthreads();
        float q[64], o[8];
#pragma unroll
        for (int d = 0; d < 64; d += 4) { const f32x4 t = *(const LAS f32x4*)(Qs + row * 68 + d); q[d] = t[0]; q[d + 1] = t[1]; q[d + 2] = t[2]; q[d + 3] = t[3]; }
#pragma unroll
        for (int e = 0; e < 8; ++e) o[e] = 0.f;
        float mx = -1e30f, ls = 0.f;
        const int kc0 = i > 8 ? i - 8 : 0;
        for (int kc = kc0; kc <= i; ++kc) {
            __syncthreads();
            const size_t tk = ((size_t)b * 32 + kc) * 64;
            load_tile64(H + tk * NH + C_AK + h * 64, NH, Ks, 68, 1.f, tid);
            load_tile64(H + tk * NH + C_AV + h * 64, NH, Vs, 68, 1.f, tid);
            __syncthreads();
            float s[8]; float cm = -1e30f;
#pragma unroll
            for (int jj = 0; jj < 8; ++jj) { const int key = sub + 8 * jj; float a = 0.f;
#pragma unroll
                for (int d = 0; d < 64; d += 4) { const f32x4 t = *(const LAS f32x4*)(Ks + key * 68 + d); a += q[d] * t[0] + q[d + 1] * t[1] + q[d + 2] * t[2] + q[d + 3] * t[3]; }
                int diff = (i - kc) * 64 + row - key; diff = diff > 128 ? 128 : diff;
                a += bs[diff + 128]; s[jj] = a; cm = fmaxf(cm, a); }
            cm = fmaxf(cm, __shfl_xor(cm, 1)); cm = fmaxf(cm, __shfl_xor(cm, 2)); cm = fmaxf(cm, __shfl_xor(cm, 4));
            const float mn = fmaxf(mx, cm), sc = __expf(mx - mn); mx = mn;
            float ps = 0.f;
#pragma unroll
            for (int jj = 0; jj < 8; ++jj) { const float pr = __expf(s[jj] - mn); ps += pr; Ps[row * 65 + sub + 8 * jj] = pr; }
            ps += __shfl_xor(ps, 1); ps += __shfl_xor(ps, 2); ps += __shfl_xor(ps, 4);
            ls = ls * sc + ps;
#pragma unroll
            for (int e = 0; e < 8; ++e) o[e] *= sc;
            asm volatile("s_waitcnt lgkmcnt(0)" ::: "memory");
#pragma unroll 8
            for (int key = 0; key < 64; ++key) { const float pr = Ps[row * 65 + key];
                const f32x4 v0 = *(const LAS f32x4*)(Vs + key * 68 + sub * 8), v1 = *(const LAS f32x4*)(Vs + key * 68 + sub * 8 + 4);
                o[0] += pr * v0[0]; o[1] += pr * v0[1]; o[2] += pr * v0[2]; o[3] += pr * v0[3]; o[4] += pr * v1[0]; o[5] += pr * v1[1]; o[6] += pr * v1[2]; o[7] += pr * v1[3]; }
        }
        const float inv = 1.f / ls;
#pragma unroll
        for (int e = 0; e < 8; ++e) o[e] *= inv;
        *(u32x4*)(O + (t0 + row) * DM + 256 + h * 64 + sub * 8) = pack8(o);
    }
}

typedef float f32x16 __attribute__((ext_vector_type(16)));
typedef short s16x4 __attribute__((ext_vector_type(4)));
__device__ __forceinline__ s16x4 lds_tr16(LAS const unsigned char* ptr) { return __builtin_bit_cast(s16x4, __builtin_amdgcn_ds_read_tr16_b64_v4i16((LAS s16x4*)ptr)); }
__device__ __forceinline__ bf16x8 scale_frag(u32x4 w, float sc) { float f[8]; unpack8(w, f);
    u32x4 o; o.x = pk2(f[0] * sc, f[1] * sc); o.y = pk2(f[2] * sc, f[3] * sc); o.z = pk2(f[4] * sc, f[5] * sc); o.w = pk2(f[6] * sc, f[7] * sc); return __builtin_bit_cast(bf16x8, o); }
__device__ __forceinline__ void attn_mfma(CPP p, int l, LAS unsigned char* lds) {
    const int tid = otid(), lane = tid & 63, wid = __builtin_amdgcn_readfirstlane(tid >> 6), r32 = lane & 31, hi = lane >> 5;
    const int h = wid >> 1, qh = wid & 1;
    LAS unsigned char* Vl = lds + wid * 17536;
    LAS unsigned char* stg = Vl;
    LAS float* bs = (LAS float*)(Vl + 16384);
    const bf16_t* H = (const bf16_t*)(p->ws + WS_E); bf16_t* O = (bf16_t*)(p->ws + WS_O);
    __syncthreads();
    for (int e = lane; e < 257; e += 64) bs[e] = p->in[4][(size_t)(l * 4 + h) * 257 + e];
    const float bfar = p->in[4][(size_t)(l * 4 + h) * 257 + 256];
#define ATT_VDMA(tk, buf) do { _Pragma("unroll") for (int c = 0; c < 8; ++c) \
        __builtin_amdgcn_global_load_lds((const unsigned*)(H + ((tk) + c * 8 + (lane >> 3)) * NH + C_AV + h * 64 + (lane & 7) * 8), (LAS unsigned*)(Vl + (buf) * 8192 + c * 1024), 16, 0, 0); } while (0)
    for (int it = obid(); it < 1024; it += ogrid()) {
        const int i = it & 31; const size_t t0 = (size_t)it * 64;
        bf16x8 qf[4];
#pragma unroll
        for (int t = 0; t < 4; ++t) qf[t] = scale_frag(*(const u32x4*)(H + (t0 + qh * 32 + r32) * NH + C_AQ + h * 64 + 16 * t + 8 * hi), 0.125f);
        const int kc0 = i > 8 ? i - 8 : 0;
        u32x4 kr[8], kn[8];
        asm volatile("s_waitcnt lgkmcnt(0)" ::: "memory");
        { const size_t tk = t0 - (size_t)(i - kc0) * 64;
#pragma unroll
            for (int t = 0; t < 4; ++t) { kn[t] = *(const u32x4*)(H + (tk + r32) * NH + C_AK + h * 64 + 16 * t + 8 * hi); kn[4 + t] = *(const u32x4*)(H + (tk + 32 + r32) * NH + C_AK + h * 64 + 16 * t + 8 * hi); }
            ATT_VDMA(tk, 0); }
        f32x16 o0, o1;
#pragma unroll
        for (int v = 0; v < 16; ++v) { o0[v] = 0.f; o1[v] = 0.f; }
        float mx = -1e30f, ls = 0.f;
        int cb = 0;
        for (int kc = kc0; kc <= i; ++kc) {
            const bool more = kc < i;
            asm volatile("s_waitcnt vmcnt(0)" ::: "memory");
#pragma unroll
            for (int c = 0; c < 8; ++c) kr[c] = kn[c];
            if (more) { const size_t tk = t0 - (size_t)(i - kc - 1) * 64;
#pragma unroll
                for (int t = 0; t < 4; ++t) { kn[t] = *(const u32x4*)(H + (tk + r32) * NH + C_AK + h * 64 + 16 * t + 8 * hi); kn[4 + t] = *(const u32x4*)(H + (tk + 32 + r32) * NH + C_AK + h * 64 + 16 * t + 8 * hi); }
                ATT_VDMA(tk, cb ^ 1); }
            f32x16 p0, p1;
#pragma unroll
            for (int v = 0; v < 16; ++v) { p0[v] = 0.f; p1[v] = 0.f; }
#pragma unroll
            for (int t = 0; t < 4; ++t) { p0 = __builtin_amdgcn_mfma_f32_32x32x16_f16(__builtin_bit_cast(half8_t, kr[t]), __builtin_bit_cast(half8_t, qf[t]), p0, 0, 0, 0);
                p1 = __builtin_amdgcn_mfma_f32_32x32x16_f16(__builtin_bit_cast(half8_t, kr[4 + t]), __builtin_bit_cast(half8_t, qf[t]), p1, 0, 0, 0); }
            const int dl = i - kc;
            if (dl >= 3) {
#pragma unroll
                for (int v = 0; v < 16; ++v) { p0[v] += bfar; p1[v] += bfar; }
            } else { const int base = dl * 64 + qh * 32 + r32 - 4 * hi + 128;
#pragma unroll
                for (int v = 0; v < 16; ++v) { const int kv = (v & 3) + 8 * (v >> 2); int d0 = base - kv, d1 = base - kv - 32; d0 = d0 > 256 ? 256 : d0; d1 = d1 > 256 ? 256 : d1;
                    p0[v] += bs[d0]; p1[v] += bs[d1]; } }
            float cm = fmaxf(p0[0], p1[0]);
#pragma unroll
            for (int v = 1; v < 16; ++v) cm = fmaxf(cm, fmaxf(p0[v], p1[v]));
            cm = fmaxf(cm, __shfl_xor(cm, 32));
            const float mn = fmaxf(mx, cm), al = __expf(mx - mn); mx = mn;
            float ps = 0.f;
#pragma unroll
            for (int v = 0; v < 16; ++v) { p0[v] = __expf(p0[v] - mn); p1[v] = __expf(p1[v] - mn); ps += p0[v] + p1[v]; }
            ls = ls * al + ps;
#pragma unroll
            for (int v = 0; v < 16; ++v) { o0[v] *= al; o1[v] *= al; }
            bf16x8 pb[4];
            { u32x4 w; w.x = cvt_pk_bf16(p0[0], p0[1]); w.y = cvt_pk_bf16(p0[2], p0[3]); w.z = cvt_pk_bf16(p0[4], p0[5]); w.w = cvt_pk_bf16(p0[6], p0[7]); pb[0] = __builtin_bit_cast(bf16x8, w);
              w.x = cvt_pk_bf16(p0[8], p0[9]); w.y = cvt_pk_bf16(p0[10], p0[11]); w.z = cvt_pk_bf16(p0[12], p0[13]); w.w = cvt_pk_bf16(p0[14], p0[15]); pb[1] = __builtin_bit_cast(bf16x8, w);
              w.x = cvt_pk_bf16(p1[0], p1[1]); w.y = cvt_pk_bf16(p1[2], p1[3]); w.z = cvt_pk_bf16(p1[4], p1[5]); w.w = cvt_pk_bf16(p1[6], p1[7]); pb[2] = __builtin_bit_cast(bf16x8, w);
              w.x = cvt_pk_bf16(p1[8], p1[9]); w.y = cvt_pk_bf16(p1[10], p1[11]); w.z = cvt_pk_bf16(p1[12], p1[13]); w.w = cvt_pk_bf16(p1[14], p1[15]); pb[3] = __builtin_bit_cast(bf16x8, w); }
            const LAS unsigned char* vb = Vl + cb * 8192 + (4 * hi + ((lane & 15) >> 2)) * 128 + ((lane >> 4) & 1) * 32 + (lane & 3) * 8;
#pragma unroll
            for (int ks = 0; ks < 4; ++ks) {
#pragma unroll
                for (int dh = 0; dh < 2; ++dh) { const s16x4 lo = lds_tr16(vb + ks * 2048 + dh * 64), hh = lds_tr16(vb + ks * 2048 + 1024 + dh * 64);
                    const bf16x8 va = (bf16x8){lo[0], lo[1], lo[2], lo[3], hh[0], hh[1], hh[2], hh[3]};
                    if (dh == 0) o0 = __builtin_amdgcn_mfma_f32_32x32x16_f16(__builtin_bit_cast(half8_t, va), __builtin_bit_cast(half8_t, pb[ks]), o0, 0, 0, 0); else o1 = __builtin_amdgcn_mfma_f32_32x32x16_f16(__builtin_bit_cast(half8_t, va), __builtin_bit_cast(half8_t, pb[ks]), o1, 0, 0, 0); } }
            cb ^= 1;
        }
        ls += __shfl_xor(ls, 32);
        const float inv = 1.f / ls;
        asm volatile("s_waitcnt lgkmcnt(0)" ::: "memory");
#pragma unroll
        for (int v = 0; v < 16; ++v) { const int d = (v & 3) + 8 * (v >> 2) + 4 * hi;
            *(LAS bf16_t*)(stg + r32 * 144 + d * 2) = (bf16_t)f2bf(o0[v] * inv); *(LAS bf16_t*)(stg + r32 * 144 + (32 + d) * 2) = (bf16_t)f2bf(o1[v] * inv); }
        asm volatile("s_waitcnt lgkmcnt(0)" ::: "memory");
#pragma unroll
        for (int c = 0; c < 4; ++c) { const int row = c * 8 + (lane >> 3), ch = lane & 7; const u32x4 w = *(const LAS u32x4*)(stg + row * 144 + ch * 16);
            *(u32x4*)(O + (t0 + qh * 32 + row) * DM + 256 + h * 64 + ch * 8) = w; }
    }
#undef ATT_VDMA
}

__device__ __forceinline__ f32x16 mma32(bf16x8 a, bf16x8 b, f32x16 c) { return __builtin_amdgcn_mfma_f32_32x32x16_f16(__builtin_bit_cast(half8_t, a), __builtin_bit_cast(half8_t, b), c, 0, 0, 0); }
__device__ __forceinline__ bf16x8 trfrag(LAS const unsigned char* a0, LAS const unsigned char* a1) { const s16x4 lo = lds_tr16(a0), hh = lds_tr16(a1); return (bf16x8){lo[0], lo[1], lo[2], lo[3], hh[0], hh[1], hh[2], hh[3]}; }
__device__ __forceinline__ f32x16 zero16() { f32x16 z;
#pragma unroll
    for (int v = 0; v < 16; ++v) z[v] = 0.f;
    return z; }
__device__ __forceinline__ void rot_frags(const bf16_t* xrow, const float* rrow, int hi, float sc, bf16x8& f0, bf16x8& f1) {
    const u32x4 w1 = *(const u32x4*)(xrow + 8 * hi), w2 = *(const u32x4*)(xrow + 16 + 8 * hi); float x1[8], x2[8]; unpack8(w1, x1); unpack8(w2, x2);
    const f32x4 c0 = *(const f32x4*)(rrow + 8 * hi), c1 = *(const f32x4*)(rrow + 8 * hi + 4), s0 = *(const f32x4*)(rrow + 16 + 8 * hi), s1 = *(const f32x4*)(rrow + 16 + 8 * hi + 4);
    float a[8], b[8];
#pragma unroll
    for (int e = 0; e < 8; ++e) { const float c = e < 4 ? c0[e & 3] : c1[e & 3], s = e < 4 ? s0[e & 3] : s1[e & 3]; a[e] = (x1[e] * c - x2[e] * s) * sc; b[e] = (x1[e] * s + x2[e] * c) * sc; }
    f0 = __builtin_bit_cast(bf16x8, pack8(a)); f1 = __builtin_bit_cast(bf16x8, pack8(b));
}
__device__ __forceinline__ float ret_logg(int h);

__device__ __forceinline__ void upd_mfma(CPP p, int l, LAS unsigned char* lds) {
    const int tid = otid(), lane = tid & 63, wid = __builtin_amdgcn_readfirstlane(tid >> 6), r32 = lane & 31, hi = lane >> 5, i16 = lane & 15;
    LAS unsigned char* kz = lds + wid * 17536;
    LAS unsigned char* vt = kz + 4096;
    LAS unsigned char* gas = kz + 12288;
    const bf16_t* H = (const bf16_t*)(p->ws + WS_E); const float* rot = (const float*)(p->ws + WS_ROT);
    float* RU = (float*)(p->ws + WS_RU); float* GU = (float*)(p->ws + WS_GU); float* GL = (float*)(p->ws + WS_GL);
    const int gw = obid() * 8 + wid, NGW = ogrid() * 8;
    __syncthreads();
    for (int it = gw; it < 8192; it += NGW) {
        const int gla = it >> 12, h = it & 3, bi = (it >> 2) & 1023, i = bi & 31; const size_t t0 = (size_t)bi * 64;
        asm volatile("s_waitcnt lgkmcnt(0)" ::: "memory");
        { const int vcol = (gla ? C_GV : C_RV) + h * 64;
#pragma unroll
            for (int c = 0; c < 8; ++c) __builtin_amdgcn_global_load_lds((const unsigned*)(H + (t0 + c * 8 + (lane >> 3)) * NH + vcol + (lane & 7) * 8), (LAS unsigned*)(vt + c * 1024), 16, 0, 0); }
        if (!gla) {
            const bf16_t* xr = H + (t0 + lane) * NH + C_RK + h * 32; const float* rr = rot + (size_t)(i * 64 + lane) * 32;
            const float sc = 0.17677669529663689f * __expf(ret_logg(h) * (float)(63 - lane));
            float x[32], cs[32], o[32];
#pragma unroll
            for (int c = 0; c < 4; ++c) unpack8(*(const u32x4*)(xr + 8 * c), x + 8 * c);
#pragma unroll
            for (int c = 0; c < 8; ++c) { const f32x4 t = *(const f32x4*)(rr + 4 * c); cs[4 * c] = t[0]; cs[4 * c + 1] = t[1]; cs[4 * c + 2] = t[2]; cs[4 * c + 3] = t[3]; }
#pragma unroll
            for (int f = 0; f < 16; ++f) { o[f] = (x[f] * cs[f] - x[f + 16] * cs[16 + f]) * sc; o[f + 16] = (x[f] * cs[16 + f] + x[f + 16] * cs[f]) * sc; }
#pragma unroll
            for (int c = 0; c < 4; ++c) *(LAS u32x4*)(kz + lane * 64 + c * 16) = pack8(o + 8 * c);
        } else {
#pragma unroll
            for (int c = 0; c < 4; ++c) __builtin_amdgcn_global_load_lds((const unsigned*)(H + (t0 + 16 * c + (lane >> 2)) * NH + C_GK + h * 32 + (lane & 3) * 8), (LAS unsigned*)(kz + c * 1024), 16, 0, 0);
#pragma unroll
            for (int c = 0; c < 2; ++c) *(LAS u32x4*)(gas + lane * 32 + c * 16) = *(const u32x4*)(H + (t0 + lane) * NH + C_GA + 8 * c);
            float wa[16];
#pragma unroll
            for (int r = 0; r < 16; ++r) wa[r] = p->in[2][(size_t)(l * 16 + r) * 128 + h * 32 + r32];
            const float ba = p->in[3][l * 128 + h * 32 + r32];
            asm volatile("s_waitcnt vmcnt(0) lgkmcnt(0)" ::: "memory");
            float cum[32]; float run = 0.f;
#pragma unroll
            for (int jj = 0; jj < 32; ++jj) { const int j = hi * 32 + jj; float g[16]; unpack8(*(const LAS u32x4*)(gas + j * 32), g); unpack8(*(const LAS u32x4*)(gas + j * 32 + 16), g + 8);
                float z = ba;
#pragma unroll
                for (int r = 0; r < 16; ++r) z += g[r] * wa[r];
                run += (fminf(z, 0.f) - log1pf(expf(-fabsf(z)))) * 0.0625f; cum[jj] = run; }
            const float tot0 = __shfl(run, r32), tot1 = __shfl(run, 32 + r32), last = tot0 + tot1, off = hi ? tot0 : 0.f;
#pragma unroll
            for (int jj = 0; jj < 32; ++jj) { const int j = hi * 32 + jj; LAS bf16_t* kp = (LAS bf16_t*)(kz + j * 64 + r32 * 2);
                *kp = (bf16_t)f2bf(bf2f(*kp) * __expf(last - (cum[jj] + off))); }
            if (hi == 0) GL[(size_t)(bi * 4 + h) * 32 + r32] = last;
        }
        asm volatile("s_waitcnt vmcnt(0) lgkmcnt(0)" ::: "memory");
        f32x16 a0 = zero16(), a1 = zero16();
        const LAS unsigned char* ka = kz + (8 * hi + (i16 >> 2)) * 64 + ((lane >> 4) & 1) * 32 + (i16 & 3) * 8;
        const LAS unsigned char* va = vt + (8 * hi + (i16 >> 2)) * 128 + ((lane >> 4) & 1) * 32 + (i16 & 3) * 8;
#pragma unroll
        for (int s = 0; s < 4; ++s) { const bf16x8 A = trfrag(ka + s * 1024, ka + s * 1024 + 256);
            const bf16x8 B0 = trfrag(va + s * 2048, va + s * 2048 + 512), B1 = trfrag(va + s * 2048 + 64, va + s * 2048 + 512 + 64);
            a0 = mma32(A, B0, a0); a1 = mma32(A, B1, a1); }
        float* dst = (gla ? GU : RU) + (size_t)(bi * 4 + h) * 2048;
#pragma unroll
        for (int v = 0; v < 16; ++v) { const int dk = (v & 3) + 8 * (v >> 2) + 4 * hi; dst[dk * 64 + r32] = a0[v]; dst[dk * 64 + 32 + r32] = a1[v]; }
    }
}

__device__ __forceinline__ void out_mfma(CPP p, int l, LAS unsigned char* lds) {
    const int tid = otid(), lane = tid & 63, wid = __builtin_amdgcn_readfirstlane(tid >> 6), r32 = lane & 31, hi = lane >> 5, i16 = lane & 15;
    const int h = wid >> 1, nh = wid & 1;
    LAS unsigned char* vt = lds + wid * 17536;
    LAS unsigned char* Rt = vt + 8192;
    LAS unsigned char* stg = vt;
    const bf16_t* H = (const bf16_t*)(p->ws + WS_E); const float* rot = (const float*)(p->ws + WS_ROT); bf16_t* O = (bf16_t*)(p->ws + WS_O);
    const float* RU = (const float*)(p->ws + WS_RU); const float* GU = (const float*)(p->ws + WS_GU);
    __syncthreads();
    for (int it = obid(); it < 2048; it += ogrid()) {
        const int gla = it >> 10, bi = it & 1023, i = bi & 31; const size_t t0 = (size_t)bi * 64; const int n = nh * 32 + r32;
        asm volatile("s_waitcnt lgkmcnt(0)" ::: "memory");
        { const float* src = (gla ? GU : RU) + (size_t)(bi * 4 + h) * 2048;
#pragma unroll
            for (int c = 0; c < 8; ++c) { const int idx = c * 256 + lane * 4; const f32x4 t = *(const f32x4*)(src + idx); u32x2 w; w.x = pk2(t[0], t[1]); w.y = pk2(t[2], t[3]);
                *(LAS u32x2*)(Rt + (idx >> 6) * 128 + (idx & 63) * 2) = w; } }
        f32x16 o0 = zero16(), o1 = zero16();
        const LAS unsigned char* ra = Rt + (8 * hi + (i16 >> 2)) * 128 + ((lane >> 4) & 1) * 32 + (i16 & 3) * 8;
        if (!gla) {
#pragma unroll
            for (int c = 0; c < 8; ++c) __builtin_amdgcn_global_load_lds((const unsigned*)(H + (t0 + c * 8 + (lane >> 3)) * NH + C_RV + h * 64 + (lane & 7) * 8), (LAS unsigned*)(vt + c * 1024), 16, 0, 0);
            const float lg = ret_logg(h);
            bf16x8 qf[2], kf0[2], kf1[2];
            rot_frags(H + (t0 + n) * NH + C_RQ + h * 32, rot + (size_t)(i * 64 + n) * 32, hi, 1.f, qf[0], qf[1]);
            rot_frags(H + (t0 + r32) * NH + C_RK + h * 32, rot + (size_t)(i * 64 + r32) * 32, hi, 0.17677669529663689f, kf0[0], kf0[1]);
            rot_frags(H + (t0 + 32 + r32) * NH + C_RK + h * 32, rot + (size_t)(i * 64 + 32 + r32) * 32, hi, 0.17677669529663689f, kf1[0], kf1[1]);
            f32x16 p0 = zero16(), p1 = zero16();
            p0 = mma32(kf0[0], qf[0], p0); p0 = mma32(kf0[1], qf[1], p0); p1 = mma32(kf1[0], qf[0], p1); p1 = mma32(kf1[1], qf[1], p1);
#pragma unroll
            for (int v = 0; v < 16; ++v) { const int m = (v & 3) + 8 * (v >> 2) + 4 * hi; const int d0 = n - m, d1 = n - m - 32;
                p0[v] *= __expf(lg * (float)(d0 < 0 ? -d0 : d0)); p1[v] *= __expf(lg * (float)(d1 < 0 ? -d1 : d1)); }
            bf16x8 pb[4];
            { u32x4 w; w.x = pk2(p0[0], p0[1]); w.y = pk2(p0[2], p0[3]); w.z = pk2(p0[4], p0[5]); w.w = pk2(p0[6], p0[7]); pb[0] = __builtin_bit_cast(bf16x8, w);
              w.x = pk2(p0[8], p0[9]); w.y = pk2(p0[10], p0[11]); w.z = pk2(p0[12], p0[13]); w.w = pk2(p0[14], p0[15]); pb[1] = __builtin_bit_cast(bf16x8, w);
              w.x = pk2(p1[0], p1[1]); w.y = pk2(p1[2], p1[3]); w.z = pk2(p1[4], p1[5]); w.w = pk2(p1[6], p1[7]); pb[2] = __builtin_bit_cast(bf16x8, w);
              w.x = pk2(p1[8], p1[9]); w.y = pk2(p1[10], p1[11]); w.z = pk2(p1[12], p1[13]); w.w = pk2(p1[14], p1[15]); pb[3] = __builtin_bit_cast(bf16x8, w); }
            asm volatile("s_waitcnt vmcnt(0) lgkmcnt(0)" ::: "memory");
            const LAS unsigned char* vb = vt + (4 * hi + (i16 >> 2)) * 128 + ((lane >> 4) & 1) * 32 + (i16 & 3) * 8;
#pragma unroll
            for (int ks = 0; ks < 4; ++ks) { o0 = mma32(trfrag(vb + ks * 2048, vb + ks * 2048 + 1024), pb[ks], o0); o1 = mma32(trfrag(vb + ks * 2048 + 64, vb + ks * 2048 + 1024 + 64), pb[ks], o1); }
            const float xi = __expf(lg * (float)(n + 1));
#pragma unroll
            for (int s = 0; s < 2; ++s) { const bf16x8 qx = scale_frag(__builtin_bit_cast(u32x4, qf[s]), xi);
                o0 = mma32(trfrag(ra + s * 2048, ra + s * 2048 + 512), qx, o0); o1 = mma32(trfrag(ra + s * 2048 + 64, ra + s * 2048 + 512 + 64), qx, o1); }
        } else {
            bf16x8 qf[2];
#pragma unroll
            for (int s = 0; s < 2; ++s) qf[s] = scale_frag(*(const u32x4*)(H + (t0 + n) * NH + C_GQ + h * 32 + 16 * s + 8 * hi), 0.17677669529663689f);
            asm volatile("s_waitcnt lgkmcnt(0)" ::: "memory");
#pragma unroll
            for (int s = 0; s < 2; ++s) { o0 = mma32(trfrag(ra + s * 2048, ra + s * 2048 + 512), qf[s], o0); o1 = mma32(trfrag(ra + s * 2048 + 64, ra + s * 2048 + 512 + 64), qf[s], o1); }
        }
        float s = 0.f;
#pragma unroll
        for (int v = 0; v < 16; ++v) s += o0[v] + o1[v];
        s += __shfl_xor(s, 32);
        const float mean = s * (1.f / 64.f); float s2 = 0.f;
#pragma unroll
        for (int v = 0; v < 16; ++v) { o0[v] -= mean; o1[v] -= mean; s2 += o0[v] * o0[v] + o1[v] * o1[v]; }
        s2 += __shfl_xor(s2, 32);
        const float rs = 1.f / sqrtf(s2 * (1.f / 64.f) + LN_EPS);
        asm volatile("s_waitcnt lgkmcnt(0)" ::: "memory");
#pragma unroll
        for (int v = 0; v < 16; ++v) { const int d = (v & 3) + 8 * (v >> 2) + 4 * hi;
            *(LAS bf16_t*)(stg + r32 * 144 + d * 2) = (bf16_t)f2bf(o0[v] * rs); *(LAS bf16_t*)(stg + r32 * 144 + (32 + d) * 2) = (bf16_t)f2bf(o1[v] * rs); }
        asm volatile("s_waitcnt lgkmcnt(0)" ::: "memory");
#pragma unroll
        for (int c = 0; c < 4; ++c) { const int row = c * 8 + (lane >> 3), ch = lane & 7; float f[8], g[8]; unpack8(*(const LAS u32x4*)(stg + row * 144 + ch * 16), f);
            unpack8(*(const u32x4*)(H + (t0 + nh * 32 + row) * NH + (gla ? C_GR : C_RG) + h * 64 + ch * 8), g);
#pragma unroll
            for (int e = 0; e < 8; ++e) f[e] *= silu_f(g[e]);
            *(u32x4*)(O + (t0 + nh * 32 + row) * DM + (gla ? 512 : 0) + h * 64 + ch * 8) = pack8(f); }
    }
}

__device__ __forceinline__ void load_rot(const bf16_t* src, const float* rot, int i, LAS float* dst, float scale, float logz, int tid) {
#pragma unroll
    for (int q = 0; q < 2; ++q) { const int idx = tid + 512 * q, j = idx >> 4, f = idx & 15;
        const float x1 = bf2f(src[(size_t)j * NH + f]), x2 = bf2f(src[(size_t)j * NH + f + 16]);
        const int pos = i * 64 + j; const float c = rot[pos * 32 + f], s = rot[pos * 32 + 16 + f];
        const float sc = scale * __expf(logz * (float)(63 - j));
        dst[j * 33 + f] = (x1 * c - x2 * s) * sc; dst[j * 33 + f + 16] = (x1 * s + x2 * c) * sc; }
}
__device__ __forceinline__ float ret_logg(int h) { return log1pf(-exp2f(-5.f - (float)h)); }

__device__ __forceinline__ void upd_items(CPP p, int l, LAS unsigned char* lds) {
    LAS float* kt = (LAS float*)lds; LAS float* vv = kt + 64 * 33; LAS float* la = vv + 64 * 68; LAS float* gas = la + 64 * 33; LAS float* was = gas + 1024; LAS float* bas = was + 512;
    const bf16_t* H = (const bf16_t*)(p->ws + WS_E); const float* rot = (const float*)(p->ws + WS_ROT);
    float* RU = (float*)(p->ws + WS_RU); float* GU = (float*)(p->ws + WS_GU); float* GL = (float*)(p->ws + WS_GL);
    const int tid = otid();
    for (int it = obid(); it < 8192; it += ogrid()) {
        const int gla = it >> 12, h = it & 3, bi = (it >> 2) & 1023, i = bi & 31;
        const size_t t0 = (size_t)bi * 64;
        __syncthreads();
        if (!gla) {
            load_rot(H + t0 * NH + C_RK + h * 32, rot, i, kt, 0.17677669529663689f, ret_logg(h), tid);
            load_tile64(H + t0 * NH + C_RV + h * 64, NH, vv, 68, 1.f, tid);
            __syncthreads();
        } else {
            if (tid < 128) { const int j = tid >> 1, c = (tid & 1) * 8; const u32x4 w = *(const u32x4*)(H + (t0 + j) * NH + C_GA + c); float f[8]; unpack8(w, f);
#pragma unroll
                for (int e = 0; e < 8; ++e) gas[j * 16 + c + e] = f[e]; }
            { const int r = tid >> 5, dk = tid & 31; was[tid] = p->in[2][(size_t)(l * 16 + r) * 128 + h * 32 + dk]; }
            if (tid < 32) bas[tid] = p->in[3][l * 128 + h * 32 + tid];
            { const int idx = tid * 4, j = idx >> 5, c = idx & 31; const u32x2 w = *(const u32x2*)(H + (t0 + j) * NH + C_GK + h * 32 + c);
                kt[j * 33 + c] = bflo(w.x); kt[j * 33 + c + 1] = bfhi(w.x); kt[j * 33 + c + 2] = bflo(w.y); kt[j * 33 + c + 3] = bfhi(w.y); }
            load_tile64(H + t0 * NH + C_GV + h * 64, NH, vv, 68, 1.f, tid);
            __syncthreads();
#pragma unroll
            for (int q = 0; q < 4; ++q) { const int e = tid + 512 * q, j = e >> 5, dk = e & 31; float z = bas[dk];
#pragma unroll
                for (int r = 0; r < 16; ++r) z += gas[j * 16 + r] * was[r * 32 + dk];
                const float lsg = fminf(z, 0.f) - log1pf(expf(-fabsf(z)));
                la[j * 33 + dk] = lsg * 0.0625f; }
            __syncthreads();
            if (tid < 32) { float run = 0.f; for (int j = 0; j < 64; ++j) { run += la[j * 33 + tid]; la[j * 33 + tid] = run; } }
            __syncthreads();
#pragma unroll
            for (int q = 0; q < 4; ++q) { const int e = tid + 512 * q, j = e >> 5, dk = e & 31; kt[j * 33 + dk] *= __expf(la[63 * 33 + dk] - la[j * 33 + dk]); }
            if (tid < 32) GL[(size_t)(bi * 4 + h) * 32 + tid] = la[63 * 33 + tid];
            __syncthreads();
        }
        const int dk = tid >> 4, dv0 = (tid & 15) * 4; f32x4 a = (f32x4){0.f, 0.f, 0.f, 0.f};
#pragma unroll 8
        for (int j = 0; j < 64; ++j) { const float kk = kt[j * 33 + dk]; const f32x4 v4 = *(const LAS f32x4*)(vv + j * 68 + dv0); a += v4 * kk; }
        float* dst = (gla ? GU : RU) + (size_t)(bi * 4 + h) * 2048 + dk * 64 + dv0;
        *(f32x4*)dst = a;
    }
}

__device__ __forceinline__ void scan_items(CPP p, int l) {
    float* RU = (float*)(p->ws + WS_RU); float* GU = (float*)(p->ws + WS_GU); const float* GL = (const float*)(p->ws + WS_GL);
    const float* ES = (const float*)(p->ws + WS_ES); bf16_t* U2 = (bf16_t*)(p->ws + WS_U2);
    const int gt = obid() * 512 + otid(), NT = ogrid() * 512;
    for (int e = gt; e < 262144; e += NT) { const int dvk = e & 2047, bh = e >> 11, h = bh & 3, b = bh >> 2;
        const float dec = expf(64.f * ret_logg(h)); float st = 0.f; float t[32];
        float* base = RU + (size_t)(b * 32 * 4 + h) * 2048 + dvk;
#pragma unroll
        for (int i = 0; i < 32; ++i) t[i] = base[(size_t)i * 8192];
#pragma unroll
        for (int i = 0; i < 32; ++i) { base[(size_t)i * 8192] = st; st = st * dec + t[i]; } }
    for (int e = gt; e < 262144; e += NT) { const int dvk = e & 2047, bh = e >> 11, h = bh & 3, b = bh >> 2; float st = 0.f; float t[32], gl[32];
        float* base = GU + (size_t)(b * 32 * 4 + h) * 2048 + dvk; const float* gb = GL + (size_t)(b * 32 * 4 + h) * 32 + (dvk >> 6);
#pragma unroll
        for (int i = 0; i < 32; ++i) { t[i] = base[(size_t)i * 8192]; gl[i] = gb[i * 128]; }
#pragma unroll
        for (int i = 0; i < 32; ++i) { st = __expf(gl[i]) * st + t[i]; base[(size_t)i * 8192] = st; } }
    for (int e = gt; e < 32768; e += NT) { const int pp = e & 63, g = (e >> 6) & 15, b = e >> 10; const int gp = (l * 16 + g) * 64 + pp;
        const float lr = p->in[5][gp], li = p->in[6][gp], dt = expf(p->in[7][l * 16 + g]);
        float ar, ai2; s5_abar_pow(lr, li, dt, 64, ar, ai2);
        float xr = 0.f, xi = 0.f; float er[32], ei[32];
        const size_t row0 = (size_t)g * 1024 + b * 32;
#pragma unroll
        for (int i = 0; i < 32; ++i) { er[i] = ES[(row0 + i) * 128 + pp]; ei[i] = ES[(row0 + i) * 128 + 64 + pp]; }
#pragma unroll
        for (int i = 0; i < 32; ++i) { U2[(row0 + i) * S5K + 1024 + pp] = (bf16_t)f2bf(xr); U2[(row0 + i) * S5K + 1088 + pp] = (bf16_t)f2bf(xi);
            const float nr = ar * xr - ai2 * xi + er[i], ni = ar * xi + ai2 * xr + ei[i]; xr = nr; xi = ni; } }
}

__device__ __forceinline__ void out_items(CPP p, int l, LAS unsigned char* lds) {
    LAS float* qt = (LAS float*)lds; LAS float* kt = qt + 64 * 33; LAS float* vv = kt + 64 * 33; LAS float* Sm = vv + 64 * 68; LAS float* Rm = Sm + 64 * 65;
    const bf16_t* H = (const bf16_t*)(p->ws + WS_E); const float* rot = (const float*)(p->ws + WS_ROT); bf16_t* O = (bf16_t*)(p->ws + WS_O);
    const float* RU = (const float*)(p->ws + WS_RU); const float* GU = (const float*)(p->ws + WS_GU);
    const int tid = otid();
    for (int it = obid(); it < 8192; it += ogrid()) {
        const int gla = it >> 12, h = it & 3, bi = (it >> 2) & 1023, i = bi & 31;
        const size_t t0 = (size_t)bi * 64;
        const int n = tid >> 3, dv0 = (tid & 7) * 8;
        float acc[8];
#pragma unroll
        for (int e = 0; e < 8; ++e) acc[e] = 0.f;
        __syncthreads();
        { const float* src = (gla ? GU : RU) + (size_t)(bi * 4 + h) * 2048; const int idx = tid * 4, dk = idx >> 6, dv = idx & 63;
            const f32x4 t = *(const f32x4*)(src + idx); Rm[dk * 68 + dv] = t[0]; Rm[dk * 68 + dv + 1] = t[1]; Rm[dk * 68 + dv + 2] = t[2]; Rm[dk * 68 + dv + 3] = t[3]; }
        if (!gla) {
            const float lg = ret_logg(h);
            load_rot(H + t0 * NH + C_RQ + h * 32, rot, i, qt, 1.f, 0.f, tid);
            load_rot(H + t0 * NH + C_RK + h * 32, rot, i, kt, 0.17677669529663689f, 0.f, tid);
            load_tile64(H + t0 * NH + C_RV + h * 64, NH, vv, 68, 1.f, tid);
            __syncthreads();
            { const int m0 = (tid & 7) * 8;
#pragma unroll
                for (int mm = 0; mm < 8; ++mm) { const int m = m0 + mm; float d = 0.f;
#pragma unroll
                    for (int dk = 0; dk < 32; ++dk) d += qt[n * 33 + dk] * kt[m * 33 + dk];
                    const int ad = n > m ? n - m : m - n; Sm[n * 65 + m] = d * __expf(lg * (float)ad); } }
            __syncthreads();
#pragma unroll 4
            for (int m = 0; m < 64; ++m) { const float sv = Sm[n * 65 + m]; const f32x4 v0 = *(const LAS f32x4*)(vv + m * 68 + dv0), v1 = *(const LAS f32x4*)(vv + m * 68 + dv0 + 4);
                acc[0] += sv * v0[0]; acc[1] += sv * v0[1]; acc[2] += sv * v0[2]; acc[3] += sv * v0[3]; acc[4] += sv * v1[0]; acc[5] += sv * v1[1]; acc[6] += sv * v1[2]; acc[7] += sv * v1[3]; }
            const float xi = __expf(lg * (float)(n + 1));
#pragma unroll 4
            for (int dk = 0; dk < 32; ++dk) { const float qx = qt[n * 33 + dk] * xi; const f32x4 v0 = *(const LAS f32x4*)(Rm + dk * 68 + dv0), v1 = *(const LAS f32x4*)(Rm + dk * 68 + dv0 + 4);
                acc[0] += qx * v0[0]; acc[1] += qx * v0[1]; acc[2] += qx * v0[2]; acc[3] += qx * v0[3]; acc[4] += qx * v1[0]; acc[5] += qx * v1[1]; acc[6] += qx * v1[2]; acc[7] += qx * v1[3]; }
        } else {
            { const int idx = tid * 4, j = idx >> 5, c = idx & 31; const u32x2 w = *(const u32x2*)(H + (t0 + j) * NH + C_GQ + h * 32 + c); const float sc = 0.17677669529663689f;
                qt[j * 33 + c] = bflo(w.x) * sc; qt[j * 33 + c + 1] = bfhi(w.x) * sc; qt[j * 33 + c + 2] = bflo(w.y) * sc; qt[j * 33 + c + 3] = bfhi(w.y) * sc; }
            __syncthreads();
#pragma unroll 4
            for (int dk = 0; dk < 32; ++dk) { const float qx = qt[n * 33 + dk]; const f32x4 v0 = *(const LAS f32x4*)(Rm + dk * 68 + dv0), v1 = *(const LAS f32x4*)(Rm + dk * 68 + dv0 + 4);
                acc[0] += qx * v0[0]; acc[1] += qx * v0[1]; acc[2] += qx * v0[2]; acc[3] += qx * v0[3]; acc[4] += qx * v1[0]; acc[5] += qx * v1[1]; acc[6] += qx * v1[2]; acc[7] += qx * v1[3]; }
        }
        float s = 0.f;
#pragma unroll
        for (int e = 0; e < 8; ++e) s += acc[e];
        s += __shfl_xor(s, 1); s += __shfl_xor(s, 2); s += __shfl_xor(s, 4);
        const float mean = s * (1.f / 64.f); float s2 = 0.f;
#pragma unroll
        for (int e = 0; e < 8; ++e) { acc[e] -= mean; s2 += acc[e] * acc[e]; }
        s2 += __shfl_xor(s2, 1); s2 += __shfl_xor(s2, 2); s2 += __shfl_xor(s2, 4);
        const float rs = 1.f / sqrtf(s2 * (1.f / 64.f) + LN_EPS);
        const u32x4 gw = *(const u32x4*)(H + (t0 + n) * NH + (gla ? C_GR : C_RG) + h * 64 + dv0); float gf[8]; unpack8(gw, gf);
        float ov[8];
#pragma unroll
        for (int e = 0; e < 8; ++e) ov[e] = silu_f(gf[e]) * acc[e] * rs;
        *(u32x4*)(O + (t0 + n) * DM + (gla ? 512 : 0) + h * 64 + dv0) = pack8(ov);
    }
}


#define XB_TMO      128
#define XB_XCNT(j)  (256  + 64 * (j))
#define XB_XSUB(j)  (1280 + 64 * (j))
#define XB_XGEN(j)  (2304 + 64 * (j))
#define XB_TOP      3328
#define XB_TOPGEN   3392
#define XCD_BAR_WORDS 3456
#define XB_SPIN_CAP (1u << 20)
__device__ __forceinline__ unsigned xb_ld(unsigned* p)              { return __hip_atomic_load(p, __ATOMIC_RELAXED, __HIP_MEMORY_SCOPE_AGENT); }
__device__ __forceinline__ unsigned xb_add(unsigned* p, unsigned v) { return __hip_atomic_fetch_add(p, v, __ATOMIC_RELAXED, __HIP_MEMORY_SCOPE_AGENT); }
__device__ __forceinline__ unsigned xb_xcc_id() { return (unsigned)__builtin_amdgcn_s_getreg((3 << 11) | 20) & 0xFu; }
#define XB_SPIN(cond, bar) do { unsigned _sp = 0; while (cond) { __builtin_amdgcn_s_sleep(1); \
    if ((++_sp & 255u) == 0u) { if (xb_ld(&(bar)[XB_TMO])) break; if (_sp > XB_SPIN_CAP) { atomicAdd(&(bar)[XB_TMO], 1u); break; } } } } while (0)
struct XcdBarrier { unsigned* bar; unsigned x; volatile LAS unsigned* st; };
__device__ __forceinline__ XcdBarrier xcd_barrier_post(unsigned* bar, volatile LAS unsigned* st) {
    XcdBarrier b; b.bar = bar; b.x = xb_xcc_id(); b.st = st;
    if (threadIdx.x == 0) (void)xb_add(&bar[XB_XCNT(b.x)], 1u);
    return b;
}
__device__ __forceinline__ void xcd_barrier_complete(unsigned* bar, unsigned x, unsigned& nloc, unsigned& nx) {
    const unsigned G = gridDim.x * gridDim.y * gridDim.z;
    unsigned sum, cnt, mine, sp = 0u;
    for (;;) {
        sum = 0u; cnt = 0u; mine = 0u;
#pragma unroll
        for (unsigned j = 0; j < 16; ++j) { const unsigned c = xb_ld(&bar[XB_XCNT(j)]); sum += c; cnt += (c > 0u) ? 1u : 0u; mine = (j == x) ? c : mine; }
        if (sum == G) break;
        __builtin_amdgcn_s_sleep(1);
        if ((++sp & 255u) == 0u) { if (xb_ld(&bar[XB_TMO])) break; if (sp > XB_SPIN_CAP) { atomicAdd(&bar[XB_TMO], 1u); break; } }
    }
    nloc = mine > 0u ? mine : 1u; nx = cnt > 0u ? cnt : 1u;
}
__device__ __forceinline__ void xcd_barrier(const XcdBarrier& b) {
    asm volatile("s_waitcnt vmcnt(0)" ::: "memory");
    __syncthreads();
    if (threadIdx.x == 0) {
        unsigned* bar = b.bar;
        __builtin_amdgcn_s_waitcnt(0);
        unsigned nloc = b.st[0], nx = b.st[1];
        if (nloc == 0u) { xcd_barrier_complete(bar, b.x, nloc, nx); b.st[0] = nloc; b.st[1] = nx; }
        const unsigned old = xb_add(&bar[XB_XSUB(b.x)], 1u);
        const unsigned gen = old / nloc;
        if (old + 1u == (gen + 1u) * nloc) {
            __builtin_amdgcn_fence(__ATOMIC_RELEASE, "agent");
            asm volatile("s_waitcnt vmcnt(0)" ::: "memory");
            const unsigned og = xb_add(&bar[XB_TOP], 1u);
            const unsigned tg = og / nx;
            if (og + 1u == (tg + 1u) * nx) xb_add(&bar[XB_TOPGEN], 1u);
            else XB_SPIN(xb_ld(&bar[XB_TOPGEN]) == tg, bar);
            __builtin_amdgcn_fence(__ATOMIC_ACQUIRE, "agent");
            xb_add(&bar[XB_XGEN(b.x)], 1u);
            asm volatile("s_waitcnt vmcnt(0)" ::: "memory");
        } else {
            XB_SPIN(xb_ld(&bar[XB_XGEN(b.x)]) == gen, bar);
            __builtin_amdgcn_fence(__ATOMIC_ACQUIRE, "agent");
            asm volatile("s_waitcnt vmcnt(0)" ::: "memory");
        }
    }
    __syncthreads();
}

__global__ void __launch_bounds__(512, 2) mega(Params p_unused) {
    extern __shared__ __attribute__((aligned(16))) unsigned char lds_raw[];
    LAS unsigned char* lds = (LAS unsigned char*)lds_raw;
    cg::grid_group grid = cg::this_grid();
    CPP p = (CPP)__builtin_amdgcn_kernarg_segment_ptr();
    unsigned char* ws = p->ws;
    bf16_t* XB = (bf16_t*)(ws + WS_XB);
    volatile LAS unsigned* bst = (volatile LAS unsigned*)(lds + LDS_BYTES - 64);
    if (threadIdx.x < 2) bst[threadIdx.x] = 0u;
    __syncthreads();
    const XcdBarrier bar = xcd_barrier_post((unsigned*)ws, bst);

    { float* rot = (float*)(ws + WS_ROT); const int gt = obid() * 512 + otid(), NT = ogrid() * 512;
        for (int e = gt; e < 2048 * 16; e += NT) { const int pos = e >> 4, f = e & 15; const float inv = 1.0f / powf(10000.0f, (float)f * (1.0f / 16.0f)); const float ang = (float)pos * inv;
            rot[pos * 32 + f] = cosf(ang); rot[pos * 32 + 16 + f] = sinf(ang); } }
    s5_tables(p, 0, lds);
    { const float* x = p->in[0]; const int gt = obid() * 512 + otid(), NT = ogrid() * 512;
        for (size_t e = gt; e < (size_t)M * DM / 8; e += NT) { const f32x4 a = *((const f32x4*)x + 2 * e), b = *((const f32x4*)x + 2 * e + 1);
            u32x4 w; w.x = pk2(a[0], a[1]); w.y = pk2(a[2], a[3]); w.z = pk2(b[0], b[1]); w.w = pk2(b[2], b[3]); *((u32x4*)XB + e) = w; } }
    grid.sync();
    convert_weights(p, 0, lds);
    xcd_barrier(bar);

    for (int l = 0; l < 4; ++l) {
        for (int s = 0; s < 12; ++s) {
            p = (CPP)__builtin_amdgcn_kernarg_segment_ptr(); asm volatile("" : "+s"(p));
            pg8::Gemm g; pg8::Sched S; pg8::Epi E;
            bool do_gemm = true;
            S.G = ogrid(); S.c = obid(); S.mode = 0; S.nM = M / 256; S.nN = 1;
            E.mode = 0; E.perm = true;
            E.ws = ws; E.dskip = p->in[12] + l * 256; E.bglu = p->in[14] + l * 256; E.bgate = p->in[16] + (size_t)l * 4096;
            g.A = XB; g.Bt = (const bf16_t*)(ws + WS_WIN); g.lda = DM; g.ldb = DM; g.K = DM;
            switch (s) {
                case 0: S.nN = NINP / 256; E.mode = 0; E.perm = true; break;
                case 1: g.A = (const bf16_t*)(ws + WS_U2); g.Bt = (const bf16_t*)(ws + WS_WE); g.lda = S5K; g.ldb = 1024; g.K = 1024; S.mode = 2; S.nM = 64; S.nN = 1; E.mode = 1; break;
                case 3: g.A = (const bf16_t*)(ws + WS_U2); g.Bt = (const bf16_t*)(ws + WS_WT); g.lda = S5K; g.ldb = S5K; g.K = S5K; S.mode = 3; S.nM = 64; S.nN = 4; E.mode = 2; break;
                case 4: g.A = (const bf16_t*)(ws + WS_YS); g.Bt = (const bf16_t*)(ws + WS_WGLU); g.lda = 256; g.ldb = 256; g.K = 256; S.nN = 1; E.mode = 3; break;
                case 5: g.A = (const bf16_t*)(ws + WS_O); g.Bt = (const bf16_t*)(ws + WS_WB); g.lda = DM; g.ldb = 256; g.K = 256; S.mode = 1; S.nN = 16; E.mode = 4; break;
                case 6: g.Bt = (const bf16_t*)(ws + WS_WG); S.nN = 16; E.mode = 5; E.perm = false; break;
                case 7: g.A = (const bf16_t*)(ws + WS_O); g.Bt = (const bf16_t*)(ws + WS_WO); S.nN = 4; E.mode = 6; E.perm = false; break;
                case 9: g.Bt = (const bf16_t*)(ws + WS_WFF); S.nN = 22; E.mode = 7; E.perm = false; break;
                case 10: g.A = (const bf16_t*)(ws + WS_E); g.Bt = (const bf16_t*)(ws + WS_WD); g.lda = DFF; g.ldb = DFF; g.K = DFF; S.nN = 4; E.mode = 6; E.perm = false; break;
                default: do_gemm = false; break;
            }
            S.nwg = S.nM * S.nN;
            if (do_gemm) pg8::gemm_phase(lds, g, S, E);
            if (s == 1) { attn_mfma(p, l, lds); upd_mfma(p, l, lds); }
            else if (s == 2) scan_items(p, l);
            else if (s == 3) out_mfma(p, l, lds);
            else if (s == 8) { ln_pass(XB, nullptr, p->in[19] + l * DM, p->in[20] + l * DM); if (l < 3) s5_tables(p, l + 1, lds); }
            else if (s == 11) { ln_pass(XB, (l == 3) ? p->out : nullptr, p->in[24] + l * DM, p->in[25] + l * DM); if (l < 3) convert_weights(p, l + 1, lds); }
            xcd_barrier(bar);
        }
    }
}

extern "C" void kernel_launch(void* const* d_in, const int* in_sizes, int n_in, void* d_out, int out_size, void* d_ws, size_t ws_size, hipStream_t stream) {
    static int grid_blocks = 0;
    if (!grid_blocks) {
        int dev = 0, cus = 0;
        hipGetDevice(&dev);
        hipDeviceGetAttribute(&cus, hipDeviceAttributeMultiprocessorCount, dev);
        hipFuncSetAttribute((const void*)mega, hipFuncAttributeMaxDynamicSharedMemorySize, LDS_BYTES);
        grid_blocks = cus > 0 ? cus : 256;
    }
    (void)hipMemsetAsync(d_ws, 0, 65536, stream);
    Params p{};
    for (int i = 0; i < 26; ++i) p.in[i] = (const float*)d_in[i];
    p.out = (float*)d_out; p.ws = (unsigned char*)d_ws;
    void* args[] = {&p};
    hipError_t e = hipLaunchCooperativeKernel((const void*)mega, dim3(grid_blocks), dim3(512), args, LDS_BYTES, stream);
    if (e != hipSuccess) fprintf(stderr, "cooperative launch failed: %s (grid %d)\n", hipGetErrorString(e), grid_blocks);
}
```

```cpp
#include <hip/hip_runtime.h>
#include <hip/hip_cooperative_groups.h>
#include <cstdint>
#include <cstdio>
namespace cg = cooperative_groups;

#define LAS __attribute__((address_space(3)))
typedef unsigned short bf16_t;
typedef short bf16x8 __attribute__((ext_vector_type(8)));
typedef float f32x4 __attribute__((ext_vector_type(4)));
typedef float f32x2 __attribute__((ext_vector_type(2)));
typedef unsigned u32x4 __attribute__((ext_vector_type(4)));
typedef unsigned u32x2 __attribute__((ext_vector_type(2)));

constexpr int M = 65536, DM = 1024, SEQ = 2048, NCH = 32;
constexpr int NH = 2320;
constexpr int NINP = 2816;
constexpr int DFF = 2816;
constexpr int S5K = 1152;
constexpr float ALPHA = 1.681792830507429f;
constexpr float LN_EPS = 1e-5f;
constexpr int C_RQ = 0, C_RK = 128, C_RV = 256, C_RG = 512, C_AQ = 768, C_AK = 1024, C_AV = 1280, C_GQ = 1536, C_GK = 1664, C_GV = 1792, C_GR = 2048, C_GA = 2304, C_SU = 2320;

constexpr size_t MiB = 1u << 20;
constexpr size_t WS_ROT = 1 * MiB;
constexpr size_t WS_KN = 2 * MiB;
constexpr size_t WS_WIN = 4 * MiB;
constexpr size_t WS_WG = 10 * MiB;
constexpr size_t WS_WB = 18 * MiB;
constexpr size_t WS_WO = 20 * MiB;
constexpr size_t WS_WFF = 22 * MiB;
constexpr size_t WS_WD = 33 * MiB;
constexpr size_t WS_WGLU = 39 * MiB;
constexpr size_t WS_WE = 40 * MiB;
constexpr size_t WS_WT = 48 * MiB;
constexpr size_t WS_XB = 88 * MiB;
constexpr size_t WS_O = 216 * MiB;
constexpr size_t WS_E = 344 * MiB;
constexpr size_t WS_U2 = 636 * MiB;
constexpr size_t WS_RU = 676 * MiB;
constexpr size_t WS_GU = 708 * MiB;
constexpr size_t WS_GL = 740 * MiB;
constexpr size_t WS_ES = 741 * MiB;
constexpr size_t WS_YS = 749 * MiB;
constexpr int LDS_BYTES = 147456;

struct Params { const float* in[26]; float* out; unsigned char* ws; };
typedef const __attribute__((address_space(4))) Params* CPP;

typedef _Float16 half2_t __attribute__((ext_vector_type(2)));
typedef _Float16 half8_t __attribute__((ext_vector_type(8)));
__device__ __forceinline__ float bflo(unsigned w) { return (float)__builtin_bit_cast(half2_t, w)[0]; }
__device__ __forceinline__ float bfhi(unsigned w) { return (float)__builtin_bit_cast(half2_t, w)[1]; }
__device__ __forceinline__ float bf2f(bf16_t b) { return (float)__builtin_bit_cast(_Float16, b); }
__device__ __forceinline__ unsigned f2bf(float f) { return (unsigned)__builtin_bit_cast(unsigned short, (_Float16)f); }
__device__ __forceinline__ unsigned pk2(float lo, float hi) { const half2_t v = {(_Float16)lo, (_Float16)hi}; return __builtin_bit_cast(unsigned, v); }
__device__ __forceinline__ unsigned cvt_pk_bf16(float lo, float hi) { return pk2(lo, hi); }
__device__ __forceinline__ float sigm(float x) { return __builtin_amdgcn_rcpf(1.0f + __expf(-x)); }
__device__ __forceinline__ float silu_f(float x) { return x * sigm(x); }
__device__ __forceinline__ float gelu_tanh(float v) { return v * sigm(1.5957691216057308f * (v + 0.044715f * v * v * v)); }
__device__ __forceinline__ void unpack8(u32x4 w, float* o) {
    o[0] = bflo(w.x); o[1] = bfhi(w.x); o[2] = bflo(w.y); o[3] = bfhi(w.y); o[4] = bflo(w.z); o[5] = bfhi(w.z); o[6] = bflo(w.w); o[7] = bfhi(w.w);
}
__device__ __forceinline__ u32x4 pack8(const float* v) { u32x4 w; w.x = pk2(v[0], v[1]); w.y = pk2(v[2], v[3]); w.z = pk2(v[4], v[5]); w.w = pk2(v[6], v[7]); return w; }
__device__ __forceinline__ int otid() { int t = threadIdx.x; asm volatile("" : "+v"(t)); return t; }
__device__ __forceinline__ int obid() { int b = blockIdx.x; asm volatile("" : "+s"(b)); return b; }
__device__ __forceinline__ int ogrid() { int b = gridDim.x; asm volatile("" : "+s"(b)); return b; }
__device__ __forceinline__ float wave_sum(float v) {
#pragma unroll
    for (int o = 1; o < 64; o <<= 1) v += __shfl_xor(v, o);
    return v;
}

namespace pg8 {
constexpr int BM = 256, BK = 64, HALF = 128, HTB = HALF * BK * 2, STAGE_BYTES = 8 * HTB, NXCD = 8, WGM = 8;
__device__ __forceinline__ int lds_byte(int r, int c) { const int st = (r >> 4) * 2 + (c >> 5), rr = r & 15, cc = c & 31, ob = rr * 64 + cc * 2; return st * 1024 + (ob ^ (((ob >> 9) & 1) << 5)); }
__device__ __forceinline__ void stage_rc(int b, int& R, int& C) { const int st = b / 1024, sb = b % 1024, swz = sb ^ (((sb >> 9) & 1) << 5); R = (st >> 1) * 16 + swz / 64; C = (st & 1) * 32 + (swz % 64) / 2; }
__device__ __forceinline__ int perm32(int rho) { const int n = rho >> 4, i = rho & 15; return 8 * (i >> 2) + 4 * n + (i & 3); }

struct Unit { int pm, pn, ak; };
struct Gemm { const bf16_t* A; const bf16_t* Bt; int lda, ldb, K; };

struct Sched {
    int nM, nN, nwg, G, c, mode;
    __device__ __forceinline__ bool next(int i, Unit& u) const {
        const long L = (long)i * G + c; if (L >= nwg) return false;
        if (mode == 2) { u.pm = (int)L; u.pn = (int)(L >> 2); u.ak = 0; return true; }
        if (mode == 3) { const int g = (int)(L >> 4); u.pm = 4 * g + (int)((L >> 2) & 3); u.pn = 4 * g + (int)(L & 3); u.ak = 0; return true; }
        int wgid = (int)L; { const int q = nwg / NXCD, r = nwg % NXCD, xcd = wgid % NXCD, off = wgid / NXCD; wgid = (xcd < r ? xcd * (q + 1) : r * (q + 1) + (xcd - r) * q) + off; }
        const int nig = WGM * nN, gid = wgid / nig, fm = gid * WGM, gsz = (nM - fm) < WGM ? (nM - fm) : WGM;
        u.pm = fm + ((wgid % nig) % gsz); u.pn = (wgid % nig) / gsz; u.ak = (mode == 1) ? (u.pn >> 2) * 256 : 0; return true;
    }
};

struct Epi {
    int mode; bool perm;
    unsigned char* ws; const float* dskip; const float* bglu; const float* bgate;
    __device__ __forceinline__ void operator()(const f32x4 (&acc)[2][2][4][2], const Unit& u, int wr, int wc, int fr, int fq) const {
        const int row0 = u.pm * BM + wr * 64 + fr;
        bf16_t* const H = (bf16_t*)(ws + WS_E); bf16_t* const U2 = (bf16_t*)(ws + WS_U2); float* const ES = (float*)(ws + WS_ES); bf16_t* const YS = (bf16_t*)(ws + WS_YS);
        bf16_t* const Ob = (bf16_t*)(ws + WS_O); bf16_t* const P = (bf16_t*)(ws + WS_E); bf16_t* const MIX = (bf16_t*)(ws + WS_O); bf16_t* const HF = (bf16_t*)(ws + WS_E);
        if (mode == 0) {
#pragma unroll
            for (int ai = 0; ai < 2; ++ai)
#pragma unroll
                for (int m = 0; m < 4; ++m) { const int r = row0 + ai * HALF + m * 16;
#pragma unroll
                    for (int bj = 0; bj < 2; ++bj) { const int c0 = u.pn * BM + bj * HALF + wc * 32 + 8 * fq;
                        const f32x4 v0 = acc[ai][bj][m][0], v1 = acc[ai][bj][m][1];
                        u32x4 w; w.x = cvt_pk_bf16(v0[0], v0[1]); w.y = cvt_pk_bf16(v0[2], v0[3]); w.z = cvt_pk_bf16(v1[0], v1[1]); w.w = cvt_pk_bf16(v1[2], v1[3]);
                        if (c0 < C_SU) *(u32x4*)(H + (size_t)r * NH + c0) = w;
                        else if (c0 < C_SU + 256) { const int c = c0 - C_SU, g = c >> 4, ci = c & 15;
                            *(u32x4*)(U2 + ((size_t)(g * 1024 + (r >> 6))) * S5K + (r & 63) * 16 + ci) = w; } } }
        } else if (mode == 1) {
#pragma unroll
            for (int ai = 0; ai < 2; ++ai)
#pragma unroll
                for (int m = 0; m < 4; ++m) { const int r = row0 + ai * HALF + m * 16; const int c0 = wc * 32 + 8 * fq;
                    *(f32x4*)(ES + (size_t)r * 128 + c0) = acc[ai][0][m][0]; *(f32x4*)(ES + (size_t)r * 128 + c0 + 4) = acc[ai][0][m][1]; }
        } else if (mode == 2) {
            const int g = u.pm >> 2;
#pragma unroll
            for (int ai = 0; ai < 2; ++ai)
#pragma unroll
                for (int m = 0; m < 4; ++m) { const int r = row0 + ai * HALF + m * 16;
#pragma unroll
                    for (int bj = 0; bj < 2; ++bj) { const int n0 = (u.pn & 3) * BM + bj * HALF + wc * 32 + 8 * fq; const int j = n0 >> 4, i0 = n0 & 15;
                        const u32x4 uw = *(const u32x4*)(U2 + (size_t)r * S5K + n0); float uf[8]; unpack8(uw, uf);
                        const f32x4 d0 = *(const f32x4*)(dskip + 16 * g + i0), d1 = *(const f32x4*)(dskip + 16 * g + i0 + 4);
                        const f32x4 v0 = acc[ai][bj][m][0], v1 = acc[ai][bj][m][1]; float y[8];
                        y[0] = gelu_tanh(v0[0] + d0[0] * uf[0]); y[1] = gelu_tanh(v0[1] + d0[1] * uf[1]); y[2] = gelu_tanh(v0[2] + d0[2] * uf[2]); y[3] = gelu_tanh(v0[3] + d0[3] * uf[3]);
                        y[4] = gelu_tanh(v1[0] + d1[0] * uf[4]); y[5] = gelu_tanh(v1[1] + d1[1] * uf[5]); y[6] = gelu_tanh(v1[2] + d1[2] * uf[6]); y[7] = gelu_tanh(v1[3] + d1[3] * uf[7]);
                        u32x4 w; w.x = cvt_pk_bf16(y[0], y[1]); w.y = cvt_pk_bf16(y[2], y[3]); w.z = cvt_pk_bf16(y[4], y[5]); w.w = cvt_pk_bf16(y[6], y[7]);
                        const size_t t = (size_t)(r & 1023) * 64 + j;
                        *(u32x4*)(YS + t * 256 + 16 * g + i0) = w; } }
        } else if (mode == 3) {
#pragma unroll
            for (int ai = 0; ai < 2; ++ai)
#pragma unroll
                for (int m = 0; m < 4; ++m) { const int r = row0 + ai * HALF + m * 16;
#pragma unroll
                    for (int bj = 0; bj < 2; ++bj) { const int c0 = bj * HALF + wc * 32 + 8 * fq;
                        const u32x4 yw = *(const u32x4*)(YS + (size_t)r * 256 + c0); float yf[8]; unpack8(yw, yf);
                        const f32x4 b0 = *(const f32x4*)(bglu + c0), b1 = *(const f32x4*)(bglu + c0 + 4);
                        const f32x4 v0 = acc[ai][bj][m][0] + b0, v1 = acc[ai][bj][m][1] + b1; float o[8];
                        o[0] = yf[0] * sigm(v0[0]); o[1] = yf[1] * sigm(v0[1]); o[2] = yf[2] * sigm(v0[2]); o[3] = yf[3] * sigm(v0[3]);
                        o[4] = yf[4] * sigm(v1[0]); o[5] = yf[5] * sigm(v1[1]); o[6] = yf[6] * sigm(v1[2]); o[7] = yf[7] * sigm(v1[3]);
                        u32x4 w; w.x = cvt_pk_bf16(o[0], o[1]); w.y = cvt_pk_bf16(o[2], o[3]); w.z = cvt_pk_bf16(o[4], o[5]); w.w = cvt_pk_bf16(o[6], o[7]);
                        *(u32x4*)(Ob + (size_t)r * DM + 768 + c0) = w; } }
        } else if (mode == 4) {
#pragma unroll
            for (int ai = 0; ai < 2; ++ai)
#pragma unroll
                for (int m = 0; m < 4; ++m) { const int r = row0 + ai * HALF + m * 16;
#pragma unroll
                    for (int bj = 0; bj < 2; ++bj) { const int c0 = u.pn * BM + bj * HALF + wc * 32 + 8 * fq;
                        const f32x4 v0 = acc[ai][bj][m][0], v1 = acc[ai][bj][m][1];
                        u32x4 w; w.x = cvt_pk_bf16(v0[0], v0[1]); w.y = cvt_pk_bf16(v0[2], v0[3]); w.z = cvt_pk_bf16(v1[0], v1[1]); w.w = cvt_pk_bf16(v1[2], v1[3]);
                        *(u32x4*)(P + (size_t)r * 4096 + c0) = w; } }
        } else if (mode == 5) {
            const int ch0 = 64 * u.pn + 16 * wc + 4 * fq;
            f32x4 bv[4];
#pragma unroll
            for (int b = 0; b < 4; ++b) bv[b] = *(const f32x4*)(bgate + b * 1024 + ch0);
#pragma unroll
            for (int ai = 0; ai < 2; ++ai)
#pragma unroll
                for (int m = 0; m < 4; ++m) { const int r = row0 + ai * HALF + m * 16; f32x4 mix = (f32x4){0.f, 0.f, 0.f, 0.f};
#pragma unroll
                    for (int bj = 0; bj < 2; ++bj)
#pragma unroll
                        for (int n = 0; n < 2; ++n) { const int b = 2 * bj + n; const f32x4 a = acc[ai][bj][m][n] + bv[b];
                            const u32x2 pw = *(const u32x2*)(P + (size_t)r * 4096 + b * 1024 + ch0);
                            mix[0] += sigm(a[0]) * bflo(pw.x); mix[1] += sigm(a[1]) * bfhi(pw.x); mix[2] += sigm(a[2]) * bflo(pw.y); mix[3] += sigm(a[3]) * bfhi(pw.y); }
                    u32x2 w; w.x = cvt_pk_bf16(mix[0], mix[1]); w.y = cvt_pk_bf16(mix[2], mix[3]);
                    *(u32x2*)(MIX + (size_t)r * DM + ch0) = w; }
        } else if (mode == 6) {
            bf16_t* const XBp = (bf16_t*)(ws + WS_XB);
#pragma unroll
            for (int ai = 0; ai < 2; ++ai)
#pragma unroll
                for (int m = 0; m < 4; ++m) { const int r = row0 + ai * HALF + m * 16;
#pragma unroll
                    for (int bj = 0; bj < 2; ++bj)
#pragma unroll
                        for (int n = 0; n < 2; ++n) { const int c = u.pn * BM + bj * HALF + wc * 32 + n * 16 + 4 * fq;
                            u32x2* px = (u32x2*)(XBp + (size_t)r * DM + c); const u32x2 xw = *px; const f32x4 a = acc[ai][bj][m][n];
                            u32x2 w; w.x = cvt_pk_bf16(bflo(xw.x) * ALPHA + a[0], bfhi(xw.x) * ALPHA + a[1]); w.y = cvt_pk_bf16(bflo(xw.y) * ALPHA + a[2], bfhi(xw.y) * ALPHA + a[3]);
                            *px = w; } }
        } else {
#pragma unroll
            for (int ai = 0; ai < 2; ++ai)
#pragma unroll
                for (int m = 0; m < 4; ++m) { const int r = row0 + ai * HALF + m * 16;
#pragma unroll
                    for (int bj = 0; bj < 2; ++bj) { const int ch0 = 128 * u.pn + 64 * bj + 16 * wc + 4 * fq;
                        const f32x4 gt = acc[ai][bj][m][0], up = acc[ai][bj][m][1];
                        u32x2 w; w.x = cvt_pk_bf16(silu_f(gt[0]) * up[0], silu_f(gt[1]) * up[1]); w.y = cvt_pk_bf16(silu_f(gt[2]) * up[2], silu_f(gt[3]) * up[3]);
                        *(u32x2*)(HF + (size_t)r * DFF + ch0) = w; } }
        }
    }
};

__device__ __forceinline__ void gemm_phase(LAS unsigned char* lds, const Gemm g, const Sched& S, const Epi& E) {
    const int tid = otid(), wid = __builtin_amdgcn_readfirstlane(tid >> 6), lane = tid & 63, wr = wid >> 2, wc = wid & 3, fr = lane & 15, fq = lane >> 4;
    const int K = g.K, nt = K / BK;
    unsigned voffA[2], voffB[2];
#pragma unroll
    for (int i = 0; i < 2; ++i) { int R, C; stage_rc(tid * 16 + i * 8192, R, C); const int Rb = E.perm ? ((R & ~31) + perm32(R & 31)) : R;
        voffA[i] = (unsigned)(R * g.lda + C) * 2u; voffB[i] = (unsigned)(Rb * g.ldb + C) * 2u; }
    const size_t kstep = (size_t)(BK * 2);
    const size_t hstepA = (size_t)HALF * g.lda * 2, hstepB = (size_t)HALF * g.ldb * 2;
    const size_t tstepA = 2 * hstepA, tstepB = 2 * hstepB;
    const unsigned ldsw = (unsigned)wid * 1024u;
    const int aoff = lds_byte(wr * 64 + fr, fq * 8), boff = lds_byte(wc * 32 + fr, fq * 8);
#define PG8_SA(b, h) (((b) * 2 + (h)) * HTB)
#define PG8_SB(b, h) ((4 + (b) * 2 + (h)) * HTB)
#define PG8_STAGE(bufoff, gbase, voff) do { _Pragma("unroll") for (int _i = 0; _i < 2; ++_i) \
        __builtin_amdgcn_global_load_lds((const unsigned*)((const char*)(gbase) + (voff)[_i]), (LAS unsigned*)(lds + (bufoff) + ldsw + _i * 8192), 16, 0, 0); } while (0)
#define PG8_LDA(dst, b, h) do { _Pragma("unroll") for (int m = 0; m < 4; ++m) _Pragma("unroll") for (int k = 0; k < 2; ++k) dst[m][k] = *(const LAS bf16x8*)(lds + PG8_SA(b, h) + aoff + m * 2048 + k * 1024); } while (0)
#define PG8_LDB(dst, b, h) do { _Pragma("unroll") for (int n = 0; n < 2; ++n) _Pragma("unroll") for (int k = 0; k < 2; ++k) dst[n][k] = *(const LAS bf16x8*)(lds + PG8_SB(b, h) + boff + n * 2048 + k * 1024); } while (0)
#define PG8_MMA(ai, bj, At, Bt) do { __builtin_amdgcn_s_setprio(1); _Pragma("unroll") for (int m = 0; m < 4; ++m) _Pragma("unroll") for (int n = 0; n < 2; ++n) _Pragma("unroll") for (int k = 0; k < 2; ++k) \
        acc[ai][bj][m][n] = __builtin_amdgcn_mfma_f32_16x16x32_f16(__builtin_bit_cast(half8_t, Bt[n][k]), __builtin_bit_cast(half8_t, At[m][k]), acc[ai][bj][m][n], 0, 0, 0); __builtin_amdgcn_s_setprio(0); } while (0)
#define PG8_WAIT_V(n) asm volatile("s_waitcnt vmcnt(" #n ")" ::: "memory")
#define PG8_WAIT_L(n) asm volatile("s_waitcnt lgkmcnt(" #n ")" ::: "memory")
#define PG8_BAR __builtin_amdgcn_s_barrier()
#define PG8_SCHED __builtin_amdgcn_sched_barrier(0)
    Unit cur, nxt; int ui = 0;
    if (!S.next(0, cur)) return;
    f32x4 acc[2][2][4][2];
#pragma unroll
    for (int a = 0; a < 2; ++a)
#pragma unroll
        for (int b = 0; b < 2; ++b)
#pragma unroll
            for (int m = 0; m < 4; ++m)
#pragma unroll
                for (int n = 0; n < 2; ++n) acc[a][b][m][n] = (f32x4){0.f, 0.f, 0.f, 0.f};
    bf16x8 At[4][2], B0[2][2], B1[2][2];
    const char* cA = (const char*)g.A + (size_t)cur.pm * tstepA + (size_t)cur.ak * 2; const char* cB = (const char*)g.Bt + (size_t)cur.pn * tstepB;
    PG8_STAGE(PG8_SB(0, 0), cB, voffB); PG8_STAGE(PG8_SB(0, 1), cB + hstepB, voffB); PG8_STAGE(PG8_SA(0, 0), cA, voffA); PG8_STAGE(PG8_SA(0, 1), cA + hstepA, voffA);
    if (wr == 1) PG8_BAR;
    PG8_WAIT_V(2); PG8_BAR;
    PG8_STAGE(PG8_SB(1, 0), cB + kstep, voffB); PG8_STAGE(PG8_SA(1, 0), cA + kstep, voffA); PG8_STAGE(PG8_SB(1, 1), cB + hstepB + kstep, voffB);
    PG8_WAIT_V(6); PG8_BAR;
    for (;;) {
        const bool has_next = S.next(ui + 1, nxt);
        const char* nA = has_next ? (const char*)g.A + (size_t)nxt.pm * tstepA + (size_t)nxt.ak * 2 : cA; const char* nB = has_next ? (const char*)g.Bt + (size_t)nxt.pn * tstepB : cB;
        for (int t = 0; t < nt; t += 2) {
            const bool last = (t == nt - 2);
            const char* a1 = cA + (size_t)(t + 1) * kstep;
            const char* a2 = last ? nA : cA + (size_t)(t + 2) * kstep; const char* b2 = last ? nB : cB + (size_t)(t + 2) * kstep;
            const char* a3 = a2 + kstep; const char* b3 = b2 + kstep;
            PG8_LDB(B0, 0, 0); PG8_LDB(B1, 0, 1); PG8_SCHED; PG8_LDA(At, 0, 0); PG8_STAGE(PG8_SA(1, 1), a1 + hstepA, voffA);
            PG8_WAIT_V(8); PG8_WAIT_L(0); PG8_BAR; PG8_MMA(0, 0, At, B0); PG8_MMA(0, 1, At, B1); PG8_BAR; PG8_SCHED;
            PG8_LDA(At, 0, 1); PG8_STAGE(PG8_SB(0, 0), b2, voffB); PG8_STAGE(PG8_SB(0, 1), b2 + hstepB, voffB); PG8_STAGE(PG8_SA(0, 0), a2, voffA);
            PG8_WAIT_V(8); PG8_WAIT_L(0); PG8_BAR; PG8_MMA(1, 0, At, B0); PG8_MMA(1, 1, At, B1); PG8_BAR; PG8_SCHED;
            PG8_LDB(B0, 1, 0); PG8_LDB(B1, 1, 1); PG8_SCHED; PG8_LDA(At, 1, 0); PG8_STAGE(PG8_SA(0, 1), a2 + hstepA, voffA);
            PG8_WAIT_V(8); PG8_WAIT_L(0); PG8_BAR; PG8_MMA(0, 0, At, B0); PG8_MMA(0, 1, At, B1); PG8_BAR; PG8_SCHED;
            PG8_LDA(At, 1, 1); PG8_STAGE(PG8_SB(1, 0), b3, voffB); PG8_STAGE(PG8_SB(1, 1), b3 + hstepB, voffB); PG8_STAGE(PG8_SA(1, 0), a3, voffA);
            PG8_WAIT_V(8); PG8_WAIT_L(0); PG8_BAR; PG8_MMA(1, 0, At, B0); PG8_MMA(1, 1, At, B1); PG8_BAR; PG8_SCHED;
        }
        if (wr == 0) PG8_BAR;
        { const int t2 = otid(), w2 = __builtin_amdgcn_readfirstlane(t2 >> 6), l2 = t2 & 63;
          E(acc, cur, w2 >> 2, w2 & 3, l2 & 15, l2 >> 4); }
        if (!has_next) break;
#pragma unroll
        for (int a = 0; a < 2; ++a)
#pragma unroll
            for (int b = 0; b < 2; ++b)
#pragma unroll
                for (int m = 0; m < 4; ++m)
#pragma unroll
                    for (int n = 0; n < 2; ++n) acc[a][b][m][n] = (f32x4){0.f, 0.f, 0.f, 0.f};
        cur = nxt; cA = nA; cB = nB; ++ui;
        if (wr == 1) PG8_BAR;
    }
    PG8_WAIT_V(0);
    PG8_BAR;
#undef PG8_SA
#undef PG8_SB
#undef PG8_STAGE
#undef PG8_LDA
#undef PG8_LDB
#undef PG8_MMA
#undef PG8_WAIT_V
#undef PG8_WAIT_L
#undef PG8_BAR
#undef PG8_SCHED
}
}

__device__ __forceinline__ int dest_row(int dmode, int arg, int n) {
    if (dmode == 1) { return ((n >> 6) << 8) + ((arg >> 1) << 7) + (((n >> 4) & 3) << 5) + ((arg & 1) << 4) + (n & 15); }
    if (dmode == 2) { return ((n >> 7) << 8) + (((n >> 6) & 1) << 7) + (((n >> 4) & 3) << 5) + (arg << 4) + (n & 15); }
    return n + arg;
}
__device__ __forceinline__ void transpose_item(const float* W, int K, int Nsrc, bf16_t* WT, int dmode, int arg, LAS float* scr, int kb, int nb, int lane) {
    const int k0 = 64 * kb, n0 = 32 * nb;
    const int nsrc = n0 + (lane & 31); const bool ok = nsrc < Nsrc;
#pragma unroll 8
    for (int i = 0; i < 32; ++i) { const int kk = 2 * i + (lane >> 5); scr[kk * 33 + (lane & 31)] = ok ? W[(size_t)(k0 + kk) * Nsrc + nsrc] : 0.f; }
    asm volatile("s_waitcnt lgkmcnt(0)" ::: "memory");
    const int c = lane & 7;
#pragma unroll
    for (int j = 0; j < 4; ++j) { const int n = (lane >> 3) + 8 * j; const LAS float* s = scr + (8 * c) * 33 + n;
        u32x4 o; o.x = pk2(s[0 * 33], s[1 * 33]); o.y = pk2(s[2 * 33], s[3 * 33]); o.z = pk2(s[4 * 33], s[5 * 33]); o.w = pk2(s[6 * 33], s[7 * 33]);
        *(u32x4*)(WT + (size_t)dest_row(dmode, arg, n0 + n) * K + k0 + 8 * c) = o; }
    asm volatile("s_waitcnt lgkmcnt(0)" ::: "memory");
}

__device__ __forceinline__ void s5_abar_pow(float lr, float li, float dt, int n, float& re, float& im) {
    const float mag = expf((float)n * lr * dt);
    const double a = (double)n * ((double)li * (double)dt);
    const double k = __builtin_rint(a * 0.15915494309189535);
    const float r = (float)__builtin_fma(-k, 6.283185307179586, a);
    re = mag * cosf(r); im = mag * sinf(r);
}
__device__ __forceinline__ void s5_coef(float lr, float li, float dt, float& cr, float& ci) {
    const float th = li * dt, em1 = expm1f(lr * dt), c1 = cosf(th), s1 = sinf(th), sh = sinf(0.5f * th);
    const float nr = em1 * c1 - 2.f * sh * sh, ni = (1.f + em1) * s1, den = lr * lr + li * li;
    cr = (nr * lr + ni * li) / den; ci = (ni * lr - nr * li) / den;
}

__device__ __forceinline__ void s5_tables(CPP p, int l, LAS unsigned char* lds) {
    LAS float* abr = (LAS float*)lds;
    LAS float* abi = abr + 1024;
    LAS float* cr = abi + 1024;
    LAS float* ci = cr + 16 * 65;
    float* KN = (float*)(p->ws + WS_KN);
    const int tid = otid();
    for (int it = obid(); it < 1024; it += ogrid()) {
        const int g = it >> 6, n = it & 63;
        __syncthreads();
        for (int e = tid; e < 1024; e += 512) { const int pp = e >> 4, c = e & 15; const int gp = (l * 16 + g) * 64 + pp;
            const float lr = p->in[5][gp], li = p->in[6][gp], dt = expf(p->in[7][l * 16 + g]);
            float ar, ai2; s5_abar_pow(lr, li, dt, n, ar, ai2);
            float qr, qi; s5_coef(lr, li, dt, qr, qi);
            const float br = p->in[8][(size_t)gp * 16 + c], bi = p->in[9][(size_t)gp * 16 + c];
            const float bbr = qr * br - qi * bi, bbi = qr * bi + qi * br;
            abr[e] = ar * bbr - ai2 * bbi; abi[e] = ar * bbi + ai2 * bbr; }
        for (int e = tid; e < 1024; e += 512) { const int i = e >> 6, pp = e & 63; const size_t gi = ((size_t)(l * 16 + g) * 16 + i) * 64 + pp;
            cr[i * 65 + pp] = p->in[10][gi]; ci[i * 65 + pp] = p->in[11][gi]; }
        __syncthreads();
        if (tid < 256) { const int i = tid >> 4, c = tid & 15; float s = 0.f;
#pragma unroll 8
            for (int pp = 0; pp < 64; ++pp) s += cr[i * 65 + pp] * abr[pp * 16 + c] - ci[i * 65 + pp] * abi[pp * 16 + c];
            KN[((size_t)(g * 64 + n) * 16 + i) * 16 + c] = s; }
    }
}

__device__ __forceinline__ void convert_weights(CPP p, int l, LAS unsigned char* lds) {
    const int tid = otid(), lane = tid & 63, wave = tid >> 6;
    LAS float* scr = (LAS float*)(lds + wave * 16384);
    const int gw = obid() * 8 + wave, NGW = ogrid() * 8;
    unsigned char* ws = p->ws;
    constexpr int J0 = 1408, J1 = J0 + 2048, J2 = J1 + 512, J3 = J2 + 512, J4 = J3 + 2816, J5 = J4 + 1408, J6 = J5 + 32;
    for (int it = gw; it < J6; it += NGW) {
        if (it < J0) { const int r = it; transpose_item(p->in[1] + (size_t)l * 1024 * 2576, 1024, 2576, (bf16_t*)(ws + WS_WIN), 0, 0, scr, r / 88, r % 88, lane); }
        else if (it < J1) { const int r = it - J0, b = r >> 9, q = r & 511; transpose_item(p->in[15] + ((size_t)l * 4 + b) * 1024 * 1024, 1024, 1024, (bf16_t*)(ws + WS_WG), 1, b, scr, q >> 5, q & 31, lane); }
        else if (it < J2) { const int r = it - J1, b = r >> 7, q = r & 127; transpose_item(p->in[17] + ((size_t)l * 4 + b) * 256 * 1024, 256, 1024, (bf16_t*)(ws + WS_WB) + (size_t)b * 1024 * 256, 0, 0, scr, q >> 5, q & 31, lane); }
        else if (it < J3) { const int q = it - J2; transpose_item(p->in[18] + (size_t)l * 1024 * 1024, 1024, 1024, (bf16_t*)(ws + WS_WO), 0, 0, scr, q >> 5, q & 31, lane); }
        else if (it < J4) { const int r = it - J3, wch = r / 1408, q = r % 1408; transpose_item(p->in[wch ? 22 : 21] + (size_t)l * 1024 * 2816, 1024, 2816, (bf16_t*)(ws + WS_WFF), 2, wch, scr, q / 88, q % 88, lane); }
        else if (it < J5) { const int q = it - J4; transpose_item(p->in[23] + (size_t)l * 2816 * 1024, 2816, 1024, (bf16_t*)(ws + WS_WD), 0, 0, scr, q >> 5, q & 31, lane); }
        else { const int q = it - J5; transpose_item(p->in[13] + (size_t)l * 256 * 256, 256, 256, (bf16_t*)(ws + WS_WGLU), 0, 0, scr, q >> 3, q & 7, lane); }
    }
    const int gt = obid() * 512 + tid, NT = ogrid() * 512;
    bf16_t* WE = (bf16_t*)(ws + WS_WE);
    for (int e = gt; e < 65536; e += NT) { const int s = e & 63, pp = (e >> 6) & 63, g = e >> 12; const int gp = (l * 16 + g) * 64 + pp;
        const float lr = p->in[5][gp], li = p->in[6][gp], dt = expf(p->in[7][l * 16 + g]);
        float ar, ai2; s5_abar_pow(lr, li, dt, 63 - s, ar, ai2);
        float qr, qi; s5_coef(lr, li, dt, qr, qi);
        float wr_[16], wi_[16];
#pragma unroll
        for (int c = 0; c < 16; ++c) { const float br = p->in[8][(size_t)gp * 16 + c], bi = p->in[9][(size_t)gp * 16 + c];
            const float bbr = qr * br - qi * bi, bbi = qr * bi + qi * br; wr_[c] = ar * bbr - ai2 * bbi; wi_[c] = ar * bbi + ai2 * bbr; }
        bf16_t* dr = WE + ((size_t)(g * 256 + pp)) * 1024 + s * 16; bf16_t* di = WE + ((size_t)(g * 256 + 64 + pp)) * 1024 + s * 16;
        *(u32x4*)dr = pack8(wr_); *(u32x4*)(dr + 8) = pack8(wr_ + 8); *(u32x4*)di = pack8(wi_); *(u32x4*)(di + 8) = pack8(wi_ + 8); }
    for (int e = gt; e < 16 * 128 * 128; e += NT) { const int c8 = e & 127, n = (e >> 7) & 127, g = e >> 14;
        *(u32x4*)(WE + ((size_t)(g * 256 + 128 + n)) * 1024 + c8 * 8) = (u32x4){0u, 0u, 0u, 0u}; }
    bf16_t* WT = (bf16_t*)(ws + WS_WT); const float* KN = (const float*)(ws + WS_KN);
    for (int e = gt; e < 16 * 1024 * 64; e += NT) { const int s = e & 63, row = (e >> 6) & 1023, g = e >> 16; const int j = row >> 4, i = row & 15;
        u32x4 w0 = (u32x4){0u, 0u, 0u, 0u}, w1 = w0;
        if (s <= j) { const float* k = KN + ((size_t)(g * 64 + (j - s)) * 16 + i) * 16; float v[16];
#pragma unroll
            for (int c = 0; c < 16; c += 4) { const f32x4 t = *(const f32x4*)(k + c); v[c] = t[0]; v[c + 1] = t[1]; v[c + 2] = t[2]; v[c + 3] = t[3]; }
            w0 = pack8(v); w1 = pack8(v + 8); }
        bf16_t* d = WT + ((size_t)(g * 1024 + row)) * S5K + s * 16; *(u32x4*)d = w0; *(u32x4*)(d + 8) = w1; }
    for (int e = gt; e < 16 * 1024 * 64; e += NT) { const int pp = e & 63, row = (e >> 6) & 1023, g = e >> 16; const int j = row >> 4, i = row & 15; const int gp = (l * 16 + g) * 64 + pp;
        const float lr = p->in[5][gp], li = p->in[6][gp], dt = expf(p->in[7][l * 16 + g]);
        float ar, ai2; s5_abar_pow(lr, li, dt, j + 1, ar, ai2);
        const size_t gi = ((size_t)(l * 16 + g) * 16 + i) * 64 + pp; const float c_r = p->in[10][gi], c_i = p->in[11][gi];
        bf16_t* d = WT + ((size_t)(g * 1024 + row)) * S5K + 1024 + pp;
        d[0] = (bf16_t)f2bf(c_r * ar - c_i * ai2); d[64] = (bf16_t)f2bf(-(c_r * ai2 + c_i * ar)); }
}

__device__ __forceinline__ void ln_pass(bf16_t* xb, float* fout, const float* gam, const float* bet) {
    const int lane = otid() & 63, gw = obid() * 8 + (otid() >> 6), NGW = ogrid() * 8;
    f32x4 gv[4], bv[4];
#pragma unroll
    for (int j = 0; j < 2; ++j) { gv[2 * j] = *(const f32x4*)(gam + 512 * j + lane * 8); gv[2 * j + 1] = *(const f32x4*)(gam + 512 * j + lane * 8 + 4);
        bv[2 * j] = *(const f32x4*)(bet + 512 * j + lane * 8); bv[2 * j + 1] = *(const f32x4*)(bet + 512 * j + lane * 8 + 4); }
    for (int m0 = gw * 2; m0 < M; m0 += NGW * 2) {
        u32x4 w[2][2];
#pragma unroll
        for (int rr = 0; rr < 2; ++rr)
#pragma unroll
            for (int j = 0; j < 2; ++j) w[rr][j] = *(const u32x4*)(xb + (size_t)(m0 + rr) * DM + 512 * j + lane * 8);
#pragma unroll
        for (int rr = 0; rr < 2; ++rr) {
            float v[16]; unpack8(w[rr][0], v); unpack8(w[rr][1], v + 8);
            float s = 0.f;
#pragma unroll
            for (int e = 0; e < 16; ++e) s += v[e];
            const float mean = wave_sum(s) * (1.f / DM); float s2 = 0.f;
#pragma unroll
            for (int e = 0; e < 16; ++e) { v[e] -= mean; s2 += v[e] * v[e]; }
            const float rstd = 1.f / sqrtf(wave_sum(s2) * (1.f / DM) + LN_EPS);
#pragma unroll
            for (int j = 0; j < 2; ++j) {
#pragma unroll
                for (int q = 0; q < 2; ++q)
#pragma unroll
                    for (int e = 0; e < 4; ++e) v[8 * j + 4 * q + e] = v[8 * j + 4 * q + e] * rstd * gv[2 * j + q][e] + bv[2 * j + q][e];
                *(u32x4*)(xb + (size_t)(m0 + rr) * DM + 512 * j + lane * 8) = pack8(v + 8 * j);
                if (fout) { *(f32x4*)(fout + (size_t)(m0 + rr) * DM + 512 * j + lane * 8) = (f32x4){v[8 * j], v[8 * j + 1], v[8 * j + 2], v[8 * j + 3]};
                    *(f32x4*)(fout + (size_t)(m0 + rr) * DM + 512 * j + lane * 8 + 4) = (f32x4){v[8 * j + 4], v[8 * j + 5], v[8 * j + 6], v[8 * j + 7]}; } }
        }
    }
}

__device__ __forceinline__ void load_tile64(const bf16_t* src, int pitch, LAS float* dst, int dpitch, float scale, int tid) {
    const int idx = tid * 8, r = idx >> 6, c = idx & 63;
    const u32x4 w = *(const u32x4*)(src + (size_t)r * pitch + c); float f[8]; unpack8(w, f);
#pragma unroll
    for (int e = 0; e < 8; ++e) dst[r * dpitch + c + e] = f[e] * scale;
}

__device__ __forceinline__ void attn_items(CPP p, int l, LAS unsigned char* lds) {
    LAS float* Qs = (LAS float*)lds; LAS float* Ks = Qs + 64 * 68; LAS float* Vs = Ks + 64 * 68; LAS float* Ps = Vs + 64 * 68; LAS float* bs = Ps + 64 * 65;
    const bf16_t* H = (const bf16_t*)(p->ws + WS_E); bf16_t* O = (bf16_t*)(p->ws + WS_O);
    const int tid = otid(), row = tid >> 3, sub = tid & 7;
    for (int it = obid(); it < 4096; it += ogrid()) {
        const int h = it & 3, bi = it >> 2, i = bi & 31, b = bi >> 5;
        const size_t t0 = (size_t)bi * 64;
        __syncthreads();
        load_tile64(H + t0 * NH + C_AQ + h * 64, NH, Qs, 68, 0.125f, tid);
        if (tid < 257) bs[tid] = p->in[4][(size_t)(l * 4 + h) * 257 + tid];
        __syncthreads();
        float q[64], o[8];
#pragma unroll
        for (int d = 0; d < 64; d += 4) { const f32x4 t = *(const LAS f32x4*)(Qs + row * 68 + d); q[d] = t[0]; q[d + 1] = t[1]; q[d + 2] = t[2]; q[d + 3] = t[3]; }
#pragma unroll
        for (int e = 0; e < 8; ++e) o[e] = 0.f;
        float mx = -1e30f, ls = 0.f;
        const int kc0 = i > 8 ? i - 8 : 0;
        for (int kc = kc0; kc <= i; ++kc) {
            __syncthreads();
            const size_t tk = ((size_t)b * 32 + kc) * 64;
            load_tile64(H + tk * NH + C_AK + h * 64, NH, Ks, 68, 1.f, tid);
            load_tile64(H + tk * NH + C_AV + h * 64, NH, Vs, 68, 1.f, tid);
            __syncthreads();
            float s[8]; float cm = -1e30f;
#pragma unroll
            for (int jj = 0; jj < 8; ++jj) { const int key = sub + 8 * jj; float a = 0.f;
#pragma unroll
                for (int d = 0; d < 64; d += 4) { const f32x4 t = *(const LAS f32x4*)(Ks + key * 68 + d); a += q[d] * t[0] + q[d + 1] * t[1] + q[d + 2] * t[2] + q[d + 3] * t[3]; }
                int diff = (i - kc) * 64 + row - key; diff = diff > 128 ? 128 : diff;
                a += bs[diff + 128]; s[jj] = a; cm = fmaxf(cm, a); }
            cm = fmaxf(cm, __shfl_xor(cm, 1)); cm = fmaxf(cm, __shfl_xor(cm, 2)); cm = fmaxf(cm, __shfl_xor(cm, 4));
            const float mn = fmaxf(mx, cm), sc = __expf(mx - mn); mx = mn;
            float ps = 0.f;
#pragma unroll
            for (int jj = 0; jj < 8; ++jj) { const float pr = __expf(s[jj] - mn); ps += pr; Ps[row * 65 + sub + 8 * jj] = pr; }
            ps += __shfl_xor(ps, 1); ps += __shfl_xor(ps, 2); ps += __shfl_xor(ps, 4);
            ls = ls * sc + ps;
#pragma unroll
            for (int e = 0; e < 8; ++e) o[e] *= sc;
            asm volatile("s_waitcnt lgkmcnt(0)" ::: "memory");
#pragma unroll 8
            for (int key = 0; key < 64; ++key) { const float pr = Ps[row * 65 + key];
                const f32x4 v0 = *(const LAS f32x4*)(Vs + key * 68 + sub * 8), v1 = *(const LAS f32x4*)(Vs + key * 68 + sub * 8 + 4);
                o[0] += pr * v0[0]; o[1] += pr * v0[1]; o[2] += pr * v0[2]; o[3] += pr * v0[3]; o[4] += pr * v1[0]; o[5] += pr * v1[1]; o[6] += pr * v1[2]; o[7] += pr * v1[3]; }
        }
        const float inv = 1.f / ls;
#pragma unroll
        for (int e = 0; e < 8; ++e) o[e] *= inv;
        *(u32x4*)(O + (t0 + row) * DM + 256 + h * 64 + sub * 8) = pack8(o);
    }
}

typedef float f32x16 __attribute__((ext_vector_type(16)));
typedef short s16x4 __attribute__((ext_vector_type(4)));
__device__ __forceinline__ s16x4 lds_tr16(LAS const unsigned char* ptr) { return __builtin_bit_cast(s16x4, __builtin_amdgcn_ds_read_tr16_b64_v4i16((LAS s16x4*)ptr)); }
__device__ __forceinline__ bf16x8 scale_frag(u32x4 w, float sc) { float f[8]; unpack8(w, f);
    u32x4 o; o.x = pk2(f[0] * sc, f[1] * sc); o.y = pk2(f[2] * sc, f[3] * sc); o.z = pk2(f[4] * sc, f[5] * sc); o.w = pk2(f[6] * sc, f[7] * sc); return __builtin_bit_cast(bf16x8, o); }
__device__ __forceinline__ void attn_mfma(CPP p, int l, LAS unsigned char* lds) {
    const int tid = otid(), lane = tid & 63, wid = __builtin_amdgcn_readfirstlane(tid >> 6), r32 = lane & 31, hi = lane >> 5;
    const int h = wid >> 1, qh = wid & 1;
    LAS unsigned char* Vl = lds + wid * 17536;
    LAS unsigned char* stg = Vl;
    LAS float* bs = (LAS float*)(Vl + 16384);
    const bf16_t* H = (const bf16_t*)(p->ws + WS_E); bf16_t* O = (bf16_t*)(p->ws + WS_O);
    __syncthreads();
    for (int e = lane; e < 257; e += 64) bs[e] = p->in[4][(size_t)(l * 4 + h) * 257 + e];
    const float bfar = p->in[4][(size_t)(l * 4 + h) * 257 + 256];
#define ATT_VDMA(tk, buf) do { _Pragma("unroll") for (int c = 0; c < 8; ++c) \
        __builtin_amdgcn_global_load_lds((const unsigned*)(H + ((tk) + c * 8 + (lane >> 3)) * NH + C_AV + h * 64 + (lane & 7) * 8), (LAS unsigned*)(Vl + (buf) * 8192 + c * 1024), 16, 0, 0); } while (0)
    const int bidA = obid(), gridA = ogrid(); const bool xmap = (gridA == 256);
    for (int itk = 0; itk < (xmap ? 4 : (1024 - bidA + gridA - 1) / gridA); ++itk) {
        const int it = xmap ? ((((bidA & 7) * 4 + itk) << 5) | (bidA >> 3)) : bidA + itk * gridA;
        const int i = it & 31; const size_t t0 = (size_t)it * 64;
        bf16x8 qf[4];
#pragma unroll
        for (int t = 0; t < 4; ++t) qf[t] = scale_frag(*(const u32x4*)(H + (t0 + qh * 32 + r32) * NH + C_AQ + h * 64 + 16 * t + 8 * hi), 0.125f);
        const int kc0 = i > 8 ? i - 8 : 0;
        u32x4 kr[8], kn[8];
        asm volatile("s_waitcnt lgkmcnt(0)" ::: "memory");
        { const size_t tk = t0 - (size_t)(i - kc0) * 64;
#pragma unroll
            for (int t = 0; t < 4; ++t) { kn[t] = *(const u32x4*)(H + (tk + r32) * NH + C_AK + h * 64 + 16 * t + 8 * hi); kn[4 + t] = *(const u32x4*)(H + (tk + 32 + r32) * NH + C_AK + h * 64 + 16 * t + 8 * hi); }
            ATT_VDMA(tk, 0); }
        f32x16 o0, o1;
#pragma unroll
        for (int v = 0; v < 16; ++v) { o0[v] = 0.f; o1[v] = 0.f; }
        float mx = -1e30f, ls = 0.f;
        int cb = 0;
        for (int kc = kc0; kc <= i; ++kc) {
            const bool more = kc < i;
            asm volatile("s_waitcnt vmcnt(0)" ::: "memory");
#pragma unroll
            for (int c = 0; c < 8; ++c) kr[c] = kn[c];
            if (more) { const size_t tk = t0 - (size_t)(i - kc - 1) * 64;
#pragma unroll
                for (int t = 0; t < 4; ++t) { kn[t] = *(const u32x4*)(H + (tk + r32) * NH + C_AK + h * 64 + 16 * t + 8 * hi); kn[4 + t] = *(const u32x4*)(H + (tk + 32 + r32) * NH + C_AK + h * 64 + 16 * t + 8 * hi); }
                ATT_VDMA(tk, cb ^ 1); }
            f32x16 p0, p1;
#pragma unroll
            for (int v = 0; v < 16; ++v) { p0[v] = 0.f; p1[v] = 0.f; }
#pragma unroll
            for (int t = 0; t < 4; ++t) { p0 = __builtin_amdgcn_mfma_f32_32x32x16_f16(__builtin_bit_cast(half8_t, kr[t]), __builtin_bit_cast(half8_t, qf[t]), p0, 0, 0, 0);
                p1 = __builtin_amdgcn_mfma_f32_32x32x16_f16(__builtin_bit_cast(half8_t, kr[4 + t]), __builtin_bit_cast(half8_t, qf[t]), p1, 0, 0, 0); }
            const int dl = i - kc;
            if (dl >= 3) {
#pragma unroll
                for (int v = 0; v < 16; ++v) { p0[v] += bfar; p1[v] += bfar; }
            } else { const int base = dl * 64 + qh * 32 + r32 - 4 * hi + 128;
#pragma unroll
                for (int v = 0; v < 16; ++v) { const int kv = (v & 3) + 8 * (v >> 2); int d0 = base - kv, d1 = base - kv - 32; d0 = d0 > 256 ? 256 : d0; d1 = d1 > 256 ? 256 : d1;
                    p0[v] += bs[d0]; p1[v] += bs[d1]; } }
            float cm = fmaxf(p0[0], p1[0]);
#pragma unroll
            for (int v = 1; v < 16; ++v) cm = fmaxf(cm, fmaxf(p0[v], p1[v]));
            cm = fmaxf(cm, __shfl_xor(cm, 32));
            const float mn = fmaxf(mx, cm), al = __expf(mx - mn); mx = mn;
            float ps = 0.f;
#pragma unroll
            for (int v = 0; v < 16; ++v) { p0[v] = __expf(p0[v] - mn); p1[v] = __expf(p1[v] - mn); ps += p0[v] + p1[v]; }
            ls = ls * al + ps;
#pragma unroll
            for (int v = 0; v < 16; ++v) { o0[v] *= al; o1[v] *= al; }
            bf16x8 pb[4];
            { u32x4 w; w.x = cvt_pk_bf16(p0[0], p0[1]); w.y = cvt_pk_bf16(p0[2], p0[3]); w.z = cvt_pk_bf16(p0[4], p0[5]); w.w = cvt_pk_bf16(p0[6], p0[7]); pb[0] = __builtin_bit_cast(bf16x8, w);
              w.x = cvt_pk_bf16(p0[8], p0[9]); w.y = cvt_pk_bf16(p0[10], p0[11]); w.z = cvt_pk_bf16(p0[12], p0[13]); w.w = cvt_pk_bf16(p0[14], p0[15]); pb[1] = __builtin_bit_cast(bf16x8, w);
              w.x = cvt_pk_bf16(p1[0], p1[1]); w.y = cvt_pk_bf16(p1[2], p1[3]); w.z = cvt_pk_bf16(p1[4], p1[5]); w.w = cvt_pk_bf16(p1[6], p1[7]); pb[2] = __builtin_bit_cast(bf16x8, w);
              w.x = cvt_pk_bf16(p1[8], p1[9]); w.y = cvt_pk_bf16(p1[10], p1[11]); w.z = cvt_pk_bf16(p1[12], p1[13]); w.w = cvt_pk_bf16(p1[14], p1[15]); pb[3] = __builtin_bit_cast(bf16x8, w); }
            const LAS unsigned char* vb = Vl + cb * 8192 + (4 * hi + ((lane & 15) >> 2)) * 128 + ((lane >> 4) & 1) * 32 + (lane & 3) * 8;
#pragma unroll
            for (int ks = 0; ks < 4; ++ks) {
#pragma unroll
                for (int dh = 0; dh < 2; ++dh) { const s16x4 lo = lds_tr16(vb + ks * 2048 + dh * 64), hh = lds_tr16(vb + ks * 2048 + 1024 + dh * 64);
                    const bf16x8 va = (bf16x8){lo[0], lo[1], lo[2], lo[3], hh[0], hh[1], hh[2], hh[3]};
                    if (dh == 0) o0 = __builtin_amdgcn_mfma_f32_32x32x16_f16(__builtin_bit_cast(half8_t, va), __builtin_bit_cast(half8_t, pb[ks]), o0, 0, 0, 0); else o1 = __builtin_amdgcn_mfma_f32_32x32x16_f16(__builtin_bit_cast(half8_t, va), __builtin_bit_cast(half8_t, pb[ks]), o1, 0, 0, 0); } }
            cb ^= 1;
        }
        ls += __shfl_xor(ls, 32);
        const float inv = 1.f / ls;
        asm volatile("s_waitcnt lgkmcnt(0)" ::: "memory");
#pragma unroll
        for (int v = 0; v < 16; ++v) { const int d = (v & 3) + 8 * (v >> 2) + 4 * hi;
            *(LAS bf16_t*)(stg + r32 * 144 + d * 2) = (bf16_t)f2bf(o0[v] * inv); *(LAS bf16_t*)(stg + r32 * 144 + (32 + d) * 2) = (bf16_t)f2bf(o1[v] * inv); }
        asm volatile("s_waitcnt lgkmcnt(0)" ::: "memory");
#pragma unroll
        for (int c = 0; c < 4; ++c) { const int row = c * 8 + (lane >> 3), ch = lane & 7; const u32x4 w = *(const LAS u32x4*)(stg + row * 144 + ch * 16);
            *(u32x4*)(O + (t0 + qh * 32 + row) * DM + 256 + h * 64 + ch * 8) = w; }
    }
#undef ATT_VDMA
}

__device__ __forceinline__ f32x16 mma32(bf16x8 a, bf16x8 b, f32x16 c) { return __builtin_amdgcn_mfma_f32_32x32x16_f16(__builtin_bit_cast(half8_t, a), __builtin_bit_cast(half8_t, b), c, 0, 0, 0); }
__device__ __forceinline__ bf16x8 trfrag(LAS const unsigned char* a0, LAS const unsigned char* a1) { const s16x4 lo = lds_tr16(a0), hh = lds_tr16(a1); return (bf16x8){lo[0], lo[1], lo[2], lo[3], hh[0], hh[1], hh[2], hh[3]}; }
__device__ __forceinline__ f32x16 zero16() { f32x16 z;
#pragma unroll
    for (int v = 0; v < 16; ++v) z[v] = 0.f;
    return z; }
__device__ __forceinline__ void rot_frags(const bf16_t* xrow, const float* rrow, int hi, float sc, bf16x8& f0, bf16x8& f1) {
    const u32x4 w1 = *(const u32x4*)(xrow + 8 * hi), w2 = *(const u32x4*)(xrow + 16 + 8 * hi); float x1[8], x2[8]; unpack8(w1, x1); unpack8(w2, x2);
    const f32x4 c0 = *(const f32x4*)(rrow + 8 * hi), c1 = *(const f32x4*)(rrow + 8 * hi + 4), s0 = *(const f32x4*)(rrow + 16 + 8 * hi), s1 = *(const f32x4*)(rrow + 16 + 8 * hi + 4);
    float a[8], b[8];
#pragma unroll
    for (int e = 0; e < 8; ++e) { const float c = e < 4 ? c0[e & 3] : c1[e & 3], s = e < 4 ? s0[e & 3] : s1[e & 3]; a[e] = (x1[e] * c - x2[e] * s) * sc; b[e] = (x1[e] * s + x2[e] * c) * sc; }
    f0 = __builtin_bit_cast(bf16x8, pack8(a)); f1 = __builtin_bit_cast(bf16x8, pack8(b));
}
__device__ __forceinline__ float ret_logg(int h);

__device__ __forceinline__ void upd_mfma(CPP p, int l, LAS unsigned char* lds) {
    const int tid = otid(), lane = tid & 63, wid = __builtin_amdgcn_readfirstlane(tid >> 6), r32 = lane & 31, hi = lane >> 5, i16 = lane & 15;
    LAS unsigned char* kz = lds + wid * 17536;
    LAS unsigned char* vt = kz + 4096;
    LAS unsigned char* gas = kz + 12288;
    const bf16_t* H = (const bf16_t*)(p->ws + WS_E); const float* rot = (const float*)(p->ws + WS_ROT);
    float* RU = (float*)(p->ws + WS_RU); float* GU = (float*)(p->ws + WS_GU); float* GL = (float*)(p->ws + WS_GL);
    const int gw = obid() * 8 + wid, NGW = ogrid() * 8;
    __syncthreads();
    for (int it = gw; it < 8192; it += NGW) {
        const int gla = it >> 12, h = it & 3, bi = (it >> 2) & 1023, i = bi & 31; const size_t t0 = (size_t)bi * 64;
        asm volatile("s_waitcnt lgkmcnt(0)" ::: "memory");
        { const int vcol = (gla ? C_GV : C_RV) + h * 64;
#pragma unroll
            for (int c = 0; c < 8; ++c) __builtin_amdgcn_global_load_lds((const unsigned*)(H + (t0 + c * 8 + (lane >> 3)) * NH + vcol + (lane & 7) * 8), (LAS unsigned*)(vt + c * 1024), 16, 0, 0); }
        if (!gla) {
            const bf16_t* xr = H + (t0 + lane) * NH + C_RK + h * 32; const float* rr = rot + (size_t)(i * 64 + lane) * 32;
            const float sc = 0.17677669529663689f * __expf(ret_logg(h) * (float)(63 - lane));
            float x[32], cs[32], o[32];
#pragma unroll
            for (int c = 0; c < 4; ++c) unpack8(*(const u32x4*)(xr + 8 * c), x + 8 * c);
#pragma unroll
            for (int c = 0; c < 8; ++c) { const f32x4 t = *(const f32x4*)(rr + 4 * c); cs[4 * c] = t[0]; cs[4 * c + 1] = t[1]; cs[4 * c + 2] = t[2]; cs[4 * c + 3] = t[3]; }
#pragma unroll
            for (int f = 0; f < 16; ++f) { o[f] = (x[f] * cs[f] - x[f + 16] * cs[16 + f]) * sc; o[f + 16] = (x[f] * cs[16 + f] + x[f + 16] * cs[f]) * sc; }
#pragma unroll
            for (int c = 0; c < 4; ++c) *(LAS u32x4*)(kz + lane * 64 + c * 16) = pack8(o + 8 * c);
        } else {
#pragma unroll
            for (int c = 0; c < 4; ++c) __builtin_amdgcn_global_load_lds((const unsigned*)(H + (t0 + 16 * c + (lane >> 2)) * NH + C_GK + h * 32 + (lane & 3) * 8), (LAS unsigned*)(kz + c * 1024), 16, 0, 0);
#pragma unroll
            for (int c = 0; c < 2; ++c) *(LAS u32x4*)(gas + lane * 32 + c * 16) = *(const u32x4*)(H + (t0 + lane) * NH + C_GA + 8 * c);
            float wa[16];
#pragma unroll
            for (int r = 0; r < 16; ++r) wa[r] = p->in[2][(size_t)(l * 16 + r) * 128 + h * 32 + r32];
            const float ba = p->in[3][l * 128 + h * 32 + r32];
            asm volatile("s_waitcnt vmcnt(0) lgkmcnt(0)" ::: "memory");
            float cum[32]; float run = 0.f;
#pragma unroll
            for (int jj = 0; jj < 32; ++jj) { const int j = hi * 32 + jj; float g[16]; unpack8(*(const LAS u32x4*)(gas + j * 32), g); unpack8(*(const LAS u32x4*)(gas + j * 32 + 16), g + 8);
                float z = ba;
#pragma unroll
                for (int r = 0; r < 16; ++r) z += g[r] * wa[r];
                run += (fminf(z, 0.f) - log1pf(expf(-fabsf(z)))) * 0.0625f; cum[jj] = run; }
            const float tot0 = __shfl(run, r32), tot1 = __shfl(run, 32 + r32), last = tot0 + tot1, off = hi ? tot0 : 0.f;
#pragma unroll
            for (int jj = 0; jj < 32; ++jj) { const int j = hi * 32 + jj; LAS bf16_t* kp = (LAS bf16_t*)(kz + j * 64 + r32 * 2);
                *kp = (bf16_t)f2bf(bf2f(*kp) * __expf(last - (cum[jj] + off))); }
            if (hi == 0) GL[(size_t)(bi * 4 + h) * 32 + r32] = last;
        }
        asm volatile("s_waitcnt vmcnt(0) lgkmcnt(0)" ::: "memory");
        f32x16 a0 = zero16(), a1 = zero16();
        const LAS unsigned char* ka = kz + (8 * hi + (i16 >> 2)) * 64 + ((lane >> 4) & 1) * 32 + (i16 & 3) * 8;
        const LAS unsigned char* va = vt + (8 * hi + (i16 >> 2)) * 128 + ((lane >> 4) & 1) * 32 + (i16 & 3) * 8;
#pragma unroll
        for (int s = 0; s < 4; ++s) { const bf16x8 A = trfrag(ka + s * 1024, ka + s * 1024 + 256);
            const bf16x8 B0 = trfrag(va + s * 2048, va + s * 2048 + 512), B1 = trfrag(va + s * 2048 + 64, va + s * 2048 + 512 + 64);
            a0 = mma32(A, B0, a0); a1 = mma32(A, B1, a1); }
        float* dst = (gla ? GU : RU) + (size_t)(bi * 4 + h) * 2048;
#pragma unroll
        for (int v = 0; v < 16; ++v) { const int dk = (v & 3) + 8 * (v >> 2) + 4 * hi; dst[dk * 64 + r32] = a0[v]; dst[dk * 64 + 32 + r32] = a1[v]; }
    }
}

__device__ __forceinline__ void out_mfma(CPP p, int l, LAS unsigned char* lds) {
    const int tid = otid(), lane = tid & 63, wid = __builtin_amdgcn_readfirstlane(tid >> 6), r32 = lane & 31, hi = lane >> 5, i16 = lane & 15;
    const int h = wid >> 1, nh = wid & 1;
    LAS unsigned char* vt = lds + wid * 17536;
    LAS unsigned char* Rt = vt + 8192;
    LAS unsigned char* stg = vt;
    const bf16_t* H = (const bf16_t*)(p->ws + WS_E); const float* rot = (const float*)(p->ws + WS_ROT); bf16_t* O = (bf16_t*)(p->ws + WS_O);
    const float* RU = (const float*)(p->ws + WS_RU); const float* GU = (const float*)(p->ws + WS_GU);
    __syncthreads();
    for (int it = obid(); it < 2048; it += ogrid()) {
        const int gla = it >> 10, bi = it & 1023, i = bi & 31; const size_t t0 = (size_t)bi * 64; const int n = nh * 32 + r32;
        asm volatile("s_waitcnt lgkmcnt(0)" ::: "memory");
        { const float* src = (gla ? GU : RU) + (size_t)(bi * 4 + h) * 2048;
#pragma unroll
            for (int c = 0; c < 8; ++c) { const int idx = c * 256 + lane * 4; const f32x4 t = *(const f32x4*)(src + idx); u32x2 w; w.x = pk2(t[0], t[1]); w.y = pk2(t[2], t[3]);
                *(LAS u32x2*)(Rt + (idx >> 6) * 128 + (idx & 63) * 2) = w; } }
        f32x16 o0 = zero16(), o1 = zero16();
        const LAS unsigned char* ra = Rt + (8 * hi + (i16 >> 2)) * 128 + ((lane >> 4) & 1) * 32 + (i16 & 3) * 8;
        if (!gla) {
#pragma unroll
            for (int c = 0; c < 8; ++c) __builtin_amdgcn_global_load_lds((const unsigned*)(H + (t0 + c * 8 + (lane >> 3)) * NH + C_RV + h * 64 + (lane & 7) * 8), (LAS unsigned*)(vt + c * 1024), 16, 0, 0);
            const float lg = ret_logg(h);
            bf16x8 qf[2], kf0[2], kf1[2];
            rot_frags(H + (t0 + n) * NH + C_RQ + h * 32, rot + (size_t)(i * 64 + n) * 32, hi, 1.f, qf[0], qf[1]);
            rot_frags(H + (t0 + r32) * NH + C_RK + h * 32, rot + (size_t)(i * 64 + r32) * 32, hi, 0.17677669529663689f, kf0[0], kf0[1]);
            rot_frags(H + (t0 + 32 + r32) * NH + C_RK + h * 32, rot + (size_t)(i * 64 + 32 + r32) * 32, hi, 0.17677669529663689f, kf1[0], kf1[1]);
            f32x16 p0 = zero16(), p1 = zero16();
            p0 = mma32(kf0[0], qf[0], p0); p0 = mma32(kf0[1], qf[1], p0); p1 = mma32(kf1[0], qf[0], p1); p1 = mma32(kf1[1], qf[1], p1);
#pragma unroll
            for (int v = 0; v < 16; ++v) { const int m = (v & 3) + 8 * (v >> 2) + 4 * hi; const int d0 = n - m, d1 = n - m - 32;
                p0[v] *= __expf(lg * (float)(d0 < 0 ? -d0 : d0)); p1[v] *= __expf(lg * (float)(d1 < 0 ? -d1 : d1)); }
            bf16x8 pb[4];
            { u32x4 w; w.x = pk2(p0[0], p0[1]); w.y = pk2(p0[2], p0[3]); w.z = pk2(p0[4], p0[5]); w.w = pk2(p0[6], p0[7]); pb[0] = __builtin_bit_cast(bf16x8, w);
              w.x = pk2(p0[8], p0[9]); w.y = pk2(p0[10], p0[11]); w.z = pk2(p0[12], p0[13]); w.w = pk2(p0[14], p0[15]); pb[1] = __builtin_bit_cast(bf16x8, w);
              w.x = pk2(p1[0], p1[1]); w.y = pk2(p1[2], p1[3]); w.z = pk2(p1[4], p1[5]); w.w = pk2(p1[6], p1[7]); pb[2] = __builtin_bit_cast(bf16x8, w);
              w.x = pk2(p1[8], p1[9]); w.y = pk2(p1[10], p1[11]); w.z = pk2(p1[12], p1[13]); w.w = pk2(p1[14], p1[15]); pb[3] = __builtin_bit_cast(bf16x8, w); }
            asm volatile("s_waitcnt vmcnt(0) lgkmcnt(0)" ::: "memory");
            const LAS unsigned char* vb = vt + (4 * hi + (i16 >> 2)) * 128 + ((lane >> 4) & 1) * 32 + (i16 & 3) * 8;
#pragma unroll
            for (int ks = 0; ks < 4; ++ks) { o0 = mma32(trfrag(vb + ks * 2048, vb + ks * 2048 + 1024), pb[ks], o0); o1 = mma32(trfrag(vb + ks * 2048 + 64, vb + ks * 2048 + 1024 + 64), pb[ks], o1); }
            const float xi = __expf(lg * (float)(n + 1));
#pragma unroll
            for (int s = 0; s < 2; ++s) { const bf16x8 qx = scale_frag(__builtin_bit_cast(u32x4, qf[s]), xi);
                o0 = mma32(trfrag(ra + s * 2048, ra + s * 2048 + 512), qx, o0); o1 = mma32(trfrag(ra + s * 2048 + 64, ra + s * 2048 + 512 + 64), qx, o1); }
        } else {
            bf16x8 qf[2];
#pragma unroll
            for (int s = 0; s < 2; ++s) qf[s] = scale_frag(*(const u32x4*)(H + (t0 + n) * NH + C_GQ + h * 32 + 16 * s + 8 * hi), 0.17677669529663689f);
            asm volatile("s_waitcnt lgkmcnt(0)" ::: "memory");
#pragma unroll
            for (int s = 0; s < 2; ++s) { o0 = mma32(trfrag(ra + s * 2048, ra + s * 2048 + 512), qf[s], o0); o1 = mma32(trfrag(ra + s * 2048 + 64, ra + s * 2048 + 512 + 64), qf[s], o1); }
        }
        float s = 0.f;
#pragma unroll
        for (int v = 0; v < 16; ++v) s += o0[v] + o1[v];
        s += __shfl_xor(s, 32);
        const float mean = s * (1.f / 64.f); float s2 = 0.f;
#pragma unroll
        for (int v = 0; v < 16; ++v) { o0[v] -= mean; o1[v] -= mean; s2 += o0[v] * o0[v] + o1[v] * o1[v]; }
        s2 += __shfl_xor(s2, 32);
        const float rs = 1.f / sqrtf(s2 * (1.f / 64.f) + LN_EPS);
        asm volatile("s_waitcnt lgkmcnt(0)" ::: "memory");
#pragma unroll
        for (int v = 0; v < 16; ++v) { const int d = (v & 3) + 8 * (v >> 2) + 4 * hi;
            *(LAS bf16_t*)(stg + r32 * 144 + d * 2) = (bf16_t)f2bf(o0[v] * rs); *(LAS bf16_t*)(stg + r32 * 144 + (32 + d) * 2) = (bf16_t)f2bf(o1[v] * rs); }
        asm volatile("s_waitcnt lgkmcnt(0)" ::: "memory");
#pragma unroll
        for (int c = 0; c < 4; ++c) { const int row = c * 8 + (lane >> 3), ch = lane & 7; float f[8], g[8]; unpack8(*(const LAS u32x4*)(stg + row * 144 + ch * 16), f);
            unpack8(*(const u32x4*)(H + (t0 + nh * 32 + row) * NH + (gla ? C_GR : C_RG) + h * 64 + ch * 8), g);
#pragma unroll
            for (int e = 0; e < 8; ++e) f[e] *= silu_f(g[e]);
            *(u32x4*)(O + (t0 + nh * 32 + row) * DM + (gla ? 512 : 0) + h * 64 + ch * 8) = pack8(f); }
    }
}

__device__ __forceinline__ void load_rot(const bf16_t* src, const float* rot, int i, LAS float* dst, float scale, float logz, int tid) {
#pragma unroll
    for (int q = 0; q < 2; ++q) { const int idx = tid + 512 * q, j = idx >> 4, f = idx & 15;
        const float x1 = bf2f(src[(size_t)j * NH + f]), x2 = bf2f(src[(size_t)j * NH + f + 16]);
        const int pos = i * 64 + j; const float c = rot[pos * 32 + f], s = rot[pos * 32 + 16 + f];
        const float sc = scale * __expf(logz * (float)(63 - j));
        dst[j * 33 + f] = (x1 * c - x2 * s) * sc; dst[j * 33 + f + 16] = (x1 * s + x2 * c) * sc; }
}
__device__ __forceinline__ float ret_logg(int h) { return log1pf(-exp2f(-5.f - (float)h)); }

__device__ __forceinline__ void upd_items(CPP p, int l, LAS unsigned char* lds) {
    LAS float* kt = (LAS float*)lds; LAS float* vv = kt + 64 * 33; LAS float* la = vv + 64 * 68; LAS float* gas = la + 64 * 33; LAS float* was = gas + 1024; LAS float* bas = was + 512;
    const bf16_t* H = (const bf16_t*)(p->ws + WS_E); const float* rot = (const float*)(p->ws + WS_ROT);
    float* RU = (float*)(p->ws + WS_RU); float* GU = (float*)(p->ws + WS_GU); float* GL = (float*)(p->ws + WS_GL);
    const int tid = otid();
    for (int it = obid(); it < 8192; it += ogrid()) {
        const int gla = it >> 12, h = it & 3, bi = (it >> 2) & 1023, i = bi & 31;
        const size_t t0 = (size_t)bi * 64;
        __syncthreads();
        if (!gla) {
            load_rot(H + t0 * NH + C_RK + h * 32, rot, i, kt, 0.17677669529663689f, ret_logg(h), tid);
            load_tile64(H + t0 * NH + C_RV + h * 64, NH, vv, 68, 1.f, tid);
            __syncthreads();
        } else {
            if (tid < 128) { const int j = tid >> 1, c = (tid & 1) * 8; const u32x4 w = *(const u32x4*)(H + (t0 + j) * NH + C_GA + c); float f[8]; unpack8(w, f);
#pragma unroll
                for (int e = 0; e < 8; ++e) gas[j * 16 + c + e] = f[e]; }
            { const int r = tid >> 5, dk = tid & 31; was[tid] = p->in[2][(size_t)(l * 16 + r) * 128 + h * 32 + dk]; }
            if (tid < 32) bas[tid] = p->in[3][l * 128 + h * 32 + tid];
            { const int idx = tid * 4, j = idx >> 5, c = idx & 31; const u32x2 w = *(const u32x2*)(H + (t0 + j) * NH + C_GK + h * 32 + c);
                kt[j * 33 + c] = bflo(w.x); kt[j * 33 + c + 1] = bfhi(w.x); kt[j * 33 + c + 2] = bflo(w.y); kt[j * 33 + c + 3] = bfhi(w.y); }
            load_tile64(H + t0 * NH + C_GV + h * 64, NH, vv, 68, 1.f, tid);
            __syncthreads();
#pragma unroll
            for (int q = 0; q < 4; ++q) { const int e = tid + 512 * q, j = e >> 5, dk = e & 31; float z = bas[dk];
#pragma unroll
                for (int r = 0; r < 16; ++r) z += gas[j * 16 + r] * was[r * 32 + dk];
                const float lsg = fminf(z, 0.f) - log1pf(expf(-fabsf(z)));
                la[j * 33 + dk] = lsg * 0.0625f; }
            __syncthreads();
            if (tid < 32) { float run = 0.f; for (int j = 0; j < 64; ++j) { run += la[j * 33 + tid]; la[j * 33 + tid] = run; } }
            __syncthreads();
#pragma unroll
            for (int q = 0; q < 4; ++q) { const int e = tid + 512 * q, j = e >> 5, dk = e & 31; kt[j * 33 + dk] *= __expf(la[63 * 33 + dk] - la[j * 33 + dk]); }
            if (tid < 32) GL[(size_t)(bi * 4 + h) * 32 + tid] = la[63 * 33 + tid];
            __syncthreads();
        }
        const int dk = tid >> 4, dv0 = (tid & 15) * 4; f32x4 a = (f32x4){0.f, 0.f, 0.f, 0.f};
#pragma unroll 8
        for (int j = 0; j < 64; ++j) { const float kk = kt[j * 33 + dk]; const f32x4 v4 = *(const LAS f32x4*)(vv + j * 68 + dv0); a += v4 * kk; }
        float* dst = (gla ? GU : RU) + (size_t)(bi * 4 + h) * 2048 + dk * 64 + dv0;
        *(f32x4*)dst = a;
    }
}

__device__ __forceinline__ void scan_items(CPP p, int l) {
    float* RU = (float*)(p->ws + WS_RU); float* GU = (float*)(p->ws + WS_GU); const float* GL = (const float*)(p->ws + WS_GL);
    const float* ES = (const float*)(p->ws + WS_ES); bf16_t* U2 = (bf16_t*)(p->ws + WS_U2);
    const int gt = obid() * 512 + otid(), NT = ogrid() * 512;
    for (int e = gt; e < 262144; e += NT) { const int dvk = e & 2047, bh = e >> 11, h = bh & 3, b = bh >> 2;
        const float dec = expf(64.f * ret_logg(h)); float st = 0.f; float t[32];
        float* base = RU + (size_t)(b * 32 * 4 + h) * 2048 + dvk;
#pragma unroll
        for (int i = 0; i < 32; ++i) t[i] = base[(size_t)i * 8192];
#pragma unroll
        for (int i = 0; i < 32; ++i) { base[(size_t)i * 8192] = st; st = st * dec + t[i]; } }
    for (int e = gt; e < 262144; e += NT) { const int dvk = e & 2047, bh = e >> 11, h = bh & 3, b = bh >> 2; float st = 0.f; float t[32], gl[32];
        float* base = GU + (size_t)(b * 32 * 4 + h) * 2048 + dvk; const float* gb = GL + (size_t)(b * 32 * 4 + h) * 32 + (dvk >> 6);
#pragma unroll
        for (int i = 0; i < 32; ++i) { t[i] = base[(size_t)i * 8192]; gl[i] = gb[i * 128]; }
#pragma unroll
        for (int i = 0; i < 32; ++i) { st = __expf(gl[i]) * st + t[i]; base[(size_t)i * 8192] = st; } }
    for (int e = gt; e < 32768; e += NT) { const int pp = e & 63, g = (e >> 6) & 15, b = e >> 10; const int gp = (l * 16 + g) * 64 + pp;
        const float lr = p->in[5][gp], li = p->in[6][gp], dt = expf(p->in[7][l * 16 + g]);
        float ar, ai2; s5_abar_pow(lr, li, dt, 64, ar, ai2);
        float xr = 0.f, xi = 0.f; float er[32], ei[32];
        const size_t row0 = (size_t)g * 1024 + b * 32;
#pragma unroll
        for (int i = 0; i < 32; ++i) { er[i] = ES[(row0 + i) * 128 + pp]; ei[i] = ES[(row0 + i) * 128 + 64 + pp]; }
#pragma unroll
        for (int i = 0; i < 32; ++i) { U2[(row0 + i) * S5K + 1024 + pp] = (bf16_t)f2bf(xr); U2[(row0 + i) * S5K + 1088 + pp] = (bf16_t)f2bf(xi);
            const float nr = ar * xr - ai2 * xi + er[i], ni = ar * xi + ai2 * xr + ei[i]; xr = nr; xi = ni; } }
}

__device__ __forceinline__ void out_items(CPP p, int l, LAS unsigned char* lds) {
    LAS float* qt = (LAS float*)lds; LAS float* kt = qt + 64 * 33; LAS float* vv = kt + 64 * 33; LAS float* Sm = vv + 64 * 68; LAS float* Rm = Sm + 64 * 65;
    const bf16_t* H = (const bf16_t*)(p->ws + WS_E); const float* rot = (const float*)(p->ws + WS_ROT); bf16_t* O = (bf16_t*)(p->ws + WS_O);
    const float* RU = (const float*)(p->ws + WS_RU); const float* GU = (const float*)(p->ws + WS_GU);
    const int tid = otid();
    for (int it = obid(); it < 8192; it += ogrid()) {
        const int gla = it >> 12, h = it & 3, bi = (it >> 2) & 1023, i = bi & 31;
        const size_t t0 = (size_t)bi * 64;
        const int n = tid >> 3, dv0 = (tid & 7) * 8;
        float acc[8];
#pragma unroll
        for (int e = 0; e < 8; ++e) acc[e] = 0.f;
        __syncthreads();
        { const float* src = (gla ? GU : RU) + (size_t)(bi * 4 + h) * 2048; const int idx = tid * 4, dk = idx >> 6, dv = idx & 63;
            const f32x4 t = *(const f32x4*)(src + idx); Rm[dk * 68 + dv] = t[0]; Rm[dk * 68 + dv + 1] = t[1]; Rm[dk * 68 + dv + 2] = t[2]; Rm[dk * 68 + dv + 3] = t[3]; }
        if (!gla) {
            const float lg = ret_logg(h);
            load_rot(H + t0 * NH + C_RQ + h * 32, rot, i, qt, 1.f, 0.f, tid);
            load_rot(H + t0 * NH + C_RK + h * 32, rot, i, kt, 0.17677669529663689f, 0.f, tid);
            load_tile64(H + t0 * NH + C_RV + h * 64, NH, vv, 68, 1.f, tid);
            __syncthreads();
            { const int m0 = (tid & 7) * 8;
#pragma unroll
                for (int mm = 0; mm < 8; ++mm) { const int m = m0 + mm; float d = 0.f;
#pragma unroll
                    for (int dk = 0; dk < 32; ++dk) d += qt[n * 33 + dk] * kt[m * 33 + dk];
                    const int ad = n > m ? n - m : m - n; Sm[n * 65 + m] = d * __expf(lg * (float)ad); } }
            __syncthreads();
#pragma unroll 4
            for (int m = 0; m < 64; ++m) { const float sv = Sm[n * 65 + m]; const f32x4 v0 = *(const LAS f32x4*)(vv + m * 68 + dv0), v1 = *(const LAS f32x4*)(vv + m * 68 + dv0 + 4);
                acc[0] += sv * v0[0]; acc[1] += sv * v0[1]; acc[2] += sv * v0[2]; acc[3] += sv * v0[3]; acc[4] += sv * v1[0]; acc[5] += sv * v1[1]; acc[6] += sv * v1[2]; acc[7] += sv * v1[3]; }
            const float xi = __expf(lg * (float)(n + 1));
#pragma unroll 4
            for (int dk = 0; dk < 32; ++dk) { const float qx = qt[n * 33 + dk] * xi; const f32x4 v0 = *(const LAS f32x4*)(Rm + dk * 68 + dv0), v1 = *(const LAS f32x4*)(Rm + dk * 68 + dv0 + 4);
                acc[0] += qx * v0[0]; acc[1] += qx * v0[1]; acc[2] += qx * v0[2]; acc[3] += qx * v0[3]; acc[4] += qx * v1[0]; acc[5] += qx * v1[1]; acc[6] += qx * v1[2]; acc[7] += qx * v1[3]; }
        } else {
            { const int idx = tid * 4, j = idx >> 5, c = idx & 31; const u32x2 w = *(const u32x2*)(H + (t0 + j) * NH + C_GQ + h * 32 + c); const float sc = 0.17677669529663689f;
                qt[j * 33 + c] = bflo(w.x) * sc; qt[j * 33 + c + 1] = bfhi(w.x) * sc; qt[j * 33 + c + 2] = bflo(w.y) * sc; qt[j * 33 + c + 3] = bfhi(w.y) * sc; }
            __syncthreads();
#pragma unroll 4
            for (int dk = 0; dk < 32; ++dk) { const float qx = qt[n * 33 + dk]; const f32x4 v0 = *(const LAS f32x4*)(Rm + dk * 68 + dv0), v1 = *(const LAS f32x4*)(Rm + dk * 68 + dv0 + 4);
                acc[0] += qx * v0[0]; acc[1] += qx * v0[1]; acc[2] += qx * v0[2]; acc[3] += qx * v0[3]; acc[4] += qx * v1[0]; acc[5] += qx * v1[1]; acc[6] += qx * v1[2]; acc[7] += qx * v1[3]; }
        }
        float s = 0.f;
#pragma unroll
        for (int e = 0; e < 8; ++e) s += acc[e];
        s += __shfl_xor(s, 1); s += __shfl_xor(s, 2); s += __shfl_xor(s, 4);
        const float mean = s * (1.f / 64.f); float s2 = 0.f;
#pragma unroll
        for (int e = 0; e < 8; ++e) { acc[e] -= mean; s2 += acc[e] * acc[e]; }
        s2 += __shfl_xor(s2, 1); s2 += __shfl_xor(s2, 2); s2 += __shfl_xor(s2, 4);
        const float rs = 1.f / sqrtf(s2 * (1.f / 64.f) + LN_EPS);
        const u32x4 gw = *(const u32x4*)(H + (t0 + n) * NH + (gla ? C_GR : C_RG) + h * 64 + dv0); float gf[8]; unpack8(gw, gf);
        float ov[8];
#pragma unroll
        for (int e = 0; e < 8; ++e) ov[e] = silu_f(gf[e]) * acc[e] * rs;
        *(u32x4*)(O + (t0 + n) * DM + (gla ? 512 : 0) + h * 64 + dv0) = pack8(ov);
    }
}


#define XB_TMO      128
#define XB_XCNT(j)  (256  + 64 * (j))
#define XB_XSUB(j)  (1280 + 64 * (j))
#define XB_XGEN(j)  (2304 + 64 * (j))
#define XB_TOP      3328
#define XB_TOPGEN   3392
#define XCD_BAR_WORDS 3456
#define XB_SPIN_CAP (1u << 20)
__device__ __forceinline__ unsigned xb_ld(unsigned* p)              { return __hip_atomic_load(p, __ATOMIC_RELAXED, __HIP_MEMORY_SCOPE_AGENT); }
__device__ __forceinline__ unsigned xb_add(unsigned* p, unsigned v) { return __hip_atomic_fetch_add(p, v, __ATOMIC_RELAXED, __HIP_MEMORY_SCOPE_AGENT); }
__device__ __forceinline__ unsigned xb_xcc_id() { return (unsigned)__builtin_amdgcn_s_getreg((3 << 11) | 20) & 0xFu; }
#define XB_SPIN(cond, bar) do { unsigned _sp = 0; while (cond) { __builtin_amdgcn_s_sleep(1); \
    if ((++_sp & 255u) == 0u) { if (xb_ld(&(bar)[XB_TMO])) break; if (_sp > XB_SPIN_CAP) { atomicAdd(&(bar)[XB_TMO], 1u); break; } } } } while (0)
struct XcdBarrier { unsigned* bar; unsigned x; volatile LAS unsigned* st; };
__device__ __forceinline__ XcdBarrier xcd_barrier_post(unsigned* bar, volatile LAS unsigned* st) {
    XcdBarrier b; b.bar = bar; b.x = xb_xcc_id(); b.st = st;
    if (threadIdx.x == 0) (void)xb_add(&bar[XB_XCNT(b.x)], 1u);
    return b;
}
__device__ __forceinline__ void xcd_barrier_complete(unsigned* bar, unsigned x, unsigned& nloc, unsigned& nx) {
    const unsigned G = gridDim.x * gridDim.y * gridDim.z;
    unsigned sum, cnt, mine, sp = 0u;
    for (;;) {
        sum = 0u; cnt = 0u; mine = 0u;
#pragma unroll
        for (unsigned j = 0; j < 16; ++j) { const unsigned c = xb_ld(&bar[XB_XCNT(j)]); sum += c; cnt += (c > 0u) ? 1u : 0u; mine = (j == x) ? c : mine; }
        if (sum == G) break;
        __builtin_amdgcn_s_sleep(1);
        if ((++sp & 255u) == 0u) { if (xb_ld(&bar[XB_TMO])) break; if (sp > XB_SPIN_CAP) { atomicAdd(&bar[XB_TMO], 1u); break; } }
    }
    nloc = mine > 0u ? mine : 1u; nx = cnt > 0u ? cnt : 1u;
}
__device__ __forceinline__ void xcd_barrier(const XcdBarrier& b) {
    asm volatile("s_waitcnt vmcnt(0)" ::: "memory");
    __syncthreads();
    if (threadIdx.x == 0) {
        unsigned* bar = b.bar;
        __builtin_amdgcn_s_waitcnt(0);
        unsigned nloc = b.st[0], nx = b.st[1];
        if (nloc == 0u) { xcd_barrier_complete(bar, b.x, nloc, nx); b.st[0] = nloc; b.st[1] = nx; }
        const unsigned old = xb_add(&bar[XB_XSUB(b.x)], 1u);
        const unsigned gen = old / nloc;
        if (old + 1u == (gen + 1u) * nloc) {
            __builtin_amdgcn_fence(__ATOMIC_RELEASE, "agent");
            asm volatile("s_waitcnt vmcnt(0)" ::: "memory");
            const unsigned og = xb_add(&bar[XB_TOP], 1u);
            const unsigned tg = og / nx;
            if (og + 1u == (tg + 1u) * nx) xb_add(&bar[XB_TOPGEN], 1u);
            else XB_SPIN(xb_ld(&bar[XB_TOPGEN]) == tg, bar);
            __builtin_amdgcn_fence(__ATOMIC_ACQUIRE, "agent");
            xb_add(&bar[XB_XGEN(b.x)], 1u);
            asm volatile("s_waitcnt vmcnt(0)" ::: "memory");
        } else {
            XB_SPIN(xb_ld(&bar[XB_XGEN(b.x)]) == gen, bar);
            __builtin_amdgcn_fence(__ATOMIC_ACQUIRE, "agent");
            asm volatile("s_waitcnt vmcnt(0)" ::: "memory");
        }
    }
    __syncthreads();
}

__global__ void __launch_bounds__(512, 2) mega(Params p_unused) {
    extern __shared__ __attribute__((aligned(16))) unsigned char lds_raw[];
    LAS unsigned char* lds = (LAS unsigned char*)lds_raw;
    cg::grid_group grid = cg::this_grid();
    CPP p = (CPP)__builtin_amdgcn_kernarg_segment_ptr();
    unsigned char* ws = p->ws;
    bf16_t* XB = (bf16_t*)(ws + WS_XB);
    volatile LAS unsigned* bst = (volatile LAS unsigned*)(lds + LDS_BYTES - 64);
    if (threadIdx.x < 2) bst[threadIdx.x] = 0u;
    __syncthreads();
    const XcdBarrier bar = xcd_barrier_post((unsigned*)ws, bst);

    { float* rot = (float*)(ws + WS_ROT); const int gt = obid() * 512 + otid(), NT = ogrid() * 512;
        for (int e = gt; e < 2048 * 16; e += NT) { const int pos = e >> 4, f = e & 15; const float inv = 1.0f / powf(10000.0f, (float)f * (1.0f / 16.0f)); const float ang = (float)pos * inv;
            rot[pos * 32 + f] = cosf(ang); rot[pos * 32 + 16 + f] = sinf(ang); } }
    s5_tables(p, 0, lds);
    { const float* x = p->in[0]; const int gt = obid() * 512 + otid(), NT = ogrid() * 512;
        for (size_t e = gt; e < (size_t)M * DM / 8; e += NT) { const f32x4 a = *((const f32x4*)x + 2 * e), b = *((const f32x4*)x + 2 * e + 1);
            u32x4 w; w.x = pk2(a[0], a[1]); w.y = pk2(a[2], a[3]); w.z = pk2(b[0], b[1]); w.w = pk2(b[2], b[3]); *((u32x4*)XB + e) = w; } }
    grid.sync();
    convert_weights(p, 0, lds);
    xcd_barrier(bar);

    for (int l = 0; l < 4; ++l) {
        for (int s = 0; s < 12; ++s) {
            p = (CPP)__builtin_amdgcn_kernarg_segment_ptr(); asm volatile("" : "+s"(p));
            pg8::Gemm g; pg8::Sched S; pg8::Epi E;
            bool do_gemm = true;
            S.G = ogrid(); S.c = obid(); S.mode = 0; S.nM = M / 256; S.nN = 1;
            E.mode = 0; E.perm = true;
            E.ws = ws; E.dskip = p->in[12] + l * 256; E.bglu = p->in[14] + l * 256; E.bgate = p->in[16] + (size_t)l * 4096;
            g.A = XB; g.Bt = (const bf16_t*)(ws + WS_WIN); g.lda = DM; g.ldb = DM; g.K = DM;
            switch (s) {
                case 0: S.nN = NINP / 256; E.mode = 0; E.perm = true; break;
                case 1: g.A = (const bf16_t*)(ws + WS_U2); g.Bt = (const bf16_t*)(ws + WS_WE); g.lda = S5K; g.ldb = 1024; g.K = 1024; S.mode = 2; S.nM = 64; S.nN = 1; E.mode = 1; break;
                case 3: g.A = (const bf16_t*)(ws + WS_U2); g.Bt = (const bf16_t*)(ws + WS_WT); g.lda = S5K; g.ldb = S5K; g.K = S5K; S.mode = 3; S.nM = 64; S.nN = 4; E.mode = 2; break;
                case 4: g.A = (const bf16_t*)(ws + WS_YS); g.Bt = (const bf16_t*)(ws + WS_WGLU); g.lda = 256; g.ldb = 256; g.K = 256; S.nN = 1; E.mode = 3; break;
                case 5: g.A = (const bf16_t*)(ws + WS_O); g.Bt = (const bf16_t*)(ws + WS_WB); g.lda = DM; g.ldb = 256; g.K = 256; S.mode = 1; S.nN = 16; E.mode = 4; break;
                case 6: g.Bt = (const bf16_t*)(ws + WS_WG); S.nN = 16; E.mode = 5; E.perm = false; break;
                case 7: g.A = (const bf16_t*)(ws + WS_O); g.Bt = (const bf16_t*)(ws + WS_WO); S.nN = 4; E.mode = 6; E.perm = false; break;
                case 9: g.Bt = (const bf16_t*)(ws + WS_WFF); S.nN = 22; E.mode = 7; E.perm = false; break;
                case 10: g.A = (const bf16_t*)(ws + WS_E); g.Bt = (const bf16_t*)(ws + WS_WD); g.lda = DFF; g.ldb = DFF; g.K = DFF; S.nN = 4; E.mode = 6; E.perm = false; break;
                default: do_gemm = false; break;
            }
            S.nwg = S.nM * S.nN;
            if (do_gemm) pg8::gemm_phase(lds, g, S, E);
            if (s == 1) { attn_mfma(p, l, lds); upd_mfma(p, l, lds); }
            else if (s == 2) scan_items(p, l);
            else if (s == 3) out_mfma(p, l, lds);
            else if (s == 8) { ln_pass(XB, nullptr, p->in[19] + l * DM, p->in[20] + l * DM); if (l < 3) s5_tables(p, l + 1, lds); }
            else if (s == 11) { ln_pass(XB, (l == 3) ? p->out : nullptr, p->in[24] + l * DM, p->in[25] + l * DM); if (l < 3) convert_weights(p, l + 1, lds); }
            xcd_barrier(bar);
        }
    }
}

extern "C" void kernel_launch(void* const* d_in, const int* in_sizes, int n_in, void* d_out, int out_size, void* d_ws, size_t ws_size, hipStream_t stream) {
    static int grid_blocks = 0;
    if (!grid_blocks) {
        int dev = 0, cus = 0;
        hipGetDevice(&dev);
        hipDeviceGetAttribute(&cus, hipDeviceAttributeMultiprocessorCount, dev);
        hipFuncSetAttribute((const void*)mega, hipFuncAttributeMaxDynamicSharedMemorySize, LDS_BYTES);
        grid_blocks = cus > 0 ? cus : 256;
    }
    (void)hipMemsetAsync(d_ws, 0, 65536, stream);
    Params p{};
    for (int i = 0; i < 26; ++i) p.in[i] = (const float*)d_in[i];
    p.out = (float*)d_out; p.ws = (unsigned char*)d_ws;
    void* args[] = {&p};
    hipError_t e = hipLaunchCooperativeKernel((const void*)mega, dim3(grid_blocks), dim3(512), args, LDS_BYTES, stream);
    if (e != hipSuccess) fprintf(stderr, "cooperative launch failed: %s (grid %d)\n", hipGetErrorString(e), grid_blocks);
}
```

```cpp
#include <hip/hip_runtime.h>
#include <hip/hip_cooperative_groups.h>
#include <cstdint>
#include <cstdio>
namespace cg = cooperative_groups;

#define LAS __attribute__((address_space(3)))
typedef unsigned short bf16_t;
typedef short bf16x8 __attribute__((ext_vector_type(8)));
typedef float f32x4 __attribute__((ext_vector_type(4)));
typedef float f32x2 __attribute__((ext_vector_type(2)));
typedef unsigned u32x4 __attribute__((ext_vector_type(4)));
typedef unsigned u32x2 __attribute__((ext_vector_type(2)));

constexpr int M = 65536, DM = 1024, SEQ = 2048, NCH = 32;
constexpr int NH = 2320;
constexpr int NINP = 2816;
constexpr int DFF = 2816;
constexpr int S5K = 1152;
constexpr float ALPHA = 1.681792830507429f;
constexpr float LN_EPS = 1e-5f;
constexpr int C_RQ = 0, C_RK = 128, C_RV = 256, C_RG = 512, C_AQ = 768, C_AK = 1024, C_AV = 1280, C_GQ = 1536, C_GK = 1664, C_GV = 1792, C_GR = 2048, C_GA = 2304, C_SU = 2320;

constexpr size_t MiB = 1u << 20;
constexpr size_t WS_ROT = 1 * MiB;
constexpr size_t WS_KN = 2 * MiB;
constexpr size_t WS_WIN = 4 * MiB;
constexpr size_t WS_WG = 10 * MiB;
constexpr size_t WS_WB = 18 * MiB;
constexpr size_t WS_WO = 20 * MiB;
constexpr size_t WS_WFF = 22 * MiB;
constexpr size_t WS_WD = 33 * MiB;
constexpr size_t WS_WGLU = 39 * MiB;
constexpr size_t WS_WE = 40 * MiB;
constexpr size_t WS_WT = 48 * MiB;
constexpr size_t WS_XB = 88 * MiB;
constexpr size_t WS_O = 216 * MiB;
constexpr size_t WS_E = 344 * MiB;
constexpr size_t WS_U2 = 636 * MiB;
constexpr size_t WS_RU = 676 * MiB;
constexpr size_t WS_GU = 708 * MiB;
constexpr size_t WS_GL = 740 * MiB;
constexpr size_t WS_ES = 741 * MiB;
constexpr size_t WS_YS = 749 * MiB;
constexpr int LDS_BYTES = 147456;

struct Params { const float* in[26]; float* out; unsigned char* ws; };
typedef const __attribute__((address_space(4))) Params* CPP;

typedef _Float16 half2_t __attribute__((ext_vector_type(2)));
typedef _Float16 half8_t __attribute__((ext_vector_type(8)));
__device__ __forceinline__ float bflo(unsigned w) { return (float)__builtin_bit_cast(half2_t, w)[0]; }
__device__ __forceinline__ float bfhi(unsigned w) { return (float)__builtin_bit_cast(half2_t, w)[1]; }
__device__ __forceinline__ float bf2f(bf16_t b) { return (float)__builtin_bit_cast(_Float16, b); }
__device__ __forceinline__ unsigned f2bf(float f) { return (unsigned)__builtin_bit_cast(unsigned short, (_Float16)f); }
__device__ __forceinline__ unsigned pk2(float lo, float hi) { const half2_t v = {(_Float16)lo, (_Float16)hi}; return __builtin_bit_cast(unsigned, v); }
__device__ __forceinline__ unsigned cvt_pk_bf16(float lo, float hi) { return pk2(lo, hi); }
__device__ __forceinline__ float sigm(float x) { return __builtin_amdgcn_rcpf(1.0f + __expf(-x)); }
__device__ __forceinline__ float silu_f(float x) { return x * sigm(x); }
__device__ __forceinline__ float gelu_tanh(float v) { return v * sigm(1.5957691216057308f * (v + 0.044715f * v * v * v)); }
__device__ __forceinline__ void unpack8(u32x4 w, float* o) {
    o[0] = bflo(w.x); o[1] = bfhi(w.x); o[2] = bflo(w.y); o[3] = bfhi(w.y); o[4] = bflo(w.z); o[5] = bfhi(w.z); o[6] = bflo(w.w); o[7] = bfhi(w.w);
}
__device__ __forceinline__ u32x4 pack8(const float* v) { u32x4 w; w.x = pk2(v[0], v[1]); w.y = pk2(v[2], v[3]); w.z = pk2(v[4], v[5]); w.w = pk2(v[6], v[7]); return w; }
__device__ __forceinline__ int otid() { int t = threadIdx.x; asm volatile("" : "+v"(t)); return t; }
__device__ __forceinline__ int obid() { int b = blockIdx.x; asm volatile("" : "+s"(b)); return b; }
__device__ __forceinline__ int ogrid() { int b = gridDim.x; asm volatile("" : "+s"(b)); return b; }
__device__ __forceinline__ float wave_sum(float v) {
#pragma unroll
    for (int o = 1; o < 64; o <<= 1) v += __shfl_xor(v, o);
    return v;
}

namespace pg8 {
constexpr int BM = 256, BK = 64, HALF = 128, HTB = HALF * BK * 2, STAGE_BYTES = 8 * HTB, NXCD = 8, WGM = 8;
__device__ __forceinline__ int lds_byte(int r, int c) { const int st = (r >> 4) * 2 + (c >> 5), rr = r & 15, cc = c & 31, ob = rr * 64 + cc * 2; return st * 1024 + (ob ^ (((ob >> 9) & 1) << 5)); }
__device__ __forceinline__ void stage_rc(int b, int& R, int& C) { const int st = b / 1024, sb = b % 1024, swz = sb ^ (((sb >> 9) & 1) << 5); R = (st >> 1) * 16 + swz / 64; C = (st & 1) * 32 + (swz % 64) / 2; }
__device__ __forceinline__ int perm32(int rho) { const int n = rho >> 4, i = rho & 15; return 8 * (i >> 2) + 4 * n + (i & 3); }

struct Unit { int pm, pn, ak; };
struct Gemm { const bf16_t* A; const bf16_t* Bt; int lda, ldb, K; };

struct Sched {
    int nM, nN, nwg, G, c, mode;
    __device__ __forceinline__ bool next(int i, Unit& u) const {
        const long L = (long)i * G + c; if (L >= nwg) return false;
        if (mode == 2) { u.pm = (int)L; u.pn = (int)(L >> 2); u.ak = 0; return true; }
        if (mode == 3) { const int g = (int)(L >> 4); u.pm = 4 * g + (int)((L >> 2) & 3); u.pn = 4 * g + (int)(L & 3); u.ak = 0; return true; }
        int wgid = (int)L; { const int q = nwg / NXCD, r = nwg % NXCD, xcd = wgid % NXCD, off = wgid / NXCD; wgid = (xcd < r ? xcd * (q + 1) : r * (q + 1) + (xcd - r) * q) + off; }
        const int nig = WGM * nN, gid = wgid / nig, fm = gid * WGM, gsz = (nM - fm) < WGM ? (nM - fm) : WGM;
        u.pm = fm + ((wgid % nig) % gsz); u.pn = (wgid % nig) / gsz; u.ak = (mode == 1) ? (u.pn >> 2) * 256 : 0; return true;
    }
};

struct Epi {
    int mode; bool perm;
    unsigned char* ws; const float* dskip; const float* bglu; const float* bgate;
    __device__ __forceinline__ void operator()(const f32x4 (&acc)[2][2][4][2], const Unit& u, int wr, int wc, int fr, int fq) const {
        const int row0 = u.pm * BM + wr * 64 + fr;
        bf16_t* const H = (bf16_t*)(ws + WS_E); bf16_t* const U2 = (bf16_t*)(ws + WS_U2); float* const ES = (float*)(ws + WS_ES); bf16_t* const YS = (bf16_t*)(ws + WS_YS);
        bf16_t* const Ob = (bf16_t*)(ws + WS_O); bf16_t* const P = (bf16_t*)(ws + WS_E); bf16_t* const MIX = (bf16_t*)(ws + WS_O); bf16_t* const HF = (bf16_t*)(ws + WS_E);
        if (mode == 0) {
#pragma unroll
            for (int ai = 0; ai < 2; ++ai)
#pragma unroll
                for (int m = 0; m < 4; ++m) { const int r = row0 + ai * HALF + m * 16;
#pragma unroll
                    for (int bj = 0; bj < 2; ++bj) { const int c0 = u.pn * BM + bj * HALF + wc * 32 + 8 * fq;
                        const f32x4 v0 = acc[ai][bj][m][0], v1 = acc[ai][bj][m][1];
                        u32x4 w; w.x = cvt_pk_bf16(v0[0], v0[1]); w.y = cvt_pk_bf16(v0[2], v0[3]); w.z = cvt_pk_bf16(v1[0], v1[1]); w.w = cvt_pk_bf16(v1[2], v1[3]);
                        if (c0 < C_SU) *(u32x4*)(H + (size_t)r * NH + c0) = w;
                        else if (c0 < C_SU + 256) { const int c = c0 - C_SU, g = c >> 4, ci = c & 15;
                            *(u32x4*)(U2 + ((size_t)(g * 1024 + (r >> 6))) * S5K + (r & 63) * 16 + ci) = w; } } }
        } else if (mode == 1) {
#pragma unroll
            for (int ai = 0; ai < 2; ++ai)
#pragma unroll
                for (int m = 0; m < 4; ++m) { const int r = row0 + ai * HALF + m * 16; const int c0 = wc * 32 + 8 * fq;
                    *(f32x4*)(ES + (size_t)r * 128 + c0) = acc[ai][0][m][0]; *(f32x4*)(ES + (size_t)r * 128 + c0 + 4) = acc[ai][0][m][1]; }
        } else if (mode == 2) {
            const int g = u.pm >> 2;
#pragma unroll
            for (int ai = 0; ai < 2; ++ai)
#pragma unroll
                for (int m = 0; m < 4; ++m) { const int r = row0 + ai * HALF + m * 16;
#pragma unroll
                    for (int bj = 0; bj < 2; ++bj) { const int n0 = (u.pn & 3) * BM + bj * HALF + wc * 32 + 8 * fq; const int j = n0 >> 4, i0 = n0 & 15;
                        const u32x4 uw = *(const u32x4*)(U2 + (size_t)r * S5K + n0); float uf[8]; unpack8(uw, uf);
                        const f32x4 d0 = *(const f32x4*)(dskip + 16 * g + i0), d1 = *(const f32x4*)(dskip + 16 * g + i0 + 4);
                        const f32x4 v0 = acc[ai][bj][m][0], v1 = acc[ai][bj][m][1]; float y[8];
                        y[0] = gelu_tanh(v0[0] + d0[0] * uf[0]); y[1] = gelu_tanh(v0[1] + d0[1] * uf[1]); y[2] = gelu_tanh(v0[2] + d0[2] * uf[2]); y[3] = gelu_tanh(v0[3] + d0[3] * uf[3]);
                        y[4] = gelu_tanh(v1[0] + d1[0] * uf[4]); y[5] = gelu_tanh(v1[1] + d1[1] * uf[5]); y[6] = gelu_tanh(v1[2] + d1[2] * uf[6]); y[7] = gelu_tanh(v1[3] + d1[3] * uf[7]);
                        u32x4 w; w.x = cvt_pk_bf16(y[0], y[1]); w.y = cvt_pk_bf16(y[2], y[3]); w.z = cvt_pk_bf16(y[4], y[5]); w.w = cvt_pk_bf16(y[6], y[7]);
                        const size_t t = (size_t)(r & 1023) * 64 + j;
                        *(u32x4*)(YS + t * 256 + 16 * g + i0) = w; } }
        } else if (mode == 3) {
#pragma unroll
            for (int ai = 0; ai < 2; ++ai)
#pragma unroll
                for (int m = 0; m < 4; ++m) { const int r = row0 + ai * HALF + m * 16;
#pragma unroll
                    for (int bj = 0; bj < 2; ++bj) { const int c0 = bj * HALF + wc * 32 + 8 * fq;
                        const u32x4 yw = *(const u32x4*)(YS + (size_t)r * 256 + c0); float yf[8]; unpack8(yw, yf);
                        const f32x4 b0 = *(const f32x4*)(bglu + c0), b1 = *(const f32x4*)(bglu + c0 + 4);
                        const f32x4 v0 = acc[ai][bj][m][0] + b0, v1 = acc[ai][bj][m][1] + b1; float o[8];
                        o[0] = yf[0] * sigm(v0[0]); o[1] = yf[1] * sigm(v0[1]); o[2] = yf[2] * sigm(v0[2]); o[3] = yf[3] * sigm(v0[3]);
                        o[4] = yf[4] * sigm(v1[0]); o[5] = yf[5] * sigm(v1[1]); o[6] = yf[6] * sigm(v1[2]); o[7] = yf[7] * sigm(v1[3]);
                        u32x4 w; w.x = cvt_pk_bf16(o[0], o[1]); w.y = cvt_pk_bf16(o[2], o[3]); w.z = cvt_pk_bf16(o[4], o[5]); w.w = cvt_pk_bf16(o[6], o[7]);
                        *(u32x4*)(Ob + (size_t)r * DM + 768 + c0) = w; } }
        } else if (mode == 4) {
#pragma unroll
            for (int ai = 0; ai < 2; ++ai)
#pragma unroll
                for (int m = 0; m < 4; ++m) { const int r = row0 + ai * HALF + m * 16;
#pragma unroll
                    for (int bj = 0; bj < 2; ++bj) { const int c0 = u.pn * BM + bj * HALF + wc * 32 + 8 * fq;
                        const f32x4 v0 = acc[ai][bj][m][0], v1 = acc[ai][bj][m][1];
                        u32x4 w; w.x = cvt_pk_bf16(v0[0], v0[1]); w.y = cvt_pk_bf16(v0[2], v0[3]); w.z = cvt_pk_bf16(v1[0], v1[1]); w.w = cvt_pk_bf16(v1[2], v1[3]);
                        *(u32x4*)(P + (size_t)r * 4096 + c0) = w; } }
        } else if (mode == 5) {
            const int ch0 = 64 * u.pn + 16 * wc + 4 * fq;
            f32x4 bv[4];
#pragma unroll
            for (int b = 0; b < 4; ++b) bv[b] = *(const f32x4*)(bgate + b * 1024 + ch0);
#pragma unroll
            for (int ai = 0; ai < 2; ++ai)
#pragma unroll
                for (int m = 0; m < 4; ++m) { const int r = row0 + ai * HALF + m * 16; f32x4 mix = (f32x4){0.f, 0.f, 0.f, 0.f};
#pragma unroll
                    for (int bj = 0; bj < 2; ++bj)
#pragma unroll
                        for (int n = 0; n < 2; ++n) { const int b = 2 * bj + n; const f32x4 a = acc[ai][bj][m][n] + bv[b];
                            const u32x2 pw = *(const u32x2*)(P + (size_t)r * 4096 + b * 1024 + ch0);
                            mix[0] += sigm(a[0]) * bflo(pw.x); mix[1] += sigm(a[1]) * bfhi(pw.x); mix[2] += sigm(a[2]) * bflo(pw.y); mix[3] += sigm(a[3]) * bfhi(pw.y); }
                    u32x2 w; w.x = cvt_pk_bf16(mix[0], mix[1]); w.y = cvt_pk_bf16(mix[2], mix[3]);
                    *(u32x2*)(MIX + (size_t)r * DM + ch0) = w; }
        } else if (mode == 6) {
            bf16_t* const XBp = (bf16_t*)(ws + WS_XB);
#pragma unroll
            for (int ai = 0; ai < 2; ++ai)
#pragma unroll
                for (int m = 0; m < 4; ++m) { const int r = row0 + ai * HALF + m * 16;
#pragma unroll
                    for (int bj = 0; bj < 2; ++bj) { const int c = u.pn * BM + bj * HALF + wc * 32 + 8 * fq;
                        u32x4* px = (u32x4*)(XBp + (size_t)r * DM + c); const u32x4 xw = *px; float xf[8]; unpack8(xw, xf);
                        const f32x4 a0 = acc[ai][bj][m][0], a1 = acc[ai][bj][m][1];
                        u32x4 w; w.x = cvt_pk_bf16(xf[0] * ALPHA + a0[0], xf[1] * ALPHA + a0[1]); w.y = cvt_pk_bf16(xf[2] * ALPHA + a0[2], xf[3] * ALPHA + a0[3]);
                        w.z = cvt_pk_bf16(xf[4] * ALPHA + a1[0], xf[5] * ALPHA + a1[1]); w.w = cvt_pk_bf16(xf[6] * ALPHA + a1[2], xf[7] * ALPHA + a1[3]);
                        *px = w; } }
        } else {
#pragma unroll
            for (int ai = 0; ai < 2; ++ai)
#pragma unroll
                for (int m = 0; m < 4; ++m) { const int r = row0 + ai * HALF + m * 16; const int ch0 = 128 * u.pn + 32 * wc + 8 * fq;
                    const f32x4 g0 = acc[ai][0][m][0], g1 = acc[ai][0][m][1], u0 = acc[ai][1][m][0], u1 = acc[ai][1][m][1];
                    u32x4 w; w.x = cvt_pk_bf16(silu_f(g0[0]) * u0[0], silu_f(g0[1]) * u0[1]); w.y = cvt_pk_bf16(silu_f(g0[2]) * u0[2], silu_f(g0[3]) * u0[3]);
                    w.z = cvt_pk_bf16(silu_f(g1[0]) * u1[0], silu_f(g1[1]) * u1[1]); w.w = cvt_pk_bf16(silu_f(g1[2]) * u1[2], silu_f(g1[3]) * u1[3]);
                    *(u32x4*)(HF + (size_t)r * DFF + ch0) = w; }
        }
    }
};

__device__ __forceinline__ void gemm_phase(LAS unsigned char* lds, const Gemm g, const Sched& S, const Epi& E) {
    const int tid = otid(), wid = __builtin_amdgcn_readfirstlane(tid >> 6), lane = tid & 63, wr = wid >> 2, wc = wid & 3, fr = lane & 15, fq = lane >> 4;
    const int K = g.K, nt = K / BK;
    unsigned voffA[2], voffB[2];
#pragma unroll
    for (int i = 0; i < 2; ++i) { int R, C; stage_rc(tid * 16 + i * 8192, R, C); const int Rb = E.perm ? ((R & ~31) + perm32(R & 31)) : R;
        voffA[i] = (unsigned)(R * g.lda + C) * 2u; voffB[i] = (unsigned)(Rb * g.ldb + C) * 2u; }
    const size_t kstep = (size_t)(BK * 2);
    const size_t hstepA = (size_t)HALF * g.lda * 2, hstepB = (size_t)HALF * g.ldb * 2;
    const size_t tstepA = 2 * hstepA, tstepB = 2 * hstepB;
    const unsigned ldsw = (unsigned)wid * 1024u;
    const int aoff = lds_byte(wr * 64 + fr, fq * 8), boff = lds_byte(wc * 32 + fr, fq * 8);
#define PG8_SA(b, h) (((b) * 2 + (h)) * HTB)
#define PG8_SB(b, h) ((4 + (b) * 2 + (h)) * HTB)
#define PG8_STAGE(bufoff, gbase, voff) do { _Pragma("unroll") for (int _i = 0; _i < 2; ++_i) \
        __builtin_amdgcn_global_load_lds((const unsigned*)((const char*)(gbase) + (voff)[_i]), (LAS unsigned*)(lds + (bufoff) + ldsw + _i * 8192), 16, 0, 0); } while (0)
#define PG8_LDA(dst, b, h) do { _Pragma("unroll") for (int m = 0; m < 4; ++m) _Pragma("unroll") for (int k = 0; k < 2; ++k) dst[m][k] = *(const LAS bf16x8*)(lds + PG8_SA(b, h) + aoff + m * 2048 + k * 1024); } while (0)
#define PG8_LDB(dst, b, h) do { _Pragma("unroll") for (int n = 0; n < 2; ++n) _Pragma("unroll") for (int k = 0; k < 2; ++k) dst[n][k] = *(const LAS bf16x8*)(lds + PG8_SB(b, h) + boff + n * 2048 + k * 1024); } while (0)
#define PG8_MMA(ai, bj, At, Bt) do { __builtin_amdgcn_s_setprio(1); _Pragma("unroll") for (int m = 0; m < 4; ++m) _Pragma("unroll") for (int n = 0; n < 2; ++n) _Pragma("unroll") for (int k = 0; k < 2; ++k) \
        acc[ai][bj][m][n] = __builtin_amdgcn_mfma_f32_16x16x32_f16(__builtin_bit_cast(half8_t, Bt[n][k]), __builtin_bit_cast(half8_t, At[m][k]), acc[ai][bj][m][n], 0, 0, 0); __builtin_amdgcn_s_setprio(0); } while (0)
#define PG8_WAIT_V(n) asm volatile("s_waitcnt vmcnt(" #n ")" ::: "memory")
#define PG8_WAIT_L(n) asm volatile("s_waitcnt lgkmcnt(" #n ")" ::: "memory")
#define PG8_BAR __builtin_amdgcn_s_barrier()
#define PG8_SCHED __builtin_amdgcn_sched_barrier(0)
    Unit cur, nxt; int ui = 0;
    if (!S.next(0, cur)) return;
    f32x4 acc[2][2][4][2];
#pragma unroll
    for (int a = 0; a < 2; ++a)
#pragma unroll
        for (int b = 0; b < 2; ++b)
#pragma unroll
            for (int m = 0; m < 4; ++m)
#pragma unroll
                for (int n = 0; n < 2; ++n) acc[a][b][m][n] = (f32x4){0.f, 0.f, 0.f, 0.f};
    bf16x8 At[4][2], B0[2][2], B1[2][2];
    const char* cA = (const char*)g.A + (size_t)cur.pm * tstepA + (size_t)cur.ak * 2; const char* cB = (const char*)g.Bt + (size_t)cur.pn * tstepB;
    PG8_STAGE(PG8_SB(0, 0), cB, voffB); PG8_STAGE(PG8_SB(0, 1), cB + hstepB, voffB); PG8_STAGE(PG8_SA(0, 0), cA, voffA); PG8_STAGE(PG8_SA(0, 1), cA + hstepA, voffA);
    if (wr == 1) PG8_BAR;
    PG8_WAIT_V(2); PG8_BAR;
    PG8_STAGE(PG8_SB(1, 0), cB + kstep, voffB); PG8_STAGE(PG8_SA(1, 0), cA + kstep, voffA); PG8_STAGE(PG8_SB(1, 1), cB + hstepB + kstep, voffB);
    PG8_WAIT_V(6); PG8_BAR;
    for (;;) {
        const bool has_next = S.next(ui + 1, nxt);
        const char* nA = has_next ? (const char*)g.A + (size_t)nxt.pm * tstepA + (size_t)nxt.ak * 2 : cA; const char* nB = has_next ? (const char*)g.Bt + (size_t)nxt.pn * tstepB : cB;
        for (int t = 0; t < nt; t += 2) {
            const bool last = (t == nt - 2);
            const char* a1 = cA + (size_t)(t + 1) * kstep;
            const char* a2 = last ? nA : cA + (size_t)(t + 2) * kstep; const char* b2 = last ? nB : cB + (size_t)(t + 2) * kstep;
            const char* a3 = a2 + kstep; const char* b3 = b2 + kstep;
            PG8_LDB(B0, 0, 0); PG8_LDB(B1, 0, 1); PG8_SCHED; PG8_LDA(At, 0, 0); PG8_STAGE(PG8_SA(1, 1), a1 + hstepA, voffA);
            PG8_WAIT_V(8); PG8_WAIT_L(0); PG8_BAR; PG8_MMA(0, 0, At, B0); PG8_MMA(0, 1, At, B1); PG8_BAR; PG8_SCHED;
            PG8_LDA(At, 0, 1); PG8_STAGE(PG8_SB(0, 0), b2, voffB); PG8_STAGE(PG8_SB(0, 1), b2 + hstepB, voffB); PG8_STAGE(PG8_SA(0, 0), a2, voffA);
            PG8_WAIT_V(8); PG8_WAIT_L(0); PG8_BAR; PG8_MMA(1, 0, At, B0); PG8_MMA(1, 1, At, B1); PG8_BAR; PG8_SCHED;
            PG8_LDB(B0, 1, 0); PG8_LDB(B1, 1, 1); PG8_SCHED; PG8_LDA(At, 1, 0); PG8_STAGE(PG8_SA(0, 1), a2 + hstepA, voffA);
            PG8_WAIT_V(8); PG8_WAIT_L(0); PG8_BAR; PG8_MMA(0, 0, At, B0); PG8_MMA(0, 1, At, B1); PG8_BAR; PG8_SCHED;
            PG8_LDA(At, 1, 1); PG8_STAGE(PG8_SB(1, 0), b3, voffB); PG8_STAGE(PG8_SB(1, 1), b3 + hstepB, voffB); PG8_STAGE(PG8_SA(1, 0), a3, voffA);
            PG8_WAIT_V(8); PG8_WAIT_L(0); PG8_BAR; PG8_MMA(1, 0, At, B0); PG8_MMA(1, 1, At, B1); PG8_BAR; PG8_SCHED;
        }
        if (wr == 0) PG8_BAR;
        { const int t2 = otid(), w2 = __builtin_amdgcn_readfirstlane(t2 >> 6), l2 = t2 & 63;
          E(acc, cur, w2 >> 2, w2 & 3, l2 & 15, l2 >> 4); }
        if (!has_next) break;
#pragma unroll
        for (int a = 0; a < 2; ++a)
#pragma unroll
            for (int b = 0; b < 2; ++b)
#pragma unroll
                for (int m = 0; m < 4; ++m)
#pragma unroll
                    for (int n = 0; n < 2; ++n) acc[a][b][m][n] = (f32x4){0.f, 0.f, 0.f, 0.f};
        cur = nxt; cA = nA; cB = nB; ++ui;
        if (wr == 1) PG8_BAR;
    }
    PG8_WAIT_V(0);
    PG8_BAR;
#undef PG8_SA
#undef PG8_SB
#undef PG8_STAGE
#undef PG8_LDA
#undef PG8_LDB
#undef PG8_MMA
#undef PG8_WAIT_V
#undef PG8_WAIT_L
#undef PG8_BAR
#undef PG8_SCHED
}
}

__device__ __forceinline__ int dest_row(int dmode, int arg, int n) {
    if (dmode == 1) { return ((n >> 6) << 8) + ((arg >> 1) << 7) + (((n >> 4) & 3) << 5) + ((arg & 1) << 4) + (n & 15); }
    if (dmode == 2) { return ((n >> 7) << 8) + (arg << 7) + (n & 127); }
    return n + arg;
}
__device__ __forceinline__ void transpose_item(const float* W, int K, int Nsrc, bf16_t* WT, int dmode, int arg, LAS float* scr, int kb, int nb, int lane) {
    const int k0 = 64 * kb, n0 = 32 * nb;
    const int nsrc = n0 + (lane & 31); const bool ok = nsrc < Nsrc;
#pragma unroll 8
    for (int i = 0; i < 32; ++i) { const int kk = 2 * i + (lane >> 5); scr[kk * 33 + (lane & 31)] = ok ? W[(size_t)(k0 + kk) * Nsrc + nsrc] : 0.f; }
    asm volatile("s_waitcnt lgkmcnt(0)" ::: "memory");
    const int c = lane & 7;
#pragma unroll
    for (int j = 0; j < 4; ++j) { const int n = (lane >> 3) + 8 * j; const LAS float* s = scr + (8 * c) * 33 + n;
        u32x4 o; o.x = pk2(s[0 * 33], s[1 * 33]); o.y = pk2(s[2 * 33], s[3 * 33]); o.z = pk2(s[4 * 33], s[5 * 33]); o.w = pk2(s[6 * 33], s[7 * 33]);
        *(u32x4*)(WT + (size_t)dest_row(dmode, arg, n0 + n) * K + k0 + 8 * c) = o; }
    asm volatile("s_waitcnt lgkmcnt(0)" ::: "memory");
}

__device__ __forceinline__ void s5_abar_pow(float lr, float li, float dt, int n, float& re, float& im) {
    const float mag = expf((float)n * lr * dt);
    const double a = (double)n * ((double)li * (double)dt);
    const double k = __builtin_rint(a * 0.15915494309189535);
    const float r = (float)__builtin_fma(-k, 6.283185307179586, a);
    re = mag * cosf(r); im = mag * sinf(r);
}
__device__ __forceinline__ void s5_coef(float lr, float li, float dt, float& cr, float& ci) {
    const float th = li * dt, em1 = expm1f(lr * dt), c1 = cosf(th), s1 = sinf(th), sh = sinf(0.5f * th);
    const float nr = em1 * c1 - 2.f * sh * sh, ni = (1.f + em1) * s1, den = lr * lr + li * li;
    cr = (nr * lr + ni * li) / den; ci = (ni * lr - nr * li) / den;
}

__device__ __forceinline__ void s5_tables(CPP p, int l, LAS unsigned char* lds) {
    LAS float* abr = (LAS float*)lds;
    LAS float* abi = abr + 1024;
    LAS float* cr = abi + 1024;
    LAS float* ci = cr + 16 * 65;
    float* KN = (float*)(p->ws + WS_KN);
    const int tid = otid();
    for (int it = obid(); it < 1024; it += ogrid()) {
        const int g = it >> 6, n = it & 63;
        __syncthreads();
        for (int e = tid; e < 1024; e += 512) { const int pp = e >> 4, c = e & 15; const int gp = (l * 16 + g) * 64 + pp;
            const float lr = p->in[5][gp], li = p->in[6][gp], dt = expf(p->in[7][l * 16 + g]);
            float ar, ai2; s5_abar_pow(lr, li, dt, n, ar, ai2);
            float qr, qi; s5_coef(lr, li, dt, qr, qi);
            const float br = p->in[8][(size_t)gp * 16 + c], bi = p->in[9][(size_t)gp * 16 + c];
            const float bbr = qr * br - qi * bi, bbi = qr * bi + qi * br;
            abr[e] = ar * bbr - ai2 * bbi; abi[e] = ar * bbi + ai2 * bbr; }
        for (int e = tid; e < 1024; e += 512) { const int i = e >> 6, pp = e & 63; const size_t gi = ((size_t)(l * 16 + g) * 16 + i) * 64 + pp;
            cr[i * 65 + pp] = p->in[10][gi]; ci[i * 65 + pp] = p->in[11][gi]; }
        __syncthreads();
        if (tid < 256) { const int i = tid >> 4, c = tid & 15; float s = 0.f;
#pragma unroll 8
            for (int pp = 0; pp < 64; ++pp) s += cr[i * 65 + pp] * abr[pp * 16 + c] - ci[i * 65 + pp] * abi[pp * 16 + c];
            KN[((size_t)(g * 64 + n) * 16 + i) * 16 + c] = s; }
    }
}

__device__ __forceinline__ void convert_weights(CPP p, int l, LAS unsigned char* lds) {
    const int tid = otid(), lane = tid & 63, wave = tid >> 6;
    LAS float* scr = (LAS float*)(lds + wave * 16384);
    const int gw = obid() * 8 + wave, NGW = ogrid() * 8;
    unsigned char* ws = p->ws;
    constexpr int J0 = 1408, J1 = J0 + 2048, J2 = J1 + 512, J3 = J2 + 512, J4 = J3 + 2816, J5 = J4 + 1408, J6 = J5 + 32;
    for (int it = gw; it < J6; it += NGW) {
        if (it < J0) { const int r = it; transpose_item(p->in[1] + (size_t)l * 1024 * 2576, 1024, 2576, (bf16_t*)(ws + WS_WIN), 0, 0, scr, r / 88, r % 88, lane); }
        else if (it < J1) { const int r = it - J0, b = r >> 9, q = r & 511; transpose_item(p->in[15] + ((size_t)l * 4 + b) * 1024 * 1024, 1024, 1024, (bf16_t*)(ws + WS_WG), 1, b, scr, q >> 5, q & 31, lane); }
        else if (it < J2) { const int r = it - J1, b = r >> 7, q = r & 127; transpose_item(p->in[17] + ((size_t)l * 4 + b) * 256 * 1024, 256, 1024, (bf16_t*)(ws + WS_WB) + (size_t)b * 1024 * 256, 0, 0, scr, q >> 5, q & 31, lane); }
        else if (it < J3) { const int q = it - J2; transpose_item(p->in[18] + (size_t)l * 1024 * 1024, 1024, 1024, (bf16_t*)(ws + WS_WO), 0, 0, scr, q >> 5, q & 31, lane); }
        else if (it < J4) { const int r = it - J3, wch = r / 1408, q = r % 1408; transpose_item(p->in[wch ? 22 : 21] + (size_t)l * 1024 * 2816, 1024, 2816, (bf16_t*)(ws + WS_WFF), 2, wch, scr, q / 88, q % 88, lane); }
        else if (it < J5) { const int q = it - J4; transpose_item(p->in[23] + (size_t)l * 2816 * 1024, 2816, 1024, (bf16_t*)(ws + WS_WD), 0, 0, scr, q >> 5, q & 31, lane); }
        else { const int q = it - J5; transpose_item(p->in[13] + (size_t)l * 256 * 256, 256, 256, (bf16_t*)(ws + WS_WGLU), 0, 0, scr, q >> 3, q & 7, lane); }
    }
    const int gt = obid() * 512 + tid, NT = ogrid() * 512;
    bf16_t* WE = (bf16_t*)(ws + WS_WE);
    for (int e = gt; e < 65536; e += NT) { const int s = e & 63, pp = (e >> 6) & 63, g = e >> 12; const int gp = (l * 16 + g) * 64 + pp;
        const float lr = p->in[5][gp], li = p->in[6][gp], dt = expf(p->in[7][l * 16 + g]);
        float ar, ai2; s5_abar_pow(lr, li, dt, 63 - s, ar, ai2);
        float qr, qi; s5_coef(lr, li, dt, qr, qi);
        float wr_[16], wi_[16];
#pragma unroll
        for (int c = 0; c < 16; ++c) { const float br = p->in[8][(size_t)gp * 16 + c], bi = p->in[9][(size_t)gp * 16 + c];
            const float bbr = qr * br - qi * bi, bbi = qr * bi + qi * br; wr_[c] = ar * bbr - ai2 * bbi; wi_[c] = ar * bbi + ai2 * bbr; }
        bf16_t* dr = WE + ((size_t)(g * 256 + pp)) * 1024 + s * 16; bf16_t* di = WE + ((size_t)(g * 256 + 64 + pp)) * 1024 + s * 16;
        *(u32x4*)dr = pack8(wr_); *(u32x4*)(dr + 8) = pack8(wr_ + 8); *(u32x4*)di = pack8(wi_); *(u32x4*)(di + 8) = pack8(wi_ + 8); }
    for (int e = gt; e < 16 * 128 * 128; e += NT) { const int c8 = e & 127, n = (e >> 7) & 127, g = e >> 14;
        *(u32x4*)(WE + ((size_t)(g * 256 + 128 + n)) * 1024 + c8 * 8) = (u32x4){0u, 0u, 0u, 0u}; }
    bf16_t* WT = (bf16_t*)(ws + WS_WT); const float* KN = (const float*)(ws + WS_KN);
    for (int e = gt; e < 16 * 1024 * 64; e += NT) { const int s = e & 63, row = (e >> 6) & 1023, g = e >> 16; const int j = row >> 4, i = row & 15;
        u32x4 w0 = (u32x4){0u, 0u, 0u, 0u}, w1 = w0;
        if (s <= j) { const float* k = KN + ((size_t)(g * 64 + (j - s)) * 16 + i) * 16; float v[16];
#pragma unroll
            for (int c = 0; c < 16; c += 4) { const f32x4 t = *(const f32x4*)(k + c); v[c] = t[0]; v[c + 1] = t[1]; v[c + 2] = t[2]; v[c + 3] = t[3]; }
            w0 = pack8(v); w1 = pack8(v + 8); }
        bf16_t* d = WT + ((size_t)(g * 1024 + row)) * S5K + s * 16; *(u32x4*)d = w0; *(u32x4*)(d + 8) = w1; }
    for (int e = gt; e < 16 * 1024 * 64; e += NT) { const int pp = e & 63, row = (e >> 6) & 1023, g = e >> 16; const int j = row >> 4, i = row & 15; const int gp = (l * 16 + g) * 64 + pp;
        const float lr = p->in[5][gp], li = p->in[6][gp], dt = expf(p->in[7][l * 16 + g]);
        float ar, ai2; s5_abar_pow(lr, li, dt, j + 1, ar, ai2);
        const size_t gi = ((size_t)(l * 16 + g) * 16 + i) * 64 + pp; const float c_r = p->in[10][gi], c_i = p->in[11][gi];
        bf16_t* d = WT + ((size_t)(g * 1024 + row)) * S5K + 1024 + pp;
        d[0] = (bf16_t)f2bf(c_r * ar - c_i * ai2); d[64] = (bf16_t)f2bf(-(c_r * ai2 + c_i * ar)); }
}

__device__ __forceinline__ void ln_pass(bf16_t* xb, float* fout, const float* gam, const float* bet) {
    const int lane = otid() & 63, gw = obid() * 8 + (otid() >> 6), NGW = ogrid() * 8;
    f32x4 gv[4], bv[4];
#pragma unroll
    for (int j = 0; j < 2; ++j) { gv[2 * j] = *(const f32x4*)(gam + 512 * j + lane * 8); gv[2 * j + 1] = *(const f32x4*)(gam + 512 * j + lane * 8 + 4);
        bv[2 * j] = *(const f32x4*)(bet + 512 * j + lane * 8); bv[2 * j + 1] = *(const f32x4*)(bet + 512 * j + lane * 8 + 4); }
    for (int m0 = gw * 2; m0 < M; m0 += NGW * 2) {
        u32x4 w[2][2];
#pragma unroll
        for (int rr = 0; rr < 2; ++rr)
#pragma unroll
            for (int j = 0; j < 2; ++j) w[rr][j] = *(const u32x4*)(xb + (size_t)(m0 + rr) * DM + 512 * j + lane * 8);
#pragma unroll
        for (int rr = 0; rr < 2; ++rr) {
            float v[16]; unpack8(w[rr][0], v); unpack8(w[rr][1], v + 8);
            float s = 0.f;
#pragma unroll
            for (int e = 0; e < 16; ++e) s += v[e];
            const float mean = wave_sum(s) * (1.f / DM); float s2 = 0.f;
#pragma unroll
            for (int e = 0; e < 16; ++e) { v[e] -= mean; s2 += v[e] * v[e]; }
            const float rstd = 1.f / sqrtf(wave_sum(s2) * (1.f / DM) + LN_EPS);
#pragma unroll
            for (int j = 0; j < 2; ++j) {
#pragma unroll
                for (int q = 0; q < 2; ++q)
#pragma unroll
                    for (int e = 0; e < 4; ++e) v[8 * j + 4 * q + e] = v[8 * j + 4 * q + e] * rstd * gv[2 * j + q][e] + bv[2 * j + q][e];
                *(u32x4*)(xb + (size_t)(m0 + rr) * DM + 512 * j + lane * 8) = pack8(v + 8 * j);
                if (fout) { *(f32x4*)(fout + (size_t)(m0 + rr) * DM + 512 * j + lane * 8) = (f32x4){v[8 * j], v[8 * j + 1], v[8 * j + 2], v[8 * j + 3]};
                    *(f32x4*)(fout + (size_t)(m0 + rr) * DM + 512 * j + lane * 8 + 4) = (f32x4){v[8 * j + 4], v[8 * j + 5], v[8 * j + 6], v[8 * j + 7]}; } }
        }
    }
}

__device__ __forceinline__ void load_tile64(const bf16_t* src, int pitch, LAS float* dst, int dpitch, float scale, int tid) {
    const int idx = tid * 8, r = idx >> 6, c = idx & 63;
    const u32x4 w = *(const u32x4*)(src + (size_t)r * pitch + c); float f[8]; unpack8(w, f);
#pragma unroll
    for (int e = 0; e < 8; ++e) dst[r * dpitch + c + e] = f[e] * scale;
}

__device__ __forceinline__ void attn_items(CPP p, int l, LAS unsigned char* lds) {
    LAS float* Qs = (LAS float*)lds; LAS float* Ks = Qs + 64 * 68; LAS float* Vs = Ks + 64 * 68; LAS float* Ps = Vs + 64 * 68; LAS float* bs = Ps + 64 * 65;
    const bf16_t* H = (const bf16_t*)(p->ws + WS_E); bf16_t* O = (bf16_t*)(p->ws + WS_O);
    const int tid = otid(), row = tid >> 3, sub = tid & 7;
    for (int it = obid(); it < 4096; it += ogrid()) {
        const int h = it & 3, bi = it >> 2, i = bi & 31, b = bi >> 5;
        const size_t t0 = (size_t)bi * 64;
        __syncthreads();
        load_tile64(H + t0 * NH + C_AQ + h * 64, NH, Qs, 68, 0.125f, tid);
        if (tid < 257) bs[tid] = p->in[4][(size_t)(l * 4 + h) * 257 + tid];
        __syncthreads();
        float q[64], o[8];
#pragma unroll
        for (int d = 0; d < 64; d += 4) { const f32x4 t = *(const LAS f32x4*)(Qs + row * 68 + d); q[d] = t[0]; q[d + 1] = t[1]; q[d + 2] = t[2]; q[d + 3] = t[3]; }
#pragma unroll
        for (int e = 0; e < 8; ++e) o[e] = 0.f;
        float mx = -1e30f, ls = 0.f;
        const int kc0 = i > 8 ? i - 8 : 0;
        for (int kc = kc0; kc <= i; ++kc) {
            __syncthreads();
            const size_t tk = ((size_t)b * 32 + kc) * 64;
            load_tile64(H + tk * NH + C_AK + h * 64, NH, Ks, 68, 1.f, tid);
            load_tile64(H + tk * NH + C_AV + h * 64, NH, Vs, 68, 1.f, tid);
            __syncthreads();
            float s[8]; float cm = -1e30f;
#pragma unroll
            for (int jj = 0; jj < 8; ++jj) { const int key = sub + 8 * jj; float a = 0.f;
#pragma unroll
                for (int d = 0; d < 64; d += 4) { const f32x4 t = *(const LAS f32x4*)(Ks + key * 68 + d); a += q[d] * t[0] + q[d + 1] * t[1] + q[d + 2] * t[2] + q[d + 3] * t[3]; }
                int diff = (i - kc) * 64 + row - key; diff = diff > 128 ? 128 : diff;
                a += bs[diff + 128]; s[jj] = a; cm = fmaxf(cm, a); }
            cm = fmaxf(cm, __shfl_xor(cm, 1)); cm = fmaxf(cm, __shfl_xor(cm, 2)); cm = fmaxf(cm, __shfl_xor(cm, 4));
            const float mn = fmaxf(mx, cm), sc = __expf(mx - mn); mx = mn;
            float ps = 0.f;
#pragma unroll
            for (int jj = 0; jj < 8; ++jj) { const float pr = __expf(s[jj] - mn); ps += pr; Ps[row * 65 + sub + 8 * jj] = pr; }
            ps += __shfl_xor(ps, 1); ps += __shfl_xor(ps, 2); ps += __shfl_xor(ps, 4);
            ls = ls * sc + ps;
#pragma unroll
            for (int e = 0; e < 8; ++e) o[e] *= sc;
            asm volatile("s_waitcnt lgkmcnt(0)" ::: "memory");
#pragma unroll 8
            for (int key = 0; key < 64; ++key) { const float pr = Ps[row * 65 + key];
                const f32x4 v0 = *(const LAS f32x4*)(Vs + key * 68 + sub * 8), v1 = *(const LAS f32x4*)(Vs + key * 68 + sub * 8 + 4);
                o[0] += pr * v0[0]; o[1] += pr * v0[1]; o[2] += pr * v0[2]; o[3] += pr * v0[3]; o[4] += pr * v1[0]; o[5] += pr * v1[1]; o[6] += pr * v1[2]; o[7] += pr * v1[3]; }
        }
        const float inv = 1.f / ls;
#pragma unroll
        for (int e = 0; e < 8; ++e) o[e] *= inv;
        *(u32x4*)(O + (t0 + row) * DM + 256 + h * 64 + sub * 8) = pack8(o);
    }
}

typedef float f32x16 __attribute__((ext_vector_type(16)));
typedef short s16x4 __attribute__((ext_vector_type(4)));
__device__ __forceinline__ s16x4 lds_tr16(LAS const unsigned char* ptr) { return __builtin_bit_cast(s16x4, __builtin_amdgcn_ds_read_tr16_b64_v4i16((LAS s16x4*)ptr)); }
__device__ __forceinline__ bf16x8 scale_frag(u32x4 w, float sc) { float f[8]; unpack8(w, f);
    u32x4 o; o.x = pk2(f[0] * sc, f[1] * sc); o.y = pk2(f[2] * sc, f[3] * sc); o.z = pk2(f[4] * sc, f[5] * sc); o.w = pk2(f[6] * sc, f[7] * sc); return __builtin_bit_cast(bf16x8, o); }
__device__ __forceinline__ void attn_mfma(CPP p, int l, LAS unsigned char* lds) {
    const int tid = otid(), lane = tid & 63, wid = __builtin_amdgcn_readfirstlane(tid >> 6), r32 = lane & 31, hi = lane >> 5;
    const int h = wid >> 1, qh = wid & 1;
    LAS unsigned char* Vl = lds + wid * 17536;
    LAS unsigned char* stg = Vl;
    LAS float* bs = (LAS float*)(Vl + 16384);
    const bf16_t* H = (const bf16_t*)(p->ws + WS_E); bf16_t* O = (bf16_t*)(p->ws + WS_O);
    __syncthreads();
    for (int e = lane; e < 257; e += 64) bs[e] = p->in[4][(size_t)(l * 4 + h) * 257 + e];
    const float bfar = p->in[4][(size_t)(l * 4 + h) * 257 + 256];
#define ATT_VDMA(tk, buf) do { _Pragma("unroll") for (int c = 0; c < 8; ++c) \
        __builtin_amdgcn_global_load_lds((const unsigned*)(H + ((tk) + c * 8 + (lane >> 3)) * NH + C_AV + h * 64 + (lane & 7) * 8), (LAS unsigned*)(Vl + (buf) * 8192 + c * 1024), 16, 0, 0); } while (0)
    const int bidA = obid(), gridA = ogrid(); const bool xmap = (gridA == 256);
    for (int itk = 0; itk < (xmap ? 4 : (1024 - bidA + gridA - 1) / gridA); ++itk) {
        const int it = xmap ? ((((bidA & 7) * 4 + itk) << 5) | (bidA >> 3)) : bidA + itk * gridA;
        const int i = it & 31; const size_t t0 = (size_t)it * 64;
        bf16x8 qf[4];
#pragma unroll
        for (int t = 0; t < 4; ++t) qf[t] = scale_frag(*(const u32x4*)(H + (t0 + qh * 32 + r32) * NH + C_AQ + h * 64 + 16 * t + 8 * hi), 0.125f);
        const int kc0 = i > 8 ? i - 8 : 0;
        u32x4 kr[8], kn[8];
        asm volatile("s_waitcnt lgkmcnt(0)" ::: "memory");
        { const size_t tk = t0 - (size_t)(i - kc0) * 64;
#pragma unroll
            for (int t = 0; t < 4; ++t) { kn[t] = *(const u32x4*)(H + (tk + r32) * NH + C_AK + h * 64 + 16 * t + 8 * hi); kn[4 + t] = *(const u32x4*)(H + (tk + 32 + r32) * NH + C_AK + h * 64 + 16 * t + 8 * hi); }
            ATT_VDMA(tk, 0); }
        f32x16 o0, o1;
#pragma unroll
        for (int v = 0; v < 16; ++v) { o0[v] = 0.f; o1[v] = 0.f; }
        float mx = -1e30f, ls = 0.f;
        int cb = 0;
        for (int kc = kc0; kc <= i; ++kc) {
            const bool more = kc < i;
            asm volatile("s_waitcnt vmcnt(0)" ::: "memory");
#pragma unroll
            for (int c = 0; c < 8; ++c) kr[c] = kn[c];
            if (more) { const size_t tk = t0 - (size_t)(i - kc - 1) * 64;
#pragma unroll
                for (int t = 0; t < 4; ++t) { kn[t] = *(const u32x4*)(H + (tk + r32) * NH + C_AK + h * 64 + 16 * t + 8 * hi); kn[4 + t] = *(const u32x4*)(H + (tk + 32 + r32) * NH + C_AK + h * 64 + 16 * t + 8 * hi); }
                ATT_VDMA(tk, cb ^ 1); }
            f32x16 p0, p1;
#pragma unroll
            for (int v = 0; v < 16; ++v) { p0[v] = 0.f; p1[v] = 0.f; }
#pragma unroll
            for (int t = 0; t < 4; ++t) { p0 = __builtin_amdgcn_mfma_f32_32x32x16_f16(__builtin_bit_cast(half8_t, kr[t]), __builtin_bit_cast(half8_t, qf[t]), p0, 0, 0, 0);
                p1 = __builtin_amdgcn_mfma_f32_32x32x16_f16(__builtin_bit_cast(half8_t, kr[4 + t]), __builtin_bit_cast(half8_t, qf[t]), p1, 0, 0, 0); }
            const int dl = i - kc;
            if (dl >= 3) {
#pragma unroll
                for (int v = 0; v < 16; ++v) { p0[v] += bfar; p1[v] += bfar; }
            } else { const int base = dl * 64 + qh * 32 + r32 - 4 * hi + 128;
#pragma unroll
                for (int v = 0; v < 16; ++v) { const int kv = (v & 3) + 8 * (v >> 2); int d0 = base - kv, d1 = base - kv - 32; d0 = d0 > 256 ? 256 : d0; d1 = d1 > 256 ? 256 : d1;
                    p0[v] += bs[d0]; p1[v] += bs[d1]; } }
            float cm = fmaxf(p0[0], p1[0]);
#pragma unroll
            for (int v = 1; v < 16; ++v) cm = fmaxf(cm, fmaxf(p0[v], p1[v]));
            cm = fmaxf(cm, __shfl_xor(cm, 32));
            const float mn = fmaxf(mx, cm), al = __expf(mx - mn); mx = mn;
            float ps = 0.f;
#pragma unroll
            for (int v = 0; v < 16; ++v) { p0[v] = __expf(p0[v] - mn); p1[v] = __expf(p1[v] - mn); ps += p0[v] + p1[v]; }
            ls = ls * al + ps;
#pragma unroll
            for (int v = 0; v < 16; ++v) { o0[v] *= al; o1[v] *= al; }
            bf16x8 pb[4];
            { u32x4 w; w.x = cvt_pk_bf16(p0[0], p0[1]); w.y = cvt_pk_bf16(p0[2], p0[3]); w.z = cvt_pk_bf16(p0[4], p0[5]); w.w = cvt_pk_bf16(p0[6], p0[7]); pb[0] = __builtin_bit_cast(bf16x8, w);
              w.x = cvt_pk_bf16(p0[8], p0[9]); w.y = cvt_pk_bf16(p0[10], p0[11]); w.z = cvt_pk_bf16(p0[12], p0[13]); w.w = cvt_pk_bf16(p0[14], p0[15]); pb[1] = __builtin_bit_cast(bf16x8, w);
              w.x = cvt_pk_bf16(p1[0], p1[1]); w.y = cvt_pk_bf16(p1[2], p1[3]); w.z = cvt_pk_bf16(p1[4], p1[5]); w.w = cvt_pk_bf16(p1[6], p1[7]); pb[2] = __builtin_bit_cast(bf16x8, w);
              w.x = cvt_pk_bf16(p1[8], p1[9]); w.y = cvt_pk_bf16(p1[10], p1[11]); w.z = cvt_pk_bf16(p1[12], p1[13]); w.w = cvt_pk_bf16(p1[14], p1[15]); pb[3] = __builtin_bit_cast(bf16x8, w); }
            const LAS unsigned char* vb = Vl + cb * 8192 + (4 * hi + ((lane & 15) >> 2)) * 128 + ((lane >> 4) & 1) * 32 + (lane & 3) * 8;
#pragma unroll
            for (int ks = 0; ks < 4; ++ks) {
#pragma unroll
                for (int dh = 0; dh < 2; ++dh) { const s16x4 lo = lds_tr16(vb + ks * 2048 + dh * 64), hh = lds_tr16(vb + ks * 2048 + 1024 + dh * 64);
                    const bf16x8 va = (bf16x8){lo[0], lo[1], lo[2], lo[3], hh[0], hh[1], hh[2], hh[3]};
                    if (dh == 0) o0 = __builtin_amdgcn_mfma_f32_32x32x16_f16(__builtin_bit_cast(half8_t, va), __builtin_bit_cast(half8_t, pb[ks]), o0, 0, 0, 0); else o1 = __builtin_amdgcn_mfma_f32_32x32x16_f16(__builtin_bit_cast(half8_t, va), __builtin_bit_cast(half8_t, pb[ks]), o1, 0, 0, 0); } }
            cb ^= 1;
        }
        ls += __shfl_xor(ls, 32);
        const float inv = 1.f / ls;
        asm volatile("s_waitcnt lgkmcnt(0)" ::: "memory");
#pragma unroll
        for (int v = 0; v < 16; ++v) { const int d = (v & 3) + 8 * (v >> 2) + 4 * hi;
            *(LAS bf16_t*)(stg + r32 * 144 + d * 2) = (bf16_t)f2bf(o0[v] * inv); *(LAS bf16_t*)(stg + r32 * 144 + (32 + d) * 2) = (bf16_t)f2bf(o1[v] * inv); }
        asm volatile("s_waitcnt lgkmcnt(0)" ::: "memory");
#pragma unroll
        for (int c = 0; c < 4; ++c) { const int row = c * 8 + (lane >> 3), ch = lane & 7; const u32x4 w = *(const LAS u32x4*)(stg + row * 144 + ch * 16);
            *(u32x4*)(O + (t0 + qh * 32 + row) * DM + 256 + h * 64 + ch * 8) = w; }
    }
#undef ATT_VDMA
}

__device__ __forceinline__ f32x16 mma32(bf16x8 a, bf16x8 b, f32x16 c) { return __builtin_amdgcn_mfma_f32_32x32x16_f16(__builtin_bit_cast(half8_t, a), __builtin_bit_cast(half8_t, b), c, 0, 0, 0); }
__device__ __forceinline__ bf16x8 trfrag(LAS const unsigned char* a0, LAS const unsigned char* a1) { const s16x4 lo = lds_tr16(a0), hh = lds_tr16(a1); return (bf16x8){lo[0], lo[1], lo[2], lo[3], hh[0], hh[1], hh[2], hh[3]}; }
__device__ __forceinline__ f32x16 zero16() { f32x16 z;
#pragma unroll
    for (int v = 0; v < 16; ++v) z[v] = 0.f;
    return z; }
__device__ __forceinline__ void rot_frags(const bf16_t* xrow, const float* rrow, int hi, float sc, bf16x8& f0, bf16x8& f1) {
    const u32x4 w1 = *(const u32x4*)(xrow + 8 * hi), w2 = *(const u32x4*)(xrow + 16 + 8 * hi); float x1[8], x2[8]; unpack8(w1, x1); unpack8(w2, x2);
    const f32x4 c0 = *(const f32x4*)(rrow + 8 * hi), c1 = *(const f32x4*)(rrow + 8 * hi + 4), s0 = *(const f32x4*)(rrow + 16 + 8 * hi), s1 = *(const f32x4*)(rrow + 16 + 8 * hi + 4);
    float a[8], b[8];
#pragma unroll
    for (int e = 0; e < 8; ++e) { const float c = e < 4 ? c0[e & 3] : c1[e & 3], s = e < 4 ? s0[e & 3] : s1[e & 3]; a[e] = (x1[e] * c - x2[e] * s) * sc; b[e] = (x1[e] * s + x2[e] * c) * sc; }
    f0 = __builtin_bit_cast(bf16x8, pack8(a)); f1 = __builtin_bit_cast(bf16x8, pack8(b));
}
__device__ __forceinline__ float ret_logg(int h);

__device__ __forceinline__ void upd_mfma(CPP p, int l, LAS unsigned char* lds) {
    const int tid = otid(), lane = tid & 63, wid = __builtin_amdgcn_readfirstlane(tid >> 6), r32 = lane & 31, hi = lane >> 5, i16 = lane & 15;
    LAS unsigned char* kz = lds + wid * 17536;
    LAS unsigned char* vt = kz + 4096;
    LAS unsigned char* gas = kz + 12288;
    const bf16_t* H = (const bf16_t*)(p->ws + WS_E); const float* rot = (const float*)(p->ws + WS_ROT);
    float* RU = (float*)(p->ws + WS_RU); float* GU = (float*)(p->ws + WS_GU); float* GL = (float*)(p->ws + WS_GL);
    const int gw = obid() * 8 + wid, NGW = ogrid() * 8;
    __syncthreads();
    for (int it = gw; it < 8192; it += NGW) {
        const int gla = it >> 12, h = it & 3, bi = (it >> 2) & 1023, i = bi & 31; const size_t t0 = (size_t)bi * 64;
        asm volatile("s_waitcnt lgkmcnt(0)" ::: "memory");
        { const int vcol = (gla ? C_GV : C_RV) + h * 64;
#pragma unroll
            for (int c = 0; c < 8; ++c) __builtin_amdgcn_global_load_lds((const unsigned*)(H + (t0 + c * 8 + (lane >> 3)) * NH + vcol + (lane & 7) * 8), (LAS unsigned*)(vt + c * 1024), 16, 0, 0); }
        if (!gla) {
            const bf16_t* xr = H + (t0 + lane) * NH + C_RK + h * 32; const float* rr = rot + (size_t)(i * 64 + lane) * 32;
            const float sc = 0.17677669529663689f * __expf(ret_logg(h) * (float)(63 - lane));
            float x[32], cs[32], o[32];
#pragma unroll
            for (int c = 0; c < 4; ++c) unpack8(*(const u32x4*)(xr + 8 * c), x + 8 * c);
#pragma unroll
            for (int c = 0; c < 8; ++c) { const f32x4 t = *(const f32x4*)(rr + 4 * c); cs[4 * c] = t[0]; cs[4 * c + 1] = t[1]; cs[4 * c + 2] = t[2]; cs[4 * c + 3] = t[3]; }
#pragma unroll
            for (int f = 0; f < 16; ++f) { o[f] = (x[f] * cs[f] - x[f + 16] * cs[16 + f]) * sc; o[f + 16] = (x[f] * cs[16 + f] + x[f + 16] * cs[f]) * sc; }
#pragma unroll
            for (int c = 0; c < 4; ++c) *(LAS u32x4*)(kz + lane * 64 + c * 16) = pack8(o + 8 * c);
        } else {
#pragma unroll
            for (int c = 0; c < 4; ++c) __builtin_amdgcn_global_load_lds((const unsigned*)(H + (t0 + 16 * c + (lane >> 2)) * NH + C_GK + h * 32 + (lane & 3) * 8), (LAS unsigned*)(kz + c * 1024), 16, 0, 0);
#pragma unroll
            for (int c = 0; c < 2; ++c) *(LAS u32x4*)(gas + lane * 32 + c * 16) = *(const u32x4*)(H + (t0 + lane) * NH + C_GA + 8 * c);
            float wa[16];
#pragma unroll
            for (int r = 0; r < 16; ++r) wa[r] = p->in[2][(size_t)(l * 16 + r) * 128 + h * 32 + r32];
            const float ba = p->in[3][l * 128 + h * 32 + r32];
            asm volatile("s_waitcnt vmcnt(0) lgkmcnt(0)" ::: "memory");
            float cum[32]; float run = 0.f;
#pragma unroll
            for (int jj = 0; jj < 32; ++jj) { const int j = hi * 32 + jj; float g[16]; unpack8(*(const LAS u32x4*)(gas + j * 32), g); unpack8(*(const LAS u32x4*)(gas + j * 32 + 16), g + 8);
                float z = ba;
#pragma unroll
                for (int r = 0; r < 16; ++r) z += g[r] * wa[r];
                run += (fminf(z, 0.f) - log1pf(expf(-fabsf(z)))) * 0.0625f; cum[jj] = run; }
            const float tot0 = __shfl(run, r32), tot1 = __shfl(run, 32 + r32), last = tot0 + tot1, off = hi ? tot0 : 0.f;
#pragma unroll
            for (int jj = 0; jj < 32; ++jj) { const int j = hi * 32 + jj; LAS bf16_t* kp = (LAS bf16_t*)(kz + j * 64 + r32 * 2);
                *kp = (bf16_t)f2bf(bf2f(*kp) * __expf(last - (cum[jj] + off))); }
            if (hi == 0) GL[(size_t)(bi * 4 + h) * 32 + r32] = last;
        }
        asm volatile("s_waitcnt vmcnt(0) lgkmcnt(0)" ::: "memory");
        f32x16 a0 = zero16(), a1 = zero16();
        const LAS unsigned char* ka = kz + (8 * hi + (i16 >> 2)) * 64 + ((lane >> 4) & 1) * 32 + (i16 & 3) * 8;
        const LAS unsigned char* va = vt + (8 * hi + (i16 >> 2)) * 128 + ((lane >> 4) & 1) * 32 + (i16 & 3) * 8;
#pragma unroll
        for (int s = 0; s < 4; ++s) { const bf16x8 A = trfrag(ka + s * 1024, ka + s * 1024 + 256);
            const bf16x8 B0 = trfrag(va + s * 2048, va + s * 2048 + 512), B1 = trfrag(va + s * 2048 + 64, va + s * 2048 + 512 + 64);
            a0 = mma32(A, B0, a0); a1 = mma32(A, B1, a1); }
        float* dst = (gla ? GU : RU) + (size_t)(bi * 4 + h) * 2048;
#pragma unroll
        for (int v = 0; v < 16; ++v) { const int dk = (v & 3) + 8 * (v >> 2) + 4 * hi; dst[dk * 64 + r32] = a0[v]; dst[dk * 64 + 32 + r32] = a1[v]; }
    }
}

__device__ __forceinline__ void out_mfma(CPP p, int l, LAS unsigned char* lds) {
    const int tid = otid(), lane = tid & 63, wid = __builtin_amdgcn_readfirstlane(tid >> 6), r32 = lane & 31, hi = lane >> 5, i16 = lane & 15;
    const int h = wid >> 1, nh = wid & 1;
    LAS unsigned char* vt = lds + wid * 17536;
    LAS unsigned char* Rt = vt + 8192;
    LAS unsigned char* stg = vt;
    const bf16_t* H = (const bf16_t*)(p->ws + WS_E); const float* rot = (const float*)(p->ws + WS_ROT); bf16_t* O = (bf16_t*)(p->ws + WS_O);
    const float* RU = (const float*)(p->ws + WS_RU); const float* GU = (const float*)(p->ws + WS_GU);
    __syncthreads();
    for (int it = obid(); it < 2048; it += ogrid()) {
        const int gla = it >> 10, bi = it & 1023, i = bi & 31; const size_t t0 = (size_t)bi * 64; const int n = nh * 32 + r32;
        asm volatile("s_waitcnt lgkmcnt(0)" ::: "memory");
        { const float* src = (gla ? GU : RU) + (size_t)(bi * 4 + h) * 2048;
#pragma unroll
            for (int c = 0; c < 8; ++c) { const int idx = c * 256 + lane * 4; const f32x4 t = *(const f32x4*)(src + idx); u32x2 w; w.x = pk2(t[0], t[1]); w.y = pk2(t[2], t[3]);
                *(LAS u32x2*)(Rt + (idx >> 6) * 128 + (idx & 63) * 2) = w; } }
        f32x16 o0 = zero16(), o1 = zero16();
        const LAS unsigned char* ra = Rt + (8 * hi + (i16 >> 2)) * 128 + ((lane >> 4) & 1) * 32 + (i16 & 3) * 8;
        if (!gla) {
#pragma unroll
            for (int c = 0; c < 8; ++c) __builtin_amdgcn_global_load_lds((const unsigned*)(H + (t0 + c * 8 + (lane >> 3)) * NH + C_RV + h * 64 + (lane & 7) * 8), (LAS unsigned*)(vt + c * 1024), 16, 0, 0);
            const float lg = ret_logg(h);
            bf16x8 qf[2], kf0[2], kf1[2];
            rot_frags(H + (t0 + n) * NH + C_RQ + h * 32, rot + (size_t)(i * 64 + n) * 32, hi, 1.f, qf[0], qf[1]);
            rot_frags(H + (t0 + r32) * NH + C_RK + h * 32, rot + (size_t)(i * 64 + r32) * 32, hi, 0.17677669529663689f, kf0[0], kf0[1]);
            rot_frags(H + (t0 + 32 + r32) * NH + C_RK + h * 32, rot + (size_t)(i * 64 + 32 + r32) * 32, hi, 0.17677669529663689f, kf1[0], kf1[1]);
            f32x16 p0 = zero16(), p1 = zero16();
            p0 = mma32(kf0[0], qf[0], p0); p0 = mma32(kf0[1], qf[1], p0); p1 = mma32(kf1[0], qf[0], p1); p1 = mma32(kf1[1], qf[1], p1);
#pragma unroll
            for (int v = 0; v < 16; ++v) { const int m = (v & 3) + 8 * (v >> 2) + 4 * hi; const int d0 = n - m, d1 = n - m - 32;
                p0[v] *= __expf(lg * (float)(d0 < 0 ? -d0 : d0)); p1[v] *= __expf(lg * (float)(d1 < 0 ? -d1 : d1)); }
            bf16x8 pb[4];
            { u32x4 w; w.x = pk2(p0[0], p0[1]); w.y = pk2(p0[2], p0[3]); w.z = pk2(p0[4], p0[5]); w.w = pk2(p0[6], p0[7]); pb[0] = __builtin_bit_cast(bf16x8, w);
              w.x = pk2(p0[8], p0[9]); w.y = pk2(p0[10], p0[11]); w.z = pk2(p0[12], p0[13]); w.w = pk2(p0[14], p0[15]); pb[1] = __builtin_bit_cast(bf16x8, w);
              w.x = pk2(p1[0], p1[1]); w.y = pk2(p1[2], p1[3]); w.z = pk2(p1[4], p1[5]); w.w = pk2(p1[6], p1[7]); pb[2] = __builtin_bit_cast(bf16x8, w);
              w.x = pk2(p1[8], p1[9]); w.y = pk2(p1[10], p1[11]); w.z = pk2(p1[12], p1[13]); w.w = pk2(p1[14], p1[15]); pb[3] = __builtin_bit_cast(bf16x8, w); }
            asm volatile("s_waitcnt vmcnt(0) lgkmcnt(0)" ::: "memory");
            const LAS unsigned char* vb = vt + (4 * hi + (i16 >> 2)) * 128 + ((lane >> 4) & 1) * 32 + (i16 & 3) * 8;
#pragma unroll
            for (int ks = 0; ks < 4; ++ks) { o0 = mma32(trfrag(vb + ks * 2048, vb + ks * 2048 + 1024), pb[ks], o0); o1 = mma32(trfrag(vb + ks * 2048 + 64, vb + ks * 2048 + 1024 + 64), pb[ks], o1); }
            const float xi = __expf(lg * (float)(n + 1));
#pragma unroll
            for (int s = 0; s < 2; ++s) { const bf16x8 qx = scale_frag(__builtin_bit_cast(u32x4, qf[s]), xi);
                o0 = mma32(trfrag(ra + s * 2048, ra + s * 2048 + 512), qx, o0); o1 = mma32(trfrag(ra + s * 2048 + 64, ra + s * 2048 + 512 + 64), qx, o1); }
        } else {
            bf16x8 qf[2];
#pragma unroll
            for (int s = 0; s < 2; ++s) qf[s] = scale_frag(*(const u32x4*)(H + (t0 + n) * NH + C_GQ + h * 32 + 16 * s + 8 * hi), 0.17677669529663689f);
            asm volatile("s_waitcnt lgkmcnt(0)" ::: "memory");
#pragma unroll
            for (int s = 0; s < 2; ++s) { o0 = mma32(trfrag(ra + s * 2048, ra + s * 2048 + 512), qf[s], o0); o1 = mma32(trfrag(ra + s * 2048 + 64, ra + s * 2048 + 512 + 64), qf[s], o1); }
        }
        float s = 0.f;
#pragma unroll
        for (int v = 0; v < 16; ++v) s += o0[v] + o1[v];
        s += __shfl_xor(s, 32);
        const float mean = s * (1.f / 64.f); float s2 = 0.f;
#pragma unroll
        for (int v = 0; v < 16; ++v) { o0[v] -= mean; o1[v] -= mean; s2 += o0[v] * o0[v] + o1[v] * o1[v]; }
        s2 += __shfl_xor(s2, 32);
        const float rs = 1.f / sqrtf(s2 * (1.f / 64.f) + LN_EPS);
        asm volatile("s_waitcnt lgkmcnt(0)" ::: "memory");
#pragma unroll
        for (int v = 0; v < 16; ++v) { const int d = (v & 3) + 8 * (v >> 2) + 4 * hi;
            *(LAS bf16_t*)(stg + r32 * 144 + d * 2) = (bf16_t)f2bf(o0[v] * rs); *(LAS bf16_t*)(stg + r32 * 144 + (32 + d) * 2) = (bf16_t)f2bf(o1[v] * rs); }
        asm volatile("s_waitcnt lgkmcnt(0)" ::: "memory");
#pragma unroll
        for (int c = 0; c < 4; ++c) { const int row = c * 8 + (lane >> 3), ch = lane & 7; float f[8], g[8]; unpack8(*(const LAS u32x4*)(stg + row * 144 + ch * 16), f);
            unpack8(*(const u32x4*)(H + (t0 + nh * 32 + row) * NH + (gla ? C_GR : C_RG) + h * 64 + ch * 8), g);
#pragma unroll
            for (int e = 0; e < 8; ++e) f[e] *= silu_f(g[e]);
            *(u32x4*)(O + (t0 + nh * 32 + row) * DM + (gla ? 512 : 0) + h * 64 + ch * 8) = pack8(f); }
    }
}

__device__ __forceinline__ void load_rot(const bf16_t* src, const float* rot, int i, LAS float* dst, float scale, float logz, int tid) {
#pragma unroll
    for (int q = 0; q < 2; ++q) { const int idx = tid + 512 * q, j = idx >> 4, f = idx & 15;
        const float x1 = bf2f(src[(size_t)j * NH + f]), x2 = bf2f(src[(size_t)j * NH + f + 16]);
        const int pos = i * 64 + j; const float c = rot[pos * 32 + f], s = rot[pos * 32 + 16 + f];
        const float sc = scale * __expf(logz * (float)(63 - j));
        dst[j * 33 + f] = (x1 * c - x2 * s) * sc; dst[j * 33 + f + 16] = (x1 * s + x2 * c) * sc; }
}
__device__ __forceinline__ float ret_logg(int h) { return log1pf(-exp2f(-5.f - (float)h)); }

__device__ __forceinline__ void upd_items(CPP p, int l, LAS unsigned char* lds) {
    LAS float* kt = (LAS float*)lds; LAS float* vv = kt + 64 * 33; LAS float* la = vv + 64 * 68; LAS float* gas = la + 64 * 33; LAS float* was = gas + 1024; LAS float* bas = was + 512;
    const bf16_t* H = (const bf16_t*)(p->ws + WS_E); const float* rot = (const float*)(p->ws + WS_ROT);
    float* RU = (float*)(p->ws + WS_RU); float* GU = (float*)(p->ws + WS_GU); float* GL = (float*)(p->ws + WS_GL);
    const int tid = otid();
    for (int it = obid(); it < 8192; it += ogrid()) {
        const int gla = it >> 12, h = it & 3, bi = (it >> 2) & 1023, i = bi & 31;
        const size_t t0 = (size_t)bi * 64;
        __syncthreads();
        if (!gla) {
            load_rot(H + t0 * NH + C_RK + h * 32, rot, i, kt, 0.17677669529663689f, ret_logg(h), tid);
            load_tile64(H + t0 * NH + C_RV + h * 64, NH, vv, 68, 1.f, tid);
            __syncthreads();
        } else {
            if (tid < 128) { const int j = tid >> 1, c = (tid & 1) * 8; const u32x4 w = *(const u32x4*)(H + (t0 + j) * NH + C_GA + c); float f[8]; unpack8(w, f);
#pragma unroll
                for (int e = 0; e < 8; ++e) gas[j * 16 + c + e] = f[e]; }
            { const int r = tid >> 5, dk = tid & 31; was[tid] = p->in[2][(size_t)(l * 16 + r) * 128 + h * 32 + dk]; }
            if (tid < 32) bas[tid] = p->in[3][l * 128 + h * 32 + tid];
            { const int idx = tid * 4, j = idx >> 5, c = idx & 31; const u32x2 w = *(const u32x2*)(H + (t0 + j) * NH + C_GK + h * 32 + c);
                kt[j * 33 + c] = bflo(w.x); kt[j * 33 + c + 1] = bfhi(w.x); kt[j * 33 + c + 2] = bflo(w.y); kt[j * 33 + c + 3] = bfhi(w.y); }
            load_tile64(H + t0 * NH + C_GV + h * 64, NH, vv, 68, 1.f, tid);
            __syncthreads();
#pragma unroll
            for (int q = 0; q < 4; ++q) { const int e = tid + 512 * q, j = e >> 5, dk = e & 31; float z = bas[dk];
#pragma unroll
                for (int r = 0; r < 16; ++r) z += gas[j * 16 + r] * was[r * 32 + dk];
                const float lsg = fminf(z, 0.f) - log1pf(expf(-fabsf(z)));
                la[j * 33 + dk] = lsg * 0.0625f; }
            __syncthreads();
            if (tid < 32) { float run = 0.f; for (int j = 0; j < 64; ++j) { run += la[j * 33 + tid]; la[j * 33 + tid] = run; } }
            __syncthreads();
#pragma unroll
            for (int q = 0; q < 4; ++q) { const int e = tid + 512 * q, j = e >> 5, dk = e & 31; kt[j * 33 + dk] *= __expf(la[63 * 33 + dk] - la[j * 33 + dk]); }
            if (tid < 32) GL[(size_t)(bi * 4 + h) * 32 + tid] = la[63 * 33 + tid];
            __syncthreads();
        }
        const int dk = tid >> 4, dv0 = (tid & 15) * 4; f32x4 a = (f32x4){0.f, 0.f, 0.f, 0.f};
#pragma unroll 8
        for (int j = 0; j < 64; ++j) { const float kk = kt[j * 33 + dk]; const f32x4 v4 = *(const LAS f32x4*)(vv + j * 68 + dv0); a += v4 * kk; }
        float* dst = (gla ? GU : RU) + (size_t)(bi * 4 + h) * 2048 + dk * 64 + dv0;
        *(f32x4*)dst = a;
    }
}

__device__ __forceinline__ void scan_items(CPP p, int l) {
    float* RU = (float*)(p->ws + WS_RU); float* GU = (float*)(p->ws + WS_GU); const float* GL = (const float*)(p->ws + WS_GL);
    const float* ES = (const float*)(p->ws + WS_ES); bf16_t* U2 = (bf16_t*)(p->ws + WS_U2);
    const int gt = obid() * 512 + otid(), NT = ogrid() * 512;
    for (int e = gt; e < 262144; e += NT) { const int dvk = e & 2047, bh = e >> 11, h = bh & 3, b = bh >> 2;
        const float dec = expf(64.f * ret_logg(h)); float st = 0.f; float t[32];
        float* base = RU + (size_t)(b * 32 * 4 + h) * 2048 + dvk;
#pragma unroll
        for (int i = 0; i < 32; ++i) t[i] = base[(size_t)i * 8192];
#pragma unroll
        for (int i = 0; i < 32; ++i) { base[(size_t)i * 8192] = st; st = st * dec + t[i]; } }
    for (int e = gt; e < 262144; e += NT) { const int dvk = e & 2047, bh = e >> 11, h = bh & 3, b = bh >> 2; float st = 0.f; float t[32], gl[32];
        float* base = GU + (size_t)(b * 32 * 4 + h) * 2048 + dvk; const float* gb = GL + (size_t)(b * 32 * 4 + h) * 32 + (dvk >> 6);
#pragma unroll
        for (int i = 0; i < 32; ++i) { t[i] = base[(size_t)i * 8192]; gl[i] = gb[i * 128]; }
#pragma unroll
        for (int i = 0; i < 32; ++i) { st = __expf(gl[i]) * st + t[i]; base[(size_t)i * 8192] = st; } }
    for (int e = gt; e < 32768; e += NT) { const int pp = e & 63, g = (e >> 6) & 15, b = e >> 10; const int gp = (l * 16 + g) * 64 + pp;
        const float lr = p->in[5][gp], li = p->in[6][gp], dt = expf(p->in[7][l * 16 + g]);
        float ar, ai2; s5_abar_pow(lr, li, dt, 64, ar, ai2);
        float xr = 0.f, xi = 0.f; float er[32], ei[32];
        const size_t row0 = (size_t)g * 1024 + b * 32;
#pragma unroll
        for (int i = 0; i < 32; ++i) { er[i] = ES[(row0 + i) * 128 + pp]; ei[i] = ES[(row0 + i) * 128 + 64 + pp]; }
#pragma unroll
        for (int i = 0; i < 32; ++i) { U2[(row0 + i) * S5K + 1024 + pp] = (bf16_t)f2bf(xr); U2[(row0 + i) * S5K + 1088 + pp] = (bf16_t)f2bf(xi);
            const float nr = ar * xr - ai2 * xi + er[i], ni = ar * xi + ai2 * xr + ei[i]; xr = nr; xi = ni; } }
}

__device__ __forceinline__ void out_items(CPP p, int l, LAS unsigned char* lds) {
    LAS float* qt = (LAS float*)lds; LAS float* kt = qt + 64 * 33; LAS float* vv = kt + 64 * 33; LAS float* Sm = vv + 64 * 68; LAS float* Rm = Sm + 64 * 65;
    const bf16_t* H = (const bf16_t*)(p->ws + WS_E); const float* rot = (const float*)(p->ws + WS_ROT); bf16_t* O = (bf16_t*)(p->ws + WS_O);
    const float* RU = (const float*)(p->ws + WS_RU); const float* GU = (const float*)(p->ws + WS_GU);
    const int tid = otid();
    for (int it = obid(); it < 8192; it += ogrid()) {
        const int gla = it >> 12, h = it & 3, bi = (it >> 2) & 1023, i = bi & 31;
        const size_t t0 = (size_t)bi * 64;
        const int n = tid >> 3, dv0 = (tid & 7) * 8;
        float acc[8];
#pragma unroll
        for (int e = 0; e < 8; ++e) acc[e] = 0.f;
        __syncthreads();
        { const float* src = (gla ? GU : RU) + (size_t)(bi * 4 + h) * 2048; const int idx = tid * 4, dk = idx >> 6, dv = idx & 63;
            const f32x4 t = *(const f32x4*)(src + idx); Rm[dk * 68 + dv] = t[0]; Rm[dk * 68 + dv + 1] = t[1]; Rm[dk * 68 + dv + 2] = t[2]; Rm[dk * 68 + dv + 3] = t[3]; }
        if (!gla) {
            const float lg = ret_logg(h);
            load_rot(H + t0 * NH + C_RQ + h * 32, rot, i, qt, 1.f, 0.f, tid);
            load_rot(H + t0 * NH + C_RK + h * 32, rot, i, kt, 0.17677669529663689f, 0.f, tid);
            load_tile64(H + t0 * NH + C_RV + h * 64, NH, vv, 68, 1.f, tid);
            __syncthreads();
            { const int m0 = (tid & 7) * 8;
#pragma unroll
                for (int mm = 0; mm < 8; ++mm) { const int m = m0 + mm; float d = 0.f;
#pragma unroll
                    for (int dk = 0; dk < 32; ++dk) d += qt[n * 33 + dk] * kt[m * 33 + dk];
                    const int ad = n > m ? n - m : m - n; Sm[n * 65 + m] = d * __expf(lg * (float)ad); } }
            __syncthreads();
#pragma unroll 4
            for (int m = 0; m < 64; ++m) { const float sv = Sm[n * 65 + m]; const f32x4 v0 = *(const LAS f32x4*)(vv + m * 68 + dv0), v1 = *(const LAS f32x4*)(vv + m * 68 + dv0 + 4);
                acc[0] += sv * v0[0]; acc[1] += sv * v0[1]; acc[2] += sv * v0[2]; acc[3] += sv * v0[3]; acc[4] += sv * v1[0]; acc[5] += sv * v1[1]; acc[6] += sv * v1[2]; acc[7] += sv * v1[3]; }
            const float xi = __expf(lg * (float)(n + 1));
#pragma unroll 4
            for (int dk = 0; dk < 32; ++dk) { const float qx = qt[n * 33 + dk] * xi; const f32x4 v0 = *(const LAS f32x4*)(Rm + dk * 68 + dv0), v1 = *(const LAS f32x4*)(Rm + dk * 68 + dv0 + 4);
                acc[0] += qx * v0[0]; acc[1] += qx * v0[1]; acc[2] += qx * v0[2]; acc[3] += qx * v0[3]; acc[4] += qx * v1[0]; acc[5] += qx * v1[1]; acc[6] += qx * v1[2]; acc[7] += qx * v1[3]; }
        } else {
            { const int idx = tid * 4, j = idx >> 5, c = idx & 31; const u32x2 w = *(const u32x2*)(H + (t0 + j) * NH + C_GQ + h * 32 + c); const float sc = 0.17677669529663689f;
                qt[j * 33 + c] = bflo(w.x) * sc; qt[j * 33 + c + 1] = bfhi(w.x) * sc; qt[j * 33 + c + 2] = bflo(w.y) * sc; qt[j * 33 + c + 3] = bfhi(w.y) * sc; }
            __syncthreads();
#pragma unroll 4
            for (int dk = 0; dk < 32; ++dk) { const float qx = qt[n * 33 + dk]; const f32x4 v0 = *(const LAS f32x4*)(Rm + dk * 68 + dv0), v1 = *(const LAS f32x4*)(Rm + dk * 68 + dv0 + 4);
                acc[0] += qx * v0[0]; acc[1] += qx * v0[1]; acc[2] += qx * v0[2]; acc[3] += qx * v0[3]; acc[4] += qx * v1[0]; acc[5] += qx * v1[1]; acc[6] += qx * v1[2]; acc[7] += qx * v1[3]; }
        }
        float s = 0.f;
#pragma unroll
        for (int e = 0; e < 8; ++e) s += acc[e];
        s += __shfl_xor(s, 1); s += __shfl_xor(s, 2); s += __shfl_xor(s, 4);
        const float mean = s * (1.f / 64.f); float s2 = 0.f;
#pragma unroll
        for (int e = 0; e < 8; ++e) { acc[e] -= mean; s2 += acc[e] * acc[e]; }
        s2 += __shfl_xor(s2, 1); s2 += __shfl_xor(s2, 2); s2 += __shfl_xor(s2, 4);
        const float rs = 1.f / sqrtf(s2 * (1.f / 64.f) + LN_EPS);
        const u32x4 gw = *(const u32x4*)(H + (t0 + n) * NH + (gla ? C_GR : C_RG) + h * 64 + dv0); float gf[8]; unpack8(gw, gf);
        float ov[8];
#pragma unroll
        for (int e = 0; e < 8; ++e) ov[e] = silu_f(gf[e]) * acc[e] * rs;
        *(u32x4*)(O + (t0 + n) * DM + (gla ? 512 : 0) + h * 64 + dv0) = pack8(ov);
    }
}


#define XB_TMO      128
#define XB_XCNT(j)  (256  + 64 * (j))
#define XB_XSUB(j)  (1280 + 64 * (j))
#define XB_XGEN(j)  (2304 + 64 * (j))
#define XB_TOP      3328
#define XB_TOPGEN   3392
#define XCD_BAR_WORDS 3456
#define XB_SPIN_CAP (1u << 20)
__device__ __forceinline__ unsigned xb_ld(unsigned* p)              { return __hip_atomic_load(p, __ATOMIC_RELAXED, __HIP_MEMORY_SCOPE_AGENT); }
__device__ __forceinline__ unsigned xb_add(unsigned* p, unsigned v) { return __hip_atomic_fetch_add(p, v, __ATOMIC_RELAXED, __HIP_MEMORY_SCOPE_AGENT); }
__device__ __forceinline__ unsigned xb_xcc_id() { return (unsigned)__builtin_amdgcn_s_getreg((3 << 11) | 20) & 0xFu; }
#define XB_SPIN(cond, bar) do { unsigned _sp = 0; while (cond) { __builtin_amdgcn_s_sleep(1); \
    if ((++_sp & 255u) == 0u) { if (xb_ld(&(bar)[XB_TMO])) break; if (_sp > XB_SPIN_CAP) { atomicAdd(&(bar)[XB_TMO], 1u); break; } } } } while (0)
struct XcdBarrier { unsigned* bar; unsigned x; volatile LAS unsigned* st; };
__device__ __forceinline__ XcdBarrier xcd_barrier_post(unsigned* bar, volatile LAS unsigned* st) {
    XcdBarrier b; b.bar = bar; b.x = xb_xcc_id(); b.st = st;
    if (threadIdx.x == 0) (void)xb_add(&bar[XB_XCNT(b.x)], 1u);
    return b;
}
__device__ __forceinline__ void xcd_barrier_complete(unsigned* bar, unsigned x, unsigned& nloc, unsigned& nx) {
    const unsigned G = gridDim.x * gridDim.y * gridDim.z;
    unsigned sum, cnt, mine, sp = 0u;
    for (;;) {
        sum = 0u; cnt = 0u; mine = 0u;
#pragma unroll
        for (unsigned j = 0; j < 16; ++j) { const unsigned c = xb_ld(&bar[XB_XCNT(j)]); sum += c; cnt += (c > 0u) ? 1u : 0u; mine = (j == x) ? c : mine; }
        if (sum == G) break;
        __builtin_amdgcn_s_sleep(1);
        if ((++sp & 255u) == 0u) { if (xb_ld(&bar[XB_TMO])) break; if (sp > XB_SPIN_CAP) { atomicAdd(&bar[XB_TMO], 1u); break; } }
    }
    nloc = mine > 0u ? mine : 1u; nx = cnt > 0u ? cnt : 1u;
}
__device__ __forceinline__ void xcd_barrier(const XcdBarrier& b) {
    asm volatile("s_waitcnt vmcnt(0)" ::: "memory");
    __syncthreads();
    if (threadIdx.x == 0) {
        unsigned* bar = b.bar;
        __builtin_amdgcn_s_waitcnt(0);
        unsigned nloc = b.st[0], nx = b.st[1];
        if (nloc == 0u) { xcd_barrier_complete(bar, b.x, nloc, nx); b.st[0] = nloc; b.st[1] = nx; }
        const unsigned old = xb_add(&bar[XB_XSUB(b.x)], 1u);
        const unsigned gen = old / nloc;
        if (old + 1u == (gen + 1u) * nloc) {
            __builtin_amdgcn_fence(__ATOMIC_RELEASE, "agent");
            asm volatile("s_waitcnt vmcnt(0)" ::: "memory");
            const unsigned og = xb_add(&bar[XB_TOP], 1u);
            const unsigned tg = og / nx;
            if (og + 1u == (tg + 1u) * nx) xb_add(&bar[XB_TOPGEN], 1u);
            else XB_SPIN(xb_ld(&bar[XB_TOPGEN]) == tg, bar);
            __builtin_amdgcn_fence(__ATOMIC_ACQUIRE, "agent");
            xb_add(&bar[XB_XGEN(b.x)], 1u);
            asm volatile("s_waitcnt vmcnt(0)" ::: "memory");
        } else {
            XB_SPIN(xb_ld(&bar[XB_XGEN(b.x)]) == gen, bar);
            __builtin_amdgcn_fence(__ATOMIC_ACQUIRE, "agent");
            asm volatile("s_waitcnt vmcnt(0)" ::: "memory");
        }
    }
    __syncthreads();
}

__global__ void __launch_bounds__(512, 2) mega(Params p_unused) {
    extern __shared__ __attribute__((aligned(16))) unsigned char lds_raw[];
    LAS unsigned char* lds = (LAS unsigned char*)lds_raw;
    cg::grid_group grid = cg::this_grid();
    CPP p = (CPP)__builtin_amdgcn_kernarg_segment_ptr();
    unsigned char* ws = p->ws;
    bf16_t* XB = (bf16_t*)(ws + WS_XB);
    volatile LAS unsigned* bst = (volatile LAS unsigned*)(lds + LDS_BYTES - 64);
    if (threadIdx.x < 2) bst[threadIdx.x] = 0u;
    __syncthreads();
    const XcdBarrier bar = xcd_barrier_post((unsigned*)ws, bst);

    { float* rot = (float*)(ws + WS_ROT); const int gt = obid() * 512 + otid(), NT = ogrid() * 512;
        for (int e = gt; e < 2048 * 16; e += NT) { const int pos = e >> 4, f = e & 15; const float inv = 1.0f / powf(10000.0f, (float)f * (1.0f / 16.0f)); const float ang = (float)pos * inv;
            rot[pos * 32 + f] = cosf(ang); rot[pos * 32 + 16 + f] = sinf(ang); } }
    s5_tables(p, 0, lds);
    { const float* x = p->in[0]; const int gt = obid() * 512 + otid(), NT = ogrid() * 512;
        for (size_t e = gt; e < (size_t)M * DM / 8; e += NT) { const f32x4 a = *((const f32x4*)x + 2 * e), b = *((const f32x4*)x + 2 * e + 1);
            u32x4 w; w.x = pk2(a[0], a[1]); w.y = pk2(a[2], a[3]); w.z = pk2(b[0], b[1]); w.w = pk2(b[2], b[3]); *((u32x4*)XB + e) = w; } }
    grid.sync();
    convert_weights(p, 0, lds);
    xcd_barrier(bar);

    for (int l = 0; l < 4; ++l) {
        for (int s = 0; s < 12; ++s) {
            p = (CPP)__builtin_amdgcn_kernarg_segment_ptr(); asm volatile("" : "+s"(p));
            pg8::Gemm g; pg8::Sched S; pg8::Epi E;
            bool do_gemm = true;
            S.G = ogrid(); S.c = obid(); S.mode = 0; S.nM = M / 256; S.nN = 1;
            E.mode = 0; E.perm = true;
            E.ws = ws; E.dskip = p->in[12] + l * 256; E.bglu = p->in[14] + l * 256; E.bgate = p->in[16] + (size_t)l * 4096;
            g.A = XB; g.Bt = (const bf16_t*)(ws + WS_WIN); g.lda = DM; g.ldb = DM; g.K = DM;
            switch (s) {
                case 0: S.nN = NINP / 256; E.mode = 0; E.perm = true; break;
                case 1: g.A = (const bf16_t*)(ws + WS_U2); g.Bt = (const bf16_t*)(ws + WS_WE); g.lda = S5K; g.ldb = 1024; g.K = 1024; S.mode = 2; S.nM = 64; S.nN = 1; E.mode = 1; break;
                case 3: g.A = (const bf16_t*)(ws + WS_U2); g.Bt = (const bf16_t*)(ws + WS_WT); g.lda = S5K; g.ldb = S5K; g.K = S5K; S.mode = 3; S.nM = 64; S.nN = 4; E.mode = 2; break;
                case 4: g.A = (const bf16_t*)(ws + WS_YS); g.Bt = (const bf16_t*)(ws + WS_WGLU); g.lda = 256; g.ldb = 256; g.K = 256; S.nN = 1; E.mode = 3; break;
                case 5: g.A = (const bf16_t*)(ws + WS_O); g.Bt = (const bf16_t*)(ws + WS_WB); g.lda = DM; g.ldb = 256; g.K = 256; S.mode = 1; S.nN = 16; E.mode = 4; break;
                case 6: g.Bt = (const bf16_t*)(ws + WS_WG); S.nN = 16; E.mode = 5; E.perm = false; break;
                case 7: g.A = (const bf16_t*)(ws + WS_O); g.Bt = (const bf16_t*)(ws + WS_WO); S.nN = 4; E.mode = 6; E.perm = true; break;
                case 9: g.Bt = (const bf16_t*)(ws + WS_WFF); S.nN = 22; E.mode = 7; E.perm = true; break;
                case 10: g.A = (const bf16_t*)(ws + WS_E); g.Bt = (const bf16_t*)(ws + WS_WD); g.lda = DFF; g.ldb = DFF; g.K = DFF; S.nN = 4; E.mode = 6; E.perm = true; break;
                default: do_gemm = false; break;
            }
            S.nwg = S.nM * S.nN;
            if (do_gemm) pg8::gemm_phase(lds, g, S, E);
            if (s == 1) { attn_mfma(p, l, lds); upd_mfma(p, l, lds); }
            else if (s == 2) scan_items(p, l);
            else if (s == 3) out_mfma(p, l, lds);
            else if (s == 8) { ln_pass(XB, nullptr, p->in[19] + l * DM, p->in[20] + l * DM); if (l < 3) s5_tables(p, l + 1, lds); }
            else if (s == 11) { ln_pass(XB, (l == 3) ? p->out : nullptr, p->in[24] + l * DM, p->in[25] + l * DM); if (l < 3) convert_weights(p, l + 1, lds); }
            xcd_barrier(bar);
        }
    }
}

extern "C" void kernel_launch(void* const* d_in, const int* in_sizes, int n_in, void* d_out, int out_size, void* d_ws, size_t ws_size, hipStream_t stream) {
    static int grid_blocks = 0;
    if (!grid_blocks) {
        int dev = 0, cus = 0;
        hipGetDevice(&dev);
        hipDeviceGetAttribute(&cus, hipDeviceAttributeMultiprocessorCount, dev);
        hipFuncSetAttribute((const void*)mega, hipFuncAttributeMaxDynamicSharedMemorySize, LDS_BYTES);
        grid_blocks = cus > 0 ? cus : 256;
    }
    (void)hipMemsetAsync(d_ws, 0, 65536, stream);
    Params p{};
    for (int i = 0; i < 26; ++i) p.in[i] = (const float*)d_in[i];
    p.out = (float*)d_out; p.ws = (unsigned char*)d_ws;
    void* args[] = {&p};
    hipError_t e = hipLaunchCooperativeKernel((const void*)mega, dim3(grid_blocks), dim3(512), args, LDS_BYTES, stream);
    if (e != hipSuccess) fprintf(stderr, "cooperative launch failed: %s (grid %d)\n", hipGetErrorString(e), grid_blocks);
}
```

```cpp
#include <hip/hip_runtime.h>
#include <hip/hip_cooperative_groups.h>
#include <cstdint>
#include <cstdio>
namespace cg = cooperative_groups;

#define LAS __attribute__((address_space(3)))
typedef unsigned short bf16_t;
typedef short bf16x8 __attribute__((ext_vector_type(8)));
typedef float f32x4 __attribute__((ext_vector_type(4)));
typedef float f32x2 __attribute__((ext_vector_type(2)));
typedef unsigned u32x4 __attribute__((ext_vector_type(4)));
typedef unsigned u32x2 __attribute__((ext_vector_type(2)));

constexpr int M = 65536, DM = 1024, SEQ = 2048, NCH = 32;
constexpr int NH = 2320;
constexpr int NINP = 2816;
constexpr int DFF = 2816;
constexpr int S5K = 1152;
constexpr float ALPHA = 1.681792830507429f;
constexpr float LN_EPS = 1e-5f;
constexpr int C_RQ = 0, C_RK = 128, C_RV = 256, C_RG = 512, C_AQ = 768, C_AK = 1024, C_AV = 1280, C_GQ = 1536, C_GK = 1664, C_GV = 1792, C_GR = 2048, C_GA = 2304, C_SU = 2320;

constexpr size_t MiB = 1u << 20;
constexpr size_t WS_ROT = 1 * MiB;
constexpr size_t WS_KN = 2 * MiB;
constexpr size_t WS_WIN = 4 * MiB;
constexpr size_t WS_WG = 10 * MiB;
constexpr size_t WS_WB = 18 * MiB;
constexpr size_t WS_WO = 20 * MiB;
constexpr size_t WS_WFF = 22 * MiB;
constexpr size_t WS_WD = 33 * MiB;
constexpr size_t WS_WGLU = 39 * MiB;
constexpr size_t WS_WE = 40 * MiB;
constexpr size_t WS_WT = 48 * MiB;
constexpr size_t WS_XB = 88 * MiB;
constexpr size_t WS_O = 216 * MiB;
constexpr size_t WS_E = 344 * MiB;
constexpr size_t WS_U2 = 636 * MiB;
constexpr size_t WS_RU = 676 * MiB;
constexpr size_t WS_GU = 708 * MiB;
constexpr size_t WS_GL = 740 * MiB;
constexpr size_t WS_ES = 741 * MiB;
constexpr size_t WS_YS = 749 * MiB;
constexpr int LDS_BYTES = 147456;

struct Params { const float* in[26]; float* out; unsigned char* ws; };
typedef const __attribute__((address_space(4))) Params* CPP;

typedef _Float16 half2_t __attribute__((ext_vector_type(2)));
typedef _Float16 half8_t __attribute__((ext_vector_type(8)));
__device__ __forceinline__ float bflo(unsigned w) { return (float)__builtin_bit_cast(half2_t, w)[0]; }
__device__ __forceinline__ float bfhi(unsigned w) { return (float)__builtin_bit_cast(half2_t, w)[1]; }
__device__ __forceinline__ float bf2f(bf16_t b) { return (float)__builtin_bit_cast(_Float16, b); }
__device__ __forceinline__ unsigned f2bf(float f) { return (unsigned)__builtin_bit_cast(unsigned short, (_Float16)f); }
__device__ __forceinline__ unsigned pk2(float lo, float hi) { const half2_t v = {(_Float16)lo, (_Float16)hi}; return __builtin_bit_cast(unsigned, v); }
__device__ __forceinline__ unsigned cvt_pk_bf16(float lo, float hi) { return pk2(lo, hi); }
__device__ __forceinline__ float sigm(float x) { return __builtin_amdgcn_rcpf(1.0f + __expf(-x)); }
__device__ __forceinline__ float silu_f(float x) { return x * sigm(x); }
__device__ __forceinline__ float gelu_tanh(float v) { return v * sigm(1.5957691216057308f * (v + 0.044715f * v * v * v)); }
__device__ __forceinline__ void unpack8(u32x4 w, float* o) {
    o[0] = bflo(w.x); o[1] = bfhi(w.x); o[2] = bflo(w.y); o[3] = bfhi(w.y); o[4] = bflo(w.z); o[5] = bfhi(w.z); o[6] = bflo(w.w); o[7] = bfhi(w.w);
}
__device__ __forceinline__ u32x4 pack8(const float* v) { u32x4 w; w.x = pk2(v[0], v[1]); w.y = pk2(v[2], v[3]); w.z = pk2(v[4], v[5]); w.w = pk2(v[6], v[7]); return w; }
__device__ __forceinline__ int otid() { int t = threadIdx.x; asm volatile("" : "+v"(t)); return t; }
__device__ __forceinline__ int obid() { int b = blockIdx.x; asm volatile("" : "+s"(b)); return b; }
__device__ __forceinline__ int ogrid() { int b = gridDim.x; asm volatile("" : "+s"(b)); return b; }
__device__ __forceinline__ float wave_sum(float v) {
#pragma unroll
    for (int o = 1; o < 64; o <<= 1) v += __shfl_xor(v, o);
    return v;
}

namespace pg8 {
constexpr int BM = 256, BK = 64, HALF = 128, HTB = HALF * BK * 2, STAGE_BYTES = 8 * HTB, NXCD = 8, WGM = 8;
__device__ __forceinline__ int lds_byte(int r, int c) { const int st = (r >> 4) * 2 + (c >> 5), rr = r & 15, cc = c & 31, ob = rr * 64 + cc * 2; return st * 1024 + (ob ^ (((ob >> 9) & 1) << 5)); }
__device__ __forceinline__ void stage_rc(int b, int& R, int& C) { const int st = b / 1024, sb = b % 1024, swz = sb ^ (((sb >> 9) & 1) << 5); R = (st >> 1) * 16 + swz / 64; C = (st & 1) * 32 + (swz % 64) / 2; }
__device__ __forceinline__ int perm32(int rho) { const int n = rho >> 4, i = rho & 15; return 8 * (i >> 2) + 4 * n + (i & 3); }

struct Unit { int pm, pn, ak; };
struct Gemm { const bf16_t* A; const bf16_t* Bt; int lda, ldb, K; };

struct Sched {
    int nM, nN, nwg, G, c, mode;
    __device__ __forceinline__ bool next(int i, Unit& u) const {
        const long L = (long)i * G + c; if (L >= nwg) return false;
        if (mode == 2) { u.pm = (int)L; u.pn = (int)(L >> 2); u.ak = 0; return true; }
        if (mode == 3) { const int g = (int)(L >> 4); u.pm = 4 * g + (int)((L >> 2) & 3); u.pn = 4 * g + (int)(L & 3); u.ak = 0; return true; }
        int wgid = (int)L; { const int q = nwg / NXCD, r = nwg % NXCD, xcd = wgid % NXCD, off = wgid / NXCD; wgid = (xcd < r ? xcd * (q + 1) : r * (q + 1) + (xcd - r) * q) + off; }
        const int nig = WGM * nN, gid = wgid / nig, fm = gid * WGM, gsz = (nM - fm) < WGM ? (nM - fm) : WGM;
        u.pm = fm + ((wgid % nig) % gsz); u.pn = (wgid % nig) / gsz; u.ak = (mode == 1) ? (u.pn >> 2) * 256 : 0; return true;
    }
};

struct Epi {
    int mode; bool perm;
    unsigned char* ws; const float* dskip; const float* bglu; const float* bgate;
    __device__ __forceinline__ void operator()(const f32x4 (&acc)[2][2][4][2], const Unit& u, int wr, int wc, int fr, int fq) const {
        const int row0 = u.pm * BM + wr * 64 + fr;
        bf16_t* const H = (bf16_t*)(ws + WS_E); bf16_t* const U2 = (bf16_t*)(ws + WS_U2); float* const ES = (float*)(ws + WS_ES); bf16_t* const YS = (bf16_t*)(ws + WS_YS);
        bf16_t* const Ob = (bf16_t*)(ws + WS_O); bf16_t* const P = (bf16_t*)(ws + WS_E); bf16_t* const MIX = (bf16_t*)(ws + WS_O); bf16_t* const HF = (bf16_t*)(ws + WS_E);
        if (mode == 0) {
#pragma unroll
            for (int ai = 0; ai < 2; ++ai)
#pragma unroll
                for (int m = 0; m < 4; ++m) { const int r = row0 + ai * HALF + m * 16;
#pragma unroll
                    for (int bj = 0; bj < 2; ++bj) { const int c0 = u.pn * BM + bj * HALF + wc * 32 + 8 * fq;
                        const f32x4 v0 = acc[ai][bj][m][0], v1 = acc[ai][bj][m][1];
                        u32x4 w; w.x = cvt_pk_bf16(v0[0], v0[1]); w.y = cvt_pk_bf16(v0[2], v0[3]); w.z = cvt_pk_bf16(v1[0], v1[1]); w.w = cvt_pk_bf16(v1[2], v1[3]);
                        if (c0 < C_SU) *(u32x4*)(H + (size_t)r * NH + c0) = w;
                        else if (c0 < C_SU + 256) { const int c = c0 - C_SU, g = c >> 4, ci = c & 15;
                            *(u32x4*)(U2 + ((size_t)(g * 1024 + (r >> 6))) * S5K + (r & 63) * 16 + ci) = w; } } }
        } else if (mode == 1) {
#pragma unroll
            for (int ai = 0; ai < 2; ++ai)
#pragma unroll
                for (int m = 0; m < 4; ++m) { const int r = row0 + ai * HALF + m * 16; const int c0 = wc * 32 + 8 * fq;
                    *(f32x4*)(ES + (size_t)r * 128 + c0) = acc[ai][0][m][0]; *(f32x4*)(ES + (size_t)r * 128 + c0 + 4) = acc[ai][0][m][1]; }
        } else if (mode == 2) {
            const int g = u.pm >> 2;
#pragma unroll
            for (int ai = 0; ai < 2; ++ai)
#pragma unroll
                for (int m = 0; m < 4; ++m) { const int r = row0 + ai * HALF + m * 16;
#pragma unroll
                    for (int bj = 0; bj < 2; ++bj) { const int n0 = (u.pn & 3) * BM + bj * HALF + wc * 32 + 8 * fq; const int j = n0 >> 4, i0 = n0 & 15;
                        const u32x4 uw = *(const u32x4*)(U2 + (size_t)r * S5K + n0); float uf[8]; unpack8(uw, uf);
                        const f32x4 d0 = *(const f32x4*)(dskip + 16 * g + i0), d1 = *(const f32x4*)(dskip + 16 * g + i0 + 4);
                        const f32x4 v0 = acc[ai][bj][m][0], v1 = acc[ai][bj][m][1]; float y[8];
                        y[0] = gelu_tanh(v0[0] + d0[0] * uf[0]); y[1] = gelu_tanh(v0[1] + d0[1] * uf[1]); y[2] = gelu_tanh(v0[2] + d0[2] * uf[2]); y[3] = gelu_tanh(v0[3] + d0[3] * uf[3]);
                        y[4] = gelu_tanh(v1[0] + d1[0] * uf[4]); y[5] = gelu_tanh(v1[1] + d1[1] * uf[5]); y[6] = gelu_tanh(v1[2] + d1[2] * uf[6]); y[7] = gelu_tanh(v1[3] + d1[3] * uf[7]);
                        u32x4 w; w.x = cvt_pk_bf16(y[0], y[1]); w.y = cvt_pk_bf16(y[2], y[3]); w.z = cvt_pk_bf16(y[4], y[5]); w.w = cvt_pk_bf16(y[6], y[7]);
                        const size_t t = (size_t)(r & 1023) * 64 + j;
                        *(u32x4*)(YS + t * 256 + 16 * g + i0) = w; } }
        } else if (mode == 3) {
#pragma unroll
            for (int ai = 0; ai < 2; ++ai)
#pragma unroll
                for (int m = 0; m < 4; ++m) { const int r = row0 + ai * HALF + m * 16;
#pragma unroll
                    for (int bj = 0; bj < 2; ++bj) { const int c0 = bj * HALF + wc * 32 + 8 * fq;
                        const u32x4 yw = *(const u32x4*)(YS + (size_t)r * 256 + c0); float yf[8]; unpack8(yw, yf);
                        const f32x4 b0 = *(const f32x4*)(bglu + c0), b1 = *(const f32x4*)(bglu + c0 + 4);
                        const f32x4 v0 = acc[ai][bj][m][0] + b0, v1 = acc[ai][bj][m][1] + b1; float o[8];
                        o[0] = yf[0] * sigm(v0[0]); o[1] = yf[1] * sigm(v0[1]); o[2] = yf[2] * sigm(v0[2]); o[3] = yf[3] * sigm(v0[3]);
                        o[4] = yf[4] * sigm(v1[0]); o[5] = yf[5] * sigm(v1[1]); o[6] = yf[6] * sigm(v1[2]); o[7] = yf[7] * sigm(v1[3]);
                        u32x4 w; w.x = cvt_pk_bf16(o[0], o[1]); w.y = cvt_pk_bf16(o[2], o[3]); w.z = cvt_pk_bf16(o[4], o[5]); w.w = cvt_pk_bf16(o[6], o[7]);
                        *(u32x4*)(Ob + (size_t)r * DM + 768 + c0) = w; } }
        } else if (mode == 4) {
#pragma unroll
            for (int ai = 0; ai < 2; ++ai)
#pragma unroll
                for (int m = 0; m < 4; ++m) { const int r = row0 + ai * HALF + m * 16;
#pragma unroll
                    for (int bj = 0; bj < 2; ++bj) { const int c0 = u.pn * BM + bj * HALF + wc * 32 + 8 * fq;
                        const f32x4 v0 = acc[ai][bj][m][0], v1 = acc[ai][bj][m][1];
                        u32x4 w; w.x = cvt_pk_bf16(v0[0], v0[1]); w.y = cvt_pk_bf16(v0[2], v0[3]); w.z = cvt_pk_bf16(v1[0], v1[1]); w.w = cvt_pk_bf16(v1[2], v1[3]);
                        *(u32x4*)(P + (size_t)r * 4096 + c0) = w; } }
        } else if (mode == 5) {
            const int ch0 = 64 * u.pn + 16 * wc + 4 * fq;
            f32x4 bv[4];
#pragma unroll
            for (int b = 0; b < 4; ++b) bv[b] = *(const f32x4*)(bgate + b * 1024 + ch0);
#pragma unroll
            for (int ai = 0; ai < 2; ++ai)
#pragma unroll
                for (int m = 0; m < 4; ++m) { const int r = row0 + ai * HALF + m * 16; f32x4 mix = (f32x4){0.f, 0.f, 0.f, 0.f};
#pragma unroll
                    for (int bj = 0; bj < 2; ++bj)
#pragma unroll
                        for (int n = 0; n < 2; ++n) { const int b = 2 * bj + n; const f32x4 a = acc[ai][bj][m][n] + bv[b];
                            const u32x2 pw = *(const u32x2*)(P + (size_t)r * 4096 + b * 1024 + ch0);
                            mix[0] += sigm(a[0]) * bflo(pw.x); mix[1] += sigm(a[1]) * bfhi(pw.x); mix[2] += sigm(a[2]) * bflo(pw.y); mix[3] += sigm(a[3]) * bfhi(pw.y); }
                    u32x2 w; w.x = cvt_pk_bf16(mix[0], mix[1]); w.y = cvt_pk_bf16(mix[2], mix[3]);
                    *(u32x2*)(MIX + (size_t)r * DM + ch0) = w; }
        } else if (mode == 6) {
            bf16_t* const XBp = (bf16_t*)(ws + WS_XB);
#pragma unroll
            for (int ai = 0; ai < 2; ++ai)
#pragma unroll
                for (int m = 0; m < 4; ++m) { const int r = row0 + ai * HALF + m * 16;
#pragma unroll
                    for (int bj = 0; bj < 2; ++bj) { const int c = u.pn * BM + bj * HALF + wc * 32 + 8 * fq;
                        u32x4* px = (u32x4*)(XBp + (size_t)r * DM + c); const u32x4 xw = *px; float xf[8]; unpack8(xw, xf);
                        const f32x4 a0 = acc[ai][bj][m][0], a1 = acc[ai][bj][m][1];
                        u32x4 w; w.x = cvt_pk_bf16(xf[0] * ALPHA + a0[0], xf[1] * ALPHA + a0[1]); w.y = cvt_pk_bf16(xf[2] * ALPHA + a0[2], xf[3] * ALPHA + a0[3]);
                        w.z = cvt_pk_bf16(xf[4] * ALPHA + a1[0], xf[5] * ALPHA + a1[1]); w.w = cvt_pk_bf16(xf[6] * ALPHA + a1[2], xf[7] * ALPHA + a1[3]);
                        *px = w; } }
        } else {
#pragma unroll
            for (int ai = 0; ai < 2; ++ai)
#pragma unroll
                for (int m = 0; m < 4; ++m) { const int r = row0 + ai * HALF + m * 16; const int ch0 = 128 * u.pn + 32 * wc + 8 * fq;
                    const f32x4 g0 = acc[ai][0][m][0], g1 = acc[ai][0][m][1], u0 = acc[ai][1][m][0], u1 = acc[ai][1][m][1];
                    u32x4 w; w.x = cvt_pk_bf16(silu_f(g0[0]) * u0[0], silu_f(g0[1]) * u0[1]); w.y = cvt_pk_bf16(silu_f(g0[2]) * u0[2], silu_f(g0[3]) * u0[3]);
                    w.z = cvt_pk_bf16(silu_f(g1[0]) * u1[0], silu_f(g1[1]) * u1[1]); w.w = cvt_pk_bf16(silu_f(g1[2]) * u1[2], silu_f(g1[3]) * u1[3]);
                    *(u32x4*)(HF + (size_t)r * DFF + ch0) = w; }
        }
    }
};

__device__ __forceinline__ void gemm_phase(LAS unsigned char* lds, const Gemm g, const Sched& S, const Epi& E) {
    const int tid = otid(), wid = __builtin_amdgcn_readfirstlane(tid >> 6), lane = tid & 63, wr = wid >> 2, wc = wid & 3, fr = lane & 15, fq = lane >> 4;
    const int K = g.K, nt = K / BK;
    unsigned voffA[2], voffB[2];
#pragma unroll
    for (int i = 0; i < 2; ++i) { int R, C; stage_rc(tid * 16 + i * 8192, R, C); const int Rb = E.perm ? ((R & ~31) + perm32(R & 31)) : R;
        voffA[i] = (unsigned)(R * g.lda + C) * 2u; voffB[i] = (unsigned)(Rb * g.ldb + C) * 2u; }
    const size_t kstep = (size_t)(BK * 2);
    const size_t hstepA = (size_t)HALF * g.lda * 2, hstepB = (size_t)HALF * g.ldb * 2;
    const size_t tstepA = 2 * hstepA, tstepB = 2 * hstepB;
    const unsigned ldsw = (unsigned)wid * 1024u;
    const int aoff = lds_byte(wr * 64 + fr, fq * 8), boff = lds_byte(wc * 32 + fr, fq * 8);
#define PG8_SA(b, h) (((b) * 2 + (h)) * HTB)
#define PG8_SB(b, h) ((4 + (b) * 2 + (h)) * HTB)
#define PG8_STAGE(bufoff, gbase, voff) do { _Pragma("unroll") for (int _i = 0; _i < 2; ++_i) \
        __builtin_amdgcn_global_load_lds((const unsigned*)((const char*)(gbase) + (voff)[_i]), (LAS unsigned*)(lds + (bufoff) + ldsw + _i * 8192), 16, 0, 0); } while (0)
#define PG8_LDA(dst, b, h) do { _Pragma("unroll") for (int m = 0; m < 4; ++m) _Pragma("unroll") for (int k = 0; k < 2; ++k) dst[m][k] = *(const LAS bf16x8*)(lds + PG8_SA(b, h) + aoff + m * 2048 + k * 1024); } while (0)
#define PG8_LDB(dst, b, h) do { _Pragma("unroll") for (int n = 0; n < 2; ++n) _Pragma("unroll") for (int k = 0; k < 2; ++k) dst[n][k] = *(const LAS bf16x8*)(lds + PG8_SB(b, h) + boff + n * 2048 + k * 1024); } while (0)
#define PG8_MMA(ai, bj, At, Bt) do { __builtin_amdgcn_s_setprio(1); _Pragma("unroll") for (int m = 0; m < 4; ++m) _Pragma("unroll") for (int n = 0; n < 2; ++n) _Pragma("unroll") for (int k = 0; k < 2; ++k) \
        acc[ai][bj][m][n] = __builtin_amdgcn_mfma_f32_16x16x32_f16(__builtin_bit_cast(half8_t, Bt[n][k]), __builtin_bit_cast(half8_t, At[m][k]), acc[ai][bj][m][n], 0, 0, 0); __builtin_amdgcn_s_setprio(0); } while (0)
#define PG8_WAIT_V(n) asm volatile("s_waitcnt vmcnt(" #n ")" ::: "memory")
#define PG8_WAIT_L(n) asm volatile("s_waitcnt lgkmcnt(" #n ")" ::: "memory")
#define PG8_BAR __builtin_amdgcn_s_barrier()
#define PG8_SCHED __builtin_amdgcn_sched_barrier(0)
    Unit cur, nxt; int ui = 0;
    if (!S.next(0, cur)) return;
    f32x4 acc[2][2][4][2];
#pragma unroll
    for (int a = 0; a < 2; ++a)
#pragma unroll
        for (int b = 0; b < 2; ++b)
#pragma unroll
            for (int m = 0; m < 4; ++m)
#pragma unroll
                for (int n = 0; n < 2; ++n) acc[a][b][m][n] = (f32x4){0.f, 0.f, 0.f, 0.f};
    bf16x8 At[4][2], B0[2][2], B1[2][2];
    const char* cA = (const char*)g.A + (size_t)cur.pm * tstepA + (size_t)cur.ak * 2; const char* cB = (const char*)g.Bt + (size_t)cur.pn * tstepB;
    PG8_STAGE(PG8_SB(0, 0), cB, voffB); PG8_STAGE(PG8_SB(0, 1), cB + hstepB, voffB); PG8_STAGE(PG8_SA(0, 0), cA, voffA); PG8_STAGE(PG8_SA(0, 1), cA + hstepA, voffA);
    if (wr == 1) PG8_BAR;
    PG8_WAIT_V(2); PG8_BAR;
    PG8_STAGE(PG8_SB(1, 0), cB + kstep, voffB); PG8_STAGE(PG8_SA(1, 0), cA + kstep, voffA); PG8_STAGE(PG8_SB(1, 1), cB + hstepB + kstep, voffB);
    PG8_WAIT_V(6); PG8_BAR;
    for (;;) {
        const bool has_next = S.next(ui + 1, nxt);
        const char* nA = has_next ? (const char*)g.A + (size_t)nxt.pm * tstepA + (size_t)nxt.ak * 2 : cA; const char* nB = has_next ? (const char*)g.Bt + (size_t)nxt.pn * tstepB : cB;
        for (int t = 0; t < nt; t += 2) {
            const bool last = (t == nt - 2);
            const char* a1 = cA + (size_t)(t + 1) * kstep;
            const char* a2 = last ? nA : cA + (size_t)(t + 2) * kstep; const char* b2 = last ? nB : cB + (size_t)(t + 2) * kstep;
            const char* a3 = a2 + kstep; const char* b3 = b2 + kstep;
            PG8_LDB(B0, 0, 0); PG8_LDB(B1, 0, 1); PG8_SCHED; PG8_LDA(At, 0, 0); PG8_STAGE(PG8_SA(1, 1), a1 + hstepA, voffA);
            PG8_WAIT_V(8); PG8_WAIT_L(0); PG8_BAR; PG8_MMA(0, 0, At, B0); PG8_MMA(0, 1, At, B1); PG8_BAR; PG8_SCHED;
            PG8_LDA(At, 0, 1); PG8_STAGE(PG8_SB(0, 0), b2, voffB); PG8_STAGE(PG8_SB(0, 1), b2 + hstepB, voffB); PG8_STAGE(PG8_SA(0, 0), a2, voffA);
            PG8_WAIT_V(8); PG8_WAIT_L(0); PG8_BAR; PG8_MMA(1, 0, At, B0); PG8_MMA(1, 1, At, B1); PG8_BAR; PG8_SCHED;
            PG8_LDB(B0, 1, 0); PG8_LDB(B1, 1, 1); PG8_SCHED; PG8_LDA(At, 1, 0); PG8_STAGE(PG8_SA(0, 1), a2 + hstepA, voffA);
            PG8_WAIT_V(8); PG8_WAIT_L(0); PG8_BAR; PG8_MMA(0, 0, At, B0); PG8_MMA(0, 1, At, B1); PG8_BAR; PG8_SCHED;
            PG8_LDA(At, 1, 1); PG8_STAGE(PG8_SB(1, 0), b3, voffB); PG8_STAGE(PG8_SB(1, 1), b3 + hstepB, voffB); PG8_STAGE(PG8_SA(1, 0), a3, voffA);
            PG8_WAIT_V(8); PG8_WAIT_L(0); PG8_BAR; PG8_MMA(1, 0, At, B0); PG8_MMA(1, 1, At, B1); PG8_BAR; PG8_SCHED;
        }
        if (wr == 0) PG8_BAR;
        { const int t2 = otid(), w2 = __builtin_amdgcn_readfirstlane(t2 >> 6), l2 = t2 & 63;
          E(acc, cur, w2 >> 2, w2 & 3, l2 & 15, l2 >> 4); }
        if (!has_next) break;
#pragma unroll
        for (int a = 0; a < 2; ++a)
#pragma unroll
            for (int b = 0; b < 2; ++b)
#pragma unroll
                for (int m = 0; m < 4; ++m)
#pragma unroll
                    for (int n = 0; n < 2; ++n) acc[a][b][m][n] = (f32x4){0.f, 0.f, 0.f, 0.f};
        cur = nxt; cA = nA; cB = nB; ++ui;
        if (wr == 1) PG8_BAR;
    }
    PG8_WAIT_V(0);
    PG8_BAR;
#undef PG8_SA
#undef PG8_SB
#undef PG8_STAGE
#undef PG8_LDA
#undef PG8_LDB
#undef PG8_MMA
#undef PG8_WAIT_V
#undef PG8_WAIT_L
#undef PG8_BAR
#undef PG8_SCHED
}
}

__device__ __forceinline__ int dest_row(int dmode, int arg, int n) {
    if (dmode == 1) { return ((n >> 6) << 8) + ((arg >> 1) << 7) + (((n >> 4) & 3) << 5) + ((arg & 1) << 4) + (n & 15); }
    if (dmode == 2) { return ((n >> 7) << 8) + (arg << 7) + (n & 127); }
    return n + arg;
}
__device__ __forceinline__ void transpose_item(const float* W, int K, int Nsrc, bf16_t* WT, int dmode, int arg, LAS float* scr, int kb, int nb, int lane) {
    const int k0 = 64 * kb, n0 = 32 * nb;
    const int nsrc = n0 + (lane & 31); const bool ok = nsrc < Nsrc;
#pragma unroll 8
    for (int i = 0; i < 32; ++i) { const int kk = 2 * i + (lane >> 5); scr[kk * 33 + (lane & 31)] = ok ? W[(size_t)(k0 + kk) * Nsrc + nsrc] : 0.f; }
    asm volatile("s_waitcnt lgkmcnt(0)" ::: "memory");
    const int c = lane & 7;
#pragma unroll
    for (int j = 0; j < 4; ++j) { const int n = (lane >> 3) + 8 * j; const LAS float* s = scr + (8 * c) * 33 + n;
        u32x4 o; o.x = pk2(s[0 * 33], s[1 * 33]); o.y = pk2(s[2 * 33], s[3 * 33]); o.z = pk2(s[4 * 33], s[5 * 33]); o.w = pk2(s[6 * 33], s[7 * 33]);
        *(u32x4*)(WT + (size_t)dest_row(dmode, arg, n0 + n) * K + k0 + 8 * c) = o; }
    asm volatile("s_waitcnt lgkmcnt(0)" ::: "memory");
}

__device__ __forceinline__ void s5_abar_pow(float lr, float li, float dt, int n, float& re, float& im) {
    const float mag = expf((float)n * lr * dt);
    const double a = (double)n * ((double)li * (double)dt);
    const double k = __builtin_rint(a * 0.15915494309189535);
    const float r = (float)__builtin_fma(-k, 6.283185307179586, a);
    re = mag * cosf(r); im = mag * sinf(r);
}
__device__ __forceinline__ void s5_coef(float lr, float li, float dt, float& cr, float& ci) {
    const float th = li * dt, em1 = expm1f(lr * dt), c1 = cosf(th), s1 = sinf(th), sh = sinf(0.5f * th);
    const float nr = em1 * c1 - 2.f * sh * sh, ni = (1.f + em1) * s1, den = lr * lr + li * li;
    cr = (nr * lr + ni * li) / den; ci = (ni * lr - nr * li) / den;
}

__device__ __forceinline__ void s5_tables(CPP p, int l, LAS unsigned char* lds) {
    LAS float* abr = (LAS float*)lds;
    LAS float* abi = abr + 1024;
    LAS float* cr = abi + 1024;
    LAS float* ci = cr + 16 * 65;
    float* KN = (float*)(p->ws + WS_KN);
    const int tid = otid();
    for (int it = obid(); it < 1024; it += ogrid()) {
        const int g = it >> 6, n = it & 63;
        __syncthreads();
        for (int e = tid; e < 1024; e += 512) { const int pp = e >> 4, c = e & 15; const int gp = (l * 16 + g) * 64 + pp;
            const float lr = p->in[5][gp], li = p->in[6][gp], dt = expf(p->in[7][l * 16 + g]);
            float ar, ai2; s5_abar_pow(lr, li, dt, n, ar, ai2);
            float qr, qi; s5_coef(lr, li, dt, qr, qi);
            const float br = p->in[8][(size_t)gp * 16 + c], bi = p->in[9][(size_t)gp * 16 + c];
            const float bbr = qr * br - qi * bi, bbi = qr * bi + qi * br;
            abr[e] = ar * bbr - ai2 * bbi; abi[e] = ar * bbi + ai2 * bbr; }
        for (int e = tid; e < 1024; e += 512) { const int i = e >> 6, pp = e & 63; const size_t gi = ((size_t)(l * 16 + g) * 16 + i) * 64 + pp;
            cr[i * 65 + pp] = p->in[10][gi]; ci[i * 65 + pp] = p->in[11][gi]; }
        __syncthreads();
        if (tid < 256) { const int i = tid >> 4, c = tid & 15; float s = 0.f;
#pragma unroll 8
            for (int pp = 0; pp < 64; ++pp) s += cr[i * 65 + pp] * abr[pp * 16 + c] - ci[i * 65 + pp] * abi[pp * 16 + c];
            KN[((size_t)(g * 64 + n) * 16 + i) * 16 + c] = s; }
    }
}

__device__ __forceinline__ void convert_weights(CPP p, int l, LAS unsigned char* lds) {
    const int tid = otid(), lane = tid & 63, wave = tid >> 6;
    LAS float* scr = (LAS float*)(lds + wave * 16384);
    const int gw = obid() * 8 + wave, NGW = ogrid() * 8;
    unsigned char* ws = p->ws;
    constexpr int J0 = 1408, J1 = J0 + 2048, J2 = J1 + 512, J3 = J2 + 512, J4 = J3 + 2816, J5 = J4 + 1408, J6 = J5 + 32;
    for (int it = gw; it < J6; it += NGW) {
        if (it < J0) { const int r = it; transpose_item(p->in[1] + (size_t)l * 1024 * 2576, 1024, 2576, (bf16_t*)(ws + WS_WIN), 0, 0, scr, r / 88, r % 88, lane); }
        else if (it < J1) { const int r = it - J0, b = r >> 9, q = r & 511; transpose_item(p->in[15] + ((size_t)l * 4 + b) * 1024 * 1024, 1024, 1024, (bf16_t*)(ws + WS_WG), 1, b, scr, q >> 5, q & 31, lane); }
        else if (it < J2) { const int r = it - J1, b = r >> 7, q = r & 127; transpose_item(p->in[17] + ((size_t)l * 4 + b) * 256 * 1024, 256, 1024, (bf16_t*)(ws + WS_WB) + (size_t)b * 1024 * 256, 0, 0, scr, q >> 5, q & 31, lane); }
        else if (it < J3) { const int q = it - J2; transpose_item(p->in[18] + (size_t)l * 1024 * 1024, 1024, 1024, (bf16_t*)(ws + WS_WO), 0, 0, scr, q >> 5, q & 31, lane); }
        else if (it < J4) { const int r = it - J3, wch = r / 1408, q = r % 1408; transpose_item(p->in[wch ? 22 : 21] + (size_t)l * 1024 * 2816, 1024, 2816, (bf16_t*)(ws + WS_WFF), 2, wch, scr, q / 88, q % 88, lane); }
        else if (it < J5) { const int q = it - J4; transpose_item(p->in[23] + (size_t)l * 2816 * 1024, 2816, 1024, (bf16_t*)(ws + WS_WD), 0, 0, scr, q >> 5, q & 31, lane); }
        else { const int q = it - J5; transpose_item(p->in[13] + (size_t)l * 256 * 256, 256, 256, (bf16_t*)(ws + WS_WGLU), 0, 0, scr, q >> 3, q & 7, lane); }
    }
    const int gt = obid() * 512 + tid, NT = ogrid() * 512;
    bf16_t* WE = (bf16_t*)(ws + WS_WE);
    for (int e = gt; e < 65536; e += NT) { const int s = e & 63, pp = (e >> 6) & 63, g = e >> 12; const int gp = (l * 16 + g) * 64 + pp;
        const float lr = p->in[5][gp], li = p->in[6][gp], dt = expf(p->in[7][l * 16 + g]);
        float ar, ai2; s5_abar_pow(lr, li, dt, 63 - s, ar, ai2);
        float qr, qi; s5_coef(lr, li, dt, qr, qi);
        float wr_[16], wi_[16];
#pragma unroll
        for (int c = 0; c < 16; ++c) { const float br = p->in[8][(size_t)gp * 16 + c], bi = p->in[9][(size_t)gp * 16 + c];
            const float bbr = qr * br - qi * bi, bbi = qr * bi + qi * br; wr_[c] = ar * bbr - ai2 * bbi; wi_[c] = ar * bbi + ai2 * bbr; }
        bf16_t* dr = WE + ((size_t)(g * 256 + pp)) * 1024 + s * 16; bf16_t* di = WE + ((size_t)(g * 256 + 64 + pp)) * 1024 + s * 16;
        *(u32x4*)dr = pack8(wr_); *(u32x4*)(dr + 8) = pack8(wr_ + 8); *(u32x4*)di = pack8(wi_); *(u32x4*)(di + 8) = pack8(wi_ + 8); }
    for (int e = gt; e < 16 * 128 * 128; e += NT) { const int c8 = e & 127, n = (e >> 7) & 127, g = e >> 14;
        *(u32x4*)(WE + ((size_t)(g * 256 + 128 + n)) * 1024 + c8 * 8) = (u32x4){0u, 0u, 0u, 0u}; }
    bf16_t* WT = (bf16_t*)(ws + WS_WT); const float* KN = (const float*)(ws + WS_KN);
    for (int e = gt; e < 16 * 1024 * 64; e += NT) { const int s = e & 63, row = (e >> 6) & 1023, g = e >> 16; const int j = row >> 4, i = row & 15;
        u32x4 w0 = (u32x4){0u, 0u, 0u, 0u}, w1 = w0;
        if (s <= j) { const float* k = KN + ((size_t)(g * 64 + (j - s)) * 16 + i) * 16; float v[16];
#pragma unroll
            for (int c = 0; c < 16; c += 4) { const f32x4 t = *(const f32x4*)(k + c); v[c] = t[0]; v[c + 1] = t[1]; v[c + 2] = t[2]; v[c + 3] = t[3]; }
            w0 = pack8(v); w1 = pack8(v + 8); }
        bf16_t* d = WT + ((size_t)(g * 1024 + row)) * S5K + s * 16; *(u32x4*)d = w0; *(u32x4*)(d + 8) = w1; }
    for (int e = gt; e < 16 * 1024 * 64; e += NT) { const int pp = e & 63, row = (e >> 6) & 1023, g = e >> 16; const int j = row >> 4, i = row & 15; const int gp = (l * 16 + g) * 64 + pp;
        const float lr = p->in[5][gp], li = p->in[6][gp], dt = expf(p->in[7][l * 16 + g]);
        float ar, ai2; s5_abar_pow(lr, li, dt, j + 1, ar, ai2);
        const size_t gi = ((size_t)(l * 16 + g) * 16 + i) * 64 + pp; const float c_r = p->in[10][gi], c_i = p->in[11][gi];
        bf16_t* d = WT + ((size_t)(g * 1024 + row)) * S5K + 1024 + pp;
        d[0] = (bf16_t)f2bf(c_r * ar - c_i * ai2); d[64] = (bf16_t)f2bf(-(c_r * ai2 + c_i * ar)); }
}

__device__ __forceinline__ void ln_pass(bf16_t* xb, float* fout, const float* gam, const float* bet) {
    const int lane = otid() & 63, gw = obid() * 8 + (otid() >> 6), NGW = ogrid() * 8;
    f32x4 gv[4], bv[4];
#pragma unroll
    for (int j = 0; j < 2; ++j) { gv[2 * j] = *(const f32x4*)(gam + 512 * j + lane * 8); gv[2 * j + 1] = *(const f32x4*)(gam + 512 * j + lane * 8 + 4);
        bv[2 * j] = *(const f32x4*)(bet + 512 * j + lane * 8); bv[2 * j + 1] = *(const f32x4*)(bet + 512 * j + lane * 8 + 4); }
    for (int m0 = gw * 2; m0 < M; m0 += NGW * 2) {
        u32x4 w[2][2];
#pragma unroll
        for (int rr = 0; rr < 2; ++rr)
#pragma unroll
            for (int j = 0; j < 2; ++j) w[rr][j] = *(const u32x4*)(xb + (size_t)(m0 + rr) * DM + 512 * j + lane * 8);
#pragma unroll
        for (int rr = 0; rr < 2; ++rr) {
            float v[16]; unpack8(w[rr][0], v); unpack8(w[rr][1], v + 8);
            float s = 0.f;
#pragma unroll
            for (int e = 0; e < 16; ++e) s += v[e];
            const float mean = wave_sum(s) * (1.f / DM); float s2 = 0.f;
#pragma unroll
            for (int e = 0; e < 16; ++e) { v[e] -= mean; s2 += v[e] * v[e]; }
            const float rstd = 1.f / sqrtf(wave_sum(s2) * (1.f / DM) + LN_EPS);
#pragma unroll
            for (int j = 0; j < 2; ++j) {
#pragma unroll
                for (int q = 0; q < 2; ++q)
#pragma unroll
                    for (int e = 0; e < 4; ++e) v[8 * j + 4 * q + e] = v[8 * j + 4 * q + e] * rstd * gv[2 * j + q][e] + bv[2 * j + q][e];
                *(u32x4*)(xb + (size_t)(m0 + rr) * DM + 512 * j + lane * 8) = pack8(v + 8 * j);
                if (fout) { *(f32x4*)(fout + (size_t)(m0 + rr) * DM + 512 * j + lane * 8) = (f32x4){v[8 * j], v[8 * j + 1], v[8 * j + 2], v[8 * j + 3]};
                    *(f32x4*)(fout + (size_t)(m0 + rr) * DM + 512 * j + lane * 8 + 4) = (f32x4){v[8 * j + 4], v[8 * j + 5], v[8 * j + 6], v[8 * j + 7]}; } }
        }
    }
}

__device__ __forceinline__ void load_tile64(const bf16_t* src, int pitch, LAS float* dst, int dpitch, float scale, int tid) {
    const int idx = tid * 8, r = idx >> 6, c = idx & 63;
    const u32x4 w = *(const u32x4*)(src + (size_t)r * pitch + c); float f[8]; unpack8(w, f);
#pragma unroll
    for (int e = 0; e < 8; ++e) dst[r * dpitch + c + e] = f[e] * scale;
}

__device__ __forceinline__ void attn_items(CPP p, int l, LAS unsigned char* lds) {
    LAS float* Qs = (LAS float*)lds; LAS float* Ks = Qs + 64 * 68; LAS float* Vs = Ks + 64 * 68; LAS float* Ps = Vs + 64 * 68; LAS float* bs = Ps + 64 * 65;
    const bf16_t* H = (const bf16_t*)(p->ws + WS_E); bf16_t* O = (bf16_t*)(p->ws + WS_O);
    const int tid = otid(), row = tid >> 3, sub = tid & 7;
    for (int it = obid(); it < 4096; it += ogrid()) {
        const int h = it & 3, bi = it >> 2, i = bi & 31, b = bi >> 5;
        const size_t t0 = (size_t)bi * 64;
        __syncthreads();
        load_tile64(H + t0 * NH + C_AQ + h * 64, NH, Qs, 68, 0.125f, tid);
        if (tid < 257) bs[tid] = p->in[4][(size_t)(l * 4 + h) * 257 + tid];
        __syncthreads();
        float q[64], o[8];
#pragma unroll
        for (int d = 0; d < 64; d += 4) { const f32x4 t = *(const LAS f32x4*)(Qs + row * 68 + d); q[d] = t[0]; q[d + 1] = t[1]; q[d + 2] = t[2]; q[d + 3] = t[3]; }
#pragma unroll
        for (int e = 0; e < 8; ++e) o[e] = 0.f;
        float mx = -1e30f, ls = 0.f;
        const int kc0 = i > 8 ? i - 8 : 0;
        for (int kc = kc0; kc <= i; ++kc) {
            __syncthreads();
            const size_t tk = ((size_t)b * 32 + kc) * 64;
            load_tile64(H + tk * NH + C_AK + h * 64, NH, Ks, 68, 1.f, tid);
            load_tile64(H + tk * NH + C_AV + h * 64, NH, Vs, 68, 1.f, tid);
            __syncthreads();
            float s[8]; float cm = -1e30f;
#pragma unroll
            for (int jj = 0; jj < 8; ++jj) { const int key = sub + 8 * jj; float a = 0.f;
#pragma unroll
                for (int d = 0; d < 64; d += 4) { const f32x4 t = *(const LAS f32x4*)(Ks + key * 68 + d); a += q[d] * t[0] + q[d + 1] * t[1] + q[d + 2] * t[2] + q[d + 3] * t[3]; }
                int diff = (i - kc) * 64 + row - key; diff = diff > 128 ? 128 : diff;
                a += bs[diff + 128]; s[jj] = a; cm = fmaxf(cm, a); }
            cm = fmaxf(cm, __shfl_xor(cm, 1)); cm = fmaxf(cm, __shfl_xor(cm, 2)); cm = fmaxf(cm, __shfl_xor(cm, 4));
            const float mn = fmaxf(mx, cm), sc = __expf(mx - mn); mx = mn;
            float ps = 0.f;
#pragma unroll
            for (int jj = 0; jj < 8; ++jj) { const float pr = __expf(s[jj] - mn); ps += pr; Ps[row * 65 + sub + 8 * jj] = pr; }
            ps += __shfl_xor(ps, 1); ps += __shfl_xor(ps, 2); ps += __shfl_xor(ps, 4);
            ls = ls * sc + ps;
#pragma unroll
            for (int e = 0; e < 8; ++e) o[e] *= sc;
            asm volatile("s_waitcnt lgkmcnt(0)" ::: "memory");
#pragma unroll 8
            for (int key = 0; key < 64; ++key) { const float pr = Ps[row * 65 + key];
                const f32x4 v0 = *(const LAS f32x4*)(Vs + key * 68 + sub * 8), v1 = *(const LAS f32x4*)(Vs + key * 68 + sub * 8 + 4);
                o[0] += pr * v0[0]; o[1] += pr * v0[1]; o[2] += pr * v0[2]; o[3] += pr * v0[3]; o[4] += pr * v1[0]; o[5] += pr * v1[1]; o[6] += pr * v1[2]; o[7] += pr * v1[3]; }
        }
        const float inv = 1.f / ls;
#pragma unroll
        for (int e = 0; e < 8; ++e) o[e] *= inv;
        *(u32x4*)(O + (t0 + row) * DM + 256 + h * 64 + sub * 8) = pack8(o);
    }
}

typedef float f32x16 __attribute__((ext_vector_type(16)));
typedef short s16x4 __attribute__((ext_vector_type(4)));
__device__ __forceinline__ s16x4 lds_tr16(LAS const unsigned char* ptr) { return __builtin_bit_cast(s16x4, __builtin_amdgcn_ds_read_tr16_b64_v4i16((LAS s16x4*)ptr)); }
__device__ __forceinline__ bf16x8 scale_frag(u32x4 w, float sc) { float f[8]; unpack8(w, f);
    u32x4 o; o.x = pk2(f[0] * sc, f[1] * sc); o.y = pk2(f[2] * sc, f[3] * sc); o.z = pk2(f[4] * sc, f[5] * sc); o.w = pk2(f[6] * sc, f[7] * sc); return __builtin_bit_cast(bf16x8, o); }
__device__ __forceinline__ void attn_mfma(CPP p, int l, LAS unsigned char* lds) {
    const int tid = otid(), lane = tid & 63, wid = __builtin_amdgcn_readfirstlane(tid >> 6), r32 = lane & 31, hi = lane >> 5;
    const int h = wid >> 1, qh = wid & 1;
    LAS unsigned char* Vl = lds + wid * 17536;
    LAS unsigned char* stg = Vl;
    LAS float* bs = (LAS float*)(Vl + 16384);
    const bf16_t* H = (const bf16_t*)(p->ws + WS_E); bf16_t* O = (bf16_t*)(p->ws + WS_O);
    __syncthreads();
    for (int e = lane; e < 257; e += 64) bs[e] = p->in[4][(size_t)(l * 4 + h) * 257 + e];
    const float bfar = p->in[4][(size_t)(l * 4 + h) * 257 + 256];
#define ATT_VDMA(tk, buf) do { _Pragma("unroll") for (int c = 0; c < 8; ++c) \
        __builtin_amdgcn_global_load_lds((const unsigned*)(H + ((tk) + c * 8 + (lane >> 3)) * NH + C_AV + h * 64 + (lane & 7) * 8), (LAS unsigned*)(Vl + (buf) * 8192 + c * 1024), 16, 0, 0); } while (0)
    const int bidA = obid(), gridA = ogrid(); const bool xmap = (gridA == 256);
    for (int itk = 0; itk < (xmap ? 4 : (1024 - bidA + gridA - 1) / gridA); ++itk) {
        const int it = xmap ? ((((bidA & 7) * 4 + itk) << 5) | (bidA >> 3)) : bidA + itk * gridA;
        const int i = it & 31; const size_t t0 = (size_t)it * 64;
        bf16x8 qf[4];
#pragma unroll
        for (int t = 0; t < 4; ++t) qf[t] = scale_frag(*(const u32x4*)(H + (t0 + qh * 32 + r32) * NH + C_AQ + h * 64 + 16 * t + 8 * hi), 0.125f);
        const int kc0 = i > 8 ? i - 8 : 0;
        u32x4 kr[8], kn[8];
        asm volatile("s_waitcnt lgkmcnt(0)" ::: "memory");
        { const size_t tk = t0 - (size_t)(i - kc0) * 64;
#pragma unroll
            for (int t = 0; t < 4; ++t) { kn[t] = *(const u32x4*)(H + (tk + r32) * NH + C_AK + h * 64 + 16 * t + 8 * hi); kn[4 + t] = *(const u32x4*)(H + (tk + 32 + r32) * NH + C_AK + h * 64 + 16 * t + 8 * hi); }
            ATT_VDMA(tk, 0); }
        f32x16 o0, o1;
#pragma unroll
        for (int v = 0; v < 16; ++v) { o0[v] = 0.f; o1[v] = 0.f; }
        float mx = -1e30f, ls = 0.f;
        int cb = 0;
        for (int kc = kc0; kc <= i; ++kc) {
            const bool more = kc < i;
            asm volatile("s_waitcnt vmcnt(0)" ::: "memory");
#pragma unroll
            for (int c = 0; c < 8; ++c) kr[c] = kn[c];
            if (more) { const size_t tk = t0 - (size_t)(i - kc - 1) * 64;
#pragma unroll
                for (int t = 0; t < 4; ++t) { kn[t] = *(const u32x4*)(H + (tk + r32) * NH + C_AK + h * 64 + 16 * t + 8 * hi); kn[4 + t] = *(const u32x4*)(H + (tk + 32 + r32) * NH + C_AK + h * 64 + 16 * t + 8 * hi); }
                ATT_VDMA(tk, cb ^ 1); }
            const int dl = i - kc; const float binit = dl >= 3 ? bfar : 0.f;
            f32x16 p0, p1;
#pragma unroll
            for (int v = 0; v < 16; ++v) { p0[v] = binit; p1[v] = binit; }
#pragma unroll
            for (int t = 0; t < 4; ++t) { p0 = __builtin_amdgcn_mfma_f32_32x32x16_f16(__builtin_bit_cast(half8_t, kr[t]), __builtin_bit_cast(half8_t, qf[t]), p0, 0, 0, 0);
                p1 = __builtin_amdgcn_mfma_f32_32x32x16_f16(__builtin_bit_cast(half8_t, kr[4 + t]), __builtin_bit_cast(half8_t, qf[t]), p1, 0, 0, 0); }
            if (dl < 3) { const int base = dl * 64 + qh * 32 + r32 - 4 * hi + 128;
#pragma unroll
                for (int v = 0; v < 16; ++v) { const int kv = (v & 3) + 8 * (v >> 2); int d0 = base - kv, d1 = base - kv - 32; d0 = d0 > 256 ? 256 : d0; d1 = d1 > 256 ? 256 : d1;
                    p0[v] += bs[d0]; p1[v] += bs[d1]; } }
            float cm = fmaxf(p0[0], p1[0]);
#pragma unroll
            for (int v = 1; v < 16; ++v) cm = fmaxf(cm, fmaxf(p0[v], p1[v]));
            cm = fmaxf(cm, __shfl_xor(cm, 32));
            const float mn = fmaxf(mx, cm), al = __expf(mx - mn); mx = mn;
            float ps = 0.f;
#pragma unroll
            for (int v = 0; v < 16; ++v) { p0[v] = __expf(p0[v] - mn); p1[v] = __expf(p1[v] - mn); ps += p0[v] + p1[v]; }
            ls = ls * al + ps;
#pragma unroll
            for (int v = 0; v < 16; ++v) { o0[v] *= al; o1[v] *= al; }
            bf16x8 pb[4];
            { u32x4 w; w.x = cvt_pk_bf16(p0[0], p0[1]); w.y = cvt_pk_bf16(p0[2], p0[3]); w.z = cvt_pk_bf16(p0[4], p0[5]); w.w = cvt_pk_bf16(p0[6], p0[7]); pb[0] = __builtin_bit_cast(bf16x8, w);
              w.x = cvt_pk_bf16(p0[8], p0[9]); w.y = cvt_pk_bf16(p0[10], p0[11]); w.z = cvt_pk_bf16(p0[12], p0[13]); w.w = cvt_pk_bf16(p0[14], p0[15]); pb[1] = __builtin_bit_cast(bf16x8, w);
              w.x = cvt_pk_bf16(p1[0], p1[1]); w.y = cvt_pk_bf16(p1[2], p1[3]); w.z = cvt_pk_bf16(p1[4], p1[5]); w.w = cvt_pk_bf16(p1[6], p1[7]); pb[2] = __builtin_bit_cast(bf16x8, w);
              w.x = cvt_pk_bf16(p1[8], p1[9]); w.y = cvt_pk_bf16(p1[10], p1[11]); w.z = cvt_pk_bf16(p1[12], p1[13]); w.w = cvt_pk_bf16(p1[14], p1[15]); pb[3] = __builtin_bit_cast(bf16x8, w); }
            const LAS unsigned char* vb = Vl + cb * 8192 + (4 * hi + ((lane & 15) >> 2)) * 128 + ((lane >> 4) & 1) * 32 + (lane & 3) * 8;
#pragma unroll
            for (int ks = 0; ks < 4; ++ks) {
#pragma unroll
                for (int dh = 0; dh < 2; ++dh) { const s16x4 lo = lds_tr16(vb + ks * 2048 + dh * 64), hh = lds_tr16(vb + ks * 2048 + 1024 + dh * 64);
                    const bf16x8 va = (bf16x8){lo[0], lo[1], lo[2], lo[3], hh[0], hh[1], hh[2], hh[3]};
                    if (dh == 0) o0 = __builtin_amdgcn_mfma_f32_32x32x16_f16(__builtin_bit_cast(half8_t, va), __builtin_bit_cast(half8_t, pb[ks]), o0, 0, 0, 0); else o1 = __builtin_amdgcn_mfma_f32_32x32x16_f16(__builtin_bit_cast(half8_t, va), __builtin_bit_cast(half8_t, pb[ks]), o1, 0, 0, 0); } }
            cb ^= 1;
        }
        ls += __shfl_xor(ls, 32);
        const float inv = 1.f / ls;
        asm volatile("s_waitcnt lgkmcnt(0)" ::: "memory");
#pragma unroll
        for (int v = 0; v < 16; ++v) { const int d = (v & 3) + 8 * (v >> 2) + 4 * hi;
            *(LAS bf16_t*)(stg + r32 * 144 + d * 2) = (bf16_t)f2bf(o0[v] * inv); *(LAS bf16_t*)(stg + r32 * 144 + (32 + d) * 2) = (bf16_t)f2bf(o1[v] * inv); }
        asm volatile("s_waitcnt lgkmcnt(0)" ::: "memory");
#pragma unroll
        for (int c = 0; c < 4; ++c) { const int row = c * 8 + (lane >> 3), ch = lane & 7; const u32x4 w = *(const LAS u32x4*)(stg + row * 144 + ch * 16);
            *(u32x4*)(O + (t0 + qh * 32 + row) * DM + 256 + h * 64 + ch * 8) = w; }
    }
#undef ATT_VDMA
}

__device__ __forceinline__ f32x16 mma32(bf16x8 a, bf16x8 b, f32x16 c) { return __builtin_amdgcn_mfma_f32_32x32x16_f16(__builtin_bit_cast(half8_t, a), __builtin_bit_cast(half8_t, b), c, 0, 0, 0); }
__device__ __forceinline__ bf16x8 trfrag(LAS const unsigned char* a0, LAS const unsigned char* a1) { const s16x4 lo = lds_tr16(a0), hh = lds_tr16(a1); return (bf16x8){lo[0], lo[1], lo[2], lo[3], hh[0], hh[1], hh[2], hh[3]}; }
__device__ __forceinline__ f32x16 zero16() { f32x16 z;
#pragma unroll
    for (int v = 0; v < 16; ++v) z[v] = 0.f;
    return z; }
__device__ __forceinline__ void rot_frags(const bf16_t* xrow, const float* rrow, int hi, float sc, bf16x8& f0, bf16x8& f1) {
    const u32x4 w1 = *(const u32x4*)(xrow + 8 * hi), w2 = *(const u32x4*)(xrow + 16 + 8 * hi); float x1[8], x2[8]; unpack8(w1, x1); unpack8(w2, x2);
    const f32x4 c0 = *(const f32x4*)(rrow + 8 * hi), c1 = *(const f32x4*)(rrow + 8 * hi + 4), s0 = *(const f32x4*)(rrow + 16 + 8 * hi), s1 = *(const f32x4*)(rrow + 16 + 8 * hi + 4);
    float a[8], b[8];
#pragma unroll
    for (int e = 0; e < 8; ++e) { const float c = e < 4 ? c0[e & 3] : c1[e & 3], s = e < 4 ? s0[e & 3] : s1[e & 3]; a[e] = (x1[e] * c - x2[e] * s) * sc; b[e] = (x1[e] * s + x2[e] * c) * sc; }
    f0 = __builtin_bit_cast(bf16x8, pack8(a)); f1 = __builtin_bit_cast(bf16x8, pack8(b));
}
__device__ __forceinline__ float ret_logg(int h);

__device__ __forceinline__ void upd_mfma(CPP p, int l, LAS unsigned char* lds) {
    const int tid = otid(), lane = tid & 63, wid = __builtin_amdgcn_readfirstlane(tid >> 6), r32 = lane & 31, hi = lane >> 5, i16 = lane & 15;
    LAS unsigned char* kz = lds + wid * 17536;
    LAS unsigned char* vt = kz + 4096;
    LAS unsigned char* gas = kz + 12288;
    const bf16_t* H = (const bf16_t*)(p->ws + WS_E); const float* rot = (const float*)(p->ws + WS_ROT);
    float* RU = (float*)(p->ws + WS_RU); float* GU = (float*)(p->ws + WS_GU); float* GL = (float*)(p->ws + WS_GL);
    const int gw = obid() * 8 + wid, NGW = ogrid() * 8;
    __syncthreads();
    for (int it = gw; it < 8192; it += NGW) {
        const int gla = it >> 12, h = it & 3, bi = (it >> 2) & 1023, i = bi & 31; const size_t t0 = (size_t)bi * 64;
        asm volatile("s_waitcnt lgkmcnt(0)" ::: "memory");
        { const int vcol = (gla ? C_GV : C_RV) + h * 64;
#pragma unroll
            for (int c = 0; c < 8; ++c) __builtin_amdgcn_global_load_lds((const unsigned*)(H + (t0 + c * 8 + (lane >> 3)) * NH + vcol + (lane & 7) * 8), (LAS unsigned*)(vt + c * 1024), 16, 0, 0); }
        if (!gla) {
            const bf16_t* xr = H + (t0 + lane) * NH + C_RK + h * 32; const float* rr = rot + (size_t)(i * 64 + lane) * 32;
            const float sc = 0.17677669529663689f * __expf(ret_logg(h) * (float)(63 - lane));
            float x[32], cs[32], o[32];
#pragma unroll
            for (int c = 0; c < 4; ++c) unpack8(*(const u32x4*)(xr + 8 * c), x + 8 * c);
#pragma unroll
            for (int c = 0; c < 8; ++c) { const f32x4 t = *(const f32x4*)(rr + 4 * c); cs[4 * c] = t[0]; cs[4 * c + 1] = t[1]; cs[4 * c + 2] = t[2]; cs[4 * c + 3] = t[3]; }
#pragma unroll
            for (int f = 0; f < 16; ++f) { o[f] = (x[f] * cs[f] - x[f + 16] * cs[16 + f]) * sc; o[f + 16] = (x[f] * cs[16 + f] + x[f + 16] * cs[f]) * sc; }
#pragma unroll
            for (int c = 0; c < 4; ++c) *(LAS u32x4*)(kz + lane * 64 + c * 16) = pack8(o + 8 * c);
        } else {
#pragma unroll
            for (int c = 0; c < 4; ++c) __builtin_amdgcn_global_load_lds((const unsigned*)(H + (t0 + 16 * c + (lane >> 2)) * NH + C_GK + h * 32 + (lane & 3) * 8), (LAS unsigned*)(kz + c * 1024), 16, 0, 0);
#pragma unroll
            for (int c = 0; c < 2; ++c) *(LAS u32x4*)(gas + lane * 32 + c * 16) = *(const u32x4*)(H + (t0 + lane) * NH + C_GA + 8 * c);
            float wa[16];
#pragma unroll
            for (int r = 0; r < 16; ++r) wa[r] = p->in[2][(size_t)(l * 16 + r) * 128 + h * 32 + r32];
            const float ba = p->in[3][l * 128 + h * 32 + r32];
            asm volatile("s_waitcnt vmcnt(0) lgkmcnt(0)" ::: "memory");
            float cum[32]; float run = 0.f;
#pragma unroll
            for (int jj = 0; jj < 32; ++jj) { const int j = hi * 32 + jj; float g[16]; unpack8(*(const LAS u32x4*)(gas + j * 32), g); unpack8(*(const LAS u32x4*)(gas + j * 32 + 16), g + 8);
                float z = ba;
#pragma unroll
                for (int r = 0; r < 16; ++r) z += g[r] * wa[r];
                run += (fminf(z, 0.f) - __logf(1.f + __expf(-fabsf(z)))) * 0.0625f; cum[jj] = run; }
            const float tot0 = __shfl(run, r32), tot1 = __shfl(run, 32 + r32), last = tot0 + tot1, off = hi ? tot0 : 0.f;
#pragma unroll
            for (int jj = 0; jj < 32; ++jj) { const int j = hi * 32 + jj; LAS bf16_t* kp = (LAS bf16_t*)(kz + j * 64 + r32 * 2);
                *kp = (bf16_t)f2bf(bf2f(*kp) * __expf(last - (cum[jj] + off))); }
            if (hi == 0) GL[(size_t)(bi * 4 + h) * 32 + r32] = last;
        }
        asm volatile("s_waitcnt vmcnt(0) lgkmcnt(0)" ::: "memory");
        f32x16 a0 = zero16(), a1 = zero16();
        const LAS unsigned char* ka = kz + (8 * hi + (i16 >> 2)) * 64 + ((lane >> 4) & 1) * 32 + (i16 & 3) * 8;
        const LAS unsigned char* va = vt + (8 * hi + (i16 >> 2)) * 128 + ((lane >> 4) & 1) * 32 + (i16 & 3) * 8;
#pragma unroll
        for (int s = 0; s < 4; ++s) { const bf16x8 A = trfrag(ka + s * 1024, ka + s * 1024 + 256);
            const bf16x8 B0 = trfrag(va + s * 2048, va + s * 2048 + 512), B1 = trfrag(va + s * 2048 + 64, va + s * 2048 + 512 + 64);
            a0 = mma32(A, B0, a0); a1 = mma32(A, B1, a1); }
        float* dst = (gla ? GU : RU) + (size_t)(bi * 4 + h) * 2048;
#pragma unroll
        for (int v = 0; v < 16; ++v) { const int dk = (v & 3) + 8 * (v >> 2) + 4 * hi; dst[dk * 64 + r32] = a0[v]; dst[dk * 64 + 32 + r32] = a1[v]; }
    }
}

__device__ __forceinline__ void out_mfma(CPP p, int l, LAS unsigned char* lds) {
    const int tid = otid(), lane = tid & 63, wid = __builtin_amdgcn_readfirstlane(tid >> 6), r32 = lane & 31, hi = lane >> 5, i16 = lane & 15;
    const int h = wid >> 1, nh = wid & 1;
    LAS unsigned char* vt = lds + wid * 17536;
    LAS unsigned char* Rt = vt + 8192;
    LAS unsigned char* stg = vt;
    const bf16_t* H = (const bf16_t*)(p->ws + WS_E); const float* rot = (const float*)(p->ws + WS_ROT); bf16_t* O = (bf16_t*)(p->ws + WS_O);
    const float* RU = (const float*)(p->ws + WS_RU); const float* GU = (const float*)(p->ws + WS_GU);
    __syncthreads();
    for (int it = obid(); it < 2048; it += ogrid()) {
        const int gla = it >> 10, bi = it & 1023, i = bi & 31; const size_t t0 = (size_t)bi * 64; const int n = nh * 32 + r32;
        asm volatile("s_waitcnt lgkmcnt(0)" ::: "memory");
        { const float* src = (gla ? GU : RU) + (size_t)(bi * 4 + h) * 2048;
#pragma unroll
            for (int c = 0; c < 8; ++c) { const int idx = c * 256 + lane * 4; const f32x4 t = *(const f32x4*)(src + idx); u32x2 w; w.x = pk2(t[0], t[1]); w.y = pk2(t[2], t[3]);
                *(LAS u32x2*)(Rt + (idx >> 6) * 128 + (idx & 63) * 2) = w; } }
        f32x16 o0 = zero16(), o1 = zero16();
        const LAS unsigned char* ra = Rt + (8 * hi + (i16 >> 2)) * 128 + ((lane >> 4) & 1) * 32 + (i16 & 3) * 8;
        if (!gla) {
#pragma unroll
            for (int c = 0; c < 8; ++c) __builtin_amdgcn_global_load_lds((const unsigned*)(H + (t0 + c * 8 + (lane >> 3)) * NH + C_RV + h * 64 + (lane & 7) * 8), (LAS unsigned*)(vt + c * 1024), 16, 0, 0);
            const float lg = ret_logg(h);
            bf16x8 qf[2], kf0[2], kf1[2];
            rot_frags(H + (t0 + n) * NH + C_RQ + h * 32, rot + (size_t)(i * 64 + n) * 32, hi, 1.f, qf[0], qf[1]);
            rot_frags(H + (t0 + r32) * NH + C_RK + h * 32, rot + (size_t)(i * 64 + r32) * 32, hi, 0.17677669529663689f, kf0[0], kf0[1]);
            rot_frags(H + (t0 + 32 + r32) * NH + C_RK + h * 32, rot + (size_t)(i * 64 + 32 + r32) * 32, hi, 0.17677669529663689f, kf1[0], kf1[1]);
            f32x16 p0 = zero16(), p1 = zero16();
            p0 = mma32(kf0[0], qf[0], p0); p0 = mma32(kf0[1], qf[1], p0); p1 = mma32(kf1[0], qf[0], p1); p1 = mma32(kf1[1], qf[1], p1);
#pragma unroll
            for (int v = 0; v < 16; ++v) { const int m = (v & 3) + 8 * (v >> 2) + 4 * hi; const int d0 = n - m, d1 = n - m - 32;
                p0[v] *= __expf(lg * (float)(d0 < 0 ? -d0 : d0)); p1[v] *= __expf(lg * (float)(d1 < 0 ? -d1 : d1)); }
            bf16x8 pb[4];
            { u32x4 w; w.x = pk2(p0[0], p0[1]); w.y = pk2(p0[2], p0[3]); w.z = pk2(p0[4], p0[5]); w.w = pk2(p0[6], p0[7]); pb[0] = __builtin_bit_cast(bf16x8, w);
              w.x = pk2(p0[8], p0[9]); w.y = pk2(p0[10], p0[11]); w.z = pk2(p0[12], p0[13]); w.w = pk2(p0[14], p0[15]); pb[1] = __builtin_bit_cast(bf16x8, w);
              w.x = pk2(p1[0], p1[1]); w.y = pk2(p1[2], p1[3]); w.z = pk2(p1[4], p1[5]); w.w = pk2(p1[6], p1[7]); pb[2] = __builtin_bit_cast(bf16x8, w);
              w.x = pk2(p1[8], p1[9]); w.y = pk2(p1[10], p1[11]); w.z = pk2(p1[12], p1[13]); w.w = pk2(p1[14], p1[15]); pb[3] = __builtin_bit_cast(bf16x8, w); }
            asm volatile("s_waitcnt vmcnt(0) lgkmcnt(0)" ::: "memory");
            const LAS unsigned char* vb = vt + (4 * hi + (i16 >> 2)) * 128 + ((lane >> 4) & 1) * 32 + (i16 & 3) * 8;
#pragma unroll
            for (int ks = 0; ks < 4; ++ks) { o0 = mma32(trfrag(vb + ks * 2048, vb + ks * 2048 + 1024), pb[ks], o0); o1 = mma32(trfrag(vb + ks * 2048 + 64, vb + ks * 2048 + 1024 + 64), pb[ks], o1); }
            const float xi = __expf(lg * (float)(n + 1));
#pragma unroll
            for (int s = 0; s < 2; ++s) { const bf16x8 qx = scale_frag(__builtin_bit_cast(u32x4, qf[s]), xi);
                o0 = mma32(trfrag(ra + s * 2048, ra + s * 2048 + 512), qx, o0); o1 = mma32(trfrag(ra + s * 2048 + 64, ra + s * 2048 + 512 + 64), qx, o1); }
        } else {
            bf16x8 qf[2];
#pragma unroll
            for (int s = 0; s < 2; ++s) qf[s] = scale_frag(*(const u32x4*)(H + (t0 + n) * NH + C_GQ + h * 32 + 16 * s + 8 * hi), 0.17677669529663689f);
            asm volatile("s_waitcnt lgkmcnt(0)" ::: "memory");
#pragma unroll
            for (int s = 0; s < 2; ++s) { o0 = mma32(trfrag(ra + s * 2048, ra + s * 2048 + 512), qf[s], o0); o1 = mma32(trfrag(ra + s * 2048 + 64, ra + s * 2048 + 512 + 64), qf[s], o1); }
        }
        float s = 0.f;
#pragma unroll
        for (int v = 0; v < 16; ++v) s += o0[v] + o1[v];
        s += __shfl_xor(s, 32);
        const float mean = s * (1.f / 64.f); float s2 = 0.f;
#pragma unroll
        for (int v = 0; v < 16; ++v) { o0[v] -= mean; o1[v] -= mean; s2 += o0[v] * o0[v] + o1[v] * o1[v]; }
        s2 += __shfl_xor(s2, 32);
        const float rs = 1.f / sqrtf(s2 * (1.f / 64.f) + LN_EPS);
        asm volatile("s_waitcnt lgkmcnt(0)" ::: "memory");
#pragma unroll
        for (int v = 0; v < 16; ++v) { const int d = (v & 3) + 8 * (v >> 2) + 4 * hi;
            *(LAS bf16_t*)(stg + r32 * 144 + d * 2) = (bf16_t)f2bf(o0[v] * rs); *(LAS bf16_t*)(stg + r32 * 144 + (32 + d) * 2) = (bf16_t)f2bf(o1[v] * rs); }
        asm volatile("s_waitcnt lgkmcnt(0)" ::: "memory");
#pragma unroll
        for (int c = 0; c < 4; ++c) { const int row = c * 8 + (lane >> 3), ch = lane & 7; float f[8], g[8]; unpack8(*(const LAS u32x4*)(stg + row * 144 + ch * 16), f);
            unpack8(*(const u32x4*)(H + (t0 + nh * 32 + row) * NH + (gla ? C_GR : C_RG) + h * 64 + ch * 8), g);
#pragma unroll
            for (int e = 0; e < 8; ++e) f[e] *= silu_f(g[e]);
            *(u32x4*)(O + (t0 + nh * 32 + row) * DM + (gla ? 512 : 0) + h * 64 + ch * 8) = pack8(f); }
    }
}

__device__ __forceinline__ void load_rot(const bf16_t* src, const float* rot, int i, LAS float* dst, float scale, float logz, int tid) {
#pragma unroll
    for (int q = 0; q < 2; ++q) { const int idx = tid + 512 * q, j = idx >> 4, f = idx & 15;
        const float x1 = bf2f(src[(size_t)j * NH + f]), x2 = bf2f(src[(size_t)j * NH + f + 16]);
        const int pos = i * 64 + j; const float c = rot[pos * 32 + f], s = rot[pos * 32 + 16 + f];
        const float sc = scale * __expf(logz * (float)(63 - j));
        dst[j * 33 + f] = (x1 * c - x2 * s) * sc; dst[j * 33 + f + 16] = (x1 * s + x2 * c) * sc; }
}
__device__ __forceinline__ float ret_logg(int h) { return log1pf(-exp2f(-5.f - (float)h)); }

__device__ __forceinline__ void upd_items(CPP p, int l, LAS unsigned char* lds) {
    LAS float* kt = (LAS float*)lds; LAS float* vv = kt + 64 * 33; LAS float* la = vv + 64 * 68; LAS float* gas = la + 64 * 33; LAS float* was = gas + 1024; LAS float* bas = was + 512;
    const bf16_t* H = (const bf16_t*)(p->ws + WS_E); const float* rot = (const float*)(p->ws + WS_ROT);
    float* RU = (float*)(p->ws + WS_RU); float* GU = (float*)(p->ws + WS_GU); float* GL = (float*)(p->ws + WS_GL);
    const int tid = otid();
    for (int it = obid(); it < 8192; it += ogrid()) {
        const int gla = it >> 12, h = it & 3, bi = (it >> 2) & 1023, i = bi & 31;
        const size_t t0 = (size_t)bi * 64;
        __syncthreads();
        if (!gla) {
            load_rot(H + t0 * NH + C_RK + h * 32, rot, i, kt, 0.17677669529663689f, ret_logg(h), tid);
            load_tile64(H + t0 * NH + C_RV + h * 64, NH, vv, 68, 1.f, tid);
            __syncthreads();
        } else {
            if (tid < 128) { const int j = tid >> 1, c = (tid & 1) * 8; const u32x4 w = *(const u32x4*)(H + (t0 + j) * NH + C_GA + c); float f[8]; unpack8(w, f);
#pragma unroll
                for (int e = 0; e < 8; ++e) gas[j * 16 + c + e] = f[e]; }
            { const int r = tid >> 5, dk = tid & 31; was[tid] = p->in[2][(size_t)(l * 16 + r) * 128 + h * 32 + dk]; }
            if (tid < 32) bas[tid] = p->in[3][l * 128 + h * 32 + tid];
            { const int idx = tid * 4, j = idx >> 5, c = idx & 31; const u32x2 w = *(const u32x2*)(H + (t0 + j) * NH + C_GK + h * 32 + c);
                kt[j * 33 + c] = bflo(w.x); kt[j * 33 + c + 1] = bfhi(w.x); kt[j * 33 + c + 2] = bflo(w.y); kt[j * 33 + c + 3] = bfhi(w.y); }
            load_tile64(H + t0 * NH + C_GV + h * 64, NH, vv, 68, 1.f, tid);
            __syncthreads();
#pragma unroll
            for (int q = 0; q < 4; ++q) { const int e = tid + 512 * q, j = e >> 5, dk = e & 31; float z = bas[dk];
#pragma unroll
                for (int r = 0; r < 16; ++r) z += gas[j * 16 + r] * was[r * 32 + dk];
                const float lsg = fminf(z, 0.f) - log1pf(expf(-fabsf(z)));
                la[j * 33 + dk] = lsg * 0.0625f; }
            __syncthreads();
            if (tid < 32) { float run = 0.f; for (int j = 0; j < 64; ++j) { run += la[j * 33 + tid]; la[j * 33 + tid] = run; } }
            __syncthreads();
#pragma unroll
            for (int q = 0; q < 4; ++q) { const int e = tid + 512 * q, j = e >> 5, dk = e & 31; kt[j * 33 + dk] *= __expf(la[63 * 33 + dk] - la[j * 33 + dk]); }
            if (tid < 32) GL[(size_t)(bi * 4 + h) * 32 + tid] = la[63 * 33 + tid];
            __syncthreads();
        }
        const int dk = tid >> 4, dv0 = (tid & 15) * 4; f32x4 a = (f32x4){0.f, 0.f, 0.f, 0.f};
#pragma unroll 8
        for (int j = 0; j < 64; ++j) { const float kk = kt[j * 33 + dk]; const f32x4 v4 = *(const LAS f32x4*)(vv + j * 68 + dv0); a += v4 * kk; }
        float* dst = (gla ? GU : RU) + (size_t)(bi * 4 + h) * 2048 + dk * 64 + dv0;
        *(f32x4*)dst = a;
    }
}

__device__ __forceinline__ void scan_items(CPP p, int l) {
    float* RU = (float*)(p->ws + WS_RU); float* GU = (float*)(p->ws + WS_GU); const float* GL = (const float*)(p->ws + WS_GL);
    const float* ES = (const float*)(p->ws + WS_ES); bf16_t* U2 = (bf16_t*)(p->ws + WS_U2);
    const int gt = obid() * 512 + otid(), NT = ogrid() * 512;
    for (int e = gt; e < 262144; e += NT) { const int dvk = e & 2047, bh = e >> 11, h = bh & 3, b = bh >> 2;
        const float dec = expf(64.f * ret_logg(h)); float st = 0.f; float t[32];
        float* base = RU + (size_t)(b * 32 * 4 + h) * 2048 + dvk;
#pragma unroll
        for (int i = 0; i < 32; ++i) t[i] = base[(size_t)i * 8192];
#pragma unroll
        for (int i = 0; i < 32; ++i) { base[(size_t)i * 8192] = st; st = st * dec + t[i]; } }
    for (int e = gt; e < 262144; e += NT) { const int dvk = e & 2047, bh = e >> 11, h = bh & 3, b = bh >> 2; float st = 0.f; float t[32], gl[32];
        float* base = GU + (size_t)(b * 32 * 4 + h) * 2048 + dvk; const float* gb = GL + (size_t)(b * 32 * 4 + h) * 32 + (dvk >> 6);
#pragma unroll
        for (int i = 0; i < 32; ++i) { t[i] = base[(size_t)i * 8192]; gl[i] = gb[i * 128]; }
#pragma unroll
        for (int i = 0; i < 32; ++i) { st = __expf(gl[i]) * st + t[i]; base[(size_t)i * 8192] = st; } }
    for (int e = gt; e < 32768; e += NT) { const int pp = e & 63, g = (e >> 6) & 15, b = e >> 10; const int gp = (l * 16 + g) * 64 + pp;
        const float lr = p->in[5][gp], li = p->in[6][gp], dt = expf(p->in[7][l * 16 + g]);
        float ar, ai2; s5_abar_pow(lr, li, dt, 64, ar, ai2);
        float xr = 0.f, xi = 0.f; float er[32], ei[32];
        const size_t row0 = (size_t)g * 1024 + b * 32;
#pragma unroll
        for (int i = 0; i < 32; ++i) { er[i] = ES[(row0 + i) * 128 + pp]; ei[i] = ES[(row0 + i) * 128 + 64 + pp]; }
#pragma unroll
        for (int i = 0; i < 32; ++i) { U2[(row0 + i) * S5K + 1024 + pp] = (bf16_t)f2bf(xr); U2[(row0 + i) * S5K + 1088 + pp] = (bf16_t)f2bf(xi);
            const float nr = ar * xr - ai2 * xi + er[i], ni = ar * xi + ai2 * xr + ei[i]; xr = nr; xi = ni; } }
}

__device__ __forceinline__ void out_items(CPP p, int l, LAS unsigned char* lds) {
    LAS float* qt = (LAS float*)lds; LAS float* kt = qt + 64 * 33; LAS float* vv = kt + 64 * 33; LAS float* Sm = vv + 64 * 68; LAS float* Rm = Sm + 64 * 65;
    const bf16_t* H = (const bf16_t*)(p->ws + WS_E); const float* rot = (const float*)(p->ws + WS_ROT); bf16_t* O = (bf16_t*)(p->ws + WS_O);
    const float* RU = (const float*)(p->ws + WS_RU); const float* GU = (const float*)(p->ws + WS_GU);
    const int tid = otid();
    for (int it = obid(); it < 8192; it += ogrid()) {
        const int gla = it >> 12, h = it & 3, bi = (it >> 2) & 1023, i = bi & 31;
        const size_t t0 = (size_t)bi * 64;
        const int n = tid >> 3, dv0 = (tid & 7) * 8;
        float acc[8];
#pragma unroll
        for (int e = 0; e < 8; ++e) acc[e] = 0.f;
        __syncthreads();
        { const float* src = (gla ? GU : RU) + (size_t)(bi * 4 + h) * 2048; const int idx = tid * 4, dk = idx >> 6, dv = idx & 63;
            const f32x4 t = *(const f32x4*)(src + idx); Rm[dk * 68 + dv] = t[0]; Rm[dk * 68 + dv + 1] = t[1]; Rm[dk * 68 + dv + 2] = t[2]; Rm[dk * 68 + dv + 3] = t[3]; }
        if (!gla) {
            const float lg = ret_logg(h);
            load_rot(H + t0 * NH + C_RQ + h * 32, rot, i, qt, 1.f, 0.f, tid);
            load_rot(H + t0 * NH + C_RK + h * 32, rot, i, kt, 0.17677669529663689f, 0.f, tid);
            load_tile64(H + t0 * NH + C_RV + h * 64, NH, vv, 68, 1.f, tid);
            __syncthreads();
            { const int m0 = (tid & 7) * 8;
#pragma unroll
                for (int mm = 0; mm < 8; ++mm) { const int m = m0 + mm; float d = 0.f;
#pragma unroll
                    for (int dk = 0; dk < 32; ++dk) d += qt[n * 33 + dk] * kt[m * 33 + dk];
                    const int ad = n > m ? n - m : m - n; Sm[n * 65 + m] = d * __expf(lg * (float)ad); } }
            __syncthreads();
#pragma unroll 4
            for (int m = 0; m < 64; ++m) { const float sv = Sm[n * 65 + m]; const f32x4 v0 = *(const LAS f32x4*)(vv + m * 68 + dv0), v1 = *(const LAS f32x4*)(vv + m * 68 + dv0 + 4);
                acc[0] += sv * v0[0]; acc[1] += sv * v0[1]; acc[2] += sv * v0[2]; acc[3] += sv * v0[3]; acc[4] += sv * v1[0]; acc[5] += sv * v1[1]; acc[6] += sv * v1[2]; acc[7] += sv * v1[3]; }
            const float xi = __expf(lg * (float)(n + 1));
#pragma unroll 4
            for (int dk = 0; dk < 32; ++dk) { const float qx = qt[n * 33 + dk] * xi; const f32x4 v0 = *(const LAS f32x4*)(Rm + dk * 68 + dv0), v1 = *(const LAS f32x4*)(Rm + dk * 68 + dv0 + 4);
                acc[0] += qx * v0[0]; acc[1] += qx * v0[1]; acc[2] += qx * v0[2]; acc[3] += qx * v0[3]; acc[4] += qx * v1[0]; acc[5] += qx * v1[1]; acc[6] += qx * v1[2]; acc[7] += qx * v1[3]; }
        } else {
            { const int idx = tid * 4, j = idx >> 5, c = idx & 31; const u32x2 w = *(const u32x2*)(H + (t0 + j) * NH + C_GQ + h * 32 + c); const float sc = 0.17677669529663689f;
                qt[j * 33 + c] = bflo(w.x) * sc; qt[j * 33 + c + 1] = bfhi(w.x) * sc; qt[j * 33 + c + 2] = bflo(w.y) * sc; qt[j * 33 + c + 3] = bfhi(w.y) * sc; }
            __syncthreads();
#pragma unroll 4
            for (int dk = 0; dk < 32; ++dk) { const float qx = qt[n * 33 + dk]; const f32x4 v0 = *(const LAS f32x4*)(Rm + dk * 68 + dv0), v1 = *(const LAS f32x4*)(Rm + dk * 68 + dv0 + 4);
                acc[0] += qx * v0[0]; acc[1] += qx * v0[1]; acc[2] += qx * v0[2]; acc[3] += qx * v0[3]; acc[4] += qx * v1[0]; acc[5] += qx * v1[1]; acc[6] += qx * v1[2]; acc[7] += qx * v1[3]; }
        }
        float s = 0.f;
#pragma unroll
        for (int e = 0; e < 8; ++e) s += acc[e];
        s += __shfl_xor(s, 1); s += __shfl_xor(s, 2); s += __shfl_xor(s, 4);
        const float mean = s * (1.f / 64.f); float s2 = 0.f;
#pragma unroll
        for (int e = 0; e < 8; ++e) { acc[e] -= mean; s2 += acc[e] * acc[e]; }
        s2 += __shfl_xor(s2, 1); s2 += __shfl_xor(s2, 2); s2 += __shfl_xor(s2, 4);
        const float rs = 1.f / sqrtf(s2 * (1.f / 64.f) + LN_EPS);
        const u32x4 gw = *(const u32x4*)(H + (t0 + n) * NH + (gla ? C_GR : C_RG) + h * 64 + dv0); float gf[8]; unpack8(gw, gf);
        float ov[8];
#pragma unroll
        for (int e = 0; e < 8; ++e) ov[e] = silu_f(gf[e]) * acc[e] * rs;
        *(u32x4*)(O + (t0 + n) * DM + (gla ? 512 : 0) + h * 64 + dv0) = pack8(ov);
    }
}


#define XB_TMO      128
#define XB_XCNT(j)  (256  + 64 * (j))
#define XB_XSUB(j)  (1280 + 64 * (j))
#define XB_XGEN(j)  (2304 + 64 * (j))
#define XB_TOP      3328
#define XB_TOPGEN   3392
#define XCD_BAR_WORDS 3456
#define XB_SPIN_CAP (1u << 20)
__device__ __forceinline__ unsigned xb_ld(unsigned* p)              { return __hip_atomic_load(p, __ATOMIC_RELAXED, __HIP_MEMORY_SCOPE_AGENT); }
__device__ __forceinline__ unsigned xb_add(unsigned* p, unsigned v) { return __hip_atomic_fetch_add(p, v, __ATOMIC_RELAXED, __HIP_MEMORY_SCOPE_AGENT); }
__device__ __forceinline__ unsigned xb_xcc_id() { return (unsigned)__builtin_amdgcn_s_getreg((3 << 11) | 20) & 0xFu; }
#define XB_SPIN(cond, bar) do { unsigned _sp = 0; while (cond) { __builtin_amdgcn_s_sleep(1); \
    if ((++_sp & 255u) == 0u) { if (xb_ld(&(bar)[XB_TMO])) break; if (_sp > XB_SPIN_CAP) { atomicAdd(&(bar)[XB_TMO], 1u); break; } } } } while (0)
struct XcdBarrier { unsigned* bar; unsigned x; volatile LAS unsigned* st; };
__device__ __forceinline__ XcdBarrier xcd_barrier_post(unsigned* bar, volatile LAS unsigned* st) {
    XcdBarrier b; b.bar = bar; b.x = xb_xcc_id(); b.st = st;
    if (threadIdx.x == 0) (void)xb_add(&bar[XB_XCNT(b.x)], 1u);
    return b;
}
__device__ __forceinline__ void xcd_barrier_complete(unsigned* bar, unsigned x, unsigned& nloc, unsigned& nx) {
    const unsigned G = gridDim.x * gridDim.y * gridDim.z;
    unsigned sum, cnt, mine, sp = 0u;
    for (;;) {
        sum = 0u; cnt = 0u; mine = 0u;
#pragma unroll
        for (unsigned j = 0; j < 16; ++j) { const unsigned c = xb_ld(&bar[XB_XCNT(j)]); sum += c; cnt += (c > 0u) ? 1u : 0u; mine = (j == x) ? c : mine; }
        if (sum == G) break;
        __builtin_amdgcn_s_sleep(1);
        if ((++sp & 255u) == 0u) { if (xb_ld(&bar[XB_TMO])) break; if (sp > XB_SPIN_CAP) { atomicAdd(&bar[XB_TMO], 1u); break; } }
    }
    nloc = mine > 0u ? mine : 1u; nx = cnt > 0u ? cnt : 1u;
}
__device__ __forceinline__ void xcd_barrier(const XcdBarrier& b) {
    asm volatile("s_waitcnt vmcnt(0)" ::: "memory");
    __syncthreads();
    if (threadIdx.x == 0) {
        unsigned* bar = b.bar;
        __builtin_amdgcn_s_waitcnt(0);
        unsigned nloc = b.st[0], nx = b.st[1];
        if (nloc == 0u) { xcd_barrier_complete(bar, b.x, nloc, nx); b.st[0] = nloc; b.st[1] = nx; }
        const unsigned old = xb_add(&bar[XB_XSUB(b.x)], 1u);
        const unsigned gen = old / nloc;
        if (old + 1u == (gen + 1u) * nloc) {
            __builtin_amdgcn_fence(__ATOMIC_RELEASE, "agent");
            asm volatile("s_waitcnt vmcnt(0)" ::: "memory");
            const unsigned og = xb_add(&bar[XB_TOP], 1u);
            const unsigned tg = og / nx;
            if (og + 1u == (tg + 1u) * nx) xb_add(&bar[XB_TOPGEN], 1u);
            else XB_SPIN(xb_ld(&bar[XB_TOPGEN]) == tg, bar);
            __builtin_amdgcn_fence(__ATOMIC_ACQUIRE, "agent");
            xb_add(&bar[XB_XGEN(b.x)], 1u);
            asm volatile("s_waitcnt vmcnt(0)" ::: "memory");
        } else {
            XB_SPIN(xb_ld(&bar[XB_XGEN(b.x)]) == gen, bar);
            __builtin_amdgcn_fence(__ATOMIC_ACQUIRE, "agent");
            asm volatile("s_waitcnt vmcnt(0)" ::: "memory");
        }
    }
    __syncthreads();
}

__global__ void __launch_bounds__(512, 2) mega(Params p_unused) {
    extern __shared__ __attribute__((aligned(16))) unsigned char lds_raw[];
    LAS unsigned char* lds = (LAS unsigned char*)lds_raw;
    cg::grid_group grid = cg::this_grid();
    CPP p = (CPP)__builtin_amdgcn_kernarg_segment_ptr();
    unsigned char* ws = p->ws;
    bf16_t* XB = (bf16_t*)(ws + WS_XB);
    volatile LAS unsigned* bst = (volatile LAS unsigned*)(lds + LDS_BYTES - 64);
    if (threadIdx.x < 2) bst[threadIdx.x] = 0u;
    __syncthreads();
    const XcdBarrier bar = xcd_barrier_post((unsigned*)ws, bst);

    { float* rot = (float*)(ws + WS_ROT); const int gt = obid() * 512 + otid(), NT = ogrid() * 512;
        for (int e = gt; e < 2048 * 16; e += NT) { const int pos = e >> 4, f = e & 15; const float inv = 1.0f / powf(10000.0f, (float)f * (1.0f / 16.0f)); const float ang = (float)pos * inv;
            rot[pos * 32 + f] = cosf(ang); rot[pos * 32 + 16 + f] = sinf(ang); } }
    s5_tables(p, 0, lds);
    { const float* x = p->in[0]; const int gt = obid() * 512 + otid(), NT = ogrid() * 512;
        for (size_t e = gt; e < (size_t)M * DM / 8; e += NT) { const f32x4 a = *((const f32x4*)x + 2 * e), b = *((const f32x4*)x + 2 * e + 1);
            u32x4 w; w.x = pk2(a[0], a[1]); w.y = pk2(a[2], a[3]); w.z = pk2(b[0], b[1]); w.w = pk2(b[2], b[3]); *((u32x4*)XB + e) = w; } }
    grid.sync();
    convert_weights(p, 0, lds);
    xcd_barrier(bar);

    for (int l = 0; l < 4; ++l) {
        for (int s = 0; s < 12; ++s) {
            p = (CPP)__builtin_amdgcn_kernarg_segment_ptr(); asm volatile("" : "+s"(p));
            pg8::Gemm g; pg8::Sched S; pg8::Epi E;
            bool do_gemm = true;
            S.G = ogrid(); S.c = obid(); S.mode = 0; S.nM = M / 256; S.nN = 1;
            E.mode = 0; E.perm = true;
            E.ws = ws; E.dskip = p->in[12] + l * 256; E.bglu = p->in[14] + l * 256; E.bgate = p->in[16] + (size_t)l * 4096;
            g.A = XB; g.Bt = (const bf16_t*)(ws + WS_WIN); g.lda = DM; g.ldb = DM; g.K = DM;
            switch (s) {
                case 0: S.nN = NINP / 256; E.mode = 0; E.perm = true; break;
                case 1: g.A = (const bf16_t*)(ws + WS_U2); g.Bt = (const bf16_t*)(ws + WS_WE); g.lda = S5K; g.ldb = 1024; g.K = 1024; S.mode = 2; S.nM = 64; S.nN = 1; E.mode = 1; break;
                case 3: g.A = (const bf16_t*)(ws + WS_U2); g.Bt = (const bf16_t*)(ws + WS_WT); g.lda = S5K; g.ldb = S5K; g.K = S5K; S.mode = 3; S.nM = 64; S.nN = 4; E.mode = 2; break;
                case 4: g.A = (const bf16_t*)(ws + WS_YS); g.Bt = (const bf16_t*)(ws + WS_WGLU); g.lda = 256; g.ldb = 256; g.K = 256; S.nN = 1; E.mode = 3; break;
                case 5: g.A = (const bf16_t*)(ws + WS_O); g.Bt = (const bf16_t*)(ws + WS_WB); g.lda = DM; g.ldb = 256; g.K = 256; S.mode = 1; S.nN = 16; E.mode = 4; break;
                case 6: g.Bt = (const bf16_t*)(ws + WS_WG); S.nN = 16; E.mode = 5; E.perm = false; break;
                case 7: g.A = (const bf16_t*)(ws + WS_O); g.Bt = (const bf16_t*)(ws + WS_WO); S.nN = 4; E.mode = 6; E.perm = true; break;
                case 9: g.Bt = (const bf16_t*)(ws + WS_WFF); S.nN = 22; E.mode = 7; E.perm = true; break;
                case 10: g.A = (const bf16_t*)(ws + WS_E); g.Bt = (const bf16_t*)(ws + WS_WD); g.lda = DFF; g.ldb = DFF; g.K = DFF; S.nN = 4; E.mode = 6; E.perm = true; break;
                default: do_gemm = false; break;
            }
            S.nwg = S.nM * S.nN;
            if (do_gemm) pg8::gemm_phase(lds, g, S, E);
            if (s == 1) { attn_mfma(p, l, lds); upd_mfma(p, l, lds); }
            else if (s == 2) scan_items(p, l);
            else if (s == 3) out_mfma(p, l, lds);
            else if (s == 8) { ln_pass(XB, nullptr, p->in[19] + l * DM, p->in[20] + l * DM); if (l < 3) s5_tables(p, l + 1, lds); }
            else if (s == 11) { ln_pass(XB, (l == 3) ? p->out : nullptr, p->in[24] + l * DM, p->in[25] + l * DM); if (l < 3) convert_weights(p, l + 1, lds); }
            xcd_barrier(bar);
        }
    }
}

extern "C" void kernel_launch(void* const* d_in, const int* in_sizes, int n_in, void* d_out, int out_size, void* d_ws, size_t ws_size, hipStream_t stream) {
    static int grid_blocks = 0;
    if (!grid_blocks) {
        int dev = 0, cus = 0;
        hipGetDevice(&dev);
        hipDeviceGetAttribute(&cus, hipDeviceAttributeMultiprocessorCount, dev);
        hipFuncSetAttribute((const void*)mega, hipFuncAttributeMaxDynamicSharedMemorySize, LDS_BYTES);
        grid_blocks = cus > 0 ? cus : 256;
    }
    (void)hipMemsetAsync(d_ws, 0, 65536, stream);
    Params p{};
    for (int i = 0; i < 26; ++i) p.in[i] = (const float*)d_in[i];
    p.out = (float*)d_out; p.ws = (unsigned char*)d_ws;
    void* args[] = {&p};
    hipError_t e = hipLaunchCooperativeKernel((const void*)mega, dim3(grid_blocks), dim3(512), args, LDS_BYTES, stream);
    if (e != hipSuccess) fprintf(stderr, "cooperative launch failed: %s (grid %d)\n", hipGetErrorString(e), grid_blocks);
}
```

```cpp
#include <hip/hip_runtime.h>
#include <hip/hip_cooperative_groups.h>
#include <cstdint>
#include <cstdio>
namespace cg = cooperative_groups;

#define LAS __attribute__((address_space(3)))
typedef unsigned short bf16_t;
typedef short bf16x8 __attribute__((ext_vector_type(8)));
typedef float f32x4 __attribute__((ext_vector_type(4)));
typedef float f32x2 __attribute__((ext_vector_type(2)));
typedef unsigned u32x4 __attribute__((ext_vector_type(4)));
typedef unsigned u32x2 __attribute__((ext_vector_type(2)));

constexpr int M = 65536, DM = 1024, SEQ = 2048, NCH = 32;
constexpr int NH = 2320;
constexpr int NINP = 2816;
constexpr int DFF = 2816;
constexpr int S5K = 1152;
constexpr float ALPHA = 1.681792830507429f;
constexpr float LN_EPS = 1e-5f;
constexpr int C_RQ = 0, C_RK = 128, C_RV = 256, C_RG = 512, C_AQ = 768, C_AK = 1024, C_AV = 1280, C_GQ = 1536, C_GK = 1664, C_GV = 1792, C_GR = 2048, C_GA = 2304, C_SU = 2320;

constexpr size_t MiB = 1u << 20;
constexpr size_t WS_ROT = 1 * MiB;
constexpr size_t WS_KN = 2 * MiB;
constexpr size_t WS_WIN = 4 * MiB;
constexpr size_t WS_WG = 10 * MiB;
constexpr size_t WS_WB = 18 * MiB;
constexpr size_t WS_WO = 20 * MiB;
constexpr size_t WS_WFF = 22 * MiB;
constexpr size_t WS_WD = 33 * MiB;
constexpr size_t WS_WGLU = 39 * MiB;
constexpr size_t WS_WE = 40 * MiB;
constexpr size_t WS_WT = 48 * MiB;
constexpr size_t WS_XB = 88 * MiB;
constexpr size_t WS_O = 216 * MiB;
constexpr size_t WS_E = 344 * MiB;
constexpr size_t WS_U2 = 636 * MiB;
constexpr size_t WS_RU = 676 * MiB;
constexpr size_t WS_GU = 708 * MiB;
constexpr size_t WS_GL = 740 * MiB;
constexpr size_t WS_ES = 741 * MiB;
constexpr size_t WS_YS = 749 * MiB;
constexpr int LDS_BYTES = 147456;

struct Params { const float* in[26]; float* out; unsigned char* ws; };
typedef const __attribute__((address_space(4))) Params* CPP;

typedef _Float16 half2_t __attribute__((ext_vector_type(2)));
typedef _Float16 half8_t __attribute__((ext_vector_type(8)));
__device__ __forceinline__ float bflo(unsigned w) { return (float)__builtin_bit_cast(half2_t, w)[0]; }
__device__ __forceinline__ float bfhi(unsigned w) { return (float)__builtin_bit_cast(half2_t, w)[1]; }
__device__ __forceinline__ float bf2f(bf16_t b) { return (float)__builtin_bit_cast(_Float16, b); }
__device__ __forceinline__ unsigned f2bf(float f) { return (unsigned)__builtin_bit_cast(unsigned short, (_Float16)f); }
__device__ __forceinline__ unsigned pk2(float lo, float hi) { const half2_t v = {(_Float16)lo, (_Float16)hi}; return __builtin_bit_cast(unsigned, v); }
__device__ __forceinline__ unsigned cvt_pk_bf16(float lo, float hi) { return pk2(lo, hi); }
__device__ __forceinline__ float sigm(float x) { return __builtin_amdgcn_rcpf(1.0f + __expf(-x)); }
__device__ __forceinline__ float silu_f(float x) { return x * sigm(x); }
__device__ __forceinline__ float gelu_tanh(float v) { return v * sigm(1.5957691216057308f * (v + 0.044715f * v * v * v)); }
__device__ __forceinline__ void unpack8(u32x4 w, float* o) {
    o[0] = bflo(w.x); o[1] = bfhi(w.x); o[2] = bflo(w.y); o[3] = bfhi(w.y); o[4] = bflo(w.z); o[5] = bfhi(w.z); o[6] = bflo(w.w); o[7] = bfhi(w.w);
}
__device__ __forceinline__ u32x4 pack8(const float* v) { u32x4 w; w.x = pk2(v[0], v[1]); w.y = pk2(v[2], v[3]); w.z = pk2(v[4], v[5]); w.w = pk2(v[6], v[7]); return w; }
__device__ __forceinline__ int otid() { int t = threadIdx.x; asm volatile("" : "+v"(t)); return t; }
__device__ __forceinline__ int obid() { int b = blockIdx.x; asm volatile("" : "+s"(b)); return b; }
__device__ __forceinline__ int ogrid() { int b = gridDim.x; asm volatile("" : "+s"(b)); return b; }
__device__ __forceinline__ float wave_sum(float v) {
#pragma unroll
    for (int o = 1; o < 64; o <<= 1) v += __shfl_xor(v, o);
    return v;
}

namespace pg8 {
constexpr int BM = 256, BK = 64, HALF = 128, HTB = HALF * BK * 2, STAGE_BYTES = 8 * HTB, NXCD = 8, WGM = 8;
__device__ __forceinline__ int lds_byte(int r, int c) { const int st = (r >> 4) * 2 + (c >> 5), rr = r & 15, cc = c & 31, ob = rr * 64 + cc * 2; return st * 1024 + (ob ^ (((ob >> 9) & 1) << 5)); }
__device__ __forceinline__ void stage_rc(int b, int& R, int& C) { const int st = b / 1024, sb = b % 1024, swz = sb ^ (((sb >> 9) & 1) << 5); R = (st >> 1) * 16 + swz / 64; C = (st & 1) * 32 + (swz % 64) / 2; }
__device__ __forceinline__ int perm32(int rho) { const int n = rho >> 4, i = rho & 15; return 8 * (i >> 2) + 4 * n + (i & 3); }

struct Unit { int pm, pn, ak; };
struct Gemm { const bf16_t* A; const bf16_t* Bt; int lda, ldb, K; };

struct Sched {
    int nM, nN, nwg, G, c, mode;
    __device__ __forceinline__ bool next(int i, Unit& u) const {
        const long L = (long)i * G + c; if (L >= nwg) return false;
        if (mode == 2) { u.pm = (int)L; u.pn = (int)(L >> 2); u.ak = 0; return true; }
        if (mode == 3) { const int g = (int)(L >> 4); u.pm = 4 * g + (int)((L >> 2) & 3); u.pn = 4 * g + (int)(L & 3); u.ak = 0; return true; }
        int wgid = (int)L; { const int q = nwg / NXCD, r = nwg % NXCD, xcd = wgid % NXCD, off = wgid / NXCD; wgid = (xcd < r ? xcd * (q + 1) : r * (q + 1) + (xcd - r) * q) + off; }
        const int nig = WGM * nN, gid = wgid / nig, fm = gid * WGM, gsz = (nM - fm) < WGM ? (nM - fm) : WGM;
        u.pm = fm + ((wgid % nig) % gsz); u.pn = (wgid % nig) / gsz; u.ak = (mode == 1) ? (u.pn >> 2) * 256 : 0; return true;
    }
};

struct Epi {
    int mode; bool perm;
    unsigned char* ws; const float* dskip; const float* bglu; const float* bgate;
    __device__ __forceinline__ void operator()(const f32x4 (&acc)[2][2][4][2], const Unit& u, int wr, int wc, int fr, int fq) const {
        const int row0 = u.pm * BM + wr * 64 + fr;
        bf16_t* const H = (bf16_t*)(ws + WS_E); bf16_t* const U2 = (bf16_t*)(ws + WS_U2); float* const ES = (float*)(ws + WS_ES); bf16_t* const YS = (bf16_t*)(ws + WS_YS);
        bf16_t* const Ob = (bf16_t*)(ws + WS_O); bf16_t* const P = (bf16_t*)(ws + WS_E); bf16_t* const MIX = (bf16_t*)(ws + WS_O); bf16_t* const HF = (bf16_t*)(ws + WS_E);
        if (mode == 0) {
#pragma unroll
            for (int ai = 0; ai < 2; ++ai)
#pragma unroll
                for (int m = 0; m < 4; ++m) { const int r = row0 + ai * HALF + m * 16;
#pragma unroll
                    for (int bj = 0; bj < 2; ++bj) { const int c0 = u.pn * BM + bj * HALF + wc * 32 + 8 * fq;
                        const f32x4 v0 = acc[ai][bj][m][0], v1 = acc[ai][bj][m][1];
                        u32x4 w; w.x = cvt_pk_bf16(v0[0], v0[1]); w.y = cvt_pk_bf16(v0[2], v0[3]); w.z = cvt_pk_bf16(v1[0], v1[1]); w.w = cvt_pk_bf16(v1[2], v1[3]);
                        if (c0 < C_SU) *(u32x4*)(H + (size_t)r * NH + c0) = w;
                        else if (c0 < C_SU + 256) { const int c = c0 - C_SU, g = c >> 4, ci = c & 15;
                            *(u32x4*)(U2 + ((size_t)(g * 1024 + (r >> 6))) * S5K + (r & 63) * 16 + ci) = w; } } }
        } else if (mode == 1) {
#pragma unroll
            for (int ai = 0; ai < 2; ++ai)
#pragma unroll
                for (int m = 0; m < 4; ++m) { const int r = row0 + ai * HALF + m * 16; const int c0 = wc * 32 + 8 * fq;
                    *(f32x4*)(ES + (size_t)r * 128 + c0) = acc[ai][0][m][0]; *(f32x4*)(ES + (size_t)r * 128 + c0 + 4) = acc[ai][0][m][1]; }
        } else if (mode == 2) {
            const int g = u.pm >> 2;
#pragma unroll
            for (int ai = 0; ai < 2; ++ai)
#pragma unroll
                for (int m = 0; m < 4; ++m) { const int r = row0 + ai * HALF + m * 16;
#pragma unroll
                    for (int bj = 0; bj < 2; ++bj) { const int n0 = (u.pn & 3) * BM + bj * HALF + wc * 32 + 8 * fq; const int j = n0 >> 4, i0 = n0 & 15;
                        const u32x4 uw = *(const u32x4*)(U2 + (size_t)r * S5K + n0); float uf[8]; unpack8(uw, uf);
                        const f32x4 d0 = *(const f32x4*)(dskip + 16 * g + i0), d1 = *(const f32x4*)(dskip + 16 * g + i0 + 4);
                        const f32x4 v0 = acc[ai][bj][m][0], v1 = acc[ai][bj][m][1]; float y[8];
                        y[0] = gelu_tanh(v0[0] + d0[0] * uf[0]); y[1] = gelu_tanh(v0[1] + d0[1] * uf[1]); y[2] = gelu_tanh(v0[2] + d0[2] * uf[2]); y[3] = gelu_tanh(v0[3] + d0[3] * uf[3]);
                        y[4] = gelu_tanh(v1[0] + d1[0] * uf[4]); y[5] = gelu_tanh(v1[1] + d1[1] * uf[5]); y[6] = gelu_tanh(v1[2] + d1[2] * uf[6]); y[7] = gelu_tanh(v1[3] + d1[3] * uf[7]);
                        u32x4 w; w.x = cvt_pk_bf16(y[0], y[1]); w.y = cvt_pk_bf16(y[2], y[3]); w.z = cvt_pk_bf16(y[4], y[5]); w.w = cvt_pk_bf16(y[6], y[7]);
                        const size_t t = (size_t)(r & 1023) * 64 + j;
                        *(u32x4*)(YS + t * 256 + 16 * g + i0) = w; } }
        } else if (mode == 3) {
#pragma unroll
            for (int ai = 0; ai < 2; ++ai)
#pragma unroll
                for (int m = 0; m < 4; ++m) { const int r = row0 + ai * HALF + m * 16;
#pragma unroll
                    for (int bj = 0; bj < 2; ++bj) { const int c0 = bj * HALF + wc * 32 + 8 * fq;
                        const u32x4 yw = *(const u32x4*)(YS + (size_t)r * 256 + c0); float yf[8]; unpack8(yw, yf);
                        const f32x4 b0 = *(const f32x4*)(bglu + c0), b1 = *(const f32x4*)(bglu + c0 + 4);
                        const f32x4 v0 = acc[ai][bj][m][0] + b0, v1 = acc[ai][bj][m][1] + b1; float o[8];
                        o[0] = yf[0] * sigm(v0[0]); o[1] = yf[1] * sigm(v0[1]); o[2] = yf[2] * sigm(v0[2]); o[3] = yf[3] * sigm(v0[3]);
                        o[4] = yf[4] * sigm(v1[0]); o[5] = yf[5] * sigm(v1[1]); o[6] = yf[6] * sigm(v1[2]); o[7] = yf[7] * sigm(v1[3]);
                        u32x4 w; w.x = cvt_pk_bf16(o[0], o[1]); w.y = cvt_pk_bf16(o[2], o[3]); w.z = cvt_pk_bf16(o[4], o[5]); w.w = cvt_pk_bf16(o[6], o[7]);
                        *(u32x4*)(Ob + (size_t)r * DM + 768 + c0) = w; } }
        } else if (mode == 4) {
#pragma unroll
            for (int ai = 0; ai < 2; ++ai)
#pragma unroll
                for (int m = 0; m < 4; ++m) { const int r = row0 + ai * HALF + m * 16;
#pragma unroll
                    for (int bj = 0; bj < 2; ++bj) { const int c0 = u.pn * BM + bj * HALF + wc * 32 + 8 * fq;
                        const f32x4 v0 = acc[ai][bj][m][0], v1 = acc[ai][bj][m][1];
                        u32x4 w; w.x = cvt_pk_bf16(v0[0], v0[1]); w.y = cvt_pk_bf16(v0[2], v0[3]); w.z = cvt_pk_bf16(v1[0], v1[1]); w.w = cvt_pk_bf16(v1[2], v1[3]);
                        *(u32x4*)(P + (size_t)r * 4096 + c0) = w; } }
        } else if (mode == 5) {
            const int ch0 = 64 * u.pn + 16 * wc + 4 * fq;
            f32x4 bv[4];
#pragma unroll
            for (int b = 0; b < 4; ++b) bv[b] = *(const f32x4*)(bgate + b * 1024 + ch0);
#pragma unroll
            for (int ai = 0; ai < 2; ++ai)
#pragma unroll
                for (int m = 0; m < 4; ++m) { const int r = row0 + ai * HALF + m * 16; f32x4 mix = (f32x4){0.f, 0.f, 0.f, 0.f};
#pragma unroll
                    for (int bj = 0; bj < 2; ++bj)
#pragma unroll
                        for (int n = 0; n < 2; ++n) { const int b = 2 * bj + n; const f32x4 a = acc[ai][bj][m][n] + bv[b];
                            const u32x2 pw = *(const u32x2*)(P + (size_t)r * 4096 + b * 1024 + ch0);
                            mix[0] += sigm(a[0]) * bflo(pw.x); mix[1] += sigm(a[1]) * bfhi(pw.x); mix[2] += sigm(a[2]) * bflo(pw.y); mix[3] += sigm(a[3]) * bfhi(pw.y); }
                    u32x2 w; w.x = cvt_pk_bf16(mix[0], mix[1]); w.y = cvt_pk_bf16(mix[2], mix[3]);
                    *(u32x2*)(MIX + (size_t)r * DM + ch0) = w; }
        } else if (mode == 6) {
            bf16_t* const XBp = (bf16_t*)(ws + WS_XB);
#pragma unroll
            for (int ai = 0; ai < 2; ++ai)
#pragma unroll
                for (int m = 0; m < 4; ++m) { const int r = row0 + ai * HALF + m * 16;
#pragma unroll
                    for (int bj = 0; bj < 2; ++bj) { const int c = u.pn * BM + bj * HALF + wc * 32 + 8 * fq;
                        u32x4* px = (u32x4*)(XBp + (size_t)r * DM + c); const u32x4 xw = *px; float xf[8]; unpack8(xw, xf);
                        const f32x4 a0 = acc[ai][bj][m][0], a1 = acc[ai][bj][m][1];
                        u32x4 w; w.x = cvt_pk_bf16(xf[0] * ALPHA + a0[0], xf[1] * ALPHA + a0[1]); w.y = cvt_pk_bf16(xf[2] * ALPHA + a0[2], xf[3] * ALPHA + a0[3]);
                        w.z = cvt_pk_bf16(xf[4] * ALPHA + a1[0], xf[5] * ALPHA + a1[1]); w.w = cvt_pk_bf16(xf[6] * ALPHA + a1[2], xf[7] * ALPHA + a1[3]);
                        *px = w; } }
        } else {
#pragma unroll
            for (int ai = 0; ai < 2; ++ai)
#pragma unroll
                for (int m = 0; m < 4; ++m) { const int r = row0 + ai * HALF + m * 16; const int ch0 = 128 * u.pn + 32 * wc + 8 * fq;
                    const f32x4 g0 = acc[ai][0][m][0], g1 = acc[ai][0][m][1], u0 = acc[ai][1][m][0], u1 = acc[ai][1][m][1];
                    u32x4 w; w.x = cvt_pk_bf16(silu_f(g0[0]) * u0[0], silu_f(g0[1]) * u0[1]); w.y = cvt_pk_bf16(silu_f(g0[2]) * u0[2], silu_f(g0[3]) * u0[3]);
                    w.z = cvt_pk_bf16(silu_f(g1[0]) * u1[0], silu_f(g1[1]) * u1[1]); w.w = cvt_pk_bf16(silu_f(g1[2]) * u1[2], silu_f(g1[3]) * u1[3]);
                    *(u32x4*)(HF + (size_t)r * DFF + ch0) = w; }
        }
    }
};

__device__ __forceinline__ void gemm_phase(LAS unsigned char* lds, const Gemm g, const Sched& S, const Epi& E) {
    const int tid = otid(), wid = __builtin_amdgcn_readfirstlane(tid >> 6), lane = tid & 63, wr = wid >> 2, wc = wid & 3, fr = lane & 15, fq = lane >> 4;
    const int K = g.K, nt = K / BK;
    unsigned voffA[2], voffB[2];
#pragma unroll
    for (int i = 0; i < 2; ++i) { int R, C; stage_rc(tid * 16 + i * 8192, R, C); const int Rb = E.perm ? ((R & ~31) + perm32(R & 31)) : R;
        voffA[i] = (unsigned)(R * g.lda + C) * 2u; voffB[i] = (unsigned)(Rb * g.ldb + C) * 2u; }
    const size_t kstep = (size_t)(BK * 2);
    const size_t hstepA = (size_t)HALF * g.lda * 2, hstepB = (size_t)HALF * g.ldb * 2;
    const size_t tstepA = 2 * hstepA, tstepB = 2 * hstepB;
    const unsigned ldsw = (unsigned)wid * 1024u;
    const int aoff = lds_byte(wr * 64 + fr, fq * 8), boff = lds_byte(wc * 32 + fr, fq * 8);
#define PG8_SA(b, h) (((b) * 2 + (h)) * HTB)
#define PG8_SB(b, h) ((4 + (b) * 2 + (h)) * HTB)
#define PG8_STAGE(bufoff, gbase, voff) do { _Pragma("unroll") for (int _i = 0; _i < 2; ++_i) \
        __builtin_amdgcn_global_load_lds((const unsigned*)((const char*)(gbase) + (voff)[_i]), (LAS unsigned*)(lds + (bufoff) + ldsw + _i * 8192), 16, 0, 0); } while (0)
#define PG8_LDA(dst, b, h) do { _Pragma("unroll") for (int m = 0; m < 4; ++m) _Pragma("unroll") for (int k = 0; k < 2; ++k) dst[m][k] = *(const LAS bf16x8*)(lds + PG8_SA(b, h) + aoff + m * 2048 + k * 1024); } while (0)
#define PG8_LDB(dst, b, h) do { _Pragma("unroll") for (int n = 0; n < 2; ++n) _Pragma("unroll") for (int k = 0; k < 2; ++k) dst[n][k] = *(const LAS bf16x8*)(lds + PG8_SB(b, h) + boff + n * 2048 + k * 1024); } while (0)
#define PG8_MMA(ai, bj, At, Bt) do { __builtin_amdgcn_s_setprio(1); _Pragma("unroll") for (int m = 0; m < 4; ++m) _Pragma("unroll") for (int n = 0; n < 2; ++n) _Pragma("unroll") for (int k = 0; k < 2; ++k) \
        acc[ai][bj][m][n] = __builtin_amdgcn_mfma_f32_16x16x32_f16(__builtin_bit_cast(half8_t, Bt[n][k]), __builtin_bit_cast(half8_t, At[m][k]), acc[ai][bj][m][n], 0, 0, 0); __builtin_amdgcn_s_setprio(0); } while (0)
#define PG8_WAIT_V(n) asm volatile("s_waitcnt vmcnt(" #n ")" ::: "memory")
#define PG8_WAIT_L(n) asm volatile("s_waitcnt lgkmcnt(" #n ")" ::: "memory")
#define PG8_BAR __builtin_amdgcn_s_barrier()
#define PG8_SCHED __builtin_amdgcn_sched_barrier(0)
    Unit cur, nxt; int ui = 0;
    if (!S.next(0, cur)) return;
    f32x4 acc[2][2][4][2];
#pragma unroll
    for (int a = 0; a < 2; ++a)
#pragma unroll
        for (int b = 0; b < 2; ++b)
#pragma unroll
            for (int m = 0; m < 4; ++m)
#pragma unroll
                for (int n = 0; n < 2; ++n) acc[a][b][m][n] = (f32x4){0.f, 0.f, 0.f, 0.f};
    bf16x8 At[4][2], B0[2][2], B1[2][2];
    const char* cA = (const char*)g.A + (size_t)cur.pm * tstepA + (size_t)cur.ak * 2; const char* cB = (const char*)g.Bt + (size_t)cur.pn * tstepB;
    PG8_STAGE(PG8_SB(0, 0), cB, voffB); PG8_STAGE(PG8_SB(0, 1), cB + hstepB, voffB); PG8_STAGE(PG8_SA(0, 0), cA, voffA); PG8_STAGE(PG8_SA(0, 1), cA + hstepA, voffA);
    if (wr == 1) PG8_BAR;
    PG8_WAIT_V(2); PG8_BAR;
    PG8_STAGE(PG8_SB(1, 0), cB + kstep, voffB); PG8_STAGE(PG8_SA(1, 0), cA + kstep, voffA); PG8_STAGE(PG8_SB(1, 1), cB + hstepB + kstep, voffB);
    PG8_WAIT_V(6); PG8_BAR;
    for (;;) {
        const bool has_next = S.next(ui + 1, nxt);
        const char* nA = has_next ? (const char*)g.A + (size_t)nxt.pm * tstepA + (size_t)nxt.ak * 2 : cA; const char* nB = has_next ? (const char*)g.Bt + (size_t)nxt.pn * tstepB : cB;
        for (int t = 0; t < nt; t += 2) {
            const bool last = (t == nt - 2);
            const char* a1 = cA + (size_t)(t + 1) * kstep;
            const char* a2 = last ? nA : cA + (size_t)(t + 2) * kstep; const char* b2 = last ? nB : cB + (size_t)(t + 2) * kstep;
            const char* a3 = a2 + kstep; const char* b3 = b2 + kstep;
            PG8_LDB(B0, 0, 0); PG8_LDB(B1, 0, 1); PG8_SCHED; PG8_LDA(At, 0, 0); PG8_STAGE(PG8_SA(1, 1), a1 + hstepA, voffA);
            PG8_WAIT_V(8); PG8_WAIT_L(0); PG8_BAR; PG8_MMA(0, 0, At, B0); PG8_MMA(0, 1, At, B1); PG8_BAR; PG8_SCHED;
            PG8_LDA(At, 0, 1); PG8_STAGE(PG8_SB(0, 0), b2, voffB); PG8_STAGE(PG8_SB(0, 1), b2 + hstepB, voffB); PG8_STAGE(PG8_SA(0, 0), a2, voffA);
            PG8_WAIT_V(8); PG8_WAIT_L(0); PG8_BAR; PG8_MMA(1, 0, At, B0); PG8_MMA(1, 1, At, B1); PG8_BAR; PG8_SCHED;
            PG8_LDB(B0, 1, 0); PG8_LDB(B1, 1, 1); PG8_SCHED; PG8_LDA(At, 1, 0); PG8_STAGE(PG8_SA(0, 1), a2 + hstepA, voffA);
            PG8_WAIT_V(8); PG8_WAIT_L(0); PG8_BAR; PG8_MMA(0, 0, At, B0); PG8_MMA(0, 1, At, B1); PG8_BAR; PG8_SCHED;
            PG8_LDA(At, 1, 1); PG8_STAGE(PG8_SB(1, 0), b3, voffB); PG8_STAGE(PG8_SB(1, 1), b3 + hstepB, voffB); PG8_STAGE(PG8_SA(1, 0), a3, voffA);
            PG8_WAIT_V(8); PG8_WAIT_L(0); PG8_BAR; PG8_MMA(1, 0, At, B0); PG8_MMA(1, 1, At, B1); PG8_BAR; PG8_SCHED;
        }
        if (wr == 0) PG8_BAR;
        { const int t2 = otid(), w2 = __builtin_amdgcn_readfirstlane(t2 >> 6), l2 = t2 & 63;
          E(acc, cur, w2 >> 2, w2 & 3, l2 & 15, l2 >> 4); }
        if (!has_next) break;
#pragma unroll
        for (int a = 0; a < 2; ++a)
#pragma unroll
            for (int b = 0; b < 2; ++b)
#pragma unroll
                for (int m = 0; m < 4; ++m)
#pragma unroll
                    for (int n = 0; n < 2; ++n) acc[a][b][m][n] = (f32x4){0.f, 0.f, 0.f, 0.f};
        cur = nxt; cA = nA; cB = nB; ++ui;
        if (wr == 1) PG8_BAR;
    }
    PG8_WAIT_V(0);
    PG8_BAR;
#undef PG8_SA
#undef PG8_SB
#undef PG8_STAGE
#undef PG8_LDA
#undef PG8_LDB
#undef PG8_MMA
#undef PG8_WAIT_V
#undef PG8_WAIT_L
#undef PG8_BAR
#undef PG8_SCHED
}
}

__device__ __forceinline__ int dest_row(int dmode, int arg, int n) {
    if (dmode == 1) { return ((n >> 6) << 8) + ((arg >> 1) << 7) + (((n >> 4) & 3) << 5) + ((arg & 1) << 4) + (n & 15); }
    if (dmode == 2) { return ((n >> 7) << 8) + (arg << 7) + (n & 127); }
    return n + arg;
}
__device__ __forceinline__ void transpose_item(const float* W, int K, int Nsrc, bf16_t* WT, int dmode, int arg, LAS float* scr, int kb, int nb, int lane) {
    const int k0 = 64 * kb, n0 = 32 * nb;
    const int nsrc = n0 + (lane & 31); const bool ok = nsrc < Nsrc;
#pragma unroll 8
    for (int i = 0; i < 32; ++i) { const int kk = 2 * i + (lane >> 5); scr[kk * 33 + (lane & 31)] = ok ? W[(size_t)(k0 + kk) * Nsrc + nsrc] : 0.f; }
    asm volatile("s_waitcnt lgkmcnt(0)" ::: "memory");
    const int c = lane & 7;
#pragma unroll
    for (int j = 0; j < 4; ++j) { const int n = (lane >> 3) + 8 * j; const LAS float* s = scr + (8 * c) * 33 + n;
        u32x4 o; o.x = pk2(s[0 * 33], s[1 * 33]); o.y = pk2(s[2 * 33], s[3 * 33]); o.z = pk2(s[4 * 33], s[5 * 33]); o.w = pk2(s[6 * 33], s[7 * 33]);
        *(u32x4*)(WT + (size_t)dest_row(dmode, arg, n0 + n) * K + k0 + 8 * c) = o; }
    asm volatile("s_waitcnt lgkmcnt(0)" ::: "memory");
}

__device__ __forceinline__ void s5_abar_pow(float lr, float li, float dt, int n, float& re, float& im) {
    const float mag = expf((float)n * lr * dt);
    const double a = (double)n * ((double)li * (double)dt);
    const double k = __builtin_rint(a * 0.15915494309189535);
    const float r = (float)__builtin_fma(-k, 6.283185307179586, a);
    re = mag * cosf(r); im = mag * sinf(r);
}
__device__ __forceinline__ void s5_coef(float lr, float li, float dt, float& cr, float& ci) {
    const float th = li * dt, em1 = expm1f(lr * dt), c1 = cosf(th), s1 = sinf(th), sh = sinf(0.5f * th);
    const float nr = em1 * c1 - 2.f * sh * sh, ni = (1.f + em1) * s1, den = lr * lr + li * li;
    cr = (nr * lr + ni * li) / den; ci = (ni * lr - nr * li) / den;
}

__device__ __forceinline__ void s5_tables(CPP p, int l, LAS unsigned char* lds) {
    LAS float* abr = (LAS float*)lds;
    LAS float* abi = abr + 1024;
    LAS float* cr = abi + 1024;
    LAS float* ci = cr + 16 * 65;
    float* KN = (float*)(p->ws + WS_KN);
    const int tid = otid();
    for (int it = obid(); it < 1024; it += ogrid()) {
        const int g = it >> 6, n = it & 63;
        __syncthreads();
        for (int e = tid; e < 1024; e += 512) { const int pp = e >> 4, c = e & 15; const int gp = (l * 16 + g) * 64 + pp;
            const float lr = p->in[5][gp], li = p->in[6][gp], dt = expf(p->in[7][l * 16 + g]);
            float ar, ai2; s5_abar_pow(lr, li, dt, n, ar, ai2);
            float qr, qi; s5_coef(lr, li, dt, qr, qi);
            const float br = p->in[8][(size_t)gp * 16 + c], bi = p->in[9][(size_t)gp * 16 + c];
            const float bbr = qr * br - qi * bi, bbi = qr * bi + qi * br;
            abr[e] = ar * bbr - ai2 * bbi; abi[e] = ar * bbi + ai2 * bbr; }
        for (int e = tid; e < 1024; e += 512) { const int i = e >> 6, pp = e & 63; const size_t gi = ((size_t)(l * 16 + g) * 16 + i) * 64 + pp;
            cr[i * 65 + pp] = p->in[10][gi]; ci[i * 65 + pp] = p->in[11][gi]; }
        __syncthreads();
        if (tid < 256) { const int i = tid >> 4, c = tid & 15; float s = 0.f;
#pragma unroll 8
            for (int pp = 0; pp < 64; ++pp) s += cr[i * 65 + pp] * abr[pp * 16 + c] - ci[i * 65 + pp] * abi[pp * 16 + c];
            KN[((size_t)(g * 64 + n) * 16 + i) * 16 + c] = s; }
    }
}

__device__ __forceinline__ void convert_weights(CPP p, int l, LAS unsigned char* lds) {
    const int tid = otid(), lane = tid & 63, wave = tid >> 6;
    LAS float* scr = (LAS float*)(lds + wave * 16384);
    const int gw = obid() * 8 + wave, NGW = ogrid() * 8;
    unsigned char* ws = p->ws;
    constexpr int J0 = 1408, J1 = J0 + 2048, J2 = J1 + 512, J3 = J2 + 512, J4 = J3 + 2816, J5 = J4 + 1408, J6 = J5 + 32;
    for (int it = gw; it < J6; it += NGW) {
        if (it < J0) { const int r = it; transpose_item(p->in[1] + (size_t)l * 1024 * 2576, 1024, 2576, (bf16_t*)(ws + WS_WIN), 0, 0, scr, r / 88, r % 88, lane); }
        else if (it < J1) { const int r = it - J0, b = r >> 9, q = r & 511; transpose_item(p->in[15] + ((size_t)l * 4 + b) * 1024 * 1024, 1024, 1024, (bf16_t*)(ws + WS_WG), 1, b, scr, q >> 5, q & 31, lane); }
        else if (it < J2) { const int r = it - J1, b = r >> 7, q = r & 127; transpose_item(p->in[17] + ((size_t)l * 4 + b) * 256 * 1024, 256, 1024, (bf16_t*)(ws + WS_WB) + (size_t)b * 1024 * 256, 0, 0, scr, q >> 5, q & 31, lane); }
        else if (it < J3) { const int q = it - J2; transpose_item(p->in[18] + (size_t)l * 1024 * 1024, 1024, 1024, (bf16_t*)(ws + WS_WO), 0, 0, scr, q >> 5, q & 31, lane); }
        else if (it < J4) { const int r = it - J3, wch = r / 1408, q = r % 1408; transpose_item(p->in[wch ? 22 : 21] + (size_t)l * 1024 * 2816, 1024, 2816, (bf16_t*)(ws + WS_WFF), 2, wch, scr, q / 88, q % 88, lane); }
        else if (it < J5) { const int q = it - J4; transpose_item(p->in[23] + (size_t)l * 2816 * 1024, 2816, 1024, (bf16_t*)(ws + WS_WD), 0, 0, scr, q >> 5, q & 31, lane); }
        else { const int q = it - J5; transpose_item(p->in[13] + (size_t)l * 256 * 256, 256, 256, (bf16_t*)(ws + WS_WGLU), 0, 0, scr, q >> 3, q & 7, lane); }
    }
    const int gt = obid() * 512 + tid, NT = ogrid() * 512;
    bf16_t* WE = (bf16_t*)(ws + WS_WE);
    for (int e = gt; e < 65536; e += NT) { const int s = e & 63, pp = (e >> 6) & 63, g = e >> 12; const int gp = (l * 16 + g) * 64 + pp;
        const float lr = p->in[5][gp], li = p->in[6][gp], dt = expf(p->in[7][l * 16 + g]);
        float ar, ai2; s5_abar_pow(lr, li, dt, 63 - s, ar, ai2);
        float qr, qi; s5_coef(lr, li, dt, qr, qi);
        float wr_[16], wi_[16];
#pragma unroll
        for (int c = 0; c < 16; ++c) { const float br = p->in[8][(size_t)gp * 16 + c], bi = p->in[9][(size_t)gp * 16 + c];
            const float bbr = qr * br - qi * bi, bbi = qr * bi + qi * br; wr_[c] = ar * bbr - ai2 * bbi; wi_[c] = ar * bbi + ai2 * bbr; }
        bf16_t* dr = WE + ((size_t)(g * 256 + pp)) * 1024 + s * 16; bf16_t* di = WE + ((size_t)(g * 256 + 64 + pp)) * 1024 + s * 16;
        *(u32x4*)dr = pack8(wr_); *(u32x4*)(dr + 8) = pack8(wr_ + 8); *(u32x4*)di = pack8(wi_); *(u32x4*)(di + 8) = pack8(wi_ + 8); }
    for (int e = gt; e < 16 * 128 * 128; e += NT) { const int c8 = e & 127, n = (e >> 7) & 127, g = e >> 14;
        *(u32x4*)(WE + ((size_t)(g * 256 + 128 + n)) * 1024 + c8 * 8) = (u32x4){0u, 0u, 0u, 0u}; }
    bf16_t* WT = (bf16_t*)(ws + WS_WT); const float* KN = (const float*)(ws + WS_KN);
    for (int e = gt; e < 16 * 1024 * 64; e += NT) { const int s = e & 63, row = (e >> 6) & 1023, g = e >> 16; const int j = row >> 4, i = row & 15;
        u32x4 w0 = (u32x4){0u, 0u, 0u, 0u}, w1 = w0;
        if (s <= j) { const float* k = KN + ((size_t)(g * 64 + (j - s)) * 16 + i) * 16; float v[16];
#pragma unroll
            for (int c = 0; c < 16; c += 4) { const f32x4 t = *(const f32x4*)(k + c); v[c] = t[0]; v[c + 1] = t[1]; v[c + 2] = t[2]; v[c + 3] = t[3]; }
            w0 = pack8(v); w1 = pack8(v + 8); }
        bf16_t* d = WT + ((size_t)(g * 1024 + row)) * S5K + s * 16; *(u32x4*)d = w0; *(u32x4*)(d + 8) = w1; }
    for (int e = gt; e < 16 * 1024 * 64; e += NT) { const int pp = e & 63, row = (e >> 6) & 1023, g = e >> 16; const int j = row >> 4, i = row & 15; const int gp = (l * 16 + g) * 64 + pp;
        const float lr = p->in[5][gp], li = p->in[6][gp], dt = expf(p->in[7][l * 16 + g]);
        float ar, ai2; s5_abar_pow(lr, li, dt, j + 1, ar, ai2);
        const size_t gi = ((size_t)(l * 16 + g) * 16 + i) * 64 + pp; const float c_r = p->in[10][gi], c_i = p->in[11][gi];
        bf16_t* d = WT + ((size_t)(g * 1024 + row)) * S5K + 1024 + pp;
        d[0] = (bf16_t)f2bf(c_r * ar - c_i * ai2); d[64] = (bf16_t)f2bf(-(c_r * ai2 + c_i * ar)); }
}

__device__ __forceinline__ void ln_pass(bf16_t* xb, float* fout, const float* gam, const float* bet) {
    const int lane = otid() & 63, gw = obid() * 8 + (otid() >> 6), NGW = ogrid() * 8;
    f32x4 gv[4], bv[4];
#pragma unroll
    for (int j = 0; j < 2; ++j) { gv[2 * j] = *(const f32x4*)(gam + 512 * j + lane * 8); gv[2 * j + 1] = *(const f32x4*)(gam + 512 * j + lane * 8 + 4);
        bv[2 * j] = *(const f32x4*)(bet + 512 * j + lane * 8); bv[2 * j + 1] = *(const f32x4*)(bet + 512 * j + lane * 8 + 4); }
    for (int m0 = gw * 2; m0 < M; m0 += NGW * 2) {
        u32x4 w[2][2];
#pragma unroll
        for (int rr = 0; rr < 2; ++rr)
#pragma unroll
            for (int j = 0; j < 2; ++j) w[rr][j] = *(const u32x4*)(xb + (size_t)(m0 + rr) * DM + 512 * j + lane * 8);
#pragma unroll
        for (int rr = 0; rr < 2; ++rr) {
            float v[16]; unpack8(w[rr][0], v); unpack8(w[rr][1], v + 8);
            float s = 0.f;
#pragma unroll
            for (int e = 0; e < 16; ++e) s += v[e];
            const float mean = wave_sum(s) * (1.f / DM); float s2 = 0.f;
#pragma unroll
            for (int e = 0; e < 16; ++e) { v[e] -= mean; s2 += v[e] * v[e]; }
            const float rstd = 1.f / sqrtf(wave_sum(s2) * (1.f / DM) + LN_EPS);
#pragma unroll
            for (int j = 0; j < 2; ++j) {
#pragma unroll
                for (int q = 0; q < 2; ++q)
#pragma unroll
                    for (int e = 0; e < 4; ++e) v[8 * j + 4 * q + e] = v[8 * j + 4 * q + e] * rstd * gv[2 * j + q][e] + bv[2 * j + q][e];
                *(u32x4*)(xb + (size_t)(m0 + rr) * DM + 512 * j + lane * 8) = pack8(v + 8 * j);
                if (fout) { *(f32x4*)(fout + (size_t)(m0 + rr) * DM + 512 * j + lane * 8) = (f32x4){v[8 * j], v[8 * j + 1], v[8 * j + 2], v[8 * j + 3]};
                    *(f32x4*)(fout + (size_t)(m0 + rr) * DM + 512 * j + lane * 8 + 4) = (f32x4){v[8 * j + 4], v[8 * j + 5], v[8 * j + 6], v[8 * j + 7]}; } }
        }
    }
}

__device__ __forceinline__ void load_tile64(const bf16_t* src, int pitch, LAS float* dst, int dpitch, float scale, int tid) {
    const int idx = tid * 8, r = idx >> 6, c = idx & 63;
    const u32x4 w = *(const u32x4*)(src + (size_t)r * pitch + c); float f[8]; unpack8(w, f);
#pragma unroll
    for (int e = 0; e < 8; ++e) dst[r * dpitch + c + e] = f[e] * scale;
}

__device__ __forceinline__ void attn_items(CPP p, int l, LAS unsigned char* lds) {
    LAS float* Qs = (LAS float*)lds; LAS float* Ks = Qs + 64 * 68; LAS float* Vs = Ks + 64 * 68; LAS float* Ps = Vs + 64 * 68; LAS float* bs = Ps + 64 * 65;
    const bf16_t* H = (const bf16_t*)(p->ws + WS_E); bf16_t* O = (bf16_t*)(p->ws + WS_O);
    const int tid = otid(), row = tid >> 3, sub = tid & 7;
    for (int it = obid(); it < 4096; it += ogrid()) {
        const int h = it & 3, bi = it >> 2, i = bi & 31, b = bi >> 5;
        const size_t t0 = (size_t)bi * 64;
        __syncthreads();
        load_tile64(H + t0 * NH + C_AQ + h * 64, NH, Qs, 68, 0.125f, tid);
        if (tid < 257) bs[tid] = p->in[4][(size_t)(l * 4 + h) * 257 + tid];
        __syncthreads();
        float q[64], o[8];
#pragma unroll
        for (int d = 0; d < 64; d += 4) { const f32x4 t = *(const LAS f32x4*)(Qs + row * 68 + d); q[d] = t[0]; q[d + 1] = t[1]; q[d + 2] = t[2]; q[d + 3] = t[3]; }
#pragma unroll
        for (int e = 0; e < 8; ++e) o[e] = 0.f;
        float mx = -1e30f, ls = 0.f;
        const int kc0 = i > 8 ? i - 8 : 0;
        for (int kc = kc0; kc <= i; ++kc) {
            __syncthreads();
            const size_t tk = ((size_t)b * 32 + kc) * 64;
            load_tile64(H + tk * NH + C_AK + h * 64, NH, Ks, 68, 1.f, tid);
            load_tile64(H + tk * NH + C_AV + h * 64, NH, Vs, 68, 1.f, tid);
            __syncthreads();
            float s[8]; float cm = -1e30f;
#pragma unroll
            for (int jj = 0; jj < 8; ++jj) { const int key = sub + 8 * jj; float a = 0.f;
#pragma unroll
                for (int d = 0; d < 64; d += 4) { const f32x4 t = *(const LAS f32x4*)(Ks + key * 68 + d); a += q[d] * t[0] + q[d + 1] * t[1] + q[d + 2] * t[2] + q[d + 3] * t[3]; }
                int diff = (i - kc) * 64 + row - key; diff = diff > 128 ? 128 : diff;
                a += bs[diff + 128]; s[jj] = a; cm = fmaxf(cm, a); }
            cm = fmaxf(cm, __shfl_xor(cm, 1)); cm = fmaxf(cm, __shfl_xor(cm, 2)); cm = fmaxf(cm, __shfl_xor(cm, 4));
            const float mn = fmaxf(mx, cm), sc = __expf(mx - mn); mx = mn;
            float ps = 0.f;
#pragma unroll
            for (int jj = 0; jj < 8; ++jj) { const float pr = __expf(s[jj] - mn); ps += pr; Ps[row * 65 + sub + 8 * jj] = pr; }
            ps += __shfl_xor(ps, 1); ps += __shfl_xor(ps, 2); ps += __shfl_xor(ps, 4);
            ls = ls * sc + ps;
#pragma unroll
            for (int e = 0; e < 8; ++e) o[e] *= sc;
            asm volatile("s_waitcnt lgkmcnt(0)" ::: "memory");
#pragma unroll 8
            for (int key = 0; key < 64; ++key) { const float pr = Ps[row * 65 + key];
                const f32x4 v0 = *(const LAS f32x4*)(Vs + key * 68 + sub * 8), v1 = *(const LAS f32x4*)(Vs + key * 68 + sub * 8 + 4);
                o[0] += pr * v0[0]; o[1] += pr * v0[1]; o[2] += pr * v0[2]; o[3] += pr * v0[3]; o[4] += pr * v1[0]; o[5] += pr * v1[1]; o[6] += pr * v1[2]; o[7] += pr * v1[3]; }
        }
        const float inv = 1.f / ls;
#pragma unroll
        for (int e = 0; e < 8; ++e) o[e] *= inv;
        *(u32x4*)(O + (t0 + row) * DM + 256 + h * 64 + sub * 8) = pack8(o);
    }
}

typedef float f32x16 __attribute__((ext_vector_type(16)));
typedef short s16x4 __attribute__((ext_vector_type(4)));
__device__ __forceinline__ s16x4 lds_tr16(LAS const unsigned char* ptr) { return __builtin_bit_cast(s16x4, __builtin_amdgcn_ds_read_tr16_b64_v4i16((LAS s16x4*)ptr)); }
__device__ __forceinline__ bf16x8 scale_frag(u32x4 w, float sc) { float f[8]; unpack8(w, f);
    u32x4 o; o.x = pk2(f[0] * sc, f[1] * sc); o.y = pk2(f[2] * sc, f[3] * sc); o.z = pk2(f[4] * sc, f[5] * sc); o.w = pk2(f[6] * sc, f[7] * sc); return __builtin_bit_cast(bf16x8, o); }
__device__ __forceinline__ float xhalf_max(float m) { const auto rr = __builtin_amdgcn_permlane32_swap(__float_as_uint(m), __float_as_uint(m), false, false); return fmaxf(__uint_as_float(rr[0]), __uint_as_float(rr[1])); }
__device__ __forceinline__ float xhalf_sum(float m) { const auto rr = __builtin_amdgcn_permlane32_swap(__float_as_uint(m), __float_as_uint(m), false, false); return __uint_as_float(rr[0]) + __uint_as_float(rr[1]); }
__device__ __forceinline__ void attn_mfma(CPP p, int l, LAS unsigned char* lds) {
    const int tid = otid(), lane = tid & 63, wid = __builtin_amdgcn_readfirstlane(tid >> 6), r32 = lane & 31, hi = lane >> 5;
    const int h = wid >> 1, qh = wid & 1;
    LAS unsigned char* Vl = lds + wid * 17536;
    LAS unsigned char* stg = Vl;
    LAS float* bs = (LAS float*)(Vl + 16384);
    const bf16_t* H = (const bf16_t*)(p->ws + WS_E); bf16_t* O = (bf16_t*)(p->ws + WS_O);
    __syncthreads();
    for (int e = lane; e < 257; e += 64) bs[e] = p->in[4][(size_t)(l * 4 + h) * 257 + e];
    const float bfar = p->in[4][(size_t)(l * 4 + h) * 257 + 256];
#define ATT_VDMA(tk, buf) do { _Pragma("unroll") for (int c = 0; c < 8; ++c) \
        __builtin_amdgcn_global_load_lds((const unsigned*)(H + ((tk) + c * 8 + (lane >> 3)) * NH + C_AV + h * 64 + (lane & 7) * 8), (LAS unsigned*)(Vl + (buf) * 8192 + c * 1024), 16, 0, 0); } while (0)
    const int bidA = obid(), gridA = ogrid(); const bool xmap = (gridA == 256);
    for (int itk = 0; itk < (xmap ? 4 : (1024 - bidA + gridA - 1) / gridA); ++itk) {
        const int it = xmap ? ((((bidA & 7) * 4 + itk) << 5) | (bidA >> 3)) : bidA + itk * gridA;
        const int i = it & 31; const size_t t0 = (size_t)it * 64;
        bf16x8 qf[4];
#pragma unroll
        for (int t = 0; t < 4; ++t) qf[t] = scale_frag(*(const u32x4*)(H + (t0 + qh * 32 + r32) * NH + C_AQ + h * 64 + 16 * t + 8 * hi), 0.125f);
        const int kc0 = i > 8 ? i - 8 : 0;
        u32x4 kr[8], kn[8];
        asm volatile("s_waitcnt lgkmcnt(0)" ::: "memory");
        { const size_t tk = t0 - (size_t)(i - kc0) * 64;
#pragma unroll
            for (int t = 0; t < 4; ++t) { kn[t] = *(const u32x4*)(H + (tk + r32) * NH + C_AK + h * 64 + 16 * t + 8 * hi); kn[4 + t] = *(const u32x4*)(H + (tk + 32 + r32) * NH + C_AK + h * 64 + 16 * t + 8 * hi); }
            ATT_VDMA(tk, 0); }
        f32x16 o0, o1;
#pragma unroll
        for (int v = 0; v < 16; ++v) { o0[v] = 0.f; o1[v] = 0.f; }
        float mx = -1e30f, ls = 0.f;
        int cb = 0;
        for (int kc = kc0; kc <= i; ++kc) {
            const bool more = kc < i;
            asm volatile("s_waitcnt vmcnt(0)" ::: "memory");
#pragma unroll
            for (int c = 0; c < 8; ++c) kr[c] = kn[c];
            if (more) { const size_t tk = t0 - (size_t)(i - kc - 1) * 64;
#pragma unroll
                for (int t = 0; t < 4; ++t) { kn[t] = *(const u32x4*)(H + (tk + r32) * NH + C_AK + h * 64 + 16 * t + 8 * hi); kn[4 + t] = *(const u32x4*)(H + (tk + 32 + r32) * NH + C_AK + h * 64 + 16 * t + 8 * hi); }
                ATT_VDMA(tk, cb ^ 1); }
            const int dl = i - kc; const float binit = dl >= 3 ? bfar : 0.f;
            f32x16 p0, p1;
#pragma unroll
            for (int v = 0; v < 16; ++v) { p0[v] = binit; p1[v] = binit; }
#pragma unroll
            for (int t = 0; t < 4; ++t) { p0 = __builtin_amdgcn_mfma_f32_32x32x16_f16(__builtin_bit_cast(half8_t, kr[t]), __builtin_bit_cast(half8_t, qf[t]), p0, 0, 0, 0);
                p1 = __builtin_amdgcn_mfma_f32_32x32x16_f16(__builtin_bit_cast(half8_t, kr[4 + t]), __builtin_bit_cast(half8_t, qf[t]), p1, 0, 0, 0); }
            if (dl < 3) { const int base = dl * 64 + qh * 32 + r32 - 4 * hi + 128;
#pragma unroll
                for (int v = 0; v < 16; ++v) { const int kv = (v & 3) + 8 * (v >> 2); int d0 = base - kv, d1 = base - kv - 32; d0 = d0 > 256 ? 256 : d0; d1 = d1 > 256 ? 256 : d1;
                    p0[v] += bs[d0]; p1[v] += bs[d1]; } }
            float cm = fmaxf(p0[0], p1[0]);
#pragma unroll
            for (int v = 1; v < 16; ++v) cm = fmaxf(cm, fmaxf(p0[v], p1[v]));
            cm = xhalf_max(cm);
            const float mn = fmaxf(mx, cm), al = __expf(mx - mn); mx = mn;
            float ps = 0.f;
#pragma unroll
            for (int v = 0; v < 16; ++v) { p0[v] = __expf(p0[v] - mn); p1[v] = __expf(p1[v] - mn); ps += p0[v] + p1[v]; }
            ls = ls * al + ps;
            if (__any(al != 1.f)) {
#pragma unroll
                for (int v = 0; v < 16; ++v) { o0[v] *= al; o1[v] *= al; } }
            bf16x8 pb[4];
            { u32x4 w; w.x = cvt_pk_bf16(p0[0], p0[1]); w.y = cvt_pk_bf16(p0[2], p0[3]); w.z = cvt_pk_bf16(p0[4], p0[5]); w.w = cvt_pk_bf16(p0[6], p0[7]); pb[0] = __builtin_bit_cast(bf16x8, w);
              w.x = cvt_pk_bf16(p0[8], p0[9]); w.y = cvt_pk_bf16(p0[10], p0[11]); w.z = cvt_pk_bf16(p0[12], p0[13]); w.w = cvt_pk_bf16(p0[14], p0[15]); pb[1] = __builtin_bit_cast(bf16x8, w);
              w.x = cvt_pk_bf16(p1[0], p1[1]); w.y = cvt_pk_bf16(p1[2], p1[3]); w.z = cvt_pk_bf16(p1[4], p1[5]); w.w = cvt_pk_bf16(p1[6], p1[7]); pb[2] = __builtin_bit_cast(bf16x8, w);
              w.x = cvt_pk_bf16(p1[8], p1[9]); w.y = cvt_pk_bf16(p1[10], p1[11]); w.z = cvt_pk_bf16(p1[12], p1[13]); w.w = cvt_pk_bf16(p1[14], p1[15]); pb[3] = __builtin_bit_cast(bf16x8, w); }
            const LAS unsigned char* vb = Vl + cb * 8192 + (4 * hi + ((lane & 15) >> 2)) * 128 + ((lane >> 4) & 1) * 32 + (lane & 3) * 8;
#pragma unroll
            for (int ks = 0; ks < 4; ++ks) {
#pragma unroll
                for (int dh = 0; dh < 2; ++dh) { const s16x4 lo = lds_tr16(vb + ks * 2048 + dh * 64), hh = lds_tr16(vb + ks * 2048 + 1024 + dh * 64);
                    const bf16x8 va = (bf16x8){lo[0], lo[1], lo[2], lo[3], hh[0], hh[1], hh[2], hh[3]};
                    if (dh == 0) o0 = __builtin_amdgcn_mfma_f32_32x32x16_f16(__builtin_bit_cast(half8_t, va), __builtin_bit_cast(half8_t, pb[ks]), o0, 0, 0, 0); else o1 = __builtin_amdgcn_mfma_f32_32x32x16_f16(__builtin_bit_cast(half8_t, va), __builtin_bit_cast(half8_t, pb[ks]), o1, 0, 0, 0); } }
            cb ^= 1;
        }
        ls = xhalf_sum(ls);
        const float inv = 1.f / ls;
        asm volatile("s_waitcnt lgkmcnt(0)" ::: "memory");
#pragma unroll
        for (int v = 0; v < 16; ++v) { const int d = (v & 3) + 8 * (v >> 2) + 4 * hi;
            *(LAS bf16_t*)(stg + r32 * 144 + d * 2) = (bf16_t)f2bf(o0[v] * inv); *(LAS bf16_t*)(stg + r32 * 144 + (32 + d) * 2) = (bf16_t)f2bf(o1[v] * inv); }
        asm volatile("s_waitcnt lgkmcnt(0)" ::: "memory");
#pragma unroll
        for (int c = 0; c < 4; ++c) { const int row = c * 8 + (lane >> 3), ch = lane & 7; const u32x4 w = *(const LAS u32x4*)(stg + row * 144 + ch * 16);
            *(u32x4*)(O + (t0 + qh * 32 + row) * DM + 256 + h * 64 + ch * 8) = w; }
    }
#undef ATT_VDMA
}

__device__ __forceinline__ f32x16 mma32(bf16x8 a, bf16x8 b, f32x16 c) { return __builtin_amdgcn_mfma_f32_32x32x16_f16(__builtin_bit_cast(half8_t, a), __builtin_bit_cast(half8_t, b), c, 0, 0, 0); }
__device__ __forceinline__ bf16x8 trfrag(LAS const unsigned char* a0, LAS const unsigned char* a1) { const s16x4 lo = lds_tr16(a0), hh = lds_tr16(a1); return (bf16x8){lo[0], lo[1], lo[2], lo[3], hh[0], hh[1], hh[2], hh[3]}; }
__device__ __forceinline__ f32x16 zero16() { f32x16 z;
#pragma unroll
    for (int v = 0; v < 16; ++v) z[v] = 0.f;
    return z; }
__device__ __forceinline__ void rot_frags(const bf16_t* xrow, const float* rrow, int hi, float sc, bf16x8& f0, bf16x8& f1) {
    const u32x4 w1 = *(const u32x4*)(xrow + 8 * hi), w2 = *(const u32x4*)(xrow + 16 + 8 * hi); float x1[8], x2[8]; unpack8(w1, x1); unpack8(w2, x2);
    const f32x4 c0 = *(const f32x4*)(rrow + 8 * hi), c1 = *(const f32x4*)(rrow + 8 * hi + 4), s0 = *(const f32x4*)(rrow + 16 + 8 * hi), s1 = *(const f32x4*)(rrow + 16 + 8 * hi + 4);
    float a[8], b[8];
#pragma unroll
    for (int e = 0; e < 8; ++e) { const float c = e < 4 ? c0[e & 3] : c1[e & 3], s = e < 4 ? s0[e & 3] : s1[e & 3]; a[e] = (x1[e] * c - x2[e] * s) * sc; b[e] = (x1[e] * s + x2[e] * c) * sc; }
    f0 = __builtin_bit_cast(bf16x8, pack8(a)); f1 = __builtin_bit_cast(bf16x8, pack8(b));
}
__device__ __forceinline__ float ret_logg(int h);

__device__ __forceinline__ void upd_mfma(CPP p, int l, LAS unsigned char* lds) {
    const int tid = otid(), lane = tid & 63, wid = __builtin_amdgcn_readfirstlane(tid >> 6), r32 = lane & 31, hi = lane >> 5, i16 = lane & 15;
    LAS unsigned char* kz = lds + wid * 17536;
    LAS unsigned char* vt = kz + 4096;
    LAS unsigned char* gas = kz + 12288;
    const bf16_t* H = (const bf16_t*)(p->ws + WS_E); const float* rot = (const float*)(p->ws + WS_ROT);
    float* RU = (float*)(p->ws + WS_RU); float* GU = (float*)(p->ws + WS_GU); float* GL = (float*)(p->ws + WS_GL);
    const int gw = obid() * 8 + wid, NGW = ogrid() * 8;
    __syncthreads();
    for (int it = gw; it < 8192; it += NGW) {
        const int gla = it >> 12, h = it & 3, bi = (it >> 2) & 1023, i = bi & 31; const size_t t0 = (size_t)bi * 64;
        asm volatile("s_waitcnt lgkmcnt(0)" ::: "memory");
        { const int vcol = (gla ? C_GV : C_RV) + h * 64;
#pragma unroll
            for (int c = 0; c < 8; ++c) __builtin_amdgcn_global_load_lds((const unsigned*)(H + (t0 + c * 8 + (lane >> 3)) * NH + vcol + (lane & 7) * 8), (LAS unsigned*)(vt + c * 1024), 16, 0, 0); }
        if (!gla) {
            const bf16_t* xr = H + (t0 + lane) * NH + C_RK + h * 32; const float* rr = rot + (size_t)(i * 64 + lane) * 32;
            const float sc = 0.17677669529663689f * __expf(ret_logg(h) * (float)(63 - lane));
            float x[32], cs[32], o[32];
#pragma unroll
            for (int c = 0; c < 4; ++c) unpack8(*(const u32x4*)(xr + 8 * c), x + 8 * c);
#pragma unroll
            for (int c = 0; c < 8; ++c) { const f32x4 t = *(const f32x4*)(rr + 4 * c); cs[4 * c] = t[0]; cs[4 * c + 1] = t[1]; cs[4 * c + 2] = t[2]; cs[4 * c + 3] = t[3]; }
#pragma unroll
            for (int f = 0; f < 16; ++f) { o[f] = (x[f] * cs[f] - x[f + 16] * cs[16 + f]) * sc; o[f + 16] = (x[f] * cs[16 + f] + x[f + 16] * cs[f]) * sc; }
#pragma unroll
            for (int c = 0; c < 4; ++c) *(LAS u32x4*)(kz + lane * 64 + c * 16) = pack8(o + 8 * c);
        } else {
#pragma unroll
            for (int c = 0; c < 4; ++c) __builtin_amdgcn_global_load_lds((const unsigned*)(H + (t0 + 16 * c + (lane >> 2)) * NH + C_GK + h * 32 + (lane & 3) * 8), (LAS unsigned*)(kz + c * 1024), 16, 0, 0);
#pragma unroll
            for (int c = 0; c < 2; ++c) *(LAS u32x4*)(gas + lane * 32 + c * 16) = *(const u32x4*)(H + (t0 + lane) * NH + C_GA + 8 * c);
            float wa[16];
#pragma unroll
            for (int r = 0; r < 16; ++r) wa[r] = p->in[2][(size_t)(l * 16 + r) * 128 + h * 32 + r32];
            const float ba = p->in[3][l * 128 + h * 32 + r32];
            asm volatile("s_waitcnt vmcnt(0) lgkmcnt(0)" ::: "memory");
            float cum[32]; float run = 0.f;
#pragma unroll
            for (int jj = 0; jj < 32; ++jj) { const int j = hi * 32 + jj; float g[16]; unpack8(*(const LAS u32x4*)(gas + j * 32), g); unpack8(*(const LAS u32x4*)(gas + j * 32 + 16), g + 8);
                float z = ba;
#pragma unroll
                for (int r = 0; r < 16; ++r) z += g[r] * wa[r];
                run += (fminf(z, 0.f) - __logf(1.f + __expf(-fabsf(z)))) * 0.0625f; cum[jj] = run; }
            const float tot0 = __shfl(run, r32), tot1 = __shfl(run, 32 + r32), last = tot0 + tot1, off = hi ? tot0 : 0.f;
#pragma unroll
            for (int jj = 0; jj < 32; ++jj) { const int j = hi * 32 + jj; LAS bf16_t* kp = (LAS bf16_t*)(kz + j * 64 + r32 * 2);
                *kp = (bf16_t)f2bf(bf2f(*kp) * __expf(last - (cum[jj] + off))); }
            if (hi == 0) GL[(size_t)(bi * 4 + h) * 32 + r32] = last;
        }
        asm volatile("s_waitcnt vmcnt(0) lgkmcnt(0)" ::: "memory");
        f32x16 a0 = zero16(), a1 = zero16();
        const LAS unsigned char* ka = kz + (8 * hi + (i16 >> 2)) * 64 + ((lane >> 4) & 1) * 32 + (i16 & 3) * 8;
        const LAS unsigned char* va = vt + (8 * hi + (i16 >> 2)) * 128 + ((lane >> 4) & 1) * 32 + (i16 & 3) * 8;
#pragma unroll
        for (int s = 0; s < 4; ++s) { const bf16x8 A = trfrag(ka + s * 1024, ka + s * 1024 + 256);
            const bf16x8 B0 = trfrag(va + s * 2048, va + s * 2048 + 512), B1 = trfrag(va + s * 2048 + 64, va + s * 2048 + 512 + 64);
            a0 = mma32(A, B0, a0); a1 = mma32(A, B1, a1); }
        float* dst = (gla ? GU : RU) + (size_t)(bi * 4 + h) * 2048;
#pragma unroll
        for (int v = 0; v < 16; ++v) { const int dk = (v & 3) + 8 * (v >> 2) + 4 * hi; dst[dk * 64 + r32] = a0[v]; dst[dk * 64 + 32 + r32] = a1[v]; }
    }
}

__device__ __forceinline__ void out_mfma(CPP p, int l, LAS unsigned char* lds) {
    const int tid = otid(), lane = tid & 63, wid = __builtin_amdgcn_readfirstlane(tid >> 6), r32 = lane & 31, hi = lane >> 5, i16 = lane & 15;
    const int h = wid >> 1, nh = wid & 1;
    LAS unsigned char* vt = lds + wid * 17536;
    LAS unsigned char* Rt = vt + 8192;
    LAS unsigned char* stg = vt;
    const bf16_t* H = (const bf16_t*)(p->ws + WS_E); const float* rot = (const float*)(p->ws + WS_ROT); bf16_t* O = (bf16_t*)(p->ws + WS_O);
    const float* RU = (const float*)(p->ws + WS_RU); const float* GU = (const float*)(p->ws + WS_GU);
    __syncthreads();
    for (int it = obid(); it < 2048; it += ogrid()) {
        const int gla = it >> 10, bi = it & 1023, i = bi & 31; const size_t t0 = (size_t)bi * 64; const int n = nh * 32 + r32;
        asm volatile("s_waitcnt lgkmcnt(0)" ::: "memory");
        { const float* src = (gla ? GU : RU) + (size_t)(bi * 4 + h) * 2048;
#pragma unroll
            for (int c = 0; c < 8; ++c) { const int idx = c * 256 + lane * 4; const f32x4 t = *(const f32x4*)(src + idx); u32x2 w; w.x = pk2(t[0], t[1]); w.y = pk2(t[2], t[3]);
                *(LAS u32x2*)(Rt + (idx >> 6) * 128 + (idx & 63) * 2) = w; } }
        f32x16 o0 = zero16(), o1 = zero16();
        const LAS unsigned char* ra = Rt + (8 * hi + (i16 >> 2)) * 128 + ((lane >> 4) & 1) * 32 + (i16 & 3) * 8;
        if (!gla) {
#pragma unroll
            for (int c = 0; c < 8; ++c) __builtin_amdgcn_global_load_lds((const unsigned*)(H + (t0 + c * 8 + (lane >> 3)) * NH + C_RV + h * 64 + (lane & 7) * 8), (LAS unsigned*)(vt + c * 1024), 16, 0, 0);
            const float lg = ret_logg(h);
            bf16x8 qf[2], kf0[2], kf1[2];
            rot_frags(H + (t0 + n) * NH + C_RQ + h * 32, rot + (size_t)(i * 64 + n) * 32, hi, 1.f, qf[0], qf[1]);
            rot_frags(H + (t0 + r32) * NH + C_RK + h * 32, rot + (size_t)(i * 64 + r32) * 32, hi, 0.17677669529663689f, kf0[0], kf0[1]);
            rot_frags(H + (t0 + 32 + r32) * NH + C_RK + h * 32, rot + (size_t)(i * 64 + 32 + r32) * 32, hi, 0.17677669529663689f, kf1[0], kf1[1]);
            f32x16 p0 = zero16(), p1 = zero16();
            p0 = mma32(kf0[0], qf[0], p0); p0 = mma32(kf0[1], qf[1], p0); p1 = mma32(kf1[0], qf[0], p1); p1 = mma32(kf1[1], qf[1], p1);
#pragma unroll
            for (int v = 0; v < 16; ++v) { const int m = (v & 3) + 8 * (v >> 2) + 4 * hi; const int d0 = n - m, d1 = n - m - 32;
                p0[v] *= __expf(lg * (float)(d0 < 0 ? -d0 : d0)); p1[v] *= __expf(lg * (float)(d1 < 0 ? -d1 : d1)); }
            bf16x8 pb[4];
            { u32x4 w; w.x = pk2(p0[0], p0[1]); w.y = pk2(p0[2], p0[3]); w.z = pk2(p0[4], p0[5]); w.w = pk2(p0[6], p0[7]); pb[0] = __builtin_bit_cast(bf16x8, w);
              w.x = pk2(p0[8], p0[9]); w.y = pk2(p0[10], p0[11]); w.z = pk2(p0[12], p0[13]); w.w = pk2(p0[14], p0[15]); pb[1] = __builtin_bit_cast(bf16x8, w);
              w.x = pk2(p1[0], p1[1]); w.y = pk2(p1[2], p1[3]); w.z = pk2(p1[4], p1[5]); w.w = pk2(p1[6], p1[7]); pb[2] = __builtin_bit_cast(bf16x8, w);
              w.x = pk2(p1[8], p1[9]); w.y = pk2(p1[10], p1[11]); w.z = pk2(p1[12], p1[13]); w.w = pk2(p1[14], p1[15]); pb[3] = __builtin_bit_cast(bf16x8, w); }
            asm volatile("s_waitcnt vmcnt(0) lgkmcnt(0)" ::: "memory");
            const LAS unsigned char* vb = vt + (4 * hi + (i16 >> 2)) * 128 + ((lane >> 4) & 1) * 32 + (i16 & 3) * 8;
#pragma unroll
            for (int ks = 0; ks < 4; ++ks) { o0 = mma32(trfrag(vb + ks * 2048, vb + ks * 2048 + 1024), pb[ks], o0); o1 = mma32(trfrag(vb + ks * 2048 + 64, vb + ks * 2048 + 1024 + 64), pb[ks], o1); }
            const float xi = __expf(lg * (float)(n + 1));
#pragma unroll
            for (int s = 0; s < 2; ++s) { const bf16x8 qx = scale_frag(__builtin_bit_cast(u32x4, qf[s]), xi);
                o0 = mma32(trfrag(ra + s * 2048, ra + s * 2048 + 512), qx, o0); o1 = mma32(trfrag(ra + s * 2048 + 64, ra + s * 2048 + 512 + 64), qx, o1); }
        } else {
            bf16x8 qf[2];
#pragma unroll
            for (int s = 0; s < 2; ++s) qf[s] = scale_frag(*(const u32x4*)(H + (t0 + n) * NH + C_GQ + h * 32 + 16 * s + 8 * hi), 0.17677669529663689f);
            asm volatile("s_waitcnt lgkmcnt(0)" ::: "memory");
#pragma unroll
            for (int s = 0; s < 2; ++s) { o0 = mma32(trfrag(ra + s * 2048, ra + s * 2048 + 512), qf[s], o0); o1 = mma32(trfrag(ra + s * 2048 + 64, ra + s * 2048 + 512 + 64), qf[s], o1); }
        }
        float s = 0.f;
#pragma unroll
        for (int v = 0; v < 16; ++v) s += o0[v] + o1[v];
        s = xhalf_sum(s);
        const float mean = s * (1.f / 64.f); float s2 = 0.f;
#pragma unroll
        for (int v = 0; v < 16; ++v) { o0[v] -= mean; o1[v] -= mean; s2 += o0[v] * o0[v] + o1[v] * o1[v]; }
        s2 = xhalf_sum(s2);
        const float rs = 1.f / sqrtf(s2 * (1.f / 64.f) + LN_EPS);
        asm volatile("s_waitcnt lgkmcnt(0)" ::: "memory");
#pragma unroll
        for (int v = 0; v < 16; ++v) { const int d = (v & 3) + 8 * (v >> 2) + 4 * hi;
            *(LAS bf16_t*)(stg + r32 * 144 + d * 2) = (bf16_t)f2bf(o0[v] * rs); *(LAS bf16_t*)(stg + r32 * 144 + (32 + d) * 2) = (bf16_t)f2bf(o1[v] * rs); }
        asm volatile("s_waitcnt lgkmcnt(0)" ::: "memory");
#pragma unroll
        for (int c = 0; c < 4; ++c) { const int row = c * 8 + (lane >> 3), ch = lane & 7; float f[8], g[8]; unpack8(*(const LAS u32x4*)(stg + row * 144 + ch * 16), f);
            unpack8(*(const u32x4*)(H + (t0 + nh * 32 + row) * NH + (gla ? C_GR : C_RG) + h * 64 + ch * 8), g);
#pragma unroll
            for (int e = 0; e < 8; ++e) f[e] *= silu_f(g[e]);
            *(u32x4*)(O + (t0 + nh * 32 + row) * DM + (gla ? 512 : 0) + h * 64 + ch * 8) = pack8(f); }
    }
}

__device__ __forceinline__ void load_rot(const bf16_t* src, const float* rot, int i, LAS float* dst, float scale, float logz, int tid) {
#pragma unroll
    for (int q = 0; q < 2; ++q) { const int idx = tid + 512 * q, j = idx >> 4, f = idx & 15;
        const float x1 = bf2f(src[(size_t)j * NH + f]), x2 = bf2f(src[(size_t)j * NH + f + 16]);
        const int pos = i * 64 + j; const float c = rot[pos * 32 + f], s = rot[pos * 32 + 16 + f];
        const float sc = scale * __expf(logz * (float)(63 - j));
        dst[j * 33 + f] = (x1 * c - x2 * s) * sc; dst[j * 33 + f + 16] = (x1 * s + x2 * c) * sc; }
}
__device__ __forceinline__ float ret_logg(int h) { return log1pf(-exp2f(-5.f - (float)h)); }

__device__ __forceinline__ void upd_items(CPP p, int l, LAS unsigned char* lds) {
    LAS float* kt = (LAS float*)lds; LAS float* vv = kt + 64 * 33; LAS float* la = vv + 64 * 68; LAS float* gas = la + 64 * 33; LAS float* was = gas + 1024; LAS float* bas = was + 512;
    const bf16_t* H = (const bf16_t*)(p->ws + WS_E); const float* rot = (const float*)(p->ws + WS_ROT);
    float* RU = (float*)(p->ws + WS_RU); float* GU = (float*)(p->ws + WS_GU); float* GL = (float*)(p->ws + WS_GL);
    const int tid = otid();
    for (int it = obid(); it < 8192; it += ogrid()) {
        const int gla = it >> 12, h = it & 3, bi = (it >> 2) & 1023, i = bi & 31;
        const size_t t0 = (size_t)bi * 64;
        __syncthreads();
        if (!gla) {
            load_rot(H + t0 * NH + C_RK + h * 32, rot, i, kt, 0.17677669529663689f, ret_logg(h), tid);
            load_tile64(H + t0 * NH + C_RV + h * 64, NH, vv, 68, 1.f, tid);
            __syncthreads();
        } else {
            if (tid < 128) { const int j = tid >> 1, c = (tid & 1) * 8; const u32x4 w = *(const u32x4*)(H + (t0 + j) * NH + C_GA + c); float f[8]; unpack8(w, f);
#pragma unroll
                for (int e = 0; e < 8; ++e) gas[j * 16 + c + e] = f[e]; }
            { const int r = tid >> 5, dk = tid & 31; was[tid] = p->in[2][(size_t)(l * 16 + r) * 128 + h * 32 + dk]; }
            if (tid < 32) bas[tid] = p->in[3][l * 128 + h * 32 + tid];
            { const int idx = tid * 4, j = idx >> 5, c = idx & 31; const u32x2 w = *(const u32x2*)(H + (t0 + j) * NH + C_GK + h * 32 + c);
                kt[j * 33 + c] = bflo(w.x); kt[j * 33 + c + 1] = bfhi(w.x); kt[j * 33 + c + 2] = bflo(w.y); kt[j * 33 + c + 3] = bfhi(w.y); }
            load_tile64(H + t0 * NH + C_GV + h * 64, NH, vv, 68, 1.f, tid);
            __syncthreads();
#pragma unroll
            for (int q = 0; q < 4; ++q) { const int e = tid + 512 * q, j = e >> 5, dk = e & 31; float z = bas[dk];
#pragma unroll
                for (int r = 0; r < 16; ++r) z += gas[j * 16 + r] * was[r * 32 + dk];
                const float lsg = fminf(z, 0.f) - log1pf(expf(-fabsf(z)));
                la[j * 33 + dk] = lsg * 0.0625f; }
            __syncthreads();
            if (tid < 32) { float run = 0.f; for (int j = 0; j < 64; ++j) { run += la[j * 33 + tid]; la[j * 33 + tid] = run; } }
            __syncthreads();
#pragma unroll
            for (int q = 0; q < 4; ++q) { const int e = tid + 512 * q, j = e >> 5, dk = e & 31; kt[j * 33 + dk] *= __expf(la[63 * 33 + dk] - la[j * 33 + dk]); }
            if (tid < 32) GL[(size_t)(bi * 4 + h) * 32 + tid] = la[63 * 33 + tid];
            __syncthreads();
        }
        const int dk = tid >> 4, dv0 = (tid & 15) * 4; f32x4 a = (f32x4){0.f, 0.f, 0.f, 0.f};
#pragma unroll 8
        for (int j = 0; j < 64; ++j) { const float kk = kt[j * 33 + dk]; const f32x4 v4 = *(const LAS f32x4*)(vv + j * 68 + dv0); a += v4 * kk; }
        float* dst = (gla ? GU : RU) + (size_t)(bi * 4 + h) * 2048 + dk * 64 + dv0;
        *(f32x4*)dst = a;
    }
}

__device__ __forceinline__ void scan_items(CPP p, int l) {
    float* RU = (float*)(p->ws + WS_RU); float* GU = (float*)(p->ws + WS_GU); const float* GL = (const float*)(p->ws + WS_GL);
    const float* ES = (const float*)(p->ws + WS_ES); bf16_t* U2 = (bf16_t*)(p->ws + WS_U2);
    const int gt = obid() * 512 + otid(), NT = ogrid() * 512;
    for (int e = gt; e < 262144; e += NT) { const int dvk = e & 2047, bh = e >> 11, h = bh & 3, b = bh >> 2;
        const float dec = expf(64.f * ret_logg(h)); float st = 0.f; float t[32];
        float* base = RU + (size_t)(b * 32 * 4 + h) * 2048 + dvk;
#pragma unroll
        for (int i = 0; i < 32; ++i) t[i] = base[(size_t)i * 8192];
#pragma unroll
        for (int i = 0; i < 32; ++i) { base[(size_t)i * 8192] = st; st = st * dec + t[i]; } }
    for (int e = gt; e < 262144; e += NT) { const int dvk = e & 2047, bh = e >> 11, h = bh & 3, b = bh >> 2; float st = 0.f; float t[32], gl[32];
        float* base = GU + (size_t)(b * 32 * 4 + h) * 2048 + dvk; const float* gb = GL + (size_t)(b * 32 * 4 + h) * 32 + (dvk >> 6);
#pragma unroll
        for (int i = 0; i < 32; ++i) { t[i] = base[(size_t)i * 8192]; gl[i] = gb[i * 128]; }
#pragma unroll
        for (int i = 0; i < 32; ++i) { st = __expf(gl[i]) * st + t[i]; base[(size_t)i * 8192] = st; } }
    for (int e = gt; e < 32768; e += NT) { const int pp = e & 63, g = (e >> 6) & 15, b = e >> 10; const int gp = (l * 16 + g) * 64 + pp;
        const float lr = p->in[5][gp], li = p->in[6][gp], dt = expf(p->in[7][l * 16 + g]);
        float ar, ai2; s5_abar_pow(lr, li, dt, 64, ar, ai2);
        float xr = 0.f, xi = 0.f; float er[32], ei[32];
        const size_t row0 = (size_t)g * 1024 + b * 32;
#pragma unroll
        for (int i = 0; i < 32; ++i) { er[i] = ES[(row0 + i) * 128 + pp]; ei[i] = ES[(row0 + i) * 128 + 64 + pp]; }
#pragma unroll
        for (int i = 0; i < 32; ++i) { U2[(row0 + i) * S5K + 1024 + pp] = (bf16_t)f2bf(xr); U2[(row0 + i) * S5K + 1088 + pp] = (bf16_t)f2bf(xi);
            const float nr = ar * xr - ai2 * xi + er[i], ni = ar * xi + ai2 * xr + ei[i]; xr = nr; xi = ni; } }
}

__device__ __forceinline__ void out_items(CPP p, int l, LAS unsigned char* lds) {
    LAS float* qt = (LAS float*)lds; LAS float* kt = qt + 64 * 33; LAS float* vv = kt + 64 * 33; LAS float* Sm = vv + 64 * 68; LAS float* Rm = Sm + 64 * 65;
    const bf16_t* H = (const bf16_t*)(p->ws + WS_E); const float* rot = (const float*)(p->ws + WS_ROT); bf16_t* O = (bf16_t*)(p->ws + WS_O);
    const float* RU = (const float*)(p->ws + WS_RU); const float* GU = (const float*)(p->ws + WS_GU);
    const int tid = otid();
    for (int it = obid(); it < 8192; it += ogrid()) {
        const int gla = it >> 12, h = it & 3, bi = (it >> 2) & 1023, i = bi & 31;
        const size_t t0 = (size_t)bi * 64;
        const int n = tid >> 3, dv0 = (tid & 7) * 8;
        float acc[8];
#pragma unroll
        for (int e = 0; e < 8; ++e) acc[e] = 0.f;
        __syncthreads();
        { const float* src = (gla ? GU : RU) + (size_t)(bi * 4 + h) * 2048; const int idx = tid * 4, dk = idx >> 6, dv = idx & 63;
            const f32x4 t = *(const f32x4*)(src + idx); Rm[dk * 68 + dv] = t[0]; Rm[dk * 68 + dv + 1] = t[1]; Rm[dk * 68 + dv + 2] = t[2]; Rm[dk * 68 + dv + 3] = t[3]; }
        if (!gla) {
            const float lg = ret_logg(h);
            load_rot(H + t0 * NH + C_RQ + h * 32, rot, i, qt, 1.f, 0.f, tid);
            load_rot(H + t0 * NH + C_RK + h * 32, rot, i, kt, 0.17677669529663689f, 0.f, tid);
            load_tile64(H + t0 * NH + C_RV + h * 64, NH, vv, 68, 1.f, tid);
            __syncthreads();
            { const int m0 = (tid & 7) * 8;
#pragma unroll
                for (int mm = 0; mm < 8; ++mm) { const int m = m0 + mm; float d = 0.f;
#pragma unroll
                    for (int dk = 0; dk < 32; ++dk) d += qt[n * 33 + dk] * kt[m * 33 + dk];
                    const int ad = n > m ? n - m : m - n; Sm[n * 65 + m] = d * __expf(lg * (float)ad); } }
            __syncthreads();
#pragma unroll 4
            for (int m = 0; m < 64; ++m) { const float sv = Sm[n * 65 + m]; const f32x4 v0 = *(const LAS f32x4*)(vv + m * 68 + dv0), v1 = *(const LAS f32x4*)(vv + m * 68 + dv0 + 4);
                acc[0] += sv * v0[0]; acc[1] += sv * v0[1]; acc[2] += sv * v0[2]; acc[3] += sv * v0[3]; acc[4] += sv * v1[0]; acc[5] += sv * v1[1]; acc[6] += sv * v1[2]; acc[7] += sv * v1[3]; }
            const float xi = __expf(lg * (float)(n + 1));
#pragma unroll 4
            for (int dk = 0; dk < 32; ++dk) { const float qx = qt[n * 33 + dk] * xi; const f32x4 v0 = *(const LAS f32x4*)(Rm + dk * 68 + dv0), v1 = *(const LAS f32x4*)(Rm + dk * 68 + dv0 + 4);
                acc[0] += qx * v0[0]; acc[1] += qx * v0[1]; acc[2] += qx * v0[2]; acc[3] += qx * v0[3]; acc[4] += qx * v1[0]; acc[5] += qx * v1[1]; acc[6] += qx * v1[2]; acc[7] += qx * v1[3]; }
        } else {
            { const int idx = tid * 4, j = idx >> 5, c = idx & 31; const u32x2 w = *(const u32x2*)(H + (t0 + j) * NH + C_GQ + h * 32 + c); const float sc = 0.17677669529663689f;
                qt[j * 33 + c] = bflo(w.x) * sc; qt[j * 33 + c + 1] = bfhi(w.x) * sc; qt[j * 33 + c + 2] = bflo(w.y) * sc; qt[j * 33 + c + 3] = bfhi(w.y) * sc; }
            __syncthreads();
#pragma unroll 4
            for (int dk = 0; dk < 32; ++dk) { const float qx = qt[n * 33 + dk]; const f32x4 v0 = *(const LAS f32x4*)(Rm + dk * 68 + dv0), v1 = *(const LAS f32x4*)(Rm + dk * 68 + dv0 + 4);
                acc[0] += qx * v0[0]; acc[1] += qx * v0[1]; acc[2] += qx * v0[2]; acc[3] += qx * v0[3]; acc[4] += qx * v1[0]; acc[5] += qx * v1[1]; acc[6] += qx * v1[2]; acc[7] += qx * v1[3]; }
        }
        float s = 0.f;
#pragma unroll
        for (int e = 0; e < 8; ++e) s += acc[e];
        s += __shfl_xor(s, 1); s += __shfl_xor(s, 2); s += __shfl_xor(s, 4);
        const float mean = s * (1.f / 64.f); float s2 = 0.f;
#pragma unroll
        for (int e = 0; e < 8; ++e) { acc[e] -= mean; s2 += acc[e] * acc[e]; }
        s2 += __shfl_xor(s2, 1); s2 += __shfl_xor(s2, 2); s2 += __shfl_xor(s2, 4);
        const float rs = 1.f / sqrtf(s2 * (1.f / 64.f) + LN_EPS);
        const u32x4 gw = *(const u32x4*)(H + (t0 + n) * NH + (gla ? C_GR : C_RG) + h * 64 + dv0); float gf[8]; unpack8(gw, gf);
        float ov[8];
#pragma unroll
        for (int e = 0; e < 8; ++e) ov[e] = silu_f(gf[e]) * acc[e] * rs;
        *(u32x4*)(O + (t0 + n) * DM + (gla ? 512 : 0) + h * 64 + dv0) = pack8(ov);
    }
}


#define XB_TMO      128
#define XB_XCNT(j)  (256  + 64 * (j))
#define XB_XSUB(j)  (1280 + 64 * (j))
#define XB_XGEN(j)  (2304 + 64 * (j))
#define XB_TOP      3328
#define XB_TOPGEN   3392
#define XCD_BAR_WORDS 3456
#define XB_SPIN_CAP (1u << 20)
__device__ __forceinline__ unsigned xb_ld(unsigned* p)              { return __hip_atomic_load(p, __ATOMIC_RELAXED, __HIP_MEMORY_SCOPE_AGENT); }
__device__ __forceinline__ unsigned xb_add(unsigned* p, unsigned v) { return __hip_atomic_fetch_add(p, v, __ATOMIC_RELAXED, __HIP_MEMORY_SCOPE_AGENT); }
__device__ __forceinline__ unsigned xb_xcc_id() { return (unsigned)__builtin_amdgcn_s_getreg((3 << 11) | 20) & 0xFu; }
#define XB_SPIN(cond, bar) do { unsigned _sp = 0; while (cond) { __builtin_amdgcn_s_sleep(1); \
    if ((++_sp & 255u) == 0u) { if (xb_ld(&(bar)[XB_TMO])) break; if (_sp > XB_SPIN_CAP) { atomicAdd(&(bar)[XB_TMO], 1u); break; } } } } while (0)
struct XcdBarrier { unsigned* bar; unsigned x; volatile LAS unsigned* st; };
__device__ __forceinline__ XcdBarrier xcd_barrier_post(unsigned* bar, volatile LAS unsigned* st) {
    XcdBarrier b; b.bar = bar; b.x = xb_xcc_id(); b.st = st;
    if (threadIdx.x == 0) (void)xb_add(&bar[XB_XCNT(b.x)], 1u);
    return b;
}
__device__ __forceinline__ void xcd_barrier_complete(unsigned* bar, unsigned x, unsigned& nloc, unsigned& nx) {
    const unsigned G = gridDim.x * gridDim.y * gridDim.z;
    unsigned sum, cnt, mine, sp = 0u;
    for (;;) {
        sum = 0u; cnt = 0u; mine = 0u;
#pragma unroll
        for (unsigned j = 0; j < 16; ++j) { const unsigned c = xb_ld(&bar[XB_XCNT(j)]); sum += c; cnt += (c > 0u) ? 1u : 0u; mine = (j == x) ? c : mine; }
        if (sum == G) break;
        __builtin_amdgcn_s_sleep(1);
        if ((++sp & 255u) == 0u) { if (xb_ld(&bar[XB_TMO])) break; if (sp > XB_SPIN_CAP) { atomicAdd(&bar[XB_TMO], 1u); break; } }
    }
    nloc = mine > 0u ? mine : 1u; nx = cnt > 0u ? cnt : 1u;
}
__device__ __forceinline__ void xcd_barrier(const XcdBarrier& b) {
    asm volatile("s_waitcnt vmcnt(0)" ::: "memory");
    __syncthreads();
    if (threadIdx.x == 0) {
        unsigned* bar = b.bar;
        __builtin_amdgcn_s_waitcnt(0);
        unsigned nloc = b.st[0], nx = b.st[1];
        if (nloc == 0u) { xcd_barrier_complete(bar, b.x, nloc, nx); b.st[0] = nloc; b.st[1] = nx; }
        const unsigned old = xb_add(&bar[XB_XSUB(b.x)], 1u);
        const unsigned gen = old / nloc;
        if (old + 1u == (gen + 1u) * nloc) {
            __builtin_amdgcn_fence(__ATOMIC_RELEASE, "agent");
            asm volatile("s_waitcnt vmcnt(0)" ::: "memory");
            const unsigned og = xb_add(&bar[XB_TOP], 1u);
            const unsigned tg = og / nx;
            if (og + 1u == (tg + 1u) * nx) xb_add(&bar[XB_TOPGEN], 1u);
            else XB_SPIN(xb_ld(&bar[XB_TOPGEN]) == tg, bar);
            __builtin_amdgcn_fence(__ATOMIC_ACQUIRE, "agent");
            xb_add(&bar[XB_XGEN(b.x)], 1u);
            asm volatile("s_waitcnt vmcnt(0)" ::: "memory");
        } else {
            XB_SPIN(xb_ld(&bar[XB_XGEN(b.x)]) == gen, bar);
            __builtin_amdgcn_fence(__ATOMIC_ACQUIRE, "agent");
            asm volatile("s_waitcnt vmcnt(0)" ::: "memory");
        }
    }
    __syncthreads();
}

__global__ void __launch_bounds__(512, 2) mega(Params p_unused) {
    extern __shared__ __attribute__((aligned(16))) unsigned char lds_raw[];
    LAS unsigned char* lds = (LAS unsigned char*)lds_raw;
    cg::grid_group grid = cg::this_grid();
    CPP p = (CPP)__builtin_amdgcn_kernarg_segment_ptr();
    unsigned char* ws = p->ws;
    bf16_t* XB = (bf16_t*)(ws + WS_XB);
    volatile LAS unsigned* bst = (volatile LAS unsigned*)(lds + LDS_BYTES - 64);
    if (threadIdx.x < 2) bst[threadIdx.x] = 0u;
    __syncthreads();
    const XcdBarrier bar = xcd_barrier_post((unsigned*)ws, bst);

    { float* rot = (float*)(ws + WS_ROT); const int gt = obid() * 512 + otid(), NT = ogrid() * 512;
        for (int e = gt; e < 2048 * 16; e += NT) { const int pos = e >> 4, f = e & 15; const float inv = 1.0f / powf(10000.0f, (float)f * (1.0f / 16.0f)); const float ang = (float)pos * inv;
            rot[pos * 32 + f] = cosf(ang); rot[pos * 32 + 16 + f] = sinf(ang); } }
    s5_tables(p, 0, lds);
    { const float* x = p->in[0]; const int gt = obid() * 512 + otid(), NT = ogrid() * 512;
        for (size_t e = gt; e < (size_t)M * DM / 8; e += NT) { const f32x4 a = *((const f32x4*)x + 2 * e), b = *((const f32x4*)x + 2 * e + 1);
            u32x4 w; w.x = pk2(a[0], a[1]); w.y = pk2(a[2], a[3]); w.z = pk2(b[0], b[1]); w.w = pk2(b[2], b[3]); *((u32x4*)XB + e) = w; } }
    grid.sync();
    convert_weights(p, 0, lds);
    xcd_barrier(bar);

    for (int l = 0; l < 4; ++l) {
        for (int s = 0; s < 12; ++s) {
            p = (CPP)__builtin_amdgcn_kernarg_segment_ptr(); asm volatile("" : "+s"(p));
            pg8::Gemm g; pg8::Sched S; pg8::Epi E;
            bool do_gemm = true;
            S.G = ogrid(); S.c = obid(); S.mode = 0; S.nM = M / 256; S.nN = 1;
            E.mode = 0; E.perm = true;
            E.ws = ws; E.dskip = p->in[12] + l * 256; E.bglu = p->in[14] + l * 256; E.bgate = p->in[16] + (size_t)l * 4096;
            g.A = XB; g.Bt = (const bf16_t*)(ws + WS_WIN); g.lda = DM; g.ldb = DM; g.K = DM;
            switch (s) {
                case 0: S.nN = NINP / 256; E.mode = 0; E.perm = true; break;
                case 1: g.A = (const bf16_t*)(ws + WS_U2); g.Bt = (const bf16_t*)(ws + WS_WE); g.lda = S5K; g.ldb = 1024; g.K = 1024; S.mode = 2; S.nM = 64; S.nN = 1; E.mode = 1; break;
                case 3: g.A = (const bf16_t*)(ws + WS_U2); g.Bt = (const bf16_t*)(ws + WS_WT); g.lda = S5K; g.ldb = S5K; g.K = S5K; S.mode = 3; S.nM = 64; S.nN = 4; E.mode = 2; break;
                case 4: g.A = (const bf16_t*)(ws + WS_YS); g.Bt = (const bf16_t*)(ws + WS_WGLU); g.lda = 256; g.ldb = 256; g.K = 256; S.nN = 1; E.mode = 3; break;
                case 5: g.A = (const bf16_t*)(ws + WS_O); g.Bt = (const bf16_t*)(ws + WS_WB); g.lda = DM; g.ldb = 256; g.K = 256; S.mode = 1; S.nN = 16; E.mode = 4; break;
                case 6: g.Bt = (const bf16_t*)(ws + WS_WG); S.nN = 16; E.mode = 5; E.perm = false; break;
                case 7: g.A = (const bf16_t*)(ws + WS_O); g.Bt = (const bf16_t*)(ws + WS_WO); S.nN = 4; E.mode = 6; E.perm = true; break;
                case 9: g.Bt = (const bf16_t*)(ws + WS_WFF); S.nN = 22; E.mode = 7; E.perm = true; break;
                case 10: g.A = (const bf16_t*)(ws + WS_E); g.Bt = (const bf16_t*)(ws + WS_WD); g.lda = DFF; g.ldb = DFF; g.K = DFF; S.nN = 4; E.mode = 6; E.perm = true; break;
                default: do_gemm = false; break;
            }
            S.nwg = S.nM * S.nN;
            if (do_gemm) pg8::gemm_phase(lds, g, S, E);
            if (s == 1) { attn_mfma(p, l, lds); upd_mfma(p, l, lds); }
            else if (s == 2) scan_items(p, l);
            else if (s == 3) out_mfma(p, l, lds);
            else if (s == 8) { ln_pass(XB, nullptr, p->in[19] + l * DM, p->in[20] + l * DM); if (l < 3) s5_tables(p, l + 1, lds); }
            else if (s == 11) { ln_pass(XB, (l == 3) ? p->out : nullptr, p->in[24] + l * DM, p->in[25] + l * DM); if (l < 3) convert_weights(p, l + 1, lds); }
            xcd_barrier(bar);
        }
    }
}

extern "C" void kernel_launch(void* const* d_in, const int* in_sizes, int n_in, void* d_out, int out_size, void* d_ws, size_t ws_size, hipStream_t stream) {
    static int grid_blocks = 0;
    if (!grid_blocks) {
        int dev = 0, cus = 0;
        hipGetDevice(&dev);
        hipDeviceGetAttribute(&cus, hipDeviceAttributeMultiprocessorCount, dev);
        hipFuncSetAttribute((const void*)mega, hipFuncAttributeMaxDynamicSharedMemorySize, LDS_BYTES);
        grid_blocks = cus > 0 ? cus : 256;
    }
    (void)hipMemsetAsync(d_ws, 0, 65536, stream);
    Params p{};
    for (int i = 0; i < 26; ++i) p.in[i] = (const float*)d_in[i];
    p.out = (float*)d_out; p.ws = (unsigned char*)d_ws;
    void* args[] = {&p};
    hipError_t e = hipLaunchCooperativeKernel((const void*)mega, dim3(grid_blocks), dim3(512), args, LDS_BYTES, stream);
    if (e != hipSuccess) fprintf(stderr, "cooperative launch failed: %s (grid %d)\n", hipGetErrorString(e), grid_blocks);
}
```
